# Optimizing an MI355X kernel written in HIP

```python
import math
import jax
import jax.numpy as jnp
from jax import lax
import numpy as np

D_MODEL = 1024
BATCH = 4
SEQ = 4096
DEPTH = 2

HEAD_DIM = 64
GROUP_HEADS = 4
GROUP_WIDTH = GROUP_HEADS * HEAD_DIM
N_MIXERS = 4
MIX_WIDTH = N_MIXERS * GROUP_WIDTH
DIFF_HALF = HEAD_DIM // 2
MLSTM_CHUNK = 64
MLSTM_CONV = 4
HGRN_KEY = 64
HGRN_CHUNK = 16
NSA_KV_DIM = HEAD_DIM
CMP_LEN = 32
CMP_STRIDE = 16
SEL_BLOCK = 64
SEL_TOPK = 16
WINDOW = 512
Q_BLOCK = 128
N_GROUPS = 4
EXPERTS_PER_GROUP = 8
TOPK_IN_GROUP = 2
D_EXPERT = 256
EPS = 1e-6
NEG_INF = -1e30
LB_FLOOR = 1e-30
F32 = jnp.float32

IN_WIDTHS = (
    GROUP_WIDTH, GROUP_WIDTH, GROUP_WIDTH,
    GROUP_WIDTH, GROUP_WIDTH, GROUP_WIDTH, GROUP_HEADS, GROUP_HEADS, GROUP_WIDTH,
    GROUP_HEADS * HGRN_KEY, GROUP_HEADS * HGRN_KEY, GROUP_WIDTH, GROUP_WIDTH,
    GROUP_WIDTH, 6 * NSA_KV_DIM, 3 * GROUP_HEADS,
)
IN_COLS = sum(IN_WIDTHS)

kernel_name = "hymba_style_diffattn_mlstm_hgrn2_nsa_hmoe"


def rms_norm(x, gain):
    xf = x.astype(F32)
    y = xf * lax.rsqrt(jnp.mean(xf * xf, axis=-1, keepdims=True) + EPS)
    return (y * gain.astype(F32)).astype(x.dtype)


def alibi_slopes():
    n = 2 * GROUP_HEADS
    s = 2.0 ** (-8.0 * np.arange(1, n + 1) / n)
    return jnp.asarray(s[0::2], F32), jnp.asarray(s[1::2], F32)


def causal_depthwise_conv(x, w):
    k_len, ch = w.shape
    xp = jnp.pad(x, ((0, 0), (k_len - 1, 0), (0, 0)))
    return lax.conv_general_dilated(xp, w[:, None, :].astype(x.dtype), (1,), 'VALID',
                                    dimension_numbers=('NWC', 'WIO', 'NWC'), feature_group_count=ch)


def diff_attention(q_in, k_in, v_in, q_gain, k_gain, lam_vecs, sub_gain, slopes, layer_idx):
    B, S, _ = q_in.shape
    H = GROUP_HEADS
    q = rms_norm(q_in.reshape(B, S, H, 2, DIFF_HALF), q_gain) * (DIFF_HALF ** -0.5)
    k = rms_norm(k_in.reshape(B, S, H, 2, DIFF_HALF), k_gain)
    v = v_in.reshape(B, S, H, HEAD_DIM)
    lam_init = 0.8 - 0.6 * math.exp(-0.3 * layer_idx)
    lv = lam_vecs.astype(F32)
    lam = jnp.exp(jnp.dot(lv[0], lv[1])) - jnp.exp(jnp.dot(lv[2], lv[3])) + lam_init
    nb = S // Q_BLOCK
    q_blocks = q.reshape(B, nb, Q_BLOCK, H, 2, DIFF_HALF).swapaxes(0, 1)
    k_pos = jnp.arange(S)

    def attend_block(args):
        q_blk, bi = args
        q_pos = bi * Q_BLOCK + jnp.arange(Q_BLOCK)
        dist = q_pos[:, None] - k_pos[None, :]
        s = jnp.einsum('bqhcd,bkhcd->bhcqk', q_blk, k).astype(F32)
        s = s - slopes[None, :, None, None, None] * dist.astype(F32)
        s = jnp.where(dist >= 0, s, NEG_INF)
        p = jax.nn.softmax(s, axis=-1)
        a = p[:, :, 0] - lam * p[:, :, 1]
        return jnp.einsum('bhqk,bkhd->bqhd', a.astype(v.dtype), v)

    o = lax.map(attend_block, (q_blocks, jnp.arange(nb)))
    o = o.swapaxes(0, 1).reshape(B, S, H, HEAD_DIM)
    o = rms_norm(o, sub_gain) * (1.0 - lam_init)
    return o.reshape(B, S, GROUP_WIDTH)


def mlstm(q_in, k_in, v_in, i_pre, f_pre, o_pre, out_gain):
    B, S, _ = q_in.shape
    H, d, L = GROUP_HEADS, HEAD_DIM, MLSTM_CHUNK
    nc = S // L

    def to_chunks(t, width):
        return t.astype(F32).reshape(B, nc, L, H, width).transpose(1, 0, 3, 2, 4)

    q = to_chunks(q_in, d) * (d ** -0.5)
    k = to_chunks(k_in, d)
    v = to_chunks(v_in, d)
    log_f = to_chunks(jax.nn.log_sigmoid(f_pre.astype(F32))[..., None], 1)[..., 0]
    log_i = to_chunks(i_pre[..., None], 1)[..., 0]
    causal = jnp.tril(jnp.ones((L, L), dtype=bool))

    def chunk_step(carry, inp):
        C, n, m = carry
        q_c, k_c, v_c, lf, li = inp
        g = jnp.cumsum(lf, axis=-1)
        g_last = g[..., -1]
        log_d = jnp.where(causal, g[..., :, None] - g[..., None, :] + li[..., None, :], NEG_INF)
        log_inter = g + m[..., None]
        m_t = jnp.maximum(log_inter, jnp.max(log_d, axis=-1))
        w_intra = jnp.einsum('bhtd,bhsd->bhts', q_c, k_c) * jnp.exp(log_d - m_t[..., None])
        w_inter = jnp.exp(log_inter - m_t)
        num = (w_inter[..., None] * jnp.einsum('bhtd,bhde->bhte', q_c, C)
               + jnp.einsum('bhts,bhse->bhte', w_intra, v_c))
        den = w_inter * jnp.einsum('bhtd,bhd->bht', q_c, n) + jnp.sum(w_intra, axis=-1)
        h = num / jnp.maximum(jnp.abs(den), jnp.exp(-m_t))[..., None]
        log_a = g_last[..., None] - g + li
        m_new = jnp.maximum(g_last + m, jnp.max(log_a, axis=-1))
        a = jnp.exp(log_a - m_new[..., None])
        decay = jnp.exp(g_last + m - m_new)
        C_new = decay[..., None, None] * C + jnp.einsum('bhs,bhsd,bhse->bhde', a, k_c, v_c)
        n_new = decay[..., None] * n + jnp.einsum('bhs,bhsd->bhd', a, k_c)
        return (C_new, n_new, m_new), h

    init = (jnp.zeros((B, H, d, d), F32), jnp.zeros((B, H, d), F32), jnp.zeros((B, H), F32))
    _, h = lax.scan(chunk_step, init, (q, k, v, log_f, log_i))
    h = h.transpose(1, 0, 3, 2, 4).reshape(B, S, H, d)
    h = rms_norm(h, out_gain) * jax.nn.sigmoid(o_pre.astype(F32)).reshape(B, S, H, d)
    return h.reshape(B, S, GROUP_WIDTH)


def hgrn2(q_in, f_in, i_in, g_in, lower_bound, out_gain):
    B, S, _ = q_in.shape
    H, dk, dv, L = GROUP_HEADS, HGRN_KEY, HEAD_DIM, HGRN_CHUNK
    nc = S // L
    lb = lower_bound.astype(F32)
    log_f = jnp.logaddexp(jnp.log(jnp.maximum(lb, LB_FLOOR)),
                          jnp.log1p(-lb) + jax.nn.log_sigmoid(f_in.astype(F32)))
    k = -jnp.expm1(log_f)
    q = jax.nn.silu(q_in.astype(F32))

    def to_chunks(t, width):
        return t.astype(F32).reshape(B, nc, L, H, width).transpose(1, 0, 3, 2, 4)

    causal = jnp.tril(jnp.ones((L, L), dtype=bool))

    def chunk_step(state, inp):
        q_c, k_c, v_c, lf = inp
        b = jnp.cumsum(lf, axis=2)
        b_last = b[:, :, -1]
        inter = jnp.einsum('bhtk,bhkv->bhtv', q_c * jnp.exp(b), state)
        rel = jnp.where(causal[:, :, None], b[:, :, :, None, :] - b[:, :, None, :, :], NEG_INF)
        attn = jnp.einsum('bhtk,bhsk,bhtsk->bhts', q_c, k_c, jnp.exp(rel))
        o = inter + jnp.einsum('bhts,bhsv->bhtv', attn, v_c)
        state = (jnp.exp(b_last)[..., None] * state
                 + jnp.einsum('bhsk,bhsv->bhkv', k_c * jnp.exp(b_last[:, :, None] - b), v_c))
        return state, o

    init = jnp.zeros((B, H, dk, dv), F32)
    _, o = lax.scan(chunk_step, init,
                    (to_chunks(q, dk), to_chunks(k, dk), to_chunks(i_in, dv), to_chunks(log_f, dk)))
    o = o.transpose(1, 0, 3, 2, 4).reshape(B, S, H, dv)
    o = rms_norm(o, out_gain) * jax.nn.sigmoid(g_in.astype(F32)).reshape(B, S, H, dv)
    return o.reshape(B, S, GROUP_WIDTH)


def nsa(q_in, kv_in, gate_in, cmp_pos, cmp_w1, cmp_w2, q_gain, k_gain, out_gain, slopes):
    B, S, _ = q_in.shape
    H, d = GROUP_HEADS, HEAD_DIM
    k_c, v_c, k_s, v_s, k_w, v_w = jnp.split(kv_in, 6, axis=-1)
    q = rms_norm(q_in.reshape(B, S, H, d), q_gain) * (d ** -0.5)
    t_pos = jnp.arange(S)

    n_cmp = (S - CMP_LEN) // CMP_STRIDE + 1
    cmp_start = jnp.arange(n_cmp) * CMP_STRIDE
    cmp_idx = cmp_start[:, None] + jnp.arange(CMP_LEN)[None, :]

    def compress(t, j):
        blocks = t[:, cmp_idx] + cmp_pos[j]
        hdn = jax.nn.gelu(blocks.reshape(B, n_cmp, CMP_LEN * d) @ cmp_w1[j])
        return hdn @ cmp_w2[j]

    k_cmp = rms_norm(compress(k_c, 0), k_gain[0])
    v_cmp = compress(v_c, 1)
    dist_c = t_pos[:, None] - (cmp_start + CMP_LEN - 1)[None, :]
    s_c = (jnp.einsum('bshd,bnd->bhsn', q, k_cmp).astype(F32)
           - slopes[None, :, None, None] * dist_c.astype(F32))
    valid_c = dist_c >= 0
    p_c = jnp.where(valid_c, jax.nn.softmax(jnp.where(valid_c, s_c, NEG_INF), axis=-1), 0.0)
    o_cmp = jnp.einsum('bhsn,bnd->bshd', p_c.astype(v_cmp.dtype), v_cmp)

    n_sel = S // SEL_BLOCK
    n_top = min(SEL_TOPK, n_sel)
    sel_start = jnp.arange(n_sel) * SEL_BLOCK
    overlap = jnp.clip(jnp.minimum(cmp_start[:, None] + CMP_LEN, sel_start[None, :] + SEL_BLOCK)
                       - jnp.maximum(cmp_start[:, None], sel_start[None, :]), 0) / CMP_LEN
    importance = jnp.einsum('bhsn,nj->bsj', p_c, overlap.astype(F32))
    q_blk = t_pos // SEL_BLOCK
    blk = jnp.arange(n_sel)
    importance = jnp.where(blk[None, :] <= q_blk[:, None], importance, -1.0)
    forced = ((blk[None, :] == 0) | (blk[None, :] == q_blk[:, None])
              | (blk[None, :] == q_blk[:, None] - 1))
    importance = jnp.where(forced, 2.0, importance)
    _, sel_idx = lax.top_k(importance, n_top)

    k_sel_blocks = rms_norm(k_s, k_gain[1]).reshape(B, n_sel, SEL_BLOCK, d)
    v_sel_blocks = v_s.reshape(B, n_sel, SEL_BLOCK, d)
    nqb = S // Q_BLOCK
    q_blocks = q.reshape(B, nqb, Q_BLOCK, H, d).swapaxes(0, 1)
    idx_blocks = sel_idx.reshape(B, nqb, Q_BLOCK, n_top).swapaxes(0, 1)
    gather = jax.vmap(lambda blocks, ids: blocks[ids])

    def select_block(args):
        q_b, ids, bi = args
        kg = gather(k_sel_blocks, ids)
        vg = gather(v_sel_blocks, ids)
        q_pos = bi * Q_BLOCK + jnp.arange(Q_BLOCK)
        k_pos = ids[..., None] * SEL_BLOCK + jnp.arange(SEL_BLOCK)
        dist = (q_pos[None, :, None, None] - k_pos)[:, None]
        s = (jnp.einsum('bqhd,bqnld->bhqnl', q_b, kg).astype(F32)
             - slopes[None, :, None, None, None] * dist.astype(F32))
        s = jnp.where(dist >= 0, s, NEG_INF).reshape(B, H, Q_BLOCK, n_top * SEL_BLOCK)
        p = jax.nn.softmax(s, axis=-1).reshape(B, H, Q_BLOCK, n_top, SEL_BLOCK)
        return jnp.einsum('bhqnl,bqnld->bqhd', p.astype(vg.dtype), vg)

    o_sel = lax.map(select_block, (q_blocks, idx_blocks, jnp.arange(nqb)))
    o_sel = o_sel.swapaxes(0, 1).reshape(B, S, H, d)

    n_back = WINDOW // Q_BLOCK
    k_win = rms_norm(k_w, k_gain[2]).reshape(B, nqb, Q_BLOCK, d)
    v_win = v_w.reshape(B, nqb, Q_BLOCK, d)

    def band(t):
        tp = jnp.pad(t, ((0, 0), (n_back, 0), (0, 0), (0, 0)))
        return jnp.concatenate([tp[:, j:j + nqb] for j in range(n_back + 1)], axis=2)

    k_band, v_band = band(k_win), band(v_win)
    q_pos = jnp.arange(nqb)[:, None] * Q_BLOCK + jnp.arange(Q_BLOCK)[None, :]
    k_pos = (jnp.arange(nqb)[:, None] - n_back) * Q_BLOCK + jnp.arange((n_back + 1) * Q_BLOCK)[None, :]
    dist = q_pos[:, :, None] - k_pos[:, None, :]
    in_win = (dist >= 0) & (dist < WINDOW) & (k_pos[:, None, :] >= 0)
    s_w = jnp.einsum('bnqhd,bnkd->bnhqk', q.reshape(B, nqb, Q_BLOCK, H, d), k_band).astype(F32)
    s_w = s_w - slopes[None, None, :, None, None] * dist[None, :, None].astype(F32)
    s_w = jnp.where(in_win[None, :, None], s_w, NEG_INF)
    p_w = jax.nn.softmax(s_w, axis=-1)
    o_win = jnp.einsum('bnhqk,bnkd->bnqhd', p_w.astype(v_band.dtype), v_band).reshape(B, S, H, d)

    gates = jax.nn.sigmoid(gate_in.astype(F32)).reshape(B, S, H, 3)
    o = gates[..., 0:1] * o_cmp + gates[..., 1:2] * o_sel + gates[..., 2:3] * o_win
    o = rms_norm(o, out_gain)
    return o.reshape(B, S, GROUP_WIDTH)


def hier_moe(h, w_group, b_group, w_expert, b_expert, w_gate, w_up, w_down):
    B, S, D = h.shape
    t = h.reshape(B * S, D)
    p_group = jax.nn.softmax((t @ w_group).astype(F32) + b_group, axis=-1)
    g_sel = jnp.argmax(p_group, axis=-1)
    g_prob = jnp.max(p_group, axis=-1)
    logits_e = ((t @ w_expert).astype(F32) + b_expert).reshape(-1, N_GROUPS, EXPERTS_PER_GROUP)
    logits_e = jnp.take_along_axis(logits_e, g_sel[:, None, None], axis=1)[:, 0]
    top_p, top_i = lax.top_k(jax.nn.softmax(logits_e, axis=-1), TOPK_IN_GROUP)
    top_w = g_prob[:, None] * top_p / jnp.sum(top_p, axis=-1, keepdims=True)
    w_e = jnp.sum(jax.nn.one_hot(top_i, EXPERTS_PER_GROUP, dtype=F32) * top_w[..., None], axis=1)
    gate = jax.nn.one_hot(g_sel, N_GROUPS, dtype=F32)[:, :, None] * w_e[:, None, :]
    out = jnp.zeros_like(t)
    for g in range(N_GROUPS):
        a = jnp.einsum('td,edf->tef', t, w_gate[g])
        u = jnp.einsum('td,edf->tef', t, w_up[g])
        act = jax.nn.silu(a) * u * gate[:, g, :, None].astype(t.dtype)
        out = out + jnp.einsum('tef,efd->td', act, w_down[g])
    return out.reshape(B, S, D)


def setup_inputs(seed: int = 0) -> dict:
    key = jax.random.key(seed)
    keys = iter(jax.random.split(key, 40))

    def nrm(shape, scale):
        return jax.random.normal(next(keys), shape, F32) * scale

    L = DEPTH
    n_exp = N_GROUPS * EXPERTS_PER_GROUP
    f_bias = jnp.linspace(3.0, 6.0, GROUP_HEADS, dtype=F32)
    return {
        'x': nrm((BATCH, SEQ, D_MODEL), 1.0),
        'norm_mix': 1.0 + nrm((L, D_MODEL), 0.02),
        'norm_ffn': 1.0 + nrm((L, D_MODEL), 0.02),
        'w_in': nrm((L, D_MODEL, IN_COLS), D_MODEL ** -0.5),
        'w_out': nrm((L, MIX_WIDTH, D_MODEL), MIX_WIDTH ** -0.5),
        'diff_q_gain': 1.0 + nrm((L, DIFF_HALF), 0.02),
        'diff_k_gain': 1.0 + nrm((L, DIFF_HALF), 0.02),
        'diff_lambda': nrm((L, 4, DIFF_HALF), 0.1),
        'diff_sub_gain': 1.0 + nrm((L, GROUP_HEADS, HEAD_DIM), 0.02),
        'mlstm_conv': nrm((L, MLSTM_CONV, 2 * GROUP_WIDTH), MLSTM_CONV ** -0.5),
        'mlstm_gate_bias': jnp.stack([nrm((L, GROUP_HEADS), 0.1),
                                      f_bias + nrm((L, GROUP_HEADS), 0.1)], axis=1),
        'mlstm_out_gain': 1.0 + nrm((L, GROUP_HEADS, HEAD_DIM), 0.02),
        'hgrn_lower_bounds': nrm((L, GROUP_HEADS * HGRN_KEY), 0.5),
        'hgrn_out_gain': 1.0 + nrm((L, GROUP_HEADS, HEAD_DIM), 0.02),
        'nsa_cmp_pos': nrm((L, 2, CMP_LEN, HEAD_DIM), 0.1),
        'nsa_cmp_w1': nrm((L, 2, CMP_LEN * HEAD_DIM, HEAD_DIM), (CMP_LEN * HEAD_DIM) ** -0.5),
        'nsa_cmp_w2': nrm((L, 2, HEAD_DIM, HEAD_DIM), HEAD_DIM ** -0.5),
        'nsa_q_gain': 1.0 + nrm((L, HEAD_DIM), 0.02),
        'nsa_k_gain': 1.0 + nrm((L, 3, HEAD_DIM), 0.02),
        'nsa_out_gain': 1.0 + nrm((L, GROUP_HEADS, HEAD_DIM), 0.02),
        'moe_w_group': nrm((L, D_MODEL, N_GROUPS), D_MODEL ** -0.5),
        'moe_b_group': nrm((L, N_GROUPS), 0.01),
        'moe_w_expert': nrm((L, D_MODEL, n_exp), D_MODEL ** -0.5),
        'moe_b_expert': nrm((L, n_exp), 0.01),
        'moe_w_gate': nrm((L, N_GROUPS, EXPERTS_PER_GROUP, D_MODEL, D_EXPERT), D_MODEL ** -0.5),
        'moe_w_up': nrm((L, N_GROUPS, EXPERTS_PER_GROUP, D_MODEL, D_EXPERT), D_MODEL ** -0.5),
        'moe_w_down': nrm((L, N_GROUPS, EXPERTS_PER_GROUP, D_EXPERT, D_MODEL), D_EXPERT ** -0.5),
    }


def reference(x, norm_mix, norm_ffn, w_in, w_out, diff_q_gain, diff_k_gain, diff_lambda, diff_sub_gain,
              mlstm_conv, mlstm_gate_bias, mlstm_out_gain, hgrn_lower_bounds, hgrn_out_gain,
              nsa_cmp_pos, nsa_cmp_w1, nsa_cmp_w2, nsa_q_gain, nsa_k_gain, nsa_out_gain,
              moe_w_group, moe_b_group, moe_w_expert, moe_b_expert, moe_w_gate, moe_w_up, moe_w_down):
    slopes_diff, slopes_nsa = alibi_slopes()
    lb_soft = jax.nn.softmax(hgrn_lower_bounds.astype(F32), axis=0)
    lower_bounds = jnp.cumsum(lb_soft, axis=0) - lb_soft[0]
    split_at = [int(v) for v in np.cumsum(IN_WIDTHS)[:-1]]
    for l in range(DEPTH):
        h = rms_norm(x, norm_mix[l])
        (a_q, a_k, a_v, b_q, b_k, b_v, b_i, b_f, b_o,
         c_q, c_f, c_i, c_g, d_q, d_kv, d_g) = jnp.split(h @ w_in[l], split_at, axis=-1)
        y_a = diff_attention(a_q, a_k, a_v, diff_q_gain[l], diff_k_gain[l], diff_lambda[l],
                             diff_sub_gain[l], slopes_diff, l)
        qk = jax.nn.silu(causal_depthwise_conv(jnp.concatenate([b_q, b_k], axis=-1), mlstm_conv[l]))
        y_b = mlstm(qk[..., :GROUP_WIDTH], qk[..., GROUP_WIDTH:], b_v,
                    b_i + mlstm_gate_bias[l, 0], b_f + mlstm_gate_bias[l, 1], b_o, mlstm_out_gain[l])
        y_c = hgrn2(c_q, c_f, c_i, c_g, lower_bounds[l], hgrn_out_gain[l])
        y_d = nsa(d_q, d_kv, d_g, nsa_cmp_pos[l], nsa_cmp_w1[l], nsa_cmp_w2[l], nsa_q_gain[l],
                  nsa_k_gain[l], nsa_out_gain[l], slopes_nsa)
        mixed = jnp.concatenate([y_a.astype(x.dtype), y_b.astype(x.dtype),
                                 y_c.astype(x.dtype), y_d.astype(x.dtype)], axis=-1)
        x = x + mixed @ w_out[l]
        x = x + hier_moe(rms_norm(x, norm_ffn[l]), moe_w_group[l], moe_b_group[l], moe_w_expert[l],
                         moe_b_expert[l], moe_w_gate[l], moe_w_up[l], moe_w_down[l])
    return x
```

```cpp
#include <hip/hip_runtime.h>
#include <stdint.h>

namespace {
constexpr int DM = 1024, NB = 4, SEQ = 4096, DEPTH = 2, MT = NB * SEQ;
constexpr int IN_COLS = 3476, LDP = 3584;
constexpr float EPS = 1e-6f, NEG = -1e30f;
constexpr int PC_AQ = 0, PC_AK = 256, PC_AV = 512, PC_BQ = 768, PC_BK = 1024, PC_BV = 1280, PC_BO = 1536, PC_CQ = 1792, PC_CF = 2048,
              PC_CI = 2304, PC_CG = 2560, PC_DQ = 2816, PC_KC = 3072, PC_VC = 3136, PC_KS = 3200, PC_VS = 3264, PC_KW = 3328, PC_VW = 3392,
              PC_BI = 3456, PC_BF = 3460, PC_DG = 3464;
constexpr int NCMP = 255;

typedef unsigned short bf16_t;
__device__ __forceinline__ float bf2f(bf16_t v) { return __uint_as_float(((unsigned)v) << 16); }
__device__ __forceinline__ bf16_t f2bf(float f) { unsigned u = __float_as_uint(f); return (bf16_t)((u + 0x7fffu + ((u >> 16) & 1u)) >> 16); }
__device__ __forceinline__ int src_col(int c) { return c < 1536 ? c : (c < 3456 ? c + 8 : (c < 3460 ? c - 3456 + 1536 : (c < 3464 ? c - 3460 + 1540 : c))); }
__device__ __forceinline__ float sigmoidf_(float x) { return 1.f / (1.f + __expf(-x)); }
__device__ __forceinline__ float siluf_(float x) { return x / (1.f + __expf(-x)); }
__device__ __forceinline__ float wave_sum(float v) {
#pragma unroll
    for (int o = 1; o < 64; o <<= 1) v += __shfl_xor(v, o);
    return v;
}
__device__ __forceinline__ float rdlane(float v, int k) { return __int_as_float(__builtin_amdgcn_readlane(__float_as_int(v), k)); }

__global__ void __launch_bounds__(256) k_norm_rows(const float* __restrict__ x, const float* __restrict__ gain, bf16_t* __restrict__ t) {
    const int row = blockIdx.x * 4 + (threadIdx.x >> 6), lane = threadIdx.x & 63;
    const float4* xr = (const float4*)(x + (size_t)row * DM);
    float4 v[4]; float s = 0.f;
#pragma unroll
    for (int j = 0; j < 4; ++j) { v[j] = xr[lane + 64 * j]; s += v[j].x * v[j].x + v[j].y * v[j].y + v[j].z * v[j].z + v[j].w * v[j].w; }
    const float r = rsqrtf(wave_sum(s) * (1.f / DM) + EPS);
#pragma unroll
    for (int j = 0; j < 4; ++j) {
        const float4 g = ((const float4*)gain)[lane + 64 * j];
        ushort4 o; o.x = f2bf(v[j].x * r * g.x); o.y = f2bf(v[j].y * r * g.y); o.z = f2bf(v[j].z * r * g.z); o.w = f2bf(v[j].w * r * g.w);
        ((ushort4*)(t + (size_t)row * DM))[lane + 64 * j] = o;
    }
}

template <int MODE>
__global__ void __launch_bounds__(256) k_gemm_naive(const bf16_t* __restrict__ A, const float* __restrict__ W, int ldw, int K,
                                                     bf16_t* __restrict__ P, const float* xin, float* xout) {
    __shared__ float As[16][65];
    __shared__ float Ws[16][64];
    const int tid = threadIdx.x, tx = tid & 15, ty = tid >> 4;
    const int m0 = blockIdx.y * 64, n0 = blockIdx.x * 64;
    float acc[4][4];
#pragma unroll
    for (int i = 0; i < 4; ++i)
#pragma unroll
        for (int j = 0; j < 4; ++j) acc[i][j] = 0.f;
    const int ar = tid >> 2, ak = (tid & 3) * 4;
    const int wk = tid >> 4, wn = (tid & 15) * 4;
    for (int k0 = 0; k0 < K; k0 += 16) {
        const ushort4 a4 = *(const ushort4*)(A + (size_t)(m0 + ar) * K + k0 + ak);
        As[ak + 0][ar] = bf2f(a4.x); As[ak + 1][ar] = bf2f(a4.y); As[ak + 2][ar] = bf2f(a4.z); As[ak + 3][ar] = bf2f(a4.w);
#pragma unroll
        for (int j = 0; j < 4; ++j) {
            const int n = n0 + wn + j; float w = 0.f;
            if (MODE == 0) { if (n < IN_COLS) w = W[(size_t)(k0 + wk) * ldw + src_col(n)]; }
            else w = W[(size_t)(k0 + wk) * ldw + n];
            Ws[wk][wn + j] = w;
        }
        __syncthreads();
#pragma unroll
        for (int kk = 0; kk < 16; ++kk) {
            float a[4], b[4];
#pragma unroll
            for (int i = 0; i < 4; ++i) a[i] = As[kk][ty * 4 + i];
#pragma unroll
            for (int j = 0; j < 4; ++j) b[j] = Ws[kk][tx * 4 + j];
#pragma unroll
            for (int i = 0; i < 4; ++i)
#pragma unroll
                for (int j = 0; j < 4; ++j) acc[i][j] += a[i] * b[j];
        }
        __syncthreads();
    }
#pragma unroll
    for (int i = 0; i < 4; ++i) {
        const int m = m0 + ty * 4 + i;
#pragma unroll
        for (int j = 0; j < 4; ++j) {
            const int n = n0 + tx * 4 + j;
            if (MODE == 0) P[(size_t)m * LDP + n] = f2bf(acc[i][j]);
            else xout[(size_t)m * DM + n] = xin[(size_t)m * DM + n] + acc[i][j];
        }
    }
}

template <int G>
__global__ void __launch_bounds__(256) k_group_norm(const bf16_t* __restrict__ P, int col0, int ngroups, const float* __restrict__ gain, float scale,
                                                     float* __restrict__ out, int ldo) {
    const int idx = blockIdx.x * 256 + threadIdx.x;
    if (idx >= MT * ngroups) return;
    const int m = idx / ngroups, g = idx % ngroups;
    const bf16_t* p = P + (size_t)m * LDP + col0 + g * G;
    float v[G]; float s = 0.f;
#pragma unroll
    for (int d = 0; d < G; ++d) { v[d] = bf2f(p[d]); s += v[d] * v[d]; }
    const float r = rsqrtf(s * (1.f / G) + EPS) * scale;
#pragma unroll
    for (int d = 0; d < G; ++d) out[(size_t)m * ldo + g * G + d] = v[d] * r * gain[d];
}

__global__ void __launch_bounds__(64) k_diff_attn(const float* __restrict__ qn, const float* __restrict__ kn, const bf16_t* __restrict__ P, float* __restrict__ O) {
    const int tb = blockIdx.x & 63, c = (blockIdx.x >> 6) & 1, h = (blockIdx.x >> 7) & 3, b = blockIdx.x >> 9;
    const int t = tb * 64 + threadIdx.x;
    const float slope = exp2f(-(float)(2 * h + 1));
    float q[32], o[64];
#pragma unroll
    for (int d = 0; d < 32; ++d) q[d] = qn[(size_t)(b * SEQ + t) * 256 + h * 64 + c * 32 + d];
#pragma unroll
    for (int e = 0; e < 64; ++e) o[e] = 0.f;
    float mrun = NEG, l = 0.f;
    const int jmax = tb * 64 + 63;
    for (int j = 0; j <= jmax; ++j) {
        const float* kr = kn + (size_t)(b * SEQ + j) * 256 + h * 64 + c * 32;
        float s = 0.f;
#pragma unroll
        for (int d = 0; d < 32; ++d) s += q[d] * kr[d];
        s -= slope * (float)(t - j);
        if (j > t) s = NEG;
        const float mn = fmaxf(mrun, s), al = __expf(mrun - mn), p = (j > t) ? 0.f : __expf(s - mn);
        l = l * al + p; mrun = mn;
        const bf16_t* vr = P + (size_t)(b * SEQ + j) * LDP + PC_AV + h * 64;
#pragma unroll
        for (int e = 0; e < 64; ++e) o[e] = o[e] * al + p * bf2f(vr[e]);
    }
    const float il = 1.f / l;
    float* op = O + ((size_t)(b * SEQ + t) * 8 + h * 2 + c) * 64;
#pragma unroll
    for (int e = 0; e < 64; ++e) op[e] = o[e] * il;
}
__global__ void __launch_bounds__(256) k_diff_combine(const float* __restrict__ O, const float* __restrict__ lamv, const float* __restrict__ subg, float lam_init,
                                                       bf16_t* __restrict__ mixed) {
    const int idx = blockIdx.x * 256 + threadIdx.x;
    const int m = idx >> 2, h = idx & 3;
    float d01 = 0.f, d23 = 0.f;
    for (int i = 0; i < 32; ++i) { d01 += lamv[i] * lamv[32 + i]; d23 += lamv[64 + i] * lamv[96 + i]; }
    const float lam = __expf(d01) - __expf(d23) + lam_init;
    const float* o0 = O + ((size_t)m * 8 + h * 2) * 64; const float* o1 = o0 + 64;
    float v[64]; float s = 0.f;
#pragma unroll
    for (int e = 0; e < 64; ++e) { v[e] = o0[e] - lam * o1[e]; s += v[e] * v[e]; }
    const float r = rsqrtf(s * (1.f / 64) + EPS) * (1.f - lam_init);
#pragma unroll
    for (int e = 0; e < 64; ++e) mixed[(size_t)m * DM + h * 64 + e] = f2bf(v[e] * r * subg[h * 64 + e]);
}

__global__ void __launch_bounds__(256) k_mlstm_conv(const bf16_t* __restrict__ P, const float* __restrict__ w, float* __restrict__ qk) {
    const int idx = blockIdx.x * 256 + threadIdx.x; const int m = idx >> 9, c = idx & 511; const int t = m & (SEQ - 1);
    float y = 0.f;
#pragma unroll
    for (int k = 0; k < 4; ++k) { const int tt = t - 3 + k; if (tt >= 0) y += w[k * 512 + c] * bf2f(P[(size_t)(m - 3 + k) * LDP + PC_BQ + c]); }
    y = siluf_(y); if (c < 256) y *= 0.125f;
    qk[(size_t)m * 512 + c] = y;
}
__global__ void __launch_bounds__(64) k_mlstm_rec(const bf16_t* __restrict__ P, const float* __restrict__ qk, const float* __restrict__ gbias  ,
                                                   const float* __restrict__ outg, bf16_t* __restrict__ mixed) {
    const int b = blockIdx.x >> 2, h = blockIdx.x & 3, lane = threadIdx.x;
    float C[64], n[64];
#pragma unroll
    for (int k = 0; k < 64; ++k) { C[k] = 0.f; n[k] = 0.f; }
    const float bi = gbias[h], bfz = gbias[4 + h], og = outg[h * 64 + lane];
    for (int t = 0; t < SEQ; ++t) {
        const size_t m = (size_t)b * SEQ + t;
        const float qv = qk[m * 512 + h * 64 + lane], kv = qk[m * 512 + 256 + h * 64 + lane];
        const float ve = bf2f(P[m * LDP + PC_BV + h * 64 + lane]);
        const float ipre = bf2f(P[m * LDP + PC_BI + h]) + bi, fpre = bf2f(P[m * LDP + PC_BF + h]) + bfz;
        const float f = sigmoidf_(fpre), ei = __expf(ipre);
        const float kse = kv * ei;
        float num = 0.f, den = 0.f;
#pragma unroll
        for (int k = 0; k < 64; ++k) {
            const float sk = rdlane(kse, k), sq = rdlane(qv, k);
            C[k] = f * C[k] + sk * ve; n[k] = f * n[k] + sk;
            num += sq * C[k]; den += sq * n[k];
        }
        const float hv = num / fmaxf(fabsf(den), 1.f);
        const float r = rsqrtf(wave_sum(hv * hv) * (1.f / 64) + EPS);
        const float go = sigmoidf_(bf2f(P[m * LDP + PC_BO + h * 64 + lane]));
        mixed[m * DM + 256 + h * 64 + lane] = f2bf(hv * r * og * go);
    }
}

__global__ void __launch_bounds__(64) k_hgrn_rec(const bf16_t* __restrict__ P, const float* __restrict__ lbp  , int layer,
                                                  const float* __restrict__ outg, bf16_t* __restrict__ mixed) {
    const int b = blockIdx.x >> 2, h = blockIdx.x & 3, lane = threadIdx.x;
    float S[64];
#pragma unroll
    for (int k = 0; k < 64; ++k) S[k] = 0.f;
    float lb = 0.f;
    if (layer == 1) lb = sigmoidf_(lbp[256 + h * 64 + lane] - lbp[h * 64 + lane]);
    const float og = outg[h * 64 + lane];
    for (int t = 0; t < SEQ; ++t) {
        const size_t m = (size_t)b * SEQ + t;
        const float z = bf2f(P[m * LDP + PC_CF + h * 64 + lane]);
        const float f = lb + (1.f - lb) * sigmoidf_(z), kk = 1.f - f;
        const float qv = siluf_(bf2f(P[m * LDP + PC_CQ + h * 64 + lane]));
        const float ve = bf2f(P[m * LDP + PC_CI + h * 64 + lane]);
        float o = 0.f;
#pragma unroll
        for (int k = 0; k < 64; ++k) {
            const float sa = rdlane(f, k), sk = rdlane(kk, k), sq = rdlane(qv, k);
            S[k] = sa * S[k] + sk * ve; o += sq * S[k];
        }
        const float r = rsqrtf(wave_sum(o * o) * (1.f / 64) + EPS);
        const float gg = sigmoidf_(bf2f(P[m * LDP + PC_CG + h * 64 + lane]));
        mixed[m * DM + 512 + h * 64 + lane] = f2bf(o * r * og * gg);
    }
}

__global__ void __launch_bounds__(256) k_nsa_compress(const bf16_t* __restrict__ P, const float* __restrict__ pos  , const float* __restrict__ w1  ,
                                                       const float* __restrict__ w2  , const float* __restrict__ kgain0, float* __restrict__ cmp) {
    __shared__ float red[4][64]; __shared__ float hid[64];
    const int n = blockIdx.x % NCMP, b = (blockIdx.x / NCMP) % NB, j = blockIdx.x / (NCMP * NB);
    const int o = threadIdx.x & 63, part = threadIdx.x >> 6;
    const int pc = j == 0 ? PC_KC : PC_VC;
    float acc = 0.f;
    for (int l = part * 8; l < part * 8 + 8; ++l) {
        const bf16_t* row = P + (size_t)(b * SEQ + 16 * n + l) * LDP + pc;
        for (int d = 0; d < 64; ++d) acc += (bf2f(row[d]) + pos[(j * 32 + l) * 64 + d]) * w1[((size_t)j * 2048 + l * 64 + d) * 64 + o];
    }
    red[part][o] = acc; __syncthreads();
    if (part == 0) {
        const float x = red[0][o] + red[1][o] + red[2][o] + red[3][o];
        hid[o] = 0.5f * x * (1.f + tanhf(0.7978845608028654f * (x + 0.044715f * x * x * x)));
    }
    __syncthreads();
    if (part == 0) {
        float y = 0.f;
        for (int i = 0; i < 64; ++i) y += hid[i] * w2[(j * 64 + i) * 64 + o];
        if (j == 0) { const float r = rsqrtf(wave_sum(y * y) * (1.f / 64) + EPS); y = y * r * kgain0[o]; }
        cmp[(((size_t)j * NB + b) * NCMP + n) * 64 + o] = y;
    }
}
__global__ void __launch_bounds__(64) k_nsa_cmp_attn(const float* __restrict__ qn  , const float* __restrict__ cmp, float* __restrict__ ocmp, float* __restrict__ imp) {
    const int m = blockIdx.x * 64 + threadIdx.x; const int b = m / SEQ, t = m % SEQ;
    const float* kc = cmp + (size_t)b * NCMP * 64; const float* vc = cmp + ((size_t)NB + b) * NCMP * 64;
    float* im = imp + (size_t)m * 64;
    for (int j = 0; j < 64; ++j) im[j] = 0.f;
    const int nv = t >= 31 ? (t - 31) / 16 + 1 : 0;
    for (int h = 0; h < 4; ++h) {
        const float slope = exp2f(-(float)(2 * h + 2));
        float q[64], o[64];
#pragma unroll
        for (int d = 0; d < 64; ++d) { q[d] = qn[(size_t)m * 256 + h * 64 + d]; o[d] = 0.f; }
        float mx = NEG;
        for (int n = 0; n < nv; ++n) { float s = 0.f;
#pragma unroll
            for (int d = 0; d < 64; ++d) s += q[d] * kc[n * 64 + d];
            s -= slope * (float)(t - (16 * n + 31)); mx = fmaxf(mx, s); }
        float l = 0.f;
        for (int n = 0; n < nv; ++n) { float s = 0.f;
#pragma unroll
            for (int d = 0; d < 64; ++d) s += q[d] * kc[n * 64 + d];
            s -= slope * (float)(t - (16 * n + 31)); l += __expf(s - mx); }
        const float il = nv > 0 ? 1.f / l : 0.f;
        for (int n = 0; n < nv; ++n) { float s = 0.f;
#pragma unroll
            for (int d = 0; d < 64; ++d) s += q[d] * kc[n * 64 + d];
            s -= slope * (float)(t - (16 * n + 31));
            const float p = __expf(s - mx) * il;
#pragma unroll
            for (int d = 0; d < 64; ++d) o[d] += p * vc[n * 64 + d];
            const int jb = n >> 2, r = n & 3;
            if (r < 3) im[jb] += p; else { im[jb] += 0.5f * p; if (jb + 1 < 64) im[jb + 1] += 0.5f * p; }
        }
#pragma unroll
        for (int d = 0; d < 64; ++d) ocmp[((size_t)m * 4 + h) * 64 + d] = o[d];
    }
}
__global__ void __launch_bounds__(64) k_nsa_topk(const float* __restrict__ imp, unsigned long long* __restrict__ selmask) {
    const int m = blockIdx.x * 64 + threadIdx.x; const int t = m % SEQ, qb = t >> 6;
    const float* im = imp + (size_t)m * 64;
    unsigned long long mask = 0ull;
    for (int j = 0; j < 64; ++j) {
        float vj = j <= qb ? im[j] : -1.f; if (j == 0 || j == qb || j == qb - 1) vj = 2.f;
        int rank = 0;
        for (int i = 0; i < 64; ++i) {
            float vi = i <= qb ? im[i] : -1.f; if (i == 0 || i == qb || i == qb - 1) vi = 2.f;
            rank += (vi > vj || (vi == vj && i < j)) ? 1 : 0;
        }
        if (rank < 16) mask |= 1ull << j;
    }
    selmask[m] = mask;
}
__global__ void __launch_bounds__(64) k_nsa_sel_win(const float* __restrict__ qn, const float* __restrict__ ksn, const float* __restrict__ kwn, const bf16_t* __restrict__ P,
                                                     const unsigned long long* __restrict__ selmask, const float* __restrict__ ocmp, const float* __restrict__ outg,
                                                     bf16_t* __restrict__ mixed) {
    const int h = blockIdx.x & 3, m = (blockIdx.x >> 2) * 64 + threadIdx.x; const int b = m / SEQ, t = m % SEQ;
    const float slope = exp2f(-(float)(2 * h + 2));
    float q[64], o[64], acc[64];
    const float g0 = sigmoidf_(bf2f(P[(size_t)m * LDP + PC_DG + h * 3 + 0])), g1 = sigmoidf_(bf2f(P[(size_t)m * LDP + PC_DG + h * 3 + 1])),
                g2 = sigmoidf_(bf2f(P[(size_t)m * LDP + PC_DG + h * 3 + 2]));
#pragma unroll
    for (int d = 0; d < 64; ++d) { q[d] = qn[(size_t)m * 256 + h * 64 + d]; acc[d] = g0 * ocmp[((size_t)m * 4 + h) * 64 + d]; o[d] = 0.f; }
    {
        const unsigned long long mask = selmask[m];
        float mrun = NEG, l = 0.f;
        for (int jb = 0; jb < 64; ++jb) {
            if (!((mask >> jb) & 1ull)) continue;
            for (int i = 0; i < 64; ++i) {
                const int kp = jb * 64 + i; if (kp > t) break;
                const float* kr = ksn + (size_t)(b * SEQ + kp) * 64; float s = 0.f;
#pragma unroll
                for (int d = 0; d < 64; ++d) s += q[d] * kr[d];
                s -= slope * (float)(t - kp);
                const float mn = fmaxf(mrun, s), al = __expf(mrun - mn), p = __expf(s - mn);
                l = l * al + p; mrun = mn;
                const bf16_t* vr = P + (size_t)(b * SEQ + kp) * LDP + PC_VS;
#pragma unroll
                for (int d = 0; d < 64; ++d) o[d] = o[d] * al + p * bf2f(vr[d]);
            }
        }
        const float il = g1 / l;
#pragma unroll
        for (int d = 0; d < 64; ++d) { acc[d] += o[d] * il; o[d] = 0.f; }
    }
    {
        float mrun = NEG, l = 0.f;
        const int k0 = t - 511 > 0 ? t - 511 : 0;
        for (int kp = k0; kp <= t; ++kp) {
            const float* kr = kwn + (size_t)(b * SEQ + kp) * 64; float s = 0.f;
#pragma unroll
            for (int d = 0; d < 64; ++d) s += q[d] * kr[d];
            s -= slope * (float)(t - kp);
            const float mn = fmaxf(mrun, s), al = __expf(mrun - mn), p = __expf(s - mn);
            l = l * al + p; mrun = mn;
            const bf16_t* vr = P + (size_t)(b * SEQ + kp) * LDP + PC_VW;
#pragma unroll
            for (int d = 0; d < 64; ++d) o[d] = o[d] * al + p * bf2f(vr[d]);
        }
        const float il = g2 / l;
#pragma unroll
        for (int d = 0; d < 64; ++d) acc[d] += o[d] * il;
    }
    float s = 0.f;
#pragma unroll
    for (int d = 0; d < 64; ++d) s += acc[d] * acc[d];
    const float r = rsqrtf(s * (1.f / 64) + EPS);
#pragma unroll
    for (int d = 0; d < 64; ++d) mixed[(size_t)m * DM + 768 + h * 64 + d] = f2bf(acc[d] * r * outg[h * 64 + d]);
}

__global__ void __launch_bounds__(256) k_moe_route(const float* __restrict__ x, const float* __restrict__ gain, const float* __restrict__ wg  , const float* __restrict__ bg,
                                                    const float* __restrict__ we  , const float* __restrict__ be, bf16_t* __restrict__ t,
                                                    int* __restrict__ re  , float* __restrict__ rw  ) {
    const int row = blockIdx.x * 4 + (threadIdx.x >> 6), lane = threadIdx.x & 63;
    const float4* xr = (const float4*)(x + (size_t)row * DM);
    float4 v[4]; float s = 0.f;
#pragma unroll
    for (int j = 0; j < 4; ++j) { v[j] = xr[lane + 64 * j]; s += v[j].x * v[j].x + v[j].y * v[j].y + v[j].z * v[j].z + v[j].w * v[j].w; }
    const float r = rsqrtf(wave_sum(s) * (1.f / DM) + EPS);
    float lg[36];
#pragma unroll
    for (int o = 0; o < 36; ++o) lg[o] = 0.f;
#pragma unroll
    for (int j = 0; j < 4; ++j) {
        const float4 g = ((const float4*)gain)[lane + 64 * j];
        float tn[4] = {v[j].x * r * g.x, v[j].y * r * g.y, v[j].z * r * g.z, v[j].w * r * g.w};
        ushort4 o4; o4.x = f2bf(tn[0]); o4.y = f2bf(tn[1]); o4.z = f2bf(tn[2]); o4.w = f2bf(tn[3]);
        ((ushort4*)(t + (size_t)row * DM))[lane + 64 * j] = o4;
#pragma unroll
        for (int i = 0; i < 4; ++i) {
            const int k = (lane + 64 * j) * 4 + i;
            const float4 w4 = ((const float4*)wg)[k];
            lg[0] += tn[i] * w4.x; lg[1] += tn[i] * w4.y; lg[2] += tn[i] * w4.z; lg[3] += tn[i] * w4.w;
#pragma unroll
            for (int e4 = 0; e4 < 8; ++e4) { const float4 w = ((const float4*)we)[k * 8 + e4];
                lg[4 + e4 * 4 + 0] += tn[i] * w.x; lg[4 + e4 * 4 + 1] += tn[i] * w.y; lg[4 + e4 * 4 + 2] += tn[i] * w.z; lg[4 + e4 * 4 + 3] += tn[i] * w.w; }
        }
    }
#pragma unroll
    for (int o = 0; o < 36; ++o) lg[o] = wave_sum(lg[o]);
    float gl[4]; float gmx = NEG; int gs = 0;
#pragma unroll
    for (int g = 0; g < 4; ++g) { gl[g] = lg[g] + bg[g]; if (gl[g] > gmx) { gmx = gl[g]; gs = g; } }
    float gz = 0.f;
#pragma unroll
    for (int g = 0; g < 4; ++g) gz += __expf(gl[g] - gmx);
    const float gprob = 1.f / gz;
    float el[8];
#pragma unroll
    for (int e = 0; e < 8; ++e) {
        const float a0 = lg[4 + e] + be[e], a1 = lg[12 + e] + be[8 + e], a2 = lg[20 + e] + be[16 + e], a3 = lg[28 + e] + be[24 + e];
        el[e] = gs == 0 ? a0 : (gs == 1 ? a1 : (gs == 2 ? a2 : a3));
    }
    float m1 = NEG; int i1 = 0;
#pragma unroll
    for (int e = 0; e < 8; ++e) if (el[e] > m1) { m1 = el[e]; i1 = e; }
    float m2 = NEG; int i2 = 0;
#pragma unroll
    for (int e = 0; e < 8; ++e) if (e != i1 && el[e] > m2) { m2 = el[e]; i2 = e; }
    const float p2 = __expf(m2 - m1);
    const float w1 = gprob / (1.f + p2), w2 = gprob * p2 / (1.f + p2);
    if (lane == 0) { re[row * 2] = gs * 8 + i1; re[row * 2 + 1] = gs * 8 + i2; rw[row * 2] = w1; rw[row * 2 + 1] = w2; }
}
__global__ void __launch_bounds__(256) k_moe_naive(const bf16_t* __restrict__ t, const int* __restrict__ re, const float* __restrict__ rw, const float* __restrict__ wgate,
                                                    const float* __restrict__ wup, const float* __restrict__ wdown, float* __restrict__ x) {
    __shared__ float ts[DM]; __shared__ float hs[256];
    const int m = blockIdx.x, tid = threadIdx.x;
    for (int k = tid; k < DM; k += 256) ts[k] = bf2f(t[(size_t)m * DM + k]);
    __syncthreads();
    float acc[4] = {0.f, 0.f, 0.f, 0.f};
    for (int i = 0; i < 2; ++i) {
        const int e = re[m * 2 + i]; const float w = rw[m * 2 + i];
        const float* Wg = wgate + (size_t)e * DM * 256; const float* Wu = wup + (size_t)e * DM * 256; const float* Wd = wdown + (size_t)e * 256 * DM;
        float a = 0.f, u = 0.f;
        for (int k = 0; k < DM; ++k) { const float tv = ts[k]; a += tv * Wg[(size_t)k * 256 + tid]; u += tv * Wu[(size_t)k * 256 + tid]; }
        hs[tid] = siluf_(a) * u * w;
        __syncthreads();
        for (int f = 0; f < 256; ++f) { const float hv = hs[f];
#pragma unroll
            for (int j = 0; j < 4; ++j) acc[j] += hv * Wd[(size_t)f * DM + tid + 256 * j]; }
        __syncthreads();
    }
#pragma unroll
    for (int j = 0; j < 4; ++j) x[(size_t)m * DM + tid + 256 * j] += acc[j];
}
}

extern "C" void kernel_launch(void* const* d_in, const int* in_sizes, int n_in, void* d_out, int out_size, void* d_ws, size_t ws_size, hipStream_t stream) {
    const float* x_in = (const float*)d_in[0];
    const float* norm_mix = (const float*)d_in[1];
    const float* norm_ffn = (const float*)d_in[2];
    const float* w_in = (const float*)d_in[3];
    const float* w_out = (const float*)d_in[4];
    const float* diff_q_gain = (const float*)d_in[5];
    const float* diff_k_gain = (const float*)d_in[6];
    const float* diff_lambda = (const float*)d_in[7];
    const float* diff_sub_gain = (const float*)d_in[8];
    const float* mlstm_conv = (const float*)d_in[9];
    const float* mlstm_gate_bias = (const float*)d_in[10];
    const float* mlstm_out_gain = (const float*)d_in[11];
    const float* hgrn_lb = (const float*)d_in[12];
    const float* hgrn_out_gain = (const float*)d_in[13];
    const float* nsa_cmp_pos = (const float*)d_in[14];
    const float* nsa_cmp_w1 = (const float*)d_in[15];
    const float* nsa_cmp_w2 = (const float*)d_in[16];
    const float* nsa_q_gain = (const float*)d_in[17];
    const float* nsa_k_gain = (const float*)d_in[18];
    const float* nsa_out_gain = (const float*)d_in[19];
    const float* moe_w_group = (const float*)d_in[20];
    const float* moe_b_group = (const float*)d_in[21];
    const float* moe_w_expert = (const float*)d_in[22];
    const float* moe_b_expert = (const float*)d_in[23];
    const float* moe_w_gate = (const float*)d_in[24];
    const float* moe_w_up = (const float*)d_in[25];
    const float* moe_w_down = (const float*)d_in[26];
    float* out = (float*)d_out;

    char* ws = (char*)d_ws; size_t off = 0;
    auto take = [&](size_t bytes) { char* p = ws + off; off += (bytes + 255) & ~(size_t)255; return p; };
    bf16_t* P = (bf16_t*)take((size_t)MT * LDP * 2);
    bf16_t* tb = (bf16_t*)take((size_t)MT * DM * 2);
    bf16_t* mixed = (bf16_t*)take((size_t)MT * DM * 2);
    float* dq = (float*)take((size_t)MT * 256 * 4);
    float* dk = (float*)take((size_t)MT * 256 * 4);
    float* dO = (float*)take((size_t)MT * 512 * 4);
    float* qk = dO;
    float* nq = dq;
    float* ksn = (float*)take((size_t)MT * 64 * 4);
    float* kwn = (float*)take((size_t)MT * 64 * 4);
    float* cmp = (float*)take((size_t)2 * NB * NCMP * 64 * 4);
    float* ocmp = dk;
    float* imp = (float*)take((size_t)MT * 64 * 4);
    unsigned long long* selmask = (unsigned long long*)take((size_t)MT * 8);
    int* re = (int*)take((size_t)MT * 2 * 4);
    float* rw = (float*)take((size_t)MT * 2 * 4);
    if (off > ws_size) return;

    for (int l = 0; l < DEPTH; ++l) {
        const float* xcur = l == 0 ? x_in : out;
        k_norm_rows<<<MT / 4, 256, 0, stream>>>(xcur, norm_mix + l * DM, tb);
        k_gemm_naive<0><<<dim3(LDP / 64, MT / 64), 256, 0, stream>>>(tb, w_in + (size_t)l * DM * IN_COLS, IN_COLS, DM, P, nullptr, nullptr);
        k_group_norm<32><<<MT * 8 / 256, 256, 0, stream>>>(P, PC_AQ, 8, diff_q_gain + l * 32, 0.17677669529663687f, dq, 256);
        k_group_norm<32><<<MT * 8 / 256, 256, 0, stream>>>(P, PC_AK, 8, diff_k_gain + l * 32, 1.f, dk, 256);
        k_diff_attn<<<NB * 4 * 2 * 64, 64, 0, stream>>>(dq, dk, P, dO);
        const float lam_init = 0.8f - 0.6f * expf(-0.3f * (float)l);
        k_diff_combine<<<MT * 4 / 256, 256, 0, stream>>>(dO, diff_lambda + l * 128, diff_sub_gain + l * 256, lam_init, mixed);
        k_mlstm_conv<<<MT * 512 / 256, 256, 0, stream>>>(P, mlstm_conv + l * 4 * 512, qk);
        k_mlstm_rec<<<NB * 4, 64, 0, stream>>>(P, qk, mlstm_gate_bias + l * 8, mlstm_out_gain + l * 256, mixed);
        k_hgrn_rec<<<NB * 4, 64, 0, stream>>>(P, hgrn_lb, l, hgrn_out_gain + l * 256, mixed);
        k_group_norm<64><<<MT * 4 / 256, 256, 0, stream>>>(P, PC_DQ, 4, nsa_q_gain + l * 64, 0.125f, nq, 256);
        k_group_norm<64><<<MT / 256, 256, 0, stream>>>(P, PC_KS, 1, nsa_k_gain + (l * 3 + 1) * 64, 1.f, ksn, 64);
        k_group_norm<64><<<MT / 256, 256, 0, stream>>>(P, PC_KW, 1, nsa_k_gain + (l * 3 + 2) * 64, 1.f, kwn, 64);
        k_nsa_compress<<<2 * NB * NCMP, 256, 0, stream>>>(P, nsa_cmp_pos + l * 2 * 32 * 64, nsa_cmp_w1 + (size_t)l * 2 * 2048 * 64, nsa_cmp_w2 + l * 2 * 64 * 64,
                                                         nsa_k_gain + (l * 3 + 0) * 64, cmp);
        k_nsa_cmp_attn<<<MT / 64, 64, 0, stream>>>(nq, cmp, ocmp, imp);
        k_nsa_topk<<<MT / 64, 64, 0, stream>>>(imp, selmask);
        k_nsa_sel_win<<<MT / 64 * 4, 64, 0, stream>>>(nq, ksn, kwn, P, selmask, ocmp, nsa_out_gain + l * 256, mixed);
        k_gemm_naive<1><<<dim3(DM / 64, MT / 64), 256, 0, stream>>>(mixed, w_out + (size_t)l * DM * DM, DM, DM, nullptr, xcur, out);
        k_moe_route<<<MT / 4, 256, 0, stream>>>(out, norm_ffn + l * DM, moe_w_group + l * DM * 4, moe_b_group + l * 4, moe_w_expert + l * DM * 32, moe_b_expert + l * 32, tb, re, rw);
        k_moe_naive<<<MT, 256, 0, stream>>>(tb, re, rw, moe_w_gate + (size_t)l * 32 * DM * 256, moe_w_up + (size_t)l * 32 * DM * 256, moe_w_down + (size_t)l * 32 * 256 * DM, out);
    }
}
```

```cpp
#include <hip/hip_runtime.h>
#include <hip/hip_cooperative_groups.h>
#include <stdint.h>
#include <cstdio>
namespace cg = cooperative_groups;

namespace {
constexpr int DM = 1024, NB = 4, SEQ = 4096, DEPTH = 2, MT = NB * SEQ;
constexpr int IN_COLS = 3476, LDP = 3584;
constexpr float EPS = 1e-6f, NEG = -1e30f;
constexpr int PC_AQ = 0, PC_AK = 256, PC_AV = 512, PC_BQ = 768, PC_BK = 1024, PC_BV = 1280, PC_BO = 1536, PC_CQ = 1792, PC_CF = 2048,
              PC_CI = 2304, PC_CG = 2560, PC_DQ = 2816, PC_KC = 3072, PC_VC = 3136, PC_KS = 3200, PC_VS = 3264, PC_KW = 3328, PC_VW = 3392,
              PC_BI = 3456, PC_BF = 3460, PC_DG = 3464;
constexpr int NCMP = 255;
constexpr int NTHR = 512, NWAVE = 8;
constexpr int LDS_BYTES = 65536;

typedef unsigned short bf16_t;
__device__ __forceinline__ float bf2f(bf16_t v) { return __uint_as_float(((unsigned)v) << 16); }
__device__ __forceinline__ bf16_t f2bf(float f) { unsigned u = __float_as_uint(f); return (bf16_t)((u + 0x7fffu + ((u >> 16) & 1u)) >> 16); }
__device__ __forceinline__ int src_col(int c) { return c < 1536 ? c : (c < 3456 ? c + 8 : (c < 3460 ? c - 3456 + 1536 : (c < 3464 ? c - 3460 + 1540 : c))); }
__device__ __forceinline__ float sigmoidf_(float x) { return 1.f / (1.f + __expf(-x)); }
__device__ __forceinline__ float siluf_(float x) { return x / (1.f + __expf(-x)); }
__device__ __forceinline__ float wave_sum(float v, int lane) {
#pragma unroll
    for (int o = 1; o < 64; o <<= 1) v += __int_as_float(__builtin_amdgcn_ds_bpermute((lane ^ o) << 2, __float_as_int(v)));
    return v;
}
__device__ __forceinline__ float rdlane(float v, int k) { return __int_as_float(__builtin_amdgcn_readlane(__float_as_int(v), k)); }

struct Params {
    const float* x_in; const float* norm_mix; const float* norm_ffn; const float* w_in; const float* w_out;
    const float* diff_q_gain; const float* diff_k_gain; const float* diff_lambda; const float* diff_sub_gain;
    const float* mlstm_conv; const float* mlstm_gate_bias; const float* mlstm_out_gain; const float* hgrn_lb; const float* hgrn_out_gain;
    const float* nsa_cmp_pos; const float* nsa_cmp_w1; const float* nsa_cmp_w2; const float* nsa_q_gain; const float* nsa_k_gain; const float* nsa_out_gain;
    const float* moe_w_group; const float* moe_b_group; const float* moe_w_expert; const float* moe_b_expert;
    const float* moe_w_gate; const float* moe_w_up; const float* moe_w_down;
    float* out; char* ws;
};


constexpr size_t al256(size_t x) { return (x + 255) & ~(size_t)255; }
constexpr size_t WS_P = 0;
constexpr size_t WS_TB = WS_P + al256((size_t)MT * LDP * 2);
constexpr size_t WS_MIXED = WS_TB + al256((size_t)MT * DM * 2);
constexpr size_t WS_DQ = WS_MIXED + al256((size_t)MT * DM * 2);
constexpr size_t WS_DK = WS_DQ + al256((size_t)MT * 256 * 4);
constexpr size_t WS_NQ = WS_DK + al256((size_t)MT * 256 * 4);
constexpr size_t WS_KSN = WS_NQ + al256((size_t)MT * 256 * 4);
constexpr size_t WS_KWN = WS_KSN + al256((size_t)MT * 64 * 4);
constexpr size_t WS_CMP = WS_KWN + al256((size_t)MT * 64 * 4);
constexpr size_t WS_OCMP = WS_CMP + al256((size_t)2 * NB * NCMP * 64 * 4);
constexpr size_t WS_IMP = WS_OCMP + al256((size_t)MT * 256 * 4);
constexpr size_t WS_SELMASK = WS_IMP + al256((size_t)MT * 64 * 4);
constexpr size_t WS_RE = WS_SELMASK + al256((size_t)MT * 8);
constexpr size_t WS_RW = WS_RE + al256((size_t)MT * 2 * 4);
constexpr size_t WS_END = WS_RW + al256((size_t)MT * 2 * 4);
#define W_P ((bf16_t*)(p.ws + WS_P))
#define W_TB ((bf16_t*)(p.ws + WS_TB))
#define W_MIXED ((bf16_t*)(p.ws + WS_MIXED))
#define W_DQ ((float*)(p.ws + WS_DQ))
#define W_DK ((float*)(p.ws + WS_DK))
#define W_DO ((float*)(p.ws + WS_TB))
#define W_NQ ((float*)(p.ws + WS_NQ))
#define W_KSN ((float*)(p.ws + WS_KSN))
#define W_KWN ((float*)(p.ws + WS_KWN))
#define W_CMP ((float*)(p.ws + WS_CMP))
#define W_OCMP ((float*)(p.ws + WS_OCMP))
#define W_IMP ((float*)(p.ws + WS_IMP))
#define W_OSEL W_DQ
#define W_OWIN W_DK
#define W_SELMASK ((unsigned long long*)(p.ws + WS_SELMASK))
#define W_RE ((int*)(p.ws + WS_RE))
#define W_RW ((float*)(p.ws + WS_RW))

__device__ __forceinline__ void norm_row(const float* x, const float* gain, bf16_t* t, int row, int lane) {
    const float4* xr = (const float4*)(x + (size_t)row * DM);
    float4 v[4]; float s = 0.f;
#pragma unroll
    for (int j = 0; j < 4; ++j) { v[j] = xr[lane + 64 * j]; s += v[j].x * v[j].x + v[j].y * v[j].y + v[j].z * v[j].z + v[j].w * v[j].w; }
    const float r = rsqrtf(wave_sum(s, lane) * (1.f / DM) + EPS);
#pragma unroll
    for (int j = 0; j < 4; ++j) {
        const float4 g = ((const float4*)gain)[lane + 64 * j];
        ushort4 o; o.x = f2bf(v[j].x * r * g.x); o.y = f2bf(v[j].y * r * g.y); o.z = f2bf(v[j].z * r * g.z); o.w = f2bf(v[j].w * r * g.w);
        ((ushort4*)(t + (size_t)row * DM))[lane + 64 * j] = o;
    }
}

template <int MODE>
__device__ __forceinline__ void gemm_naive_vb(const bf16_t* A, const float* W, int ldw, int K, bf16_t* P, const float* xin, float* xout,
                                              int bx, int by, int tid, float* ldsf) {
    float (*As)[65] = (float (*)[65])ldsf;
    float (*Ws)[64] = (float (*)[64])(ldsf + 16 * 65);
    const int tx = tid & 15, ty = tid >> 4;
    const int m0 = by * 64, n0 = bx * 64;
    float acc[4][4];
#pragma unroll
    for (int i = 0; i < 4; ++i)
#pragma unroll
        for (int j = 0; j < 4; ++j) acc[i][j] = 0.f;
    const int ar = tid >> 2, ak = (tid & 3) * 4;
    const int wk = tid >> 4, wn = (tid & 15) * 4;
    for (int k0 = 0; k0 < K; k0 += 16) {
        const ushort4 a4 = *(const ushort4*)(A + (size_t)(m0 + ar) * K + k0 + ak);
        As[ak + 0][ar] = bf2f(a4.x); As[ak + 1][ar] = bf2f(a4.y); As[ak + 2][ar] = bf2f(a4.z); As[ak + 3][ar] = bf2f(a4.w);
#pragma unroll
        for (int j = 0; j < 4; ++j) {
            const int n = n0 + wn + j; float w = 0.f;
            if (MODE == 0) { if (n < IN_COLS) w = W[(size_t)(k0 + wk) * ldw + src_col(n)]; }
            else w = W[(size_t)(k0 + wk) * ldw + n];
            Ws[wk][wn + j] = w;
        }
        __syncthreads();
#pragma unroll
        for (int kk = 0; kk < 16; ++kk) {
            float a[4], b[4];
#pragma unroll
            for (int i = 0; i < 4; ++i) a[i] = As[kk][ty * 4 + i];
#pragma unroll
            for (int j = 0; j < 4; ++j) b[j] = Ws[kk][tx * 4 + j];
#pragma unroll
            for (int i = 0; i < 4; ++i)
#pragma unroll
                for (int j = 0; j < 4; ++j) acc[i][j] += a[i] * b[j];
        }
        __syncthreads();
    }
#pragma unroll
    for (int i = 0; i < 4; ++i) {
        const int m = m0 + ty * 4 + i;
#pragma unroll
        for (int j = 0; j < 4; ++j) {
            const int n = n0 + tx * 4 + j;
            if (MODE == 0) P[(size_t)m * LDP + n] = f2bf(acc[i][j]);
            else xout[(size_t)m * DM + n] = xin[(size_t)m * DM + n] + acc[i][j];
        }
    }
}

template <int G>
__device__ __forceinline__ void group_norm_item(const bf16_t* P, int col0, int ngroups, const float* gain, float scale, float* out, int ldo, int idx) {
    const int m = idx / ngroups, g = idx % ngroups;
    const bf16_t* p = P + (size_t)m * LDP + col0 + g * G;
    float v[G]; float s = 0.f;
#pragma unroll
    for (int d = 0; d < G; ++d) { v[d] = bf2f(p[d]); s += v[d] * v[d]; }
    const float r = rsqrtf(s * (1.f / G) + EPS) * scale;
#pragma unroll
    for (int d = 0; d < G; ++d) out[(size_t)m * ldo + g * G + d] = v[d] * r * gain[d];
}

__device__ __forceinline__ void diff_attn_item(const float* qn, const float* kn, const bf16_t* P, float* O, int item, int lane) {
    const int tb = item & 63, c = (item >> 6) & 1, h = (item >> 7) & 3, b = item >> 9;
    const int t = tb * 64 + lane;
    const float slope = exp2f(-(float)(2 * h + 1));
    float q[32], o[64];
#pragma unroll
    for (int d = 0; d < 32; ++d) q[d] = qn[(size_t)(b * SEQ + t) * 256 + h * 64 + c * 32 + d];
#pragma unroll
    for (int e = 0; e < 64; ++e) o[e] = 0.f;
    float mrun = NEG, l = 0.f;
    const int jmax = tb * 64 + 63;
    for (int j = 0; j <= jmax; ++j) {
        const float* kr = kn + (size_t)(b * SEQ + j) * 256 + h * 64 + c * 32;
        float s = 0.f;
#pragma unroll
        for (int d = 0; d < 32; ++d) s += q[d] * kr[d];
        s -= slope * (float)(t - j);
        if (j > t) s = NEG;
        const float mn = fmaxf(mrun, s), al = __expf(mrun - mn), p = (j > t) ? 0.f : __expf(s - mn);
        l = l * al + p; mrun = mn;
        const bf16_t* vr = P + (size_t)(b * SEQ + j) * LDP + PC_AV + h * 64;
#pragma unroll
        for (int e = 0; e < 64; ++e) o[e] = o[e] * al + p * bf2f(vr[e]);
    }
    const float il = 1.f / l;
    float* op = O + ((size_t)(b * SEQ + t) * 8 + h * 2 + c) * 64;
#pragma unroll
    for (int e = 0; e < 64; ++e) op[e] = o[e] * il;
}
__device__ __forceinline__ void diff_combine_item(const float* O, const float* lamv, const float* subg, float lam_init, bf16_t* mixed, int idx) {
    const int m = idx >> 2, h = idx & 3;
    float d01 = 0.f, d23 = 0.f;
    for (int i = 0; i < 32; ++i) { d01 += lamv[i] * lamv[32 + i]; d23 += lamv[64 + i] * lamv[96 + i]; }
    const float lam = __expf(d01) - __expf(d23) + lam_init;
    const float* o0 = O + ((size_t)m * 8 + h * 2) * 64; const float* o1 = o0 + 64;
    float v[64]; float s = 0.f;
#pragma unroll
    for (int e = 0; e < 64; ++e) { v[e] = o0[e] - lam * o1[e]; s += v[e] * v[e]; }
    const float r = rsqrtf(s * (1.f / 64) + EPS) * (1.f - lam_init);
#pragma unroll
    for (int e = 0; e < 64; ++e) mixed[(size_t)m * DM + h * 64 + e] = f2bf(v[e] * r * subg[h * 64 + e]);
}

__device__ __forceinline__ void mlstm_rec_item(const bf16_t* P, const float* cw, const float* gbias, const float* outg, bf16_t* mixed, int item, int lane) {
    const int b = item >> 2, h = item & 3;
    float C[64]; float nvec = 0.f;
#pragma unroll
    for (int k = 0; k < 64; ++k) C[k] = 0.f;
    const float bi = gbias[h], bfz = gbias[4 + h], og = outg[h * 64 + lane];
    for (int t = 0; t < SEQ; ++t) {
        const size_t m = (size_t)b * SEQ + t;
        float qv = 0.f, kv = 0.f;
#pragma unroll
        for (int k = 0; k < 4; ++k) { const int tt = t - 3 + k; if (tt >= 0) {
            qv += cw[k * 512 + h * 64 + lane] * bf2f(P[(m - 3 + k) * LDP + PC_BQ + h * 64 + lane]);
            kv += cw[k * 512 + 256 + h * 64 + lane] * bf2f(P[(m - 3 + k) * LDP + PC_BK + h * 64 + lane]); } }
        qv = siluf_(qv) * 0.125f; kv = siluf_(kv);
        const float ve = bf2f(P[m * LDP + PC_BV + h * 64 + lane]);
        const float ipre = bf2f(P[m * LDP + PC_BI + h]) + bi, fpre = bf2f(P[m * LDP + PC_BF + h]) + bfz;
        const float f = sigmoidf_(fpre), ei = __expf(ipre);
        const float kse = kv * ei;
        float num = 0.f;
        nvec = f * nvec + kse;
        const float den = wave_sum(qv * nvec, lane);
#pragma unroll
        for (int k = 0; k < 64; ++k) {
            const float sk = rdlane(kse, k), sq = rdlane(qv, k);
            C[k] = f * C[k] + sk * ve;
            num += sq * C[k];
        }
        const float hv = num / fmaxf(fabsf(den), 1.f);
        const float r = rsqrtf(wave_sum(hv * hv, lane) * (1.f / 64) + EPS);
        const float go = sigmoidf_(bf2f(P[m * LDP + PC_BO + h * 64 + lane]));
        mixed[m * DM + 256 + h * 64 + lane] = f2bf(hv * r * og * go);
    }
}
__device__ __forceinline__ void hgrn_rec_item(const bf16_t* P, const float* lbp, int layer, const float* outg, bf16_t* mixed, int item, int lane) {
    const int b = item >> 2, h = item & 3;
    float S[64];
#pragma unroll
    for (int k = 0; k < 64; ++k) S[k] = 0.f;
    float lb = 0.f;
    if (layer == 1) lb = sigmoidf_(lbp[256 + h * 64 + lane] - lbp[h * 64 + lane]);
    const float og = outg[h * 64 + lane];
    for (int t = 0; t < SEQ; ++t) {
        const size_t m = (size_t)b * SEQ + t;
        const float z = bf2f(P[m * LDP + PC_CF + h * 64 + lane]);
        const float f = lb + (1.f - lb) * sigmoidf_(z), kk = 1.f - f;
        const float qv = siluf_(bf2f(P[m * LDP + PC_CQ + h * 64 + lane]));
        const float ve = bf2f(P[m * LDP + PC_CI + h * 64 + lane]);
        float o = 0.f;
#pragma unroll
        for (int k = 0; k < 64; ++k) {
            const float sa = rdlane(f, k), sk = rdlane(kk, k), sq = rdlane(qv, k);
            S[k] = sa * S[k] + sk * ve; o += sq * S[k];
        }
        const float r = rsqrtf(wave_sum(o * o, lane) * (1.f / 64) + EPS);
        const float gg = sigmoidf_(bf2f(P[m * LDP + PC_CG + h * 64 + lane]));
        mixed[m * DM + 512 + h * 64 + lane] = f2bf(o * r * og * gg);
    }
}

__device__ __forceinline__ void nsa_compress_vb(const bf16_t* P, const float* pos, const float* w1, const float* w2, const float* kgain0, float* cmp, int vb, int tid, float* ldsf) {
    float (*red)[64] = (float (*)[64])ldsf; float* hid = ldsf + 256;
    const int n = vb % NCMP, b = (vb / NCMP) % NB, j = vb / (NCMP * NB);
    const int o = tid & 63, part = tid >> 6;
    const int pc = j == 0 ? PC_KC : PC_VC;
    float acc = 0.f;
    for (int l = part * 8; l < part * 8 + 8; ++l) {
        const bf16_t* row = P + (size_t)(b * SEQ + 16 * n + l) * LDP + pc;
        for (int d = 0; d < 64; ++d) acc += (bf2f(row[d]) + pos[(j * 32 + l) * 64 + d]) * w1[((size_t)j * 2048 + l * 64 + d) * 64 + o];
    }
    red[part][o] = acc; __syncthreads();
    if (part == 0) {
        const float x = red[0][o] + red[1][o] + red[2][o] + red[3][o];
        hid[o] = 0.5f * x * (1.f + tanhf(0.7978845608028654f * (x + 0.044715f * x * x * x)));
    }
    __syncthreads();
    if (part == 0) {
        float y = 0.f;
        for (int i = 0; i < 64; ++i) y += hid[i] * w2[(j * 64 + i) * 64 + o];
        if (j == 0) { const float r = rsqrtf(wave_sum(y * y, o) * (1.f / 64) + EPS); y = y * r * kgain0[o]; }
        cmp[(((size_t)j * NB + b) * NCMP + n) * 64 + o] = y;
    }
    __syncthreads();
}
__device__ __forceinline__ void nsa_cmp_attn_item(const float* qn, const float* cmp, float* ocmp, float* imp, int item, int lane) {
    const int m = item * 64 + lane; const int b = m / SEQ, t = m % SEQ;
    const float* kc = cmp + (size_t)b * NCMP * 64; const float* vc = cmp + ((size_t)NB + b) * NCMP * 64;
    float* im = imp + (size_t)m * 64;
    for (int j = 0; j < 64; ++j) im[j] = 0.f;
    const int nv = t >= 31 ? (t - 31) / 16 + 1 : 0;
#pragma unroll 1
    for (int h = 0; h < 4; ++h) {
        const float slope = exp2f(-(float)(2 * h + 2));
        float q[64], o[64];
#pragma unroll
        for (int d = 0; d < 64; ++d) { q[d] = qn[(size_t)m * 256 + h * 64 + d]; o[d] = 0.f; }
        float mx = NEG;
#pragma unroll 1
        for (int n = 0; n < nv; ++n) { float s = 0.f;
#pragma unroll
            for (int d = 0; d < 32; ++d) s += q[d] * kc[n * 64 + d];
            asm volatile("" ::: "memory");
#pragma unroll
            for (int d = 32; d < 64; ++d) s += q[d] * kc[n * 64 + d];
            asm volatile("" ::: "memory");
            s -= slope * (float)(t - (16 * n + 31)); mx = fmaxf(mx, s); }
        float l = 0.f;
#pragma unroll 1
        for (int n = 0; n < nv; ++n) { float s = 0.f;
#pragma unroll
            for (int d = 0; d < 32; ++d) s += q[d] * kc[n * 64 + d];
            asm volatile("" ::: "memory");
#pragma unroll
            for (int d = 32; d < 64; ++d) s += q[d] * kc[n * 64 + d];
            asm volatile("" ::: "memory");
            s -= slope * (float)(t - (16 * n + 31)); l += __expf(s - mx); }
        const float il = nv > 0 ? 1.f / l : 0.f;
#pragma unroll 1
        for (int n = 0; n < nv; ++n) { float s = 0.f;
#pragma unroll
            for (int d = 0; d < 32; ++d) s += q[d] * kc[n * 64 + d];
            asm volatile("" ::: "memory");
#pragma unroll
            for (int d = 32; d < 64; ++d) s += q[d] * kc[n * 64 + d];
            asm volatile("" ::: "memory");
            s -= slope * (float)(t - (16 * n + 31));
            const float p = __expf(s - mx) * il;
            asm volatile("" ::: "memory");
#pragma unroll
            for (int d = 0; d < 32; ++d) o[d] += p * vc[n * 64 + d];
            asm volatile("" ::: "memory");
#pragma unroll
            for (int d = 32; d < 64; ++d) o[d] += p * vc[n * 64 + d];
            asm volatile("" ::: "memory");
            const int jb = n >> 2, r = n & 3;
            if (r < 3) im[jb] += p; else { im[jb] += 0.5f * p; if (jb + 1 < 64) im[jb + 1] += 0.5f * p; }
        }
#pragma unroll
        for (int d = 0; d < 64; ++d) ocmp[((size_t)m * 4 + h) * 64 + d] = o[d];
    }
}
__device__ __forceinline__ void nsa_topk_item(const float* imp, unsigned long long* selmask, int m) {
    const int t = m % SEQ, qb = t >> 6;
    const float* im = imp + (size_t)m * 64;
    unsigned long long mask = 0ull;
    for (int j = 0; j < 64; ++j) {
        float vj = j <= qb ? im[j] : -1.f; if (j == 0 || j == qb || j == qb - 1) vj = 2.f;
        int rank = 0;
        for (int i = 0; i < 64; ++i) {
            float vi = i <= qb ? im[i] : -1.f; if (i == 0 || i == qb || i == qb - 1) vi = 2.f;
            rank += (vi > vj || (vi == vj && i < j)) ? 1 : 0;
        }
        if (rank < 16) mask |= 1ull << j;
    }
    selmask[m] = mask;
}
template <int KIND>
__device__ __forceinline__ void nsa_branch_item(const float* qn, const float* kn, const bf16_t* P, const unsigned long long* selmask, float* obr, int item, int lane) {
    const int h = item & 3, m = (item >> 2) * 64 + lane; const int b = m / SEQ, t = m % SEQ;
    const float slope = exp2f(-(float)(2 * h + 2));
    float q[64], o[64];
#pragma unroll
    for (int d = 0; d < 64; ++d) { q[d] = qn[(size_t)m * 256 + h * 64 + d]; o[d] = 0.f; }
    float mrun = NEG, l = 0.f;
    const int pcv = KIND == 0 ? PC_VS : PC_VW;
    if (KIND == 0) {
        const unsigned long long mask = selmask[m];
        for (int jb = 0; jb < 64; ++jb) {
            if (!((mask >> jb) & 1ull)) continue;
            for (int i = 0; i < 64; ++i) {
                const int kp = jb * 64 + i; if (kp > t) break;
                const float* kr = kn + (size_t)(b * SEQ + kp) * 64; float s = 0.f;
#pragma unroll
                for (int d = 0; d < 64; ++d) s += q[d] * kr[d];
                s -= slope * (float)(t - kp);
                const float mn = fmaxf(mrun, s), al = __expf(mrun - mn), p = __expf(s - mn);
                l = l * al + p; mrun = mn;
                const bf16_t* vr = P + (size_t)(b * SEQ + kp) * LDP + pcv;
#pragma unroll
                for (int d = 0; d < 64; ++d) o[d] = o[d] * al + p * bf2f(vr[d]);
            }
        }
    } else {
        const int k0 = t - 511 > 0 ? t - 511 : 0;
        for (int kp = k0; kp <= t; ++kp) {
            const float* kr = kn + (size_t)(b * SEQ + kp) * 64; float s = 0.f;
#pragma unroll
            for (int d = 0; d < 64; ++d) s += q[d] * kr[d];
            s -= slope * (float)(t - kp);
            const float mn = fmaxf(mrun, s), al = __expf(mrun - mn), p = __expf(s - mn);
            l = l * al + p; mrun = mn;
            const bf16_t* vr = P + (size_t)(b * SEQ + kp) * LDP + pcv;
#pragma unroll
            for (int d = 0; d < 64; ++d) o[d] = o[d] * al + p * bf2f(vr[d]);
        }
    }
    const float il = 1.f / l;
#pragma unroll
    for (int d = 0; d < 64; ++d) obr[((size_t)m * 4 + h) * 64 + d] = o[d] * il;
}
__device__ __forceinline__ void nsa_combine_item(const bf16_t* P, const float* ocmp, const float* osel, const float* owin, const float* outg, bf16_t* mixed, int idx) {
    const int m = idx >> 2, h = idx & 3;
    const float g0 = sigmoidf_(bf2f(P[(size_t)m * LDP + PC_DG + h * 3 + 0])), g1 = sigmoidf_(bf2f(P[(size_t)m * LDP + PC_DG + h * 3 + 1])),
                g2 = sigmoidf_(bf2f(P[(size_t)m * LDP + PC_DG + h * 3 + 2]));
    const size_t base = ((size_t)m * 4 + h) * 64;
    float v[64]; float s = 0.f;
#pragma unroll
    for (int d = 0; d < 64; ++d) { v[d] = g0 * ocmp[base + d] + g1 * osel[base + d] + g2 * owin[base + d]; s += v[d] * v[d]; }
    const float r = rsqrtf(s * (1.f / 64) + EPS);
#pragma unroll
    for (int d = 0; d < 64; ++d) mixed[(size_t)m * DM + 768 + h * 64 + d] = f2bf(v[d] * r * outg[h * 64 + d]);
}

__device__ __forceinline__ void moe_route_row(const float* x, const float* gain, const float* wg, const float* bg, const float* we, const float* be, bf16_t* t, int* re, float* rw,
                                              int row, int lane) {
    const float4* xr = (const float4*)(x + (size_t)row * DM);
    float4 v[4]; float s = 0.f;
#pragma unroll
    for (int j = 0; j < 4; ++j) { v[j] = xr[lane + 64 * j]; s += v[j].x * v[j].x + v[j].y * v[j].y + v[j].z * v[j].z + v[j].w * v[j].w; }
    const float r = rsqrtf(wave_sum(s, lane) * (1.f / DM) + EPS);
    float lg[36];
#pragma unroll
    for (int o = 0; o < 36; ++o) lg[o] = 0.f;
#pragma unroll
    for (int j = 0; j < 4; ++j) {
        const float4 g = ((const float4*)gain)[lane + 64 * j];
        float tn[4] = {v[j].x * r * g.x, v[j].y * r * g.y, v[j].z * r * g.z, v[j].w * r * g.w};
        ushort4 o4; o4.x = f2bf(tn[0]); o4.y = f2bf(tn[1]); o4.z = f2bf(tn[2]); o4.w = f2bf(tn[3]);
        ((ushort4*)(t + (size_t)row * DM))[lane + 64 * j] = o4;
#pragma unroll
        for (int i = 0; i < 4; ++i) {
            const int k = (lane + 64 * j) * 4 + i;
            const float4 w4 = ((const float4*)wg)[k];
            lg[0] += tn[i] * w4.x; lg[1] += tn[i] * w4.y; lg[2] += tn[i] * w4.z; lg[3] += tn[i] * w4.w;
#pragma unroll
            for (int e4 = 0; e4 < 8; ++e4) { const float4 w = ((const float4*)we)[k * 8 + e4];
                lg[4 + e4 * 4 + 0] += tn[i] * w.x; lg[4 + e4 * 4 + 1] += tn[i] * w.y; lg[4 + e4 * 4 + 2] += tn[i] * w.z; lg[4 + e4 * 4 + 3] += tn[i] * w.w; }
        }
    }
#pragma unroll
    for (int o = 0; o < 36; ++o) lg[o] = wave_sum(lg[o], lane);
    float gl[4]; float gmx = NEG; int gs = 0;
#pragma unroll
    for (int g = 0; g < 4; ++g) { gl[g] = lg[g] + bg[g]; if (gl[g] > gmx) { gmx = gl[g]; gs = g; } }
    float gz = 0.f;
#pragma unroll
    for (int g = 0; g < 4; ++g) gz += __expf(gl[g] - gmx);
    const float gprob = 1.f / gz;
    float el[8];
#pragma unroll
    for (int e = 0; e < 8; ++e) {
        const float a0 = lg[4 + e] + be[e], a1 = lg[12 + e] + be[8 + e], a2 = lg[20 + e] + be[16 + e], a3 = lg[28 + e] + be[24 + e];
        el[e] = gs == 0 ? a0 : (gs == 1 ? a1 : (gs == 2 ? a2 : a3));
    }
    float m1 = NEG; int i1 = 0;
#pragma unroll
    for (int e = 0; e < 8; ++e) if (el[e] > m1) { m1 = el[e]; i1 = e; }
    float m2 = NEG; int i2 = 0;
#pragma unroll
    for (int e = 0; e < 8; ++e) if (e != i1 && el[e] > m2) { m2 = el[e]; i2 = e; }
    const float p2 = __expf(m2 - m1);
    const float w1 = gprob / (1.f + p2), w2 = gprob * p2 / (1.f + p2);
    if (lane == 0) { re[row * 2] = gs * 8 + i1; re[row * 2 + 1] = gs * 8 + i2; rw[row * 2] = w1; rw[row * 2 + 1] = w2; }
}
__device__ __forceinline__ void moe_naive_vb(const bf16_t* t, const int* re, const float* rw, const float* wgate, const float* wup, const float* wdown, float* x, int m, int tid, float* ldsf) {
    float* ts = ldsf; float* hs = ldsf + DM;
    for (int k = tid; k < DM; k += 256) ts[k] = bf2f(t[(size_t)m * DM + k]);
    __syncthreads();
    float acc[4] = {0.f, 0.f, 0.f, 0.f};
    for (int i = 0; i < 2; ++i) {
        const int e = re[m * 2 + i]; const float w = rw[m * 2 + i];
        const float* Wg = wgate + (size_t)e * DM * 256; const float* Wu = wup + (size_t)e * DM * 256; const float* Wd = wdown + (size_t)e * 256 * DM;
        float a = 0.f, u = 0.f;
        for (int k = 0; k < DM; ++k) { const float tv = ts[k]; a += tv * Wg[(size_t)k * 256 + tid]; u += tv * Wu[(size_t)k * 256 + tid]; }
        hs[tid] = siluf_(a) * u * w;
        __syncthreads();
        for (int f = 0; f < 256; ++f) { const float hv = hs[f];
#pragma unroll
            for (int j = 0; j < 4; ++j) acc[j] += hv * Wd[(size_t)f * DM + tid + 256 * j]; }
        __syncthreads();
    }
#pragma unroll
    for (int j = 0; j < 4; ++j) x[(size_t)m * DM + tid + 256 * j] += acc[j];
}

__global__ void __launch_bounds__(NTHR) mega_fwd(Params p) {
    extern __shared__ __attribute__((aligned(16))) unsigned char lds[];
    cg::grid_group grid = cg::this_grid();
    const int G = gridDim.x, bid = blockIdx.x;
#define PHASE_VARS \
    int tid = threadIdx.x; asm volatile("" : "+v"(tid)); \
    const int lane = tid & 63, wave = tid >> 6, half = tid >> 8, tid256 = tid & 255; \
    const int gw = bid * NWAVE + wave, NGW = G * NWAVE; \
    const int gt = bid * NTHR + tid, NGT = G * NTHR; \
    float* ldsf = (float*)lds + half * 4096; \
    (void)lane; (void)tid256; (void)gw; (void)NGW; (void)gt; (void)NGT; (void)ldsf;

    for (int l = 0; l < DEPTH; ++l) {
        const float* xcur = l == 0 ? p.x_in : p.out;
        {   PHASE_VARS
        for (int row = gw; row < MT; row += NGW) norm_row(xcur, p.norm_mix + l * DM, W_TB, row, lane);
        }
        grid.sync();
        {   PHASE_VARS
        for (int it = bid; it < (LDP / 64) * (MT / 64) / 2; it += G) { const int vb = it * 2 + half;
            gemm_naive_vb<0>(W_TB, p.w_in + (size_t)l * DM * IN_COLS, IN_COLS, DM, W_P, nullptr, nullptr, vb % (LDP / 64), vb / (LDP / 64), tid256, ldsf); }
        }
        grid.sync();
        {   PHASE_VARS
        for (int i = gt; i < MT * 8; i += NGT) group_norm_item<32>(W_P, PC_AQ, 8, p.diff_q_gain + l * 32, 0.17677669529663687f, W_DQ, 256, i);
        for (int i = gt; i < MT * 8; i += NGT) group_norm_item<32>(W_P, PC_AK, 8, p.diff_k_gain + l * 32, 1.f, W_DK, 256, i);
        for (int i = gt; i < MT * 4; i += NGT) group_norm_item<64>(W_P, PC_DQ, 4, p.nsa_q_gain + l * 64, 0.125f, W_NQ, 256, i);
        for (int i = gt; i < MT; i += NGT) group_norm_item<64>(W_P, PC_KS, 1, p.nsa_k_gain + (l * 3 + 1) * 64, 1.f, W_KSN, 64, i);
        for (int i = gt; i < MT; i += NGT) group_norm_item<64>(W_P, PC_KW, 1, p.nsa_k_gain + (l * 3 + 2) * 64, 1.f, W_KWN, 64, i);
        for (int it = bid; it < 2 * NB * NCMP / 2; it += G) { const int vb = it * 2 + half;
            nsa_compress_vb(W_P, p.nsa_cmp_pos + l * 2 * 32 * 64, p.nsa_cmp_w1 + (size_t)l * 2 * 2048 * 64, p.nsa_cmp_w2 + l * 2 * 64 * 64, p.nsa_k_gain + (l * 3 + 0) * 64, W_CMP, vb, tid256, ldsf); }
        }
        grid.sync();
        {   PHASE_VARS
        if (gw < 16) mlstm_rec_item(W_P, p.mlstm_conv + l * 4 * 512, p.mlstm_gate_bias + l * 8, p.mlstm_out_gain + l * 256, W_MIXED, gw, lane);
        else if (gw < 32) hgrn_rec_item(W_P, p.hgrn_lb, l, p.hgrn_out_gain + l * 256, W_MIXED, gw - 16, lane);
        for (int it = gw; it < 2048; it += NGW) diff_attn_item(W_DQ, W_DK, W_P, W_DO, it, lane);
        for (int it = gw; it < 256; it += NGW) nsa_cmp_attn_item(W_NQ, W_CMP, W_OCMP, W_IMP, it, lane);
        }
        grid.sync();
        {   PHASE_VARS
        const float lam_init = 0.8f - 0.6f * __expf(-0.3f * (float)l);
        for (int i = gt; i < MT * 4; i += NGT) diff_combine_item(W_DO, p.diff_lambda + l * 128, p.diff_sub_gain + l * 256, lam_init, W_MIXED, i);
        for (int i = gt; i < MT; i += NGT) nsa_topk_item(W_IMP, W_SELMASK, i);
        }
        grid.sync();
        {   PHASE_VARS
        for (int it = gw; it < 1024; it += NGW) nsa_branch_item<0>(W_NQ, W_KSN, W_P, W_SELMASK, W_OSEL, it, lane);
        for (int it = gw; it < 1024; it += NGW) nsa_branch_item<1>(W_NQ, W_KWN, W_P, W_SELMASK, W_OWIN, it, lane);
        }
        grid.sync();
        {   PHASE_VARS
        for (int i = gt; i < MT * 4; i += NGT) nsa_combine_item(W_P, W_OCMP, W_OSEL, W_OWIN, p.nsa_out_gain + l * 256, W_MIXED, i);
        }
        grid.sync();
        {   PHASE_VARS
        for (int it = bid; it < (DM / 64) * (MT / 64) / 2; it += G) { const int vb = it * 2 + half;
            gemm_naive_vb<1>(W_MIXED, p.w_out + (size_t)l * DM * DM, DM, DM, nullptr, xcur, p.out, vb % (DM / 64), vb / (DM / 64), tid256, ldsf); }
        }
        grid.sync();
        {   PHASE_VARS
        for (int row = gw; row < MT; row += NGW)
            moe_route_row(p.out, p.norm_ffn + l * DM, p.moe_w_group + l * DM * 4, p.moe_b_group + l * 4, p.moe_w_expert + l * DM * 32, p.moe_b_expert + l * 32, W_TB, W_RE, W_RW, row, lane);
        }
        grid.sync();
        {   PHASE_VARS
        for (int it = bid; it < MT / 2; it += G) { const int m = it * 2 + half;
            moe_naive_vb(W_TB, W_RE, W_RW, p.moe_w_gate + (size_t)l * 32 * DM * 256, p.moe_w_up + (size_t)l * 32 * DM * 256, p.moe_w_down + (size_t)l * 32 * 256 * DM, p.out, m, tid256, ldsf); }
        }
        grid.sync();
    }
}
}

extern "C" void kernel_launch(void* const* d_in, const int* in_sizes, int n_in, void* d_out, int out_size, void* d_ws, size_t ws_size, hipStream_t stream) {
    Params p{};
    p.x_in = (const float*)d_in[0]; p.norm_mix = (const float*)d_in[1]; p.norm_ffn = (const float*)d_in[2]; p.w_in = (const float*)d_in[3]; p.w_out = (const float*)d_in[4];
    p.diff_q_gain = (const float*)d_in[5]; p.diff_k_gain = (const float*)d_in[6]; p.diff_lambda = (const float*)d_in[7]; p.diff_sub_gain = (const float*)d_in[8];
    p.mlstm_conv = (const float*)d_in[9]; p.mlstm_gate_bias = (const float*)d_in[10]; p.mlstm_out_gain = (const float*)d_in[11]; p.hgrn_lb = (const float*)d_in[12];
    p.hgrn_out_gain = (const float*)d_in[13]; p.nsa_cmp_pos = (const float*)d_in[14]; p.nsa_cmp_w1 = (const float*)d_in[15]; p.nsa_cmp_w2 = (const float*)d_in[16];
    p.nsa_q_gain = (const float*)d_in[17]; p.nsa_k_gain = (const float*)d_in[18]; p.nsa_out_gain = (const float*)d_in[19];
    p.moe_w_group = (const float*)d_in[20]; p.moe_b_group = (const float*)d_in[21]; p.moe_w_expert = (const float*)d_in[22]; p.moe_b_expert = (const float*)d_in[23];
    p.moe_w_gate = (const float*)d_in[24]; p.moe_w_up = (const float*)d_in[25]; p.moe_w_down = (const float*)d_in[26];
    p.out = (float*)d_out;

    p.ws = (char*)d_ws;
    if (WS_END > ws_size) { fprintf(stderr, "kernel_launch: workspace too small: need %zu, have %zu\n", (size_t)WS_END, ws_size); return; }

    static int grid_blocks = 0;
    if (!grid_blocks) {
        int dev = 0, cus = 0, per_cu = 0;
        hipGetDevice(&dev);
        hipDeviceGetAttribute(&cus, hipDeviceAttributeMultiprocessorCount, dev);
        hipFuncSetAttribute((const void*)mega_fwd, hipFuncAttributeMaxDynamicSharedMemorySize, LDS_BYTES);
        hipOccupancyMaxActiveBlocksPerMultiprocessor(&per_cu, (const void*)mega_fwd, NTHR, LDS_BYTES);
        if (per_cu < 1) per_cu = 1;
        if (per_cu > 1) per_cu = 1;
        grid_blocks = cus * per_cu;
    }
    void* args[] = {&p};
    hipError_t e = hipLaunchCooperativeKernel((const void*)mega_fwd, dim3(grid_blocks), dim3(NTHR), args, LDS_BYTES, stream);
    if (e != hipSuccess) fprintf(stderr, "cooperative launch failed: %s (grid %d)\n", hipGetErrorString(e), grid_blocks);
}
```

```cpp
#include <hip/hip_runtime.h>
#include <hip/hip_cooperative_groups.h>
#include <stdint.h>
#include <cstdio>
namespace cg = cooperative_groups;

namespace {
constexpr int DM = 1024, NB = 4, SEQ = 4096, DEPTH = 2, MT = NB * SEQ;
constexpr int IN_COLS = 3476, LDP = 3584;
constexpr float EPS = 1e-6f, NEG = -1e30f;
constexpr int PC_AQ = 0, PC_AK = 256, PC_AV = 512, PC_BQ = 768, PC_BK = 1024, PC_BV = 1280, PC_BO = 1536, PC_CQ = 1792, PC_CF = 2048,
              PC_CI = 2304, PC_CG = 2560, PC_DQ = 2816, PC_KC = 3072, PC_VC = 3136, PC_KS = 3200, PC_VS = 3264, PC_KW = 3328, PC_VW = 3392,
              PC_BI = 3456, PC_BF = 3460, PC_DG = 3464;
constexpr int NCMP = 255;
constexpr int NTHR = 512, NWAVE = 8;
constexpr int LDS_BYTES = 147456;

typedef unsigned short bf16_t;
__device__ __forceinline__ float bf2f(bf16_t v) { return __uint_as_float(((unsigned)v) << 16); }
__device__ __forceinline__ bf16_t f2bf(float f) { unsigned u = __float_as_uint(f); return (bf16_t)((u + 0x7fffu + ((u >> 16) & 1u)) >> 16); }
__device__ __forceinline__ int src_col(int c) { return c < 1536 ? c : (c < 3456 ? c + 8 : (c < 3460 ? c - 3456 + 1536 : (c < 3464 ? c - 3460 + 1540 : c))); }
__device__ __forceinline__ float sigmoidf_(float x) { return 1.f / (1.f + __expf(-x)); }
__device__ __forceinline__ float siluf_(float x) { return x / (1.f + __expf(-x)); }
__device__ __forceinline__ float wave_sum(float v, int lane) {
#pragma unroll
    for (int o = 1; o < 64; o <<= 1) v += __int_as_float(__builtin_amdgcn_ds_bpermute((lane ^ o) << 2, __float_as_int(v)));
    return v;
}
__device__ __forceinline__ float rdlane(float v, int k) { return __int_as_float(__builtin_amdgcn_readlane(__float_as_int(v), k)); }

namespace pg8 {
#define PG8_LAS __attribute__((address_space(3)))
typedef unsigned short bf16_t;
typedef short bf16x8 __attribute__((ext_vector_type(8)));
typedef float f32x4 __attribute__((ext_vector_type(4)));
typedef unsigned u32x4 __attribute__((ext_vector_type(4)));
constexpr int BM = 256, BK = 64, HALF = 128, HTB = HALF * BK * 2  , STAGE_BYTES = 8 * HTB, NXCD = 8, WGM = 8;

__host__ __device__ __forceinline__ int lds_byte(int r, int c) { const int st = (r >> 4) * 2 + (c >> 5), rr = r & 15, cc = c & 31, ob = rr * 64 + cc * 2; return st * 1024 + (ob ^ (((ob >> 9) & 1) << 5)); }
__host__ __device__ __forceinline__ void stage_rc(int b, int& R, int& C) { const int st = b / 1024, sb = b % 1024, swz = sb ^ (((sb >> 9) & 1) << 5); R = (st >> 1) * 16 + swz / 64; C = (st & 1) * 32 + (swz % 64) / 2; }
__host__ __device__ __forceinline__ int perm32(int rho) { const int n = rho >> 4, i = rho & 15; return 8 * (i >> 2) + 4 * n + (i & 3); }

struct Unit { int pm, pn; };
struct Gemm { const bf16_t* A; const bf16_t* Bt; int M, N, K; };

struct StaticOrder {
    int nM, nN, nwg, G, c;
    __host__ __device__ void init(int M, int N, int G_, int c_) { nM = M / BM; nN = N / BM; nwg = nM * nN; G = G_; c = c_; }
    __host__ __device__ bool next(int i, Unit& u) const {
        const long L = (long)i * G + c; if (L >= nwg) return false;
        int wgid = (int)L; { const int q = nwg / NXCD, r = nwg % NXCD, xcd = wgid % NXCD, off = wgid / NXCD; wgid = (xcd < r ? xcd * (q + 1) : r * (q + 1) + (xcd - r) * q) + off; }
        const int nig = WGM * nN, gid = wgid / nig, fm = gid * WGM, gsz = (nM - fm) < WGM ? (nM - fm) : WGM;
        u.pm = fm + ((wgid % nig) % gsz); u.pn = (wgid % nig) / gsz; return true;
    }
    __device__ __forceinline__ void a_ready(const Unit&) const {}
    __device__ __forceinline__ void done(const Unit&) const {}
};

__device__ __forceinline__ unsigned cvt_pk_bf16(float lo, float hi) { unsigned r; asm volatile("v_cvt_pk_bf16_f32 %0, %1, %2" : "=v"(r) : "v"(lo), "v"(hi)); return r; }
template <int ACT  > struct EpiBf16 {
    static constexpr bool PERM = true, AFTER_DRAIN = false; static_assert(ACT == 0, "EpiBf16: only ACT 0 here");
    bf16_t* O; int ldc; const float* bias; int split_cols; size_t split_stride; float scale0;
    __device__ __forceinline__ void operator()(const f32x4 (&acc)[2][2][4][2], const Unit& u, int wr, int wc, int fr, int fq) const {
        const int row0 = u.pm * BM + wr * 64 + fr; int colt = u.pn * BM; bf16_t* base = O;
        float sc = 1.f; if (split_cols) { const int t = colt / split_cols; base += (size_t)t * split_stride; colt -= t * split_cols; if (t == 0) sc = scale0; }
        const int col0 = colt + wc * 32 + 8 * fq, bcol0 = u.pn * BM + wc * 32 + 8 * fq;
        f32x4 bv[2][2];
#pragma unroll
        for (int bj = 0; bj < 2; ++bj)
#pragma unroll
            for (int n = 0; n < 2; ++n) bv[bj][n] = bias ? *(const f32x4*)(bias + bcol0 + bj * HALF + 4 * n) : (f32x4){0.f, 0.f, 0.f, 0.f};
#pragma unroll
        for (int ai = 0; ai < 2; ++ai)
#pragma unroll
            for (int m = 0; m < 4; ++m) { bf16_t* rowp = base + (size_t)(row0 + ai * HALF + m * 16) * ldc + col0;
#pragma unroll
                for (int bj = 0; bj < 2; ++bj) { f32x4 v0 = acc[ai][bj][m][0] + bv[bj][0], v1 = acc[ai][bj][m][1] + bv[bj][1];
                    v0 = v0 * sc; v1 = v1 * sc; u32x4 w; w.x = cvt_pk_bf16(v0[0], v0[1]); w.y = cvt_pk_bf16(v0[2], v0[3]); w.z = cvt_pk_bf16(v1[0], v1[1]); w.w = cvt_pk_bf16(v1[2], v1[3]);
                    *(u32x4*)(rowp + bj * HALF) = w; } }
    }
};


struct EpiResF32 {
    static constexpr bool PERM = false, AFTER_DRAIN = false;
    const float* base; float* out; int ldc;
    __device__ __forceinline__ void operator()(const f32x4 (&acc)[2][2][4][2], const Unit& u, int wr, int wc, int fr, int fq) const {
        const int col0 = u.pn * BM + wc * 32 + 4 * fq;
#pragma unroll
        for (int ai = 0; ai < 2; ++ai)
#pragma unroll
            for (int m = 0; m < 4; ++m) { const size_t off = (size_t)(u.pm * BM + ai * HALF + wr * 64 + m * 16 + fr) * ldc + col0;
#pragma unroll
                for (int bj = 0; bj < 2; ++bj)
#pragma unroll
                    for (int n = 0; n < 2; ++n) { const f32x4 bs = *(const f32x4*)(base + off + bj * HALF + n * 16); *(f32x4*)(out + off + bj * HALF + n * 16) = bs + acc[ai][bj][m][n]; } }
    }
};
template <class Epi, class Sched, bool ALIGN_EPI = false, bool SP2 = false>
__device__ __forceinline__ void gemm_phase(PG8_LAS unsigned char* lds, const Gemm g, const Sched& S, const Epi& E) {
    const int tid = threadIdx.x, wid = __builtin_amdgcn_readfirstlane(tid >> 6), lane = tid & 63, wr = wid >> 2, wc = wid & 3, fr = lane & 15, fq = lane >> 4;
    const int K = g.K, nt = K / BK;
    unsigned voffA[2], voffB[2];
#pragma unroll
    for (int i = 0; i < 2; ++i) { int R, C; stage_rc(tid * 16 + i * 8192, R, C); const int Rb = Epi::PERM ? ((R & ~31) + perm32(R & 31)) : R;
        voffA[i] = (unsigned)(R * K + C) * 2u; voffB[i] = (unsigned)(Rb * K + C) * 2u; }
    const size_t kstep = (size_t)(BK * 2);
    const size_t hstep = (size_t)HALF * K * 2;
    const size_t tstep = 2 * hstep;
    const unsigned ldsw = (unsigned)wid * 1024u;
    const int aoff = lds_byte(wr * 64 + fr, fq * 8), boff = lds_byte(wc * 32 + fr, fq * 8);
#define PG8_SA(b, h) (((b) * 2 + (h)) * HTB)
#define PG8_SB(b, h) ((4 + (b) * 2 + (h)) * HTB)
#define PG8_STAGE(bufoff, gbase, voff) do { _Pragma("unroll") for (int _i = 0; _i < 2; ++_i) \
        __builtin_amdgcn_global_load_lds((const unsigned*)((const char*)(gbase) + (voff)[_i]), (PG8_LAS unsigned*)(lds + (bufoff) + ldsw + _i * 8192), 16, 0, 0); } while (0)
#define PG8_LDA(dst, b, h) do { _Pragma("unroll") for (int m = 0; m < 4; ++m) _Pragma("unroll") for (int k = 0; k < 2; ++k) dst[m][k] = *(const PG8_LAS bf16x8*)(lds + PG8_SA(b, h) + aoff + m * 2048 + k * 1024); } while (0)
#define PG8_LDB(dst, b, h) do { _Pragma("unroll") for (int n = 0; n < 2; ++n) _Pragma("unroll") for (int k = 0; k < 2; ++k) dst[n][k] = *(const PG8_LAS bf16x8*)(lds + PG8_SB(b, h) + boff + n * 2048 + k * 1024); } while (0)
#define PG8_MMA(ai, bj, At, Bt) do { __builtin_amdgcn_s_setprio(1); _Pragma("unroll") for (int m = 0; m < 4; ++m) _Pragma("unroll") for (int n = 0; n < 2; ++n) _Pragma("unroll") for (int k = 0; k < 2; ++k) \
        acc[ai][bj][m][n] = __builtin_amdgcn_mfma_f32_16x16x32_bf16(Bt[n][k], At[m][k], acc[ai][bj][m][n], 0, 0, 0); __builtin_amdgcn_s_setprio(0); } while (0)
#define PG8_WAIT_V(n) asm volatile("s_waitcnt vmcnt(" #n ")" ::: "memory")
#define PG8_WAIT_L(n) asm volatile("s_waitcnt lgkmcnt(" #n ")" ::: "memory")
#define PG8_BAR __builtin_amdgcn_s_barrier()
#define PG8_SCHED __builtin_amdgcn_sched_barrier(0)
    Unit cur, nxt; int ui = 0;
    if (!S.next(0, cur)) return;
    f32x4 acc[2][2][4][2];
#pragma unroll
    for (int a = 0; a < 2; ++a)
#pragma unroll
        for (int b = 0; b < 2; ++b)
#pragma unroll
            for (int m = 0; m < 4; ++m)
#pragma unroll
                for (int n = 0; n < 2; ++n) acc[a][b][m][n] = (f32x4){0.f, 0.f, 0.f, 0.f};
    bf16x8 At[4][2], B0[2][2], B1[2][2];
    const char* cA = (const char*)g.A + (size_t)cur.pm * tstep; const char* cB = (const char*)g.Bt + (size_t)cur.pn * tstep;
    S.a_ready(cur);
    if constexpr (SP2) {
        PG8_STAGE(PG8_SB(0, 0), cB, voffB); PG8_STAGE(PG8_SB(0, 1), cB + hstep, voffB); PG8_STAGE(PG8_SA(0, 0), cA, voffA); PG8_STAGE(PG8_SA(0, 1), cA + hstep, voffA);
        if (wr == 1) PG8_BAR;
        PG8_WAIT_V(2); PG8_BAR;
        PG8_STAGE(PG8_SB(1, 0), cB + kstep, voffB); PG8_STAGE(PG8_SA(1, 0), cA + kstep, voffA); PG8_STAGE(PG8_SB(1, 1), cB + hstep + kstep, voffB);
        PG8_WAIT_V(6); PG8_BAR;
    } else {
        PG8_STAGE(PG8_SB(0, 0), cB, voffB); PG8_STAGE(PG8_SA(0, 0), cA, voffA); PG8_STAGE(PG8_SB(0, 1), cB + hstep, voffB); PG8_STAGE(PG8_SA(0, 1), cA + hstep, voffA);
        if (wr == 1) PG8_BAR;
        PG8_WAIT_V(4); PG8_BAR;
        PG8_STAGE(PG8_SB(1, 0), cB + kstep, voffB); PG8_STAGE(PG8_SA(1, 0), cA + kstep, voffA); PG8_STAGE(PG8_SB(1, 1), cB + hstep + kstep, voffB);
        PG8_WAIT_V(6); PG8_BAR;
    }
    for (;;) {
        const bool has_next = S.next(ui + 1, nxt);
        const char* nA = has_next ? (const char*)g.A + (size_t)nxt.pm * tstep : cA; const char* nB = has_next ? (const char*)g.Bt + (size_t)nxt.pn * tstep : cB;
        for (int t = 0; t < nt; t += 2) {
            const bool last = (t == nt - 2);
            const char* a1 = cA + (size_t)(t + 1) * kstep;
            const char* a2 = last ? nA : cA + (size_t)(t + 2) * kstep; const char* b2 = last ? nB : cB + (size_t)(t + 2) * kstep;
            const char* a3 = a2 + kstep; const char* b3 = b2 + kstep;
            if (last && has_next) S.a_ready(nxt);
            if constexpr (SP2) {
            PG8_LDB(B0, 0, 0); PG8_LDB(B1, 0, 1); PG8_SCHED; PG8_LDA(At, 0, 0); PG8_STAGE(PG8_SA(1, 1), a1 + hstep, voffA);
            PG8_WAIT_V(8); PG8_WAIT_L(0); PG8_BAR; PG8_MMA(0, 0, At, B0); PG8_MMA(0, 1, At, B1); PG8_BAR; PG8_SCHED;
            PG8_LDA(At, 0, 1); PG8_STAGE(PG8_SB(0, 0), b2, voffB); PG8_STAGE(PG8_SB(0, 1), b2 + hstep, voffB); PG8_STAGE(PG8_SA(0, 0), a2, voffA);
            PG8_WAIT_V(8); PG8_WAIT_L(0); PG8_BAR; PG8_MMA(1, 0, At, B0); PG8_MMA(1, 1, At, B1); PG8_BAR; PG8_SCHED;
            PG8_LDB(B0, 1, 0); PG8_LDB(B1, 1, 1); PG8_SCHED; PG8_LDA(At, 1, 0); PG8_STAGE(PG8_SA(0, 1), a2 + hstep, voffA);
            PG8_WAIT_V(8); PG8_WAIT_L(0); PG8_BAR; PG8_MMA(0, 0, At, B0); PG8_MMA(0, 1, At, B1); PG8_BAR; PG8_SCHED;
            PG8_LDA(At, 1, 1); PG8_STAGE(PG8_SB(1, 0), b3, voffB); PG8_STAGE(PG8_SB(1, 1), b3 + hstep, voffB); PG8_STAGE(PG8_SA(1, 0), a3, voffA);
            PG8_WAIT_V(8); PG8_WAIT_L(0); PG8_BAR; PG8_MMA(1, 0, At, B0); PG8_MMA(1, 1, At, B1); PG8_BAR; PG8_SCHED;
            } else {
            PG8_LDB(B0, 0, 0); PG8_SCHED; PG8_LDA(At, 0, 0); PG8_STAGE(PG8_SA(1, 1), a1 + hstep, voffA);
            PG8_WAIT_L(8); PG8_BAR; PG8_WAIT_L(0); PG8_MMA(0, 0, At, B0); PG8_BAR; PG8_SCHED;
            PG8_LDB(B1, 0, 1); PG8_STAGE(PG8_SB(0, 0), b2, voffB);
            PG8_BAR; PG8_WAIT_L(0); PG8_MMA(0, 1, At, B1); PG8_BAR;
            PG8_LDA(At, 0, 1); PG8_STAGE(PG8_SA(0, 0), a2, voffA);
            PG8_BAR; PG8_WAIT_L(0); PG8_MMA(1, 0, At, B0); PG8_BAR; PG8_SCHED;
            PG8_STAGE(PG8_SB(0, 1), b2 + hstep, voffB);
            PG8_WAIT_V(6); PG8_BAR; PG8_MMA(1, 1, At, B1); PG8_BAR;
            PG8_LDB(B0, 1, 0); PG8_SCHED; PG8_LDA(At, 1, 0); PG8_STAGE(PG8_SA(0, 1), a2 + hstep, voffA);
            PG8_WAIT_L(8); PG8_BAR; PG8_WAIT_L(0); PG8_MMA(0, 0, At, B0); PG8_BAR; PG8_SCHED;
            PG8_LDB(B1, 1, 1); PG8_STAGE(PG8_SB(1, 0), b3, voffB);
            PG8_BAR; PG8_WAIT_L(0); PG8_MMA(0, 1, At, B1); PG8_BAR;
            PG8_LDA(At, 1, 1); PG8_STAGE(PG8_SA(1, 0), a3, voffA);
            PG8_BAR; PG8_WAIT_L(0); PG8_MMA(1, 0, At, B0); PG8_BAR; PG8_SCHED;
            PG8_STAGE(PG8_SB(1, 1), b3 + hstep, voffB);
            PG8_WAIT_V(6); PG8_BAR; PG8_MMA(1, 1, At, B1); PG8_BAR;
            }
        }
        if constexpr (ALIGN_EPI) { if (wr == 0) PG8_BAR; }
        if constexpr (!Epi::AFTER_DRAIN) { E(acc, cur, wr, wc, fr, fq); S.done(cur); }
        if (!has_next) break;
#pragma unroll
        for (int a = 0; a < 2; ++a)
#pragma unroll
            for (int b = 0; b < 2; ++b)
#pragma unroll
                for (int m = 0; m < 4; ++m)
#pragma unroll
                    for (int n = 0; n < 2; ++n) acc[a][b][m][n] = (f32x4){0.f, 0.f, 0.f, 0.f};
        cur = nxt; cA = nA; cB = nB; ++ui;
        if constexpr (ALIGN_EPI) { if (wr == 1) PG8_BAR; }
    }
    PG8_WAIT_V(0);
    if constexpr (!ALIGN_EPI) { if (wr == 0) PG8_BAR; }
    PG8_BAR;
    if constexpr (Epi::AFTER_DRAIN) { E.fused(acc, cur, wr, wc, fr, fq, lds, wid, lane); S.done(cur); }
#undef PG8_SA
#undef PG8_SB
#undef PG8_STAGE
#undef PG8_LDA
#undef PG8_LDB
#undef PG8_MMA
#undef PG8_WAIT_V
#undef PG8_WAIT_L
#undef PG8_BAR
#undef PG8_SCHED
}
}

struct Params {
    const float* x_in; const float* norm_mix; const float* norm_ffn; const float* w_in; const float* w_out;
    const float* diff_q_gain; const float* diff_k_gain; const float* diff_lambda; const float* diff_sub_gain;
    const float* mlstm_conv; const float* mlstm_gate_bias; const float* mlstm_out_gain; const float* hgrn_lb; const float* hgrn_out_gain;
    const float* nsa_cmp_pos; const float* nsa_cmp_w1; const float* nsa_cmp_w2; const float* nsa_q_gain; const float* nsa_k_gain; const float* nsa_out_gain;
    const float* moe_w_group; const float* moe_b_group; const float* moe_w_expert; const float* moe_b_expert;
    const float* moe_w_gate; const float* moe_w_up; const float* moe_w_down;
    float* out; char* ws;
};


constexpr size_t al256(size_t x) { return (x + 255) & ~(size_t)255; }
constexpr size_t WS_P = 0;
constexpr size_t WS_TB = WS_P + al256((size_t)MT * LDP * 2);
constexpr size_t WS_MIXED = WS_TB + al256((size_t)MT * DM * 2);
constexpr size_t WS_DQ = WS_MIXED + al256((size_t)MT * DM * 2);
constexpr size_t WS_DK = WS_DQ + al256((size_t)MT * 256 * 4);
constexpr size_t WS_NQ = WS_DK + al256((size_t)MT * 256 * 4);
constexpr size_t WS_KSN = WS_NQ + al256((size_t)MT * 256 * 4);
constexpr size_t WS_KWN = WS_KSN + al256((size_t)MT * 64 * 4);
constexpr size_t WS_CMP = WS_KWN + al256((size_t)MT * 64 * 4);
constexpr size_t WS_OCMP = WS_CMP + al256((size_t)2 * NB * NCMP * 64 * 4);
constexpr size_t WS_IMP = WS_OCMP + al256((size_t)MT * 256 * 4);
constexpr size_t WS_SELMASK = WS_IMP + al256((size_t)MT * 64 * 4);
constexpr size_t WS_RE = WS_SELMASK + al256((size_t)MT * 8);
constexpr size_t WS_RW = WS_RE + al256((size_t)MT * 2 * 4);
constexpr size_t WS_WIN_T = WS_RW + al256((size_t)MT * 2 * 4);
constexpr size_t WS_WOUT_T = WS_WIN_T + al256((size_t)LDP * DM * 2);
constexpr size_t WS_END = WS_WOUT_T + al256((size_t)DM * DM * 2);
#define W_P ((bf16_t*)(pq->ws + WS_P))
#define W_TB ((bf16_t*)(pq->ws + WS_TB))
#define W_MIXED ((bf16_t*)(pq->ws + WS_MIXED))
#define W_DQ ((float*)(pq->ws + WS_DQ))
#define W_DK ((float*)(pq->ws + WS_DK))
#define W_DO ((float*)(pq->ws + WS_TB))
#define W_NQ ((float*)(pq->ws + WS_NQ))
#define W_KSN ((float*)(pq->ws + WS_KSN))
#define W_KWN ((float*)(pq->ws + WS_KWN))
#define W_CMP ((float*)(pq->ws + WS_CMP))
#define W_OCMP ((float*)(pq->ws + WS_OCMP))
#define W_IMP ((float*)(pq->ws + WS_IMP))
#define W_OSEL W_DQ
#define W_OWIN W_DK
#define W_SELMASK ((unsigned long long*)(pq->ws + WS_SELMASK))
#define W_RE ((int*)(pq->ws + WS_RE))
#define W_RW ((float*)(pq->ws + WS_RW))
#define W_WIN_T ((bf16_t*)(pq->ws + WS_WIN_T))
#define W_WOUT_T ((bf16_t*)(pq->ws + WS_WOUT_T))

__device__ __forceinline__ void norm_row(const float* x, const float* gain, bf16_t* t, int row, int lane) {
    const float4* xr = (const float4*)(x + (size_t)row * DM);
    float4 v[4]; float s = 0.f;
#pragma unroll
    for (int j = 0; j < 4; ++j) { v[j] = xr[lane + 64 * j]; s += v[j].x * v[j].x + v[j].y * v[j].y + v[j].z * v[j].z + v[j].w * v[j].w; }
    const float r = rsqrtf(wave_sum(s, lane) * (1.f / DM) + EPS);
#pragma unroll
    for (int j = 0; j < 4; ++j) {
        const float4 g = ((const float4*)gain)[lane + 64 * j];
        ushort4 o; o.x = f2bf(v[j].x * r * g.x); o.y = f2bf(v[j].y * r * g.y); o.z = f2bf(v[j].z * r * g.z); o.w = f2bf(v[j].w * r * g.w);
        ((ushort4*)(t + (size_t)row * DM))[lane + 64 * j] = o;
    }
}


typedef __attribute__((address_space(3))) float lds_f32;
typedef unsigned v4u_t __attribute__((ext_vector_type(4)));
__device__ __forceinline__ unsigned pk2bf(float lo, float hi) { return (unsigned)f2bf(lo) | ((unsigned)f2bf(hi) << 16); }
template <bool MAP>
__device__ __forceinline__ void transpose_item(const float* W, int K, int Nsrc, int Nnew, bf16_t* WT, lds_f32* scr, int item, int lane) {
    const int nblk = Nnew / 32, kb = item / nblk, nb = item % nblk, k0 = 64 * kb, n0 = 32 * nb;
    const int n = n0 + (lane & 31); const int sc = MAP ? src_col(n) : n; const bool ok = MAP ? (n < IN_COLS) : true;
#pragma unroll 8
    for (int i = 0; i < 32; ++i) { const int kk = 2 * i + (lane >> 5); scr[kk * 33 + (lane & 31)] = ok ? W[(size_t)(k0 + kk) * Nsrc + sc] : 0.f; }
    asm volatile("s_waitcnt lgkmcnt(0)" ::: "memory");
    const int c = lane & 7;
#pragma unroll
    for (int j = 0; j < 4; ++j) { const int nn = (lane >> 3) + 8 * j; const lds_f32* sp = scr + (8 * c) * 33 + nn;
        v4u_t o; o.x = pk2bf(sp[0 * 33], sp[1 * 33]); o.y = pk2bf(sp[2 * 33], sp[3 * 33]); o.z = pk2bf(sp[4 * 33], sp[5 * 33]); o.w = pk2bf(sp[6 * 33], sp[7 * 33]);
        *(v4u_t*)(WT + (size_t)(n0 + nn) * K + k0 + 8 * c) = o; }
    asm volatile("s_waitcnt lgkmcnt(0)" ::: "memory");
}

template <int G>
__device__ __forceinline__ void group_norm_item(const bf16_t* P, int col0, int ngroups, const float* gain, float scale, float* out, int ldo, int idx) {
    const int m = idx / ngroups, g = idx % ngroups;
    const bf16_t* p = P + (size_t)m * LDP + col0 + g * G;
    float v[G]; float s = 0.f;
#pragma unroll
    for (int d = 0; d < G; ++d) { v[d] = bf2f(p[d]); s += v[d] * v[d]; }
    const float r = rsqrtf(s * (1.f / G) + EPS) * scale;
#pragma unroll
    for (int d = 0; d < G; ++d) out[(size_t)m * ldo + g * G + d] = v[d] * r * gain[d];
}

__device__ __forceinline__ void diff_attn_item(const float* qn, const float* kn, const bf16_t* P, float* O, int item, int lane) {
    const int tb = item & 63, c = (item >> 6) & 1, h = (item >> 7) & 3, b = item >> 9;
    const int t = tb * 64 + lane;
    const float slope = exp2f(-(float)(2 * h + 1));
    float q[32], o[64];
#pragma unroll
    for (int d = 0; d < 32; ++d) q[d] = qn[(size_t)(b * SEQ + t) * 256 + h * 64 + c * 32 + d];
#pragma unroll
    for (int e = 0; e < 64; ++e) o[e] = 0.f;
    float mrun = NEG, l = 0.f;
    const int jmax = tb * 64 + 63;
    for (int j = 0; j <= jmax; ++j) {
        const float* kr = kn + (size_t)(b * SEQ + j) * 256 + h * 64 + c * 32;
        float s = 0.f;
#pragma unroll
        for (int d = 0; d < 32; ++d) s += q[d] * kr[d];
        s -= slope * (float)(t - j);
        if (j > t) s = NEG;
        const float mn = fmaxf(mrun, s), al = __expf(mrun - mn), p = (j > t) ? 0.f : __expf(s - mn);
        l = l * al + p; mrun = mn;
        const bf16_t* vr = P + (size_t)(b * SEQ + j) * LDP + PC_AV + h * 64;
#pragma unroll
        for (int e = 0; e < 64; ++e) o[e] = o[e] * al + p * bf2f(vr[e]);
    }
    const float il = 1.f / l;
    float* op = O + ((size_t)(b * SEQ + t) * 8 + h * 2 + c) * 64;
#pragma unroll
    for (int e = 0; e < 64; ++e) op[e] = o[e] * il;
}
__device__ __forceinline__ void diff_combine_item(const float* O, const float* lamv, const float* subg, float lam_init, bf16_t* mixed, int idx) {
    const int m = idx >> 2, h = idx & 3;
    float d01 = 0.f, d23 = 0.f;
    for (int i = 0; i < 32; ++i) { d01 += lamv[i] * lamv[32 + i]; d23 += lamv[64 + i] * lamv[96 + i]; }
    const float lam = __expf(d01) - __expf(d23) + lam_init;
    const float* o0 = O + ((size_t)m * 8 + h * 2) * 64; const float* o1 = o0 + 64;
    float v[64]; float s = 0.f;
#pragma unroll
    for (int e = 0; e < 64; ++e) { v[e] = o0[e] - lam * o1[e]; s += v[e] * v[e]; }
    const float r = rsqrtf(s * (1.f / 64) + EPS) * (1.f - lam_init);
#pragma unroll
    for (int e = 0; e < 64; ++e) mixed[(size_t)m * DM + h * 64 + e] = f2bf(v[e] * r * subg[h * 64 + e]);
}

__device__ __forceinline__ void mlstm_rec_item(const bf16_t* P, const float* cw, const float* gbias, const float* outg, bf16_t* mixed, int item, int lane) {
    const int b = item >> 2, h = item & 3;
    float C[64]; float nvec = 0.f;
#pragma unroll
    for (int k = 0; k < 64; ++k) C[k] = 0.f;
    const float bi = gbias[h], bfz = gbias[4 + h], og = outg[h * 64 + lane];
    for (int t = 0; t < SEQ; ++t) {
        const size_t m = (size_t)b * SEQ + t;
        float qv = 0.f, kv = 0.f;
#pragma unroll
        for (int k = 0; k < 4; ++k) { const int tt = t - 3 + k; if (tt >= 0) {
            qv += cw[k * 512 + h * 64 + lane] * bf2f(P[(m - 3 + k) * LDP + PC_BQ + h * 64 + lane]);
            kv += cw[k * 512 + 256 + h * 64 + lane] * bf2f(P[(m - 3 + k) * LDP + PC_BK + h * 64 + lane]); } }
        qv = siluf_(qv) * 0.125f; kv = siluf_(kv);
        const float ve = bf2f(P[m * LDP + PC_BV + h * 64 + lane]);
        const float ipre = bf2f(P[m * LDP + PC_BI + h]) + bi, fpre = bf2f(P[m * LDP + PC_BF + h]) + bfz;
        const float f = sigmoidf_(fpre), ei = __expf(ipre);
        const float kse = kv * ei;
        float num = 0.f;
        nvec = f * nvec + kse;
        const float den = wave_sum(qv * nvec, lane);
#pragma unroll
        for (int k = 0; k < 64; ++k) {
            const float sk = rdlane(kse, k), sq = rdlane(qv, k);
            C[k] = f * C[k] + sk * ve;
            num += sq * C[k];
        }
        const float hv = num / fmaxf(fabsf(den), 1.f);
        const float r = rsqrtf(wave_sum(hv * hv, lane) * (1.f / 64) + EPS);
        const float go = sigmoidf_(bf2f(P[m * LDP + PC_BO + h * 64 + lane]));
        mixed[m * DM + 256 + h * 64 + lane] = f2bf(hv * r * og * go);
    }
}
__device__ __forceinline__ void hgrn_rec_item(const bf16_t* P, const float* lbp, int layer, const float* outg, bf16_t* mixed, int item, int lane) {
    const int b = item >> 2, h = item & 3;
    float S[64];
#pragma unroll
    for (int k = 0; k < 64; ++k) S[k] = 0.f;
    float lb = 0.f;
    if (layer == 1) lb = sigmoidf_(lbp[256 + h * 64 + lane] - lbp[h * 64 + lane]);
    const float og = outg[h * 64 + lane];
    for (int t = 0; t < SEQ; ++t) {
        const size_t m = (size_t)b * SEQ + t;
        const float z = bf2f(P[m * LDP + PC_CF + h * 64 + lane]);
        const float f = lb + (1.f - lb) * sigmoidf_(z), kk = 1.f - f;
        const float qv = siluf_(bf2f(P[m * LDP + PC_CQ + h * 64 + lane]));
        const float ve = bf2f(P[m * LDP + PC_CI + h * 64 + lane]);
        float o = 0.f;
#pragma unroll
        for (int k = 0; k < 64; ++k) {
            const float sa = rdlane(f, k), sk = rdlane(kk, k), sq = rdlane(qv, k);
            S[k] = sa * S[k] + sk * ve; o += sq * S[k];
        }
        const float r = rsqrtf(wave_sum(o * o, lane) * (1.f / 64) + EPS);
        const float gg = sigmoidf_(bf2f(P[m * LDP + PC_CG + h * 64 + lane]));
        mixed[m * DM + 512 + h * 64 + lane] = f2bf(o * r * og * gg);
    }
}

__device__ __forceinline__ void nsa_compress_vb(const bf16_t* P, const float* pos, const float* w1, const float* w2, const float* kgain0, float* cmp, int vb, int tid, float* ldsf) {
    float (*red)[64] = (float (*)[64])ldsf; float* hid = ldsf + 256;
    const int n = vb % NCMP, b = (vb / NCMP) % NB, j = vb / (NCMP * NB);
    const int o = tid & 63, part = tid >> 6;
    const int pc = j == 0 ? PC_KC : PC_VC;
    float acc = 0.f;
    for (int l = part * 8; l < part * 8 + 8; ++l) {
        const bf16_t* row = P + (size_t)(b * SEQ + 16 * n + l) * LDP + pc;
        for (int d = 0; d < 64; ++d) acc += (bf2f(row[d]) + pos[(j * 32 + l) * 64 + d]) * w1[((size_t)j * 2048 + l * 64 + d) * 64 + o];
    }
    red[part][o] = acc; __syncthreads();
    if (part == 0) {
        const float x = red[0][o] + red[1][o] + red[2][o] + red[3][o];
        hid[o] = 0.5f * x * (1.f + tanhf(0.7978845608028654f * (x + 0.044715f * x * x * x)));
    }
    __syncthreads();
    if (part == 0) {
        float y = 0.f;
        for (int i = 0; i < 64; ++i) y += hid[i] * w2[(j * 64 + i) * 64 + o];
        if (j == 0) { const float r = rsqrtf(wave_sum(y * y, o) * (1.f / 64) + EPS); y = y * r * kgain0[o]; }
        cmp[(((size_t)j * NB + b) * NCMP + n) * 64 + o] = y;
    }
    __syncthreads();
}
__device__ __forceinline__ void nsa_cmp_attn_item(const float* qn, const float* cmp, float* ocmp, float* imp, int item, int lane) {
    const int m = item * 64 + lane; const int b = m / SEQ, t = m % SEQ;
    const float* kc = cmp + (size_t)b * NCMP * 64; const float* vc = cmp + ((size_t)NB + b) * NCMP * 64;
    float* im = imp + (size_t)m * 64;
    for (int j = 0; j < 64; ++j) im[j] = 0.f;
    const int nv = t >= 31 ? (t - 31) / 16 + 1 : 0;
#pragma unroll 1
    for (int h = 0; h < 4; ++h) {
        const float slope = exp2f(-(float)(2 * h + 2));
        float q[64], o[64];
#pragma unroll
        for (int d = 0; d < 64; ++d) { q[d] = qn[(size_t)m * 256 + h * 64 + d]; o[d] = 0.f; }
        float mx = NEG;
#pragma unroll 1
        for (int n = 0; n < nv; ++n) { float s = 0.f;
#pragma unroll
            for (int d = 0; d < 32; ++d) s += q[d] * kc[n * 64 + d];
            asm volatile("" ::: "memory");
#pragma unroll
            for (int d = 32; d < 64; ++d) s += q[d] * kc[n * 64 + d];
            asm volatile("" ::: "memory");
            s -= slope * (float)(t - (16 * n + 31)); mx = fmaxf(mx, s); }
        float l = 0.f;
#pragma unroll 1
        for (int n = 0; n < nv; ++n) { float s = 0.f;
#pragma unroll
            for (int d = 0; d < 32; ++d) s += q[d] * kc[n * 64 + d];
            asm volatile("" ::: "memory");
#pragma unroll
            for (int d = 32; d < 64; ++d) s += q[d] * kc[n * 64 + d];
            asm volatile("" ::: "memory");
            s -= slope * (float)(t - (16 * n + 31)); l += __expf(s - mx); }
        const float il = nv > 0 ? 1.f / l : 0.f;
#pragma unroll 1
        for (int n = 0; n < nv; ++n) { float s = 0.f;
#pragma unroll
            for (int d = 0; d < 32; ++d) s += q[d] * kc[n * 64 + d];
            asm volatile("" ::: "memory");
#pragma unroll
            for (int d = 32; d < 64; ++d) s += q[d] * kc[n * 64 + d];
            asm volatile("" ::: "memory");
            s -= slope * (float)(t - (16 * n + 31));
            const float p = __expf(s - mx) * il;
            asm volatile("" ::: "memory");
#pragma unroll
            for (int d = 0; d < 32; ++d) o[d] += p * vc[n * 64 + d];
            asm volatile("" ::: "memory");
#pragma unroll
            for (int d = 32; d < 64; ++d) o[d] += p * vc[n * 64 + d];
            asm volatile("" ::: "memory");
            const int jb = n >> 2, r = n & 3;
            if (r < 3) im[jb] += p; else { im[jb] += 0.5f * p; if (jb + 1 < 64) im[jb + 1] += 0.5f * p; }
        }
#pragma unroll
        for (int d = 0; d < 64; ++d) ocmp[((size_t)m * 4 + h) * 64 + d] = o[d];
    }
}
__device__ __forceinline__ void nsa_topk_item(const float* imp, unsigned long long* selmask, int m) {
    const int t = m % SEQ, qb = t >> 6;
    const float* im = imp + (size_t)m * 64;
    unsigned long long mask = 0ull;
    for (int j = 0; j < 64; ++j) {
        float vj = j <= qb ? im[j] : -1.f; if (j == 0 || j == qb || j == qb - 1) vj = 2.f;
        int rank = 0;
        for (int i = 0; i < 64; ++i) {
            float vi = i <= qb ? im[i] : -1.f; if (i == 0 || i == qb || i == qb - 1) vi = 2.f;
            rank += (vi > vj || (vi == vj && i < j)) ? 1 : 0;
        }
        if (rank < 16) mask |= 1ull << j;
    }
    selmask[m] = mask;
}
template <int KIND>
__device__ __forceinline__ void nsa_branch_item(const float* qn, const float* kn, const bf16_t* P, const unsigned long long* selmask, float* obr, int item, int lane) {
    const int h = item & 3, m = (item >> 2) * 64 + lane; const int b = m / SEQ, t = m % SEQ;
    const float slope = exp2f(-(float)(2 * h + 2));
    float q[64], o[64];
#pragma unroll
    for (int d = 0; d < 64; ++d) { q[d] = qn[(size_t)m * 256 + h * 64 + d]; o[d] = 0.f; }
    float mrun = NEG, l = 0.f;
    const int pcv = KIND == 0 ? PC_VS : PC_VW;
    if (KIND == 0) {
        const unsigned long long mask = selmask[m];
        for (int jb = 0; jb < 64; ++jb) {
            if (!((mask >> jb) & 1ull)) continue;
            for (int i = 0; i < 64; ++i) {
                const int kp = jb * 64 + i; if (kp > t) break;
                const float* kr = kn + (size_t)(b * SEQ + kp) * 64; float s = 0.f;
#pragma unroll
                for (int d = 0; d < 64; ++d) s += q[d] * kr[d];
                s -= slope * (float)(t - kp);
                const float mn = fmaxf(mrun, s), al = __expf(mrun - mn), p = __expf(s - mn);
                l = l * al + p; mrun = mn;
                const bf16_t* vr = P + (size_t)(b * SEQ + kp) * LDP + pcv;
#pragma unroll
                for (int d = 0; d < 64; ++d) o[d] = o[d] * al + p * bf2f(vr[d]);
            }
        }
    } else {
        const int k0 = t - 511 > 0 ? t - 511 : 0;
        for (int kp = k0; kp <= t; ++kp) {
            const float* kr = kn + (size_t)(b * SEQ + kp) * 64; float s = 0.f;
#pragma unroll
            for (int d = 0; d < 64; ++d) s += q[d] * kr[d];
            s -= slope * (float)(t - kp);
            const float mn = fmaxf(mrun, s), al = __expf(mrun - mn), p = __expf(s - mn);
            l = l * al + p; mrun = mn;
            const bf16_t* vr = P + (size_t)(b * SEQ + kp) * LDP + pcv;
#pragma unroll
            for (int d = 0; d < 64; ++d) o[d] = o[d] * al + p * bf2f(vr[d]);
        }
    }
    const float il = 1.f / l;
#pragma unroll
    for (int d = 0; d < 64; ++d) obr[((size_t)m * 4 + h) * 64 + d] = o[d] * il;
}
__device__ __forceinline__ void nsa_combine_item(const bf16_t* P, const float* ocmp, const float* osel, const float* owin, const float* outg, bf16_t* mixed, int idx) {
    const int m = idx >> 2, h = idx & 3;
    const float g0 = sigmoidf_(bf2f(P[(size_t)m * LDP + PC_DG + h * 3 + 0])), g1 = sigmoidf_(bf2f(P[(size_t)m * LDP + PC_DG + h * 3 + 1])),
                g2 = sigmoidf_(bf2f(P[(size_t)m * LDP + PC_DG + h * 3 + 2]));
    const size_t base = ((size_t)m * 4 + h) * 64;
    float v[64]; float s = 0.f;
#pragma unroll
    for (int d = 0; d < 64; ++d) { v[d] = g0 * ocmp[base + d] + g1 * osel[base + d] + g2 * owin[base + d]; s += v[d] * v[d]; }
    const float r = rsqrtf(s * (1.f / 64) + EPS);
#pragma unroll
    for (int d = 0; d < 64; ++d) mixed[(size_t)m * DM + 768 + h * 64 + d] = f2bf(v[d] * r * outg[h * 64 + d]);
}

__device__ __forceinline__ void moe_route_row(const float* x, const float* gain, const float* wg, const float* bg, const float* we, const float* be, bf16_t* t, int* re, float* rw,
                                              int row, int lane) {
    const float4* xr = (const float4*)(x + (size_t)row * DM);
    float4 v[4]; float s = 0.f;
#pragma unroll
    for (int j = 0; j < 4; ++j) { v[j] = xr[lane + 64 * j]; s += v[j].x * v[j].x + v[j].y * v[j].y + v[j].z * v[j].z + v[j].w * v[j].w; }
    const float r = rsqrtf(wave_sum(s, lane) * (1.f / DM) + EPS);
    float lg[36];
#pragma unroll
    for (int o = 0; o < 36; ++o) lg[o] = 0.f;
#pragma unroll
    for (int j = 0; j < 4; ++j) {
        const float4 g = ((const float4*)gain)[lane + 64 * j];
        float tn[4] = {v[j].x * r * g.x, v[j].y * r * g.y, v[j].z * r * g.z, v[j].w * r * g.w};
        ushort4 o4; o4.x = f2bf(tn[0]); o4.y = f2bf(tn[1]); o4.z = f2bf(tn[2]); o4.w = f2bf(tn[3]);
        ((ushort4*)(t + (size_t)row * DM))[lane + 64 * j] = o4;
#pragma unroll
        for (int i = 0; i < 4; ++i) {
            const int k = (lane + 64 * j) * 4 + i;
            const float4 w4 = ((const float4*)wg)[k];
            lg[0] += tn[i] * w4.x; lg[1] += tn[i] * w4.y; lg[2] += tn[i] * w4.z; lg[3] += tn[i] * w4.w;
#pragma unroll
            for (int e4 = 0; e4 < 8; ++e4) { const float4 w = ((const float4*)we)[k * 8 + e4];
                lg[4 + e4 * 4 + 0] += tn[i] * w.x; lg[4 + e4 * 4 + 1] += tn[i] * w.y; lg[4 + e4 * 4 + 2] += tn[i] * w.z; lg[4 + e4 * 4 + 3] += tn[i] * w.w; }
        }
    }
#pragma unroll
    for (int o = 0; o < 36; ++o) lg[o] = wave_sum(lg[o], lane);
    float gl[4]; float gmx = NEG; int gs = 0;
#pragma unroll
    for (int g = 0; g < 4; ++g) { gl[g] = lg[g] + bg[g]; if (gl[g] > gmx) { gmx = gl[g]; gs = g; } }
    float gz = 0.f;
#pragma unroll
    for (int g = 0; g < 4; ++g) gz += __expf(gl[g] - gmx);
    const float gprob = 1.f / gz;
    float el[8];
#pragma unroll
    for (int e = 0; e < 8; ++e) {
        const float a0 = lg[4 + e] + be[e], a1 = lg[12 + e] + be[8 + e], a2 = lg[20 + e] + be[16 + e], a3 = lg[28 + e] + be[24 + e];
        el[e] = gs == 0 ? a0 : (gs == 1 ? a1 : (gs == 2 ? a2 : a3));
    }
    float m1 = NEG; int i1 = 0;
#pragma unroll
    for (int e = 0; e < 8; ++e) if (el[e] > m1) { m1 = el[e]; i1 = e; }
    float m2 = NEG; int i2 = 0;
#pragma unroll
    for (int e = 0; e < 8; ++e) if (e != i1 && el[e] > m2) { m2 = el[e]; i2 = e; }
    const float p2 = __expf(m2 - m1);
    const float w1 = gprob / (1.f + p2), w2 = gprob * p2 / (1.f + p2);
    if (lane == 0) { re[row * 2] = gs * 8 + i1; re[row * 2 + 1] = gs * 8 + i2; rw[row * 2] = w1; rw[row * 2 + 1] = w2; }
}
__device__ __forceinline__ void moe_naive_vb(const bf16_t* t, const int* re, const float* rw, const float* wgate, const float* wup, const float* wdown, float* x, int m, int tid, float* ldsf) {
    float* ts = ldsf; float* hs = ldsf + DM;
    for (int k = tid; k < DM; k += 256) ts[k] = bf2f(t[(size_t)m * DM + k]);
    __syncthreads();
    float acc[4] = {0.f, 0.f, 0.f, 0.f};
    for (int i = 0; i < 2; ++i) {
        const int e = re[m * 2 + i]; const float w = rw[m * 2 + i];
        const float* Wg = wgate + (size_t)e * DM * 256; const float* Wu = wup + (size_t)e * DM * 256; const float* Wd = wdown + (size_t)e * 256 * DM;
        float a = 0.f, u = 0.f;
        for (int k = 0; k < DM; ++k) { const float tv = ts[k]; a += tv * Wg[(size_t)k * 256 + tid]; u += tv * Wu[(size_t)k * 256 + tid]; }
        hs[tid] = siluf_(a) * u * w;
        __syncthreads();
        for (int f = 0; f < 256; ++f) { const float hv = hs[f];
#pragma unroll
            for (int j = 0; j < 4; ++j) acc[j] += hv * Wd[(size_t)f * DM + tid + 256 * j]; }
        __syncthreads();
    }
#pragma unroll
    for (int j = 0; j < 4; ++j) x[(size_t)m * DM + tid + 256 * j] += acc[j];
}

__global__ void __launch_bounds__(NTHR) mega_fwd(Params p_unused) {
    extern __shared__ __attribute__((aligned(16))) unsigned char lds[];
    cg::grid_group grid = cg::this_grid();
    const int G = gridDim.x, bid = blockIdx.x;
    typedef const __attribute__((address_space(4))) Params* cparams_t;
    const cparams_t pp = (cparams_t)__builtin_amdgcn_kernarg_segment_ptr();
#define PHASE_VARS \
    int tid = threadIdx.x; asm volatile("" : "+v"(tid)); \
    cparams_t pq = pp; asm volatile("" : "+s"(pq)); \
    const float* xcur = l == 0 ? pq->x_in : pq->out; (void)xcur; \
    const int lane = tid & 63, wave = tid >> 6, half = tid >> 8, tid256 = tid & 255; \
    const int gw = bid * NWAVE + wave, NGW = G * NWAVE; \
    const int gt = bid * NTHR + tid, NGT = G * NTHR; \
    float* ldsf = (float*)lds + half * 4096; \
    (void)lane; (void)tid256; (void)gw; (void)NGW; (void)gt; (void)NGT; (void)ldsf;

    for (int l = 0; l < DEPTH; ++l) {
        {   PHASE_VARS
        {   lds_f32* scr = (lds_f32*)lds + wave * (64 * 33);
            for (int it = gw; it < (DM / 64) * (LDP / 32); it += NGW) transpose_item<true>(pq->w_in + (size_t)l * DM * IN_COLS, DM, IN_COLS, LDP, W_WIN_T, scr, it, lane);
            for (int it = gw; it < (DM / 64) * (DM / 32); it += NGW) transpose_item<false>(pq->w_out + (size_t)l * DM * DM, DM, DM, DM, W_WOUT_T, scr, it, lane); }
        for (int row = gw; row < MT; row += NGW) norm_row(xcur, pq->norm_mix + l * DM, W_TB, row, lane);
        }
        grid.sync();
        {   PHASE_VARS
        {   pg8::Gemm g{W_TB, W_WIN_T, MT, LDP, DM}; pg8::StaticOrder S; S.init(MT, LDP, G, bid);
            pg8::EpiBf16<0> E{W_P, LDP, nullptr, 0, 0, 1.f};
            pg8::gemm_phase<pg8::EpiBf16<0>, pg8::StaticOrder, true, true>((PG8_LAS unsigned char*)lds, g, S, E); }
        }
        grid.sync();
        {   PHASE_VARS
        for (int i = gt; i < MT * 8; i += NGT) group_norm_item<32>(W_P, PC_AQ, 8, pq->diff_q_gain + l * 32, 0.17677669529663687f, W_DQ, 256, i);
        for (int i = gt; i < MT * 8; i += NGT) group_norm_item<32>(W_P, PC_AK, 8, pq->diff_k_gain + l * 32, 1.f, W_DK, 256, i);
        for (int i = gt; i < MT * 4; i += NGT) group_norm_item<64>(W_P, PC_DQ, 4, pq->nsa_q_gain + l * 64, 0.125f, W_NQ, 256, i);
        for (int i = gt; i < MT; i += NGT) group_norm_item<64>(W_P, PC_KS, 1, pq->nsa_k_gain + (l * 3 + 1) * 64, 1.f, W_KSN, 64, i);
        for (int i = gt; i < MT; i += NGT) group_norm_item<64>(W_P, PC_KW, 1, pq->nsa_k_gain + (l * 3 + 2) * 64, 1.f, W_KWN, 64, i);
        for (int it = bid; it < 2 * NB * NCMP / 2; it += G) { const int vb = it * 2 + half;
            nsa_compress_vb(W_P, pq->nsa_cmp_pos + l * 2 * 32 * 64, pq->nsa_cmp_w1 + (size_t)l * 2 * 2048 * 64, pq->nsa_cmp_w2 + l * 2 * 64 * 64, pq->nsa_k_gain + (l * 3 + 0) * 64, W_CMP, vb, tid256, ldsf); }
        }
        grid.sync();
        {   PHASE_VARS
        if (gw < 16) mlstm_rec_item(W_P, pq->mlstm_conv + l * 4 * 512, pq->mlstm_gate_bias + l * 8, pq->mlstm_out_gain + l * 256, W_MIXED, gw, lane);
        else if (gw < 32) hgrn_rec_item(W_P, pq->hgrn_lb, l, pq->hgrn_out_gain + l * 256, W_MIXED, gw - 16, lane);
        for (int it = gw; it < 2048; it += NGW) diff_attn_item(W_DQ, W_DK, W_P, W_DO, it, lane);
        for (int it = gw; it < 256; it += NGW) nsa_cmp_attn_item(W_NQ, W_CMP, W_OCMP, W_IMP, it, lane);
        }
        grid.sync();
        {   PHASE_VARS
        const float lam_init = 0.8f - 0.6f * __expf(-0.3f * (float)l);
        for (int i = gt; i < MT * 4; i += NGT) diff_combine_item(W_DO, pq->diff_lambda + l * 128, pq->diff_sub_gain + l * 256, lam_init, W_MIXED, i);
        for (int i = gt; i < MT; i += NGT) nsa_topk_item(W_IMP, W_SELMASK, i);
        }
        grid.sync();
        {   PHASE_VARS
        for (int it = gw; it < 1024; it += NGW) nsa_branch_item<0>(W_NQ, W_KSN, W_P, W_SELMASK, W_OSEL, it, lane);
        for (int it = gw; it < 1024; it += NGW) nsa_branch_item<1>(W_NQ, W_KWN, W_P, W_SELMASK, W_OWIN, it, lane);
        }
        grid.sync();
        {   PHASE_VARS
        for (int i = gt; i < MT * 4; i += NGT) nsa_combine_item(W_P, W_OCMP, W_OSEL, W_OWIN, pq->nsa_out_gain + l * 256, W_MIXED, i);
        }
        grid.sync();
        {   PHASE_VARS
        {   pg8::Gemm g{W_MIXED, W_WOUT_T, MT, DM, DM}; pg8::StaticOrder S; S.init(MT, DM, G, bid);
            pg8::EpiResF32 E{xcur, pq->out, DM};
            pg8::gemm_phase<pg8::EpiResF32, pg8::StaticOrder, true, true>((PG8_LAS unsigned char*)lds, g, S, E); }
        }
        grid.sync();
        {   PHASE_VARS
        for (int row = gw; row < MT; row += NGW)
            moe_route_row(pq->out, pq->norm_ffn + l * DM, pq->moe_w_group + l * DM * 4, pq->moe_b_group + l * 4, pq->moe_w_expert + l * DM * 32, pq->moe_b_expert + l * 32, W_TB, W_RE, W_RW, row, lane);
        }
        grid.sync();
        {   PHASE_VARS
        for (int it = bid; it < MT / 2; it += G) { const int m = it * 2 + half;
            moe_naive_vb(W_TB, W_RE, W_RW, pq->moe_w_gate + (size_t)l * 32 * DM * 256, pq->moe_w_up + (size_t)l * 32 * DM * 256, pq->moe_w_down + (size_t)l * 32 * 256 * DM, pq->out, m, tid256, ldsf); }
        }
        grid.sync();
    }
}
}

extern "C" void kernel_launch(void* const* d_in, const int* in_sizes, int n_in, void* d_out, int out_size, void* d_ws, size_t ws_size, hipStream_t stream) {
    Params p{};
    p.x_in = (const float*)d_in[0]; p.norm_mix = (const float*)d_in[1]; p.norm_ffn = (const float*)d_in[2]; p.w_in = (const float*)d_in[3]; p.w_out = (const float*)d_in[4];
    p.diff_q_gain = (const float*)d_in[5]; p.diff_k_gain = (const float*)d_in[6]; p.diff_lambda = (const float*)d_in[7]; p.diff_sub_gain = (const float*)d_in[8];
    p.mlstm_conv = (const float*)d_in[9]; p.mlstm_gate_bias = (const float*)d_in[10]; p.mlstm_out_gain = (const float*)d_in[11]; p.hgrn_lb = (const float*)d_in[12];
    p.hgrn_out_gain = (const float*)d_in[13]; p.nsa_cmp_pos = (const float*)d_in[14]; p.nsa_cmp_w1 = (const float*)d_in[15]; p.nsa_cmp_w2 = (const float*)d_in[16];
    p.nsa_q_gain = (const float*)d_in[17]; p.nsa_k_gain = (const float*)d_in[18]; p.nsa_out_gain = (const float*)d_in[19];
    p.moe_w_group = (const float*)d_in[20]; p.moe_b_group = (const float*)d_in[21]; p.moe_w_expert = (const float*)d_in[22]; p.moe_b_expert = (const float*)d_in[23];
    p.moe_w_gate = (const float*)d_in[24]; p.moe_w_up = (const float*)d_in[25]; p.moe_w_down = (const float*)d_in[26];
    p.out = (float*)d_out;

    p.ws = (char*)d_ws;
    if (WS_END > ws_size) { fprintf(stderr, "kernel_launch: workspace too small: need %zu, have %zu\n", (size_t)WS_END, ws_size); return; }

    static int grid_blocks = 0;
    if (!grid_blocks) {
        int dev = 0, cus = 0, per_cu = 0;
        hipGetDevice(&dev);
        hipDeviceGetAttribute(&cus, hipDeviceAttributeMultiprocessorCount, dev);
        hipFuncSetAttribute((const void*)mega_fwd, hipFuncAttributeMaxDynamicSharedMemorySize, LDS_BYTES);
        hipOccupancyMaxActiveBlocksPerMultiprocessor(&per_cu, (const void*)mega_fwd, NTHR, LDS_BYTES);
        if (per_cu < 1) per_cu = 1;
        if (per_cu > 1) per_cu = 1;
        grid_blocks = cus * per_cu;
    }
    void* args[] = {&p};
    hipError_t e = hipLaunchCooperativeKernel((const void*)mega_fwd, dim3(grid_blocks), dim3(NTHR), args, LDS_BYTES, stream);
    if (e != hipSuccess) fprintf(stderr, "cooperative launch failed: %s (grid %d)\n", hipGetErrorString(e), grid_blocks);
}
```

```cpp
#include <hip/hip_runtime.h>
#include <hip/hip_cooperative_groups.h>
#include <stdint.h>
#include <cstdio>
namespace cg = cooperative_groups;

namespace {
constexpr int DM = 1024, NB = 4, SEQ = 4096, DEPTH = 2, MT = NB * SEQ;
constexpr int IN_COLS = 3476, LDP = 3584;
constexpr float EPS = 1e-6f, NEG = -1e30f;
constexpr int PC_AQ = 0, PC_AK = 256, PC_AV = 512, PC_BQ = 768, PC_BK = 1024, PC_BV = 1280, PC_BO = 1536, PC_CQ = 1792, PC_CF = 2048,
              PC_CI = 2304, PC_CG = 2560, PC_DQ = 2816, PC_KC = 3072, PC_VC = 3136, PC_KS = 3200, PC_VS = 3264, PC_KW = 3328, PC_VW = 3392,
              PC_BI = 3456, PC_BF = 3460, PC_DG = 3464;
constexpr int NCMP = 255;
constexpr int NTHR = 512, NWAVE = 8;
constexpr int LDS_BYTES = 147456;

typedef unsigned short bf16_t;
__device__ __forceinline__ float bf2f(bf16_t v) { return __uint_as_float(((unsigned)v) << 16); }
__device__ __forceinline__ bf16_t f2bf(float f) { unsigned u = __float_as_uint(f); return (bf16_t)((u + 0x7fffu + ((u >> 16) & 1u)) >> 16); }
__device__ __forceinline__ int src_col(int c) { return c < 1536 ? c : (c < 3456 ? c + 8 : (c < 3460 ? c - 3456 + 1536 : (c < 3464 ? c - 3460 + 1540 : c))); }
__device__ __forceinline__ float sigmoidf_(float x) { return 1.f / (1.f + __expf(-x)); }
__device__ __forceinline__ float siluf_(float x) { return x / (1.f + __expf(-x)); }
__device__ __forceinline__ float wave_sum(float v, int lane) {
#pragma unroll
    for (int o = 1; o < 64; o <<= 1) v += __int_as_float(__builtin_amdgcn_ds_bpermute((lane ^ o) << 2, __float_as_int(v)));
    return v;
}
__device__ __forceinline__ float rdlane(float v, int k) { return __int_as_float(__builtin_amdgcn_readlane(__float_as_int(v), k)); }

namespace pg8 {
#define PG8_LAS __attribute__((address_space(3)))
typedef unsigned short bf16_t;
typedef short bf16x8 __attribute__((ext_vector_type(8)));
typedef float f32x4 __attribute__((ext_vector_type(4)));
typedef unsigned u32x4 __attribute__((ext_vector_type(4)));
constexpr int BM = 256, BK = 64, HALF = 128, HTB = HALF * BK * 2  , STAGE_BYTES = 8 * HTB, NXCD = 8, WGM = 8;

__host__ __device__ __forceinline__ int lds_byte(int r, int c) { const int st = (r >> 4) * 2 + (c >> 5), rr = r & 15, cc = c & 31, ob = rr * 64 + cc * 2; return st * 1024 + (ob ^ (((ob >> 9) & 1) << 5)); }
__host__ __device__ __forceinline__ void stage_rc(int b, int& R, int& C) { const int st = b / 1024, sb = b % 1024, swz = sb ^ (((sb >> 9) & 1) << 5); R = (st >> 1) * 16 + swz / 64; C = (st & 1) * 32 + (swz % 64) / 2; }
__host__ __device__ __forceinline__ int perm32(int rho) { const int n = rho >> 4, i = rho & 15; return 8 * (i >> 2) + 4 * n + (i & 3); }

struct Unit { int pm, pn; };
struct Gemm { const bf16_t* A; const bf16_t* Bt; int M, N, K; };

struct StaticOrder {
    int nM, nN, nwg, G, c;
    __host__ __device__ void init(int M, int N, int G_, int c_) { nM = M / BM; nN = N / BM; nwg = nM * nN; G = G_; c = c_; }
    __host__ __device__ bool next(int i, Unit& u) const {
        const long L = (long)i * G + c; if (L >= nwg) return false;
        int wgid = (int)L; { const int q = nwg / NXCD, r = nwg % NXCD, xcd = wgid % NXCD, off = wgid / NXCD; wgid = (xcd < r ? xcd * (q + 1) : r * (q + 1) + (xcd - r) * q) + off; }
        const int nig = WGM * nN, gid = wgid / nig, fm = gid * WGM, gsz = (nM - fm) < WGM ? (nM - fm) : WGM;
        u.pm = fm + ((wgid % nig) % gsz); u.pn = (wgid % nig) / gsz; return true;
    }
    __device__ __forceinline__ void a_ready(const Unit&) const {}
    __device__ __forceinline__ void done(const Unit&) const {}
};

__device__ __forceinline__ unsigned cvt_pk_bf16(float lo, float hi) { unsigned r; asm volatile("v_cvt_pk_bf16_f32 %0, %1, %2" : "=v"(r) : "v"(lo), "v"(hi)); return r; }
template <int ACT  > struct EpiBf16 {
    static constexpr bool PERM = true, AFTER_DRAIN = false; static_assert(ACT == 0, "EpiBf16: only ACT 0 here");
    bf16_t* O; int ldc; const float* bias; int split_cols; size_t split_stride; float scale0;
    __device__ __forceinline__ void operator()(const f32x4 (&acc)[2][2][4][2], const Unit& u, int wr, int wc, int fr, int fq) const {
        const int row0 = u.pm * BM + wr * 64 + fr; int colt = u.pn * BM; bf16_t* base = O;
        float sc = 1.f; if (split_cols) { const int t = colt / split_cols; base += (size_t)t * split_stride; colt -= t * split_cols; if (t == 0) sc = scale0; }
        const int col0 = colt + wc * 32 + 8 * fq, bcol0 = u.pn * BM + wc * 32 + 8 * fq;
        f32x4 bv[2][2];
#pragma unroll
        for (int bj = 0; bj < 2; ++bj)
#pragma unroll
            for (int n = 0; n < 2; ++n) bv[bj][n] = bias ? *(const f32x4*)(bias + bcol0 + bj * HALF + 4 * n) : (f32x4){0.f, 0.f, 0.f, 0.f};
#pragma unroll
        for (int ai = 0; ai < 2; ++ai)
#pragma unroll
            for (int m = 0; m < 4; ++m) { bf16_t* rowp = base + (size_t)(row0 + ai * HALF + m * 16) * ldc + col0;
#pragma unroll
                for (int bj = 0; bj < 2; ++bj) { f32x4 v0 = acc[ai][bj][m][0] + bv[bj][0], v1 = acc[ai][bj][m][1] + bv[bj][1];
                    v0 = v0 * sc; v1 = v1 * sc; u32x4 w; w.x = cvt_pk_bf16(v0[0], v0[1]); w.y = cvt_pk_bf16(v0[2], v0[3]); w.z = cvt_pk_bf16(v1[0], v1[1]); w.w = cvt_pk_bf16(v1[2], v1[3]);
                    *(u32x4*)(rowp + bj * HALF) = w; } }
    }
};


struct EpiResF32 {
    static constexpr bool PERM = false, AFTER_DRAIN = false;
    const float* base; float* out; int ldc;
    __device__ __forceinline__ void operator()(const f32x4 (&acc)[2][2][4][2], const Unit& u, int wr, int wc, int fr, int fq) const {
        const int col0 = u.pn * BM + wc * 32 + 4 * fq;
#pragma unroll
        for (int ai = 0; ai < 2; ++ai)
#pragma unroll
            for (int m = 0; m < 4; ++m) { const size_t off = (size_t)(u.pm * BM + ai * HALF + wr * 64 + m * 16 + fr) * ldc + col0;
#pragma unroll
                for (int bj = 0; bj < 2; ++bj)
#pragma unroll
                    for (int n = 0; n < 2; ++n) { const f32x4 bs = *(const f32x4*)(base + off + bj * HALF + n * 16); *(f32x4*)(out + off + bj * HALF + n * 16) = bs + acc[ai][bj][m][n]; } }
    }
};

struct EpiSwiglu {
    static constexpr bool PERM = true, AFTER_DRAIN = false;
    bf16_t* H; const float* row_w;
    __device__ __forceinline__ void operator()(const f32x4 (&acc)[2][2][4][2], const Unit& u, int wr, int wc, int fr, int fq) const {
        const int row0 = u.pm * BM + wr * 64 + fr, col0 = (u.pn & 1) * HALF + wc * 32 + 8 * fq;
#pragma unroll
        for (int ai = 0; ai < 2; ++ai)
#pragma unroll
            for (int m = 0; m < 4; ++m) { const int row = row0 + ai * HALF + m * 16; const float w = row_w[row];
                float h[8];
#pragma unroll
                for (int n = 0; n < 2; ++n)
#pragma unroll
                    for (int i = 0; i < 4; ++i) { const float g = acc[ai][0][m][n][i], up = acc[ai][1][m][n][i]; h[n * 4 + i] = g / (1.f + __expf(-g)) * up * w; }
                u32x4 o; o.x = cvt_pk_bf16(h[0], h[1]); o.y = cvt_pk_bf16(h[2], h[3]); o.z = cvt_pk_bf16(h[4], h[5]); o.w = cvt_pk_bf16(h[6], h[7]);
                *(u32x4*)(H + (size_t)row * 256 + col0) = o; }
    }
};
struct EpiScatterAdd {
    static constexpr bool PERM = false, AFTER_DRAIN = false;
    float* out; const int* row_tok;
    __device__ __forceinline__ void operator()(const f32x4 (&acc)[2][2][4][2], const Unit& u, int wr, int wc, int fr, int fq) const {
        const int col0 = (u.pn & 3) * BM + wc * 32 + 4 * fq;
#pragma unroll
        for (int ai = 0; ai < 2; ++ai)
#pragma unroll
            for (int m = 0; m < 4; ++m) { const int tok = row_tok[u.pm * BM + ai * HALF + wr * 64 + m * 16 + fr];
                if (tok >= 0) { float* o = out + (size_t)tok * 1024 + col0;
#pragma unroll
                    for (int bj = 0; bj < 2; ++bj)
#pragma unroll
                        for (int n = 0; n < 2; ++n)
#pragma unroll
                            for (int i = 0; i < 4; ++i) unsafeAtomicAdd(o + bj * HALF + n * 16 + i, acc[ai][bj][m][n][i]); } }
    }
};
struct MoeOrder {
    int G, c, ntiles, nsub; const PG8_LAS int* tile_e;
    __device__ __forceinline__ bool next(int i, Unit& u) const {
        const int L = i * G + c; if (L >= ntiles * nsub) return false;
        const int T = L / nsub, j = L - T * nsub; u.pm = T; u.pn = tile_e[T] * nsub + j; return true;
    }
    __device__ __forceinline__ void a_ready(const Unit&) const {}
    __device__ __forceinline__ void done(const Unit&) const {}
};
template <class Epi, class Sched, bool ALIGN_EPI = false, bool SP2 = false>
__device__ __forceinline__ void gemm_phase(PG8_LAS unsigned char* lds, const Gemm g, const Sched& S, const Epi& E) {
    int tid_ = threadIdx.x; asm volatile("" : "+v"(tid_));
    const int tid = tid_, wid = __builtin_amdgcn_readfirstlane(tid >> 6), lane = tid & 63, wr = wid >> 2, wc = wid & 3, fr = lane & 15, fq = lane >> 4;
    const int K = g.K, nt = K / BK;
    unsigned voffA[2], voffB[2];
#pragma unroll
    for (int i = 0; i < 2; ++i) { int R, C; stage_rc(tid * 16 + i * 8192, R, C); const int Rb = Epi::PERM ? ((R & ~31) + perm32(R & 31)) : R;
        voffA[i] = (unsigned)(R * K + C) * 2u; voffB[i] = (unsigned)(Rb * K + C) * 2u; }
    const size_t kstep = (size_t)(BK * 2);
    const size_t hstep = (size_t)HALF * K * 2;
    const size_t tstep = 2 * hstep;
    const unsigned ldsw = (unsigned)wid * 1024u;
    const int aoff = lds_byte(wr * 64 + fr, fq * 8), boff = lds_byte(wc * 32 + fr, fq * 8);
#define PG8_SA(b, h) (((b) * 2 + (h)) * HTB)
#define PG8_SB(b, h) ((4 + (b) * 2 + (h)) * HTB)
#define PG8_STAGE(bufoff, gbase, voff) do { _Pragma("unroll") for (int _i = 0; _i < 2; ++_i) \
        __builtin_amdgcn_global_load_lds((const unsigned*)((const char*)(gbase) + (voff)[_i]), (PG8_LAS unsigned*)(lds + (bufoff) + ldsw + _i * 8192), 16, 0, 0); } while (0)
#define PG8_LDA(dst, b, h) do { _Pragma("unroll") for (int m = 0; m < 4; ++m) _Pragma("unroll") for (int k = 0; k < 2; ++k) dst[m][k] = *(const PG8_LAS bf16x8*)(lds + PG8_SA(b, h) + aoff + m * 2048 + k * 1024); } while (0)
#define PG8_LDB(dst, b, h) do { _Pragma("unroll") for (int n = 0; n < 2; ++n) _Pragma("unroll") for (int k = 0; k < 2; ++k) dst[n][k] = *(const PG8_LAS bf16x8*)(lds + PG8_SB(b, h) + boff + n * 2048 + k * 1024); } while (0)
#define PG8_MMA(ai, bj, At, Bt) do { __builtin_amdgcn_s_setprio(1); _Pragma("unroll") for (int m = 0; m < 4; ++m) _Pragma("unroll") for (int n = 0; n < 2; ++n) _Pragma("unroll") for (int k = 0; k < 2; ++k) \
        acc[ai][bj][m][n] = __builtin_amdgcn_mfma_f32_16x16x32_bf16(Bt[n][k], At[m][k], acc[ai][bj][m][n], 0, 0, 0); __builtin_amdgcn_s_setprio(0); } while (0)
#define PG8_WAIT_V(n) asm volatile("s_waitcnt vmcnt(" #n ")" ::: "memory")
#define PG8_WAIT_L(n) asm volatile("s_waitcnt lgkmcnt(" #n ")" ::: "memory")
#define PG8_BAR __builtin_amdgcn_s_barrier()
#define PG8_SCHED __builtin_amdgcn_sched_barrier(0)
    Unit cur, nxt; int ui = 0;
    if (!S.next(0, cur)) return;
    f32x4 acc[2][2][4][2];
#pragma unroll
    for (int a = 0; a < 2; ++a)
#pragma unroll
        for (int b = 0; b < 2; ++b)
#pragma unroll
            for (int m = 0; m < 4; ++m)
#pragma unroll
                for (int n = 0; n < 2; ++n) acc[a][b][m][n] = (f32x4){0.f, 0.f, 0.f, 0.f};
    bf16x8 At[4][2], B0[2][2], B1[2][2];
    const char* cA = (const char*)g.A + (size_t)cur.pm * tstep; const char* cB = (const char*)g.Bt + (size_t)cur.pn * tstep;
    S.a_ready(cur);
    if constexpr (SP2) {
        PG8_STAGE(PG8_SB(0, 0), cB, voffB); PG8_STAGE(PG8_SB(0, 1), cB + hstep, voffB); PG8_STAGE(PG8_SA(0, 0), cA, voffA); PG8_STAGE(PG8_SA(0, 1), cA + hstep, voffA);
        if (wr == 1) PG8_BAR;
        PG8_WAIT_V(2); PG8_BAR;
        PG8_STAGE(PG8_SB(1, 0), cB + kstep, voffB); PG8_STAGE(PG8_SA(1, 0), cA + kstep, voffA); PG8_STAGE(PG8_SB(1, 1), cB + hstep + kstep, voffB);
        PG8_WAIT_V(6); PG8_BAR;
    } else {
        PG8_STAGE(PG8_SB(0, 0), cB, voffB); PG8_STAGE(PG8_SA(0, 0), cA, voffA); PG8_STAGE(PG8_SB(0, 1), cB + hstep, voffB); PG8_STAGE(PG8_SA(0, 1), cA + hstep, voffA);
        if (wr == 1) PG8_BAR;
        PG8_WAIT_V(4); PG8_BAR;
        PG8_STAGE(PG8_SB(1, 0), cB + kstep, voffB); PG8_STAGE(PG8_SA(1, 0), cA + kstep, voffA); PG8_STAGE(PG8_SB(1, 1), cB + hstep + kstep, voffB);
        PG8_WAIT_V(6); PG8_BAR;
    }
    for (;;) {
        const bool has_next = S.next(ui + 1, nxt);
        const char* nA = has_next ? (const char*)g.A + (size_t)nxt.pm * tstep : cA; const char* nB = has_next ? (const char*)g.Bt + (size_t)nxt.pn * tstep : cB;
        for (int t = 0; t < nt; t += 2) {
            const bool last = (t == nt - 2);
            const char* a1 = cA + (size_t)(t + 1) * kstep;
            const char* a2 = last ? nA : cA + (size_t)(t + 2) * kstep; const char* b2 = last ? nB : cB + (size_t)(t + 2) * kstep;
            const char* a3 = a2 + kstep; const char* b3 = b2 + kstep;
            if (last && has_next) S.a_ready(nxt);
            if constexpr (SP2) {
            PG8_LDB(B0, 0, 0); PG8_LDB(B1, 0, 1); PG8_SCHED; PG8_LDA(At, 0, 0); PG8_STAGE(PG8_SA(1, 1), a1 + hstep, voffA);
            PG8_WAIT_V(8); PG8_WAIT_L(0); PG8_BAR; PG8_MMA(0, 0, At, B0); PG8_MMA(0, 1, At, B1); PG8_BAR; PG8_SCHED;
            PG8_LDA(At, 0, 1); PG8_STAGE(PG8_SB(0, 0), b2, voffB); PG8_STAGE(PG8_SB(0, 1), b2 + hstep, voffB); PG8_STAGE(PG8_SA(0, 0), a2, voffA);
            PG8_WAIT_V(8); PG8_WAIT_L(0); PG8_BAR; PG8_MMA(1, 0, At, B0); PG8_MMA(1, 1, At, B1); PG8_BAR; PG8_SCHED;
            PG8_LDB(B0, 1, 0); PG8_LDB(B1, 1, 1); PG8_SCHED; PG8_LDA(At, 1, 0); PG8_STAGE(PG8_SA(0, 1), a2 + hstep, voffA);
            PG8_WAIT_V(8); PG8_WAIT_L(0); PG8_BAR; PG8_MMA(0, 0, At, B0); PG8_MMA(0, 1, At, B1); PG8_BAR; PG8_SCHED;
            PG8_LDA(At, 1, 1); PG8_STAGE(PG8_SB(1, 0), b3, voffB); PG8_STAGE(PG8_SB(1, 1), b3 + hstep, voffB); PG8_STAGE(PG8_SA(1, 0), a3, voffA);
            PG8_WAIT_V(8); PG8_WAIT_L(0); PG8_BAR; PG8_MMA(1, 0, At, B0); PG8_MMA(1, 1, At, B1); PG8_BAR; PG8_SCHED;
            } else {
            PG8_LDB(B0, 0, 0); PG8_SCHED; PG8_LDA(At, 0, 0); PG8_STAGE(PG8_SA(1, 1), a1 + hstep, voffA);
            PG8_WAIT_L(8); PG8_BAR; PG8_WAIT_L(0); PG8_MMA(0, 0, At, B0); PG8_BAR; PG8_SCHED;
            PG8_LDB(B1, 0, 1); PG8_STAGE(PG8_SB(0, 0), b2, voffB);
            PG8_BAR; PG8_WAIT_L(0); PG8_MMA(0, 1, At, B1); PG8_BAR;
            PG8_LDA(At, 0, 1); PG8_STAGE(PG8_SA(0, 0), a2, voffA);
            PG8_BAR; PG8_WAIT_L(0); PG8_MMA(1, 0, At, B0); PG8_BAR; PG8_SCHED;
            PG8_STAGE(PG8_SB(0, 1), b2 + hstep, voffB);
            PG8_WAIT_V(6); PG8_BAR; PG8_MMA(1, 1, At, B1); PG8_BAR;
            PG8_LDB(B0, 1, 0); PG8_SCHED; PG8_LDA(At, 1, 0); PG8_STAGE(PG8_SA(0, 1), a2 + hstep, voffA);
            PG8_WAIT_L(8); PG8_BAR; PG8_WAIT_L(0); PG8_MMA(0, 0, At, B0); PG8_BAR; PG8_SCHED;
            PG8_LDB(B1, 1, 1); PG8_STAGE(PG8_SB(1, 0), b3, voffB);
            PG8_BAR; PG8_WAIT_L(0); PG8_MMA(0, 1, At, B1); PG8_BAR;
            PG8_LDA(At, 1, 1); PG8_STAGE(PG8_SA(1, 0), a3, voffA);
            PG8_BAR; PG8_WAIT_L(0); PG8_MMA(1, 0, At, B0); PG8_BAR; PG8_SCHED;
            PG8_STAGE(PG8_SB(1, 1), b3 + hstep, voffB);
            PG8_WAIT_V(6); PG8_BAR; PG8_MMA(1, 1, At, B1); PG8_BAR;
            }
        }
        if constexpr (ALIGN_EPI) { if (wr == 0) PG8_BAR; }
        if constexpr (!Epi::AFTER_DRAIN) { E(acc, cur, wr, wc, fr, fq); S.done(cur); }
        if (!has_next) break;
#pragma unroll
        for (int a = 0; a < 2; ++a)
#pragma unroll
            for (int b = 0; b < 2; ++b)
#pragma unroll
                for (int m = 0; m < 4; ++m)
#pragma unroll
                    for (int n = 0; n < 2; ++n) acc[a][b][m][n] = (f32x4){0.f, 0.f, 0.f, 0.f};
        cur = nxt; cA = nA; cB = nB; ++ui;
        if constexpr (ALIGN_EPI) { if (wr == 1) PG8_BAR; }
    }
    PG8_WAIT_V(0);
    if constexpr (!ALIGN_EPI) { if (wr == 0) PG8_BAR; }
    PG8_BAR;
    if constexpr (Epi::AFTER_DRAIN) { E.fused(acc, cur, wr, wc, fr, fq, lds, wid, lane); S.done(cur); }
#undef PG8_SA
#undef PG8_SB
#undef PG8_STAGE
#undef PG8_LDA
#undef PG8_LDB
#undef PG8_MMA
#undef PG8_WAIT_V
#undef PG8_WAIT_L
#undef PG8_BAR
#undef PG8_SCHED
}
}

struct Params {
    const float* x_in; const float* norm_mix; const float* norm_ffn; const float* w_in; const float* w_out;
    const float* diff_q_gain; const float* diff_k_gain; const float* diff_lambda; const float* diff_sub_gain;
    const float* mlstm_conv; const float* mlstm_gate_bias; const float* mlstm_out_gain; const float* hgrn_lb; const float* hgrn_out_gain;
    const float* nsa_cmp_pos; const float* nsa_cmp_w1; const float* nsa_cmp_w2; const float* nsa_q_gain; const float* nsa_k_gain; const float* nsa_out_gain;
    const float* moe_w_group; const float* moe_b_group; const float* moe_w_expert; const float* moe_b_expert;
    const float* moe_w_gate; const float* moe_w_up; const float* moe_w_down;
    float* out; char* ws;
};


constexpr size_t al256(size_t x) { return (x + 255) & ~(size_t)255; }
constexpr size_t WS_P = 0;
constexpr size_t WS_TB = WS_P + al256((size_t)MT * LDP * 2);
constexpr size_t WS_MIXED = WS_TB + al256((size_t)MT * DM * 2);
constexpr size_t WS_DQ = WS_MIXED + al256((size_t)MT * DM * 2);
constexpr size_t WS_DK = WS_DQ + al256((size_t)MT * 256 * 4);
constexpr size_t WS_NQ = WS_DK + al256((size_t)MT * 256 * 4);
constexpr size_t WS_KSN = WS_NQ + al256((size_t)MT * 256 * 4);
constexpr size_t WS_KWN = WS_KSN + al256((size_t)MT * 64 * 4);
constexpr size_t WS_CMP = WS_KWN + al256((size_t)MT * 64 * 4);
constexpr size_t WS_OCMP = WS_CMP + al256((size_t)2 * NB * NCMP * 64 * 4);
constexpr size_t WS_IMP = WS_OCMP + al256((size_t)MT * 256 * 4);
constexpr size_t WS_SELMASK = WS_IMP + al256((size_t)MT * 64 * 4);
constexpr size_t WS_RE = WS_SELMASK + al256((size_t)MT * 8);
constexpr size_t WS_RW = WS_RE + al256((size_t)MT * 2 * 4);
constexpr size_t WS_RS = WS_RW + al256((size_t)MT * 2 * 4);
constexpr int MOE_ROWS_MAX = 2 * MT + 32 * 256;
constexpr size_t WS_ROWTOK = WS_RS + al256((size_t)MT * 2 * 4);
constexpr size_t WS_ROWW = WS_ROWTOK + al256((size_t)MOE_ROWS_MAX * 4);
constexpr size_t WS_CNT = WS_ROWW + al256((size_t)MOE_ROWS_MAX * 4);
constexpr size_t WS_WIN_T = WS_CNT + 256;
constexpr size_t WS_WOUT_T = WS_WIN_T + al256((size_t)LDP * DM * 2);
constexpr size_t WS_END = WS_WOUT_T + al256((size_t)DM * DM * 2);
static_assert((size_t)32 * 512 * DM * 2 + (size_t)32 * DM * 256 * 2 + (size_t)MOE_ROWS_MAX * 256 * 2 <= WS_TB, "MoE weight copies + H overlay P");
static_assert(WS_MIXED + (size_t)MOE_ROWS_MAX * DM * 2 <= WS_SELMASK, "sorted activations overlay mixed..imp");
#define W_P ((bf16_t*)(pq->ws + WS_P))
#define W_TB ((bf16_t*)(pq->ws + WS_TB))
#define W_MIXED ((bf16_t*)(pq->ws + WS_MIXED))
#define W_DQ ((float*)(pq->ws + WS_DQ))
#define W_DK ((float*)(pq->ws + WS_DK))
#define W_DO ((float*)(pq->ws + WS_TB))
#define W_NQ ((float*)(pq->ws + WS_NQ))
#define W_KSN ((float*)(pq->ws + WS_KSN))
#define W_KWN ((float*)(pq->ws + WS_KWN))
#define W_CMP ((float*)(pq->ws + WS_CMP))
#define W_OCMP ((float*)(pq->ws + WS_OCMP))
#define W_IMP ((float*)(pq->ws + WS_IMP))
#define W_OSEL W_DQ
#define W_OWIN W_DK
#define W_SELMASK ((unsigned long long*)(pq->ws + WS_SELMASK))
#define W_RE ((int*)(pq->ws + WS_RE))
#define W_RW ((float*)(pq->ws + WS_RW))
#define W_RS ((int*)(pq->ws + WS_RS))
#define W_ROWTOK ((int*)(pq->ws + WS_ROWTOK))
#define W_ROWW ((float*)(pq->ws + WS_ROWW))
#define W_CNT ((int*)(pq->ws + WS_CNT))
#define W_WGU_T ((bf16_t*)(pq->ws + WS_P))
#define W_WD_T ((bf16_t*)(pq->ws + WS_P + (size_t)32 * 512 * DM * 2))
#define W_HS ((bf16_t*)(pq->ws + WS_P + (size_t)32 * 512 * DM * 2 + (size_t)32 * DM * 256 * 2))
#define W_ASORT ((bf16_t*)(pq->ws + WS_MIXED))
#define W_WIN_T ((bf16_t*)(pq->ws + WS_WIN_T))
#define W_WOUT_T ((bf16_t*)(pq->ws + WS_WOUT_T))

__device__ __forceinline__ void norm_row(const float* x, const float* gain, bf16_t* t, int row, int lane) {
    const float4* xr = (const float4*)(x + (size_t)row * DM);
    float4 v[4]; float s = 0.f;
#pragma unroll
    for (int j = 0; j < 4; ++j) { v[j] = xr[lane + 64 * j]; s += v[j].x * v[j].x + v[j].y * v[j].y + v[j].z * v[j].z + v[j].w * v[j].w; }
    const float r = rsqrtf(wave_sum(s, lane) * (1.f / DM) + EPS);
#pragma unroll
    for (int j = 0; j < 4; ++j) {
        const float4 g = ((const float4*)gain)[lane + 64 * j];
        ushort4 o; o.x = f2bf(v[j].x * r * g.x); o.y = f2bf(v[j].y * r * g.y); o.z = f2bf(v[j].z * r * g.z); o.w = f2bf(v[j].w * r * g.w);
        ((ushort4*)(t + (size_t)row * DM))[lane + 64 * j] = o;
    }
}


typedef __attribute__((address_space(3))) float lds_f32;
typedef unsigned v4u_t __attribute__((ext_vector_type(4)));
__device__ __forceinline__ unsigned pk2bf(float lo, float hi) { return (unsigned)f2bf(lo) | ((unsigned)f2bf(hi) << 16); }
template <bool MAP>
__device__ __forceinline__ void transpose_item(const float* W, int K, int Nsrc, int Nnew, bf16_t* WT, lds_f32* scr, int item, int lane) {
    const int nblk = Nnew / 32, kb = item / nblk, nb = item % nblk, k0 = 64 * kb, n0 = 32 * nb;
    const int n = n0 + (lane & 31); const int sc = MAP ? src_col(n) : n; const bool ok = MAP ? (n < IN_COLS) : true;
#pragma unroll 8
    for (int i = 0; i < 32; ++i) { const int kk = 2 * i + (lane >> 5); scr[kk * 33 + (lane & 31)] = ok ? W[(size_t)(k0 + kk) * Nsrc + sc] : 0.f; }
    asm volatile("s_waitcnt lgkmcnt(0)" ::: "memory");
    const int c = lane & 7;
#pragma unroll
    for (int j = 0; j < 4; ++j) { const int nn = (lane >> 3) + 8 * j; const lds_f32* sp = scr + (8 * c) * 33 + nn;
        v4u_t o; o.x = pk2bf(sp[0 * 33], sp[1 * 33]); o.y = pk2bf(sp[2 * 33], sp[3 * 33]); o.z = pk2bf(sp[4 * 33], sp[5 * 33]); o.w = pk2bf(sp[6 * 33], sp[7 * 33]);
        *(v4u_t*)(WT + (size_t)(n0 + nn) * K + k0 + 8 * c) = o; }
    asm volatile("s_waitcnt lgkmcnt(0)" ::: "memory");
}

template <int G>
__device__ __forceinline__ void group_norm_item(const bf16_t* P, int col0, int ngroups, const float* gain, float scale, float* out, int ldo, int idx) {
    const int m = idx / ngroups, g = idx % ngroups;
    const bf16_t* p = P + (size_t)m * LDP + col0 + g * G;
    float v[G]; float s = 0.f;
#pragma unroll
    for (int d = 0; d < G; ++d) { v[d] = bf2f(p[d]); s += v[d] * v[d]; }
    const float r = rsqrtf(s * (1.f / G) + EPS) * scale;
#pragma unroll
    for (int d = 0; d < G; ++d) out[(size_t)m * ldo + g * G + d] = v[d] * r * gain[d];
}

__device__ __forceinline__ void diff_attn_item(const float* qn, const float* kn, const bf16_t* P, float* O, int item, int lane) {
    const int tb = item & 63, c = (item >> 6) & 1, h = (item >> 7) & 3, b = item >> 9;
    const int t = tb * 64 + lane;
    const float slope = exp2f(-(float)(2 * h + 1));
    float q[32], o[64];
#pragma unroll
    for (int d = 0; d < 32; ++d) q[d] = qn[(size_t)(b * SEQ + t) * 256 + h * 64 + c * 32 + d];
#pragma unroll
    for (int e = 0; e < 64; ++e) o[e] = 0.f;
    float mrun = NEG, l = 0.f;
    const int jmax = tb * 64 + 63;
    for (int j = 0; j <= jmax; ++j) {
        const float* kr = kn + (size_t)(b * SEQ + j) * 256 + h * 64 + c * 32;
        float s = 0.f;
#pragma unroll
        for (int d = 0; d < 32; ++d) s += q[d] * kr[d];
        s -= slope * (float)(t - j);
        if (j > t) s = NEG;
        const float mn = fmaxf(mrun, s), al = __expf(mrun - mn), p = (j > t) ? 0.f : __expf(s - mn);
        l = l * al + p; mrun = mn;
        const bf16_t* vr = P + (size_t)(b * SEQ + j) * LDP + PC_AV + h * 64;
#pragma unroll
        for (int e = 0; e < 64; ++e) o[e] = o[e] * al + p * bf2f(vr[e]);
    }
    const float il = 1.f / l;
    float* op = O + ((size_t)(b * SEQ + t) * 8 + h * 2 + c) * 64;
#pragma unroll
    for (int e = 0; e < 64; ++e) op[e] = o[e] * il;
}
__device__ __forceinline__ void diff_combine_item(const float* O, const float* lamv, const float* subg, float lam_init, bf16_t* mixed, int idx) {
    const int m = idx >> 2, h = idx & 3;
    float d01 = 0.f, d23 = 0.f;
    for (int i = 0; i < 32; ++i) { d01 += lamv[i] * lamv[32 + i]; d23 += lamv[64 + i] * lamv[96 + i]; }
    const float lam = __expf(d01) - __expf(d23) + lam_init;
    const float* o0 = O + ((size_t)m * 8 + h * 2) * 64; const float* o1 = o0 + 64;
    float v[64]; float s = 0.f;
#pragma unroll
    for (int e = 0; e < 64; ++e) { v[e] = o0[e] - lam * o1[e]; s += v[e] * v[e]; }
    const float r = rsqrtf(s * (1.f / 64) + EPS) * (1.f - lam_init);
#pragma unroll
    for (int e = 0; e < 64; ++e) mixed[(size_t)m * DM + h * 64 + e] = f2bf(v[e] * r * subg[h * 64 + e]);
}

__device__ __forceinline__ void mlstm_rec_item(const bf16_t* P, const float* cw, const float* gbias, const float* outg, bf16_t* mixed, int item, int lane) {
    const int b = item >> 2, h = item & 3;
    float C[64]; float nvec = 0.f;
#pragma unroll
    for (int k = 0; k < 64; ++k) C[k] = 0.f;
    const float bi = gbias[h], bfz = gbias[4 + h], og = outg[h * 64 + lane];
    for (int t = 0; t < SEQ; ++t) {
        const size_t m = (size_t)b * SEQ + t;
        float qv = 0.f, kv = 0.f;
#pragma unroll
        for (int k = 0; k < 4; ++k) { const int tt = t - 3 + k; if (tt >= 0) {
            qv += cw[k * 512 + h * 64 + lane] * bf2f(P[(m - 3 + k) * LDP + PC_BQ + h * 64 + lane]);
            kv += cw[k * 512 + 256 + h * 64 + lane] * bf2f(P[(m - 3 + k) * LDP + PC_BK + h * 64 + lane]); } }
        qv = siluf_(qv) * 0.125f; kv = siluf_(kv);
        const float ve = bf2f(P[m * LDP + PC_BV + h * 64 + lane]);
        const float ipre = bf2f(P[m * LDP + PC_BI + h]) + bi, fpre = bf2f(P[m * LDP + PC_BF + h]) + bfz;
        const float f = sigmoidf_(fpre), ei = __expf(ipre);
        const float kse = kv * ei;
        float num = 0.f;
        nvec = f * nvec + kse;
        const float den = wave_sum(qv * nvec, lane);
#pragma unroll
        for (int k = 0; k < 64; ++k) {
            const float sk = rdlane(kse, k), sq = rdlane(qv, k);
            C[k] = f * C[k] + sk * ve;
            num += sq * C[k];
        }
        const float hv = num / fmaxf(fabsf(den), 1.f);
        const float r = rsqrtf(wave_sum(hv * hv, lane) * (1.f / 64) + EPS);
        const float go = sigmoidf_(bf2f(P[m * LDP + PC_BO + h * 64 + lane]));
        mixed[m * DM + 256 + h * 64 + lane] = f2bf(hv * r * og * go);
    }
}
__device__ __forceinline__ void hgrn_rec_item(const bf16_t* P, const float* lbp, int layer, const float* outg, bf16_t* mixed, int item, int lane) {
    const int b = item >> 2, h = item & 3;
    float S[64];
#pragma unroll
    for (int k = 0; k < 64; ++k) S[k] = 0.f;
    float lb = 0.f;
    if (layer == 1) lb = sigmoidf_(lbp[256 + h * 64 + lane] - lbp[h * 64 + lane]);
    const float og = outg[h * 64 + lane];
    for (int t = 0; t < SEQ; ++t) {
        const size_t m = (size_t)b * SEQ + t;
        const float z = bf2f(P[m * LDP + PC_CF + h * 64 + lane]);
        const float f = lb + (1.f - lb) * sigmoidf_(z), kk = 1.f - f;
        const float qv = siluf_(bf2f(P[m * LDP + PC_CQ + h * 64 + lane]));
        const float ve = bf2f(P[m * LDP + PC_CI + h * 64 + lane]);
        float o = 0.f;
#pragma unroll
        for (int k = 0; k < 64; ++k) {
            const float sa = rdlane(f, k), sk = rdlane(kk, k), sq = rdlane(qv, k);
            S[k] = sa * S[k] + sk * ve; o += sq * S[k];
        }
        const float r = rsqrtf(wave_sum(o * o, lane) * (1.f / 64) + EPS);
        const float gg = sigmoidf_(bf2f(P[m * LDP + PC_CG + h * 64 + lane]));
        mixed[m * DM + 512 + h * 64 + lane] = f2bf(o * r * og * gg);
    }
}

__device__ __forceinline__ void nsa_compress_vb(const bf16_t* P, const float* pos, const float* w1, const float* w2, const float* kgain0, float* cmp, int vb, int tid, float* ldsf) {
    float (*red)[64] = (float (*)[64])ldsf; float* hid = ldsf + 256;
    const int n = vb % NCMP, b = (vb / NCMP) % NB, j = vb / (NCMP * NB);
    const int o = tid & 63, part = tid >> 6;
    const int pc = j == 0 ? PC_KC : PC_VC;
    float acc = 0.f;
    for (int l = part * 8; l < part * 8 + 8; ++l) {
        const bf16_t* row = P + (size_t)(b * SEQ + 16 * n + l) * LDP + pc;
        for (int d = 0; d < 64; ++d) acc += (bf2f(row[d]) + pos[(j * 32 + l) * 64 + d]) * w1[((size_t)j * 2048 + l * 64 + d) * 64 + o];
    }
    red[part][o] = acc; __syncthreads();
    if (part == 0) {
        const float x = red[0][o] + red[1][o] + red[2][o] + red[3][o];
        hid[o] = 0.5f * x * (1.f + tanhf(0.7978845608028654f * (x + 0.044715f * x * x * x)));
    }
    __syncthreads();
    if (part == 0) {
        float y = 0.f;
        for (int i = 0; i < 64; ++i) y += hid[i] * w2[(j * 64 + i) * 64 + o];
        if (j == 0) { const float r = rsqrtf(wave_sum(y * y, o) * (1.f / 64) + EPS); y = y * r * kgain0[o]; }
        cmp[(((size_t)j * NB + b) * NCMP + n) * 64 + o] = y;
    }
    __syncthreads();
}
__device__ __forceinline__ void nsa_cmp_attn_item(const float* qn, const float* cmp, float* ocmp, float* imp, int item, int lane) {
    const int m = item * 64 + lane; const int b = m / SEQ, t = m % SEQ;
    const float* kc = cmp + (size_t)b * NCMP * 64; const float* vc = cmp + ((size_t)NB + b) * NCMP * 64;
    float* im = imp + (size_t)m * 64;
    for (int j = 0; j < 64; ++j) im[j] = 0.f;
    const int nv = t >= 31 ? (t - 31) / 16 + 1 : 0;
#pragma unroll 1
    for (int h = 0; h < 4; ++h) {
        const float slope = exp2f(-(float)(2 * h + 2));
        float q[64], o[64];
#pragma unroll
        for (int d = 0; d < 64; ++d) { q[d] = qn[(size_t)m * 256 + h * 64 + d]; o[d] = 0.f; }
        float mx = NEG;
#pragma unroll 1
        for (int n = 0; n < nv; ++n) { float s = 0.f;
#pragma unroll
            for (int d = 0; d < 32; ++d) s += q[d] * kc[n * 64 + d];
            asm volatile("" ::: "memory");
#pragma unroll
            for (int d = 32; d < 64; ++d) s += q[d] * kc[n * 64 + d];
            asm volatile("" ::: "memory");
            s -= slope * (float)(t - (16 * n + 31)); mx = fmaxf(mx, s); }
        float l = 0.f;
#pragma unroll 1
        for (int n = 0; n < nv; ++n) { float s = 0.f;
#pragma unroll
            for (int d = 0; d < 32; ++d) s += q[d] * kc[n * 64 + d];
            asm volatile("" ::: "memory");
#pragma unroll
            for (int d = 32; d < 64; ++d) s += q[d] * kc[n * 64 + d];
            asm volatile("" ::: "memory");
            s -= slope * (float)(t - (16 * n + 31)); l += __expf(s - mx); }
        const float il = nv > 0 ? 1.f / l : 0.f;
#pragma unroll 1
        for (int n = 0; n < nv; ++n) { float s = 0.f;
#pragma unroll
            for (int d = 0; d < 32; ++d) s += q[d] * kc[n * 64 + d];
            asm volatile("" ::: "memory");
#pragma unroll
            for (int d = 32; d < 64; ++d) s += q[d] * kc[n * 64 + d];
            asm volatile("" ::: "memory");
            s -= slope * (float)(t - (16 * n + 31));
            const float p = __expf(s - mx) * il;
            asm volatile("" ::: "memory");
#pragma unroll
            for (int d = 0; d < 32; ++d) o[d] += p * vc[n * 64 + d];
            asm volatile("" ::: "memory");
#pragma unroll
            for (int d = 32; d < 64; ++d) o[d] += p * vc[n * 64 + d];
            asm volatile("" ::: "memory");
            const int jb = n >> 2, r = n & 3;
            if (r < 3) im[jb] += p; else { im[jb] += 0.5f * p; if (jb + 1 < 64) im[jb + 1] += 0.5f * p; }
        }
#pragma unroll
        for (int d = 0; d < 64; ++d) ocmp[((size_t)m * 4 + h) * 64 + d] = o[d];
    }
}
__device__ __forceinline__ void nsa_topk_item(const float* imp, unsigned long long* selmask, int m) {
    const int t = m % SEQ, qb = t >> 6;
    const float* im = imp + (size_t)m * 64;
    unsigned long long mask = 0ull;
    for (int j = 0; j < 64; ++j) {
        float vj = j <= qb ? im[j] : -1.f; if (j == 0 || j == qb || j == qb - 1) vj = 2.f;
        int rank = 0;
        for (int i = 0; i < 64; ++i) {
            float vi = i <= qb ? im[i] : -1.f; if (i == 0 || i == qb || i == qb - 1) vi = 2.f;
            rank += (vi > vj || (vi == vj && i < j)) ? 1 : 0;
        }
        if (rank < 16) mask |= 1ull << j;
    }
    selmask[m] = mask;
}
template <int KIND>
__device__ __forceinline__ void nsa_branch_item(const float* qn, const float* kn, const bf16_t* P, const unsigned long long* selmask, float* obr, int item, int lane) {
    const int h = item & 3, m = (item >> 2) * 64 + lane; const int b = m / SEQ, t = m % SEQ;
    const float slope = exp2f(-(float)(2 * h + 2));
    float q[64], o[64];
#pragma unroll
    for (int d = 0; d < 64; ++d) { q[d] = qn[(size_t)m * 256 + h * 64 + d]; o[d] = 0.f; }
    float mrun = NEG, l = 0.f;
    const int pcv = KIND == 0 ? PC_VS : PC_VW;
    if (KIND == 0) {
        const unsigned long long mask = selmask[m];
        for (int jb = 0; jb < 64; ++jb) {
            if (!((mask >> jb) & 1ull)) continue;
            for (int i = 0; i < 64; ++i) {
                const int kp = jb * 64 + i; if (kp > t) break;
                const float* kr = kn + (size_t)(b * SEQ + kp) * 64; float s = 0.f;
#pragma unroll
                for (int d = 0; d < 64; ++d) s += q[d] * kr[d];
                s -= slope * (float)(t - kp);
                const float mn = fmaxf(mrun, s), al = __expf(mrun - mn), p = __expf(s - mn);
                l = l * al + p; mrun = mn;
                const bf16_t* vr = P + (size_t)(b * SEQ + kp) * LDP + pcv;
#pragma unroll
                for (int d = 0; d < 64; ++d) o[d] = o[d] * al + p * bf2f(vr[d]);
            }
        }
    } else {
        const int k0 = t - 511 > 0 ? t - 511 : 0;
        for (int kp = k0; kp <= t; ++kp) {
            const float* kr = kn + (size_t)(b * SEQ + kp) * 64; float s = 0.f;
#pragma unroll
            for (int d = 0; d < 64; ++d) s += q[d] * kr[d];
            s -= slope * (float)(t - kp);
            const float mn = fmaxf(mrun, s), al = __expf(mrun - mn), p = __expf(s - mn);
            l = l * al + p; mrun = mn;
            const bf16_t* vr = P + (size_t)(b * SEQ + kp) * LDP + pcv;
#pragma unroll
            for (int d = 0; d < 64; ++d) o[d] = o[d] * al + p * bf2f(vr[d]);
        }
    }
    const float il = 1.f / l;
#pragma unroll
    for (int d = 0; d < 64; ++d) obr[((size_t)m * 4 + h) * 64 + d] = o[d] * il;
}
__device__ __forceinline__ void nsa_combine_item(const bf16_t* P, const float* ocmp, const float* osel, const float* owin, const float* outg, bf16_t* mixed, int idx) {
    const int m = idx >> 2, h = idx & 3;
    const float g0 = sigmoidf_(bf2f(P[(size_t)m * LDP + PC_DG + h * 3 + 0])), g1 = sigmoidf_(bf2f(P[(size_t)m * LDP + PC_DG + h * 3 + 1])),
                g2 = sigmoidf_(bf2f(P[(size_t)m * LDP + PC_DG + h * 3 + 2]));
    const size_t base = ((size_t)m * 4 + h) * 64;
    float v[64]; float s = 0.f;
#pragma unroll
    for (int d = 0; d < 64; ++d) { v[d] = g0 * ocmp[base + d] + g1 * osel[base + d] + g2 * owin[base + d]; s += v[d] * v[d]; }
    const float r = rsqrtf(s * (1.f / 64) + EPS);
#pragma unroll
    for (int d = 0; d < 64; ++d) mixed[(size_t)m * DM + 768 + h * 64 + d] = f2bf(v[d] * r * outg[h * 64 + d]);
}

__device__ __forceinline__ void moe_route_row(const float* x, const float* gain, const float* wg, const float* bg, const float* we, const float* be, bf16_t* t, int* re, float* rw, int* rs, int* cnt,
                                              int row, int lane) {
    const float4* xr = (const float4*)(x + (size_t)row * DM);
    float4 v[4]; float s = 0.f;
#pragma unroll
    for (int j = 0; j < 4; ++j) { v[j] = xr[lane + 64 * j]; s += v[j].x * v[j].x + v[j].y * v[j].y + v[j].z * v[j].z + v[j].w * v[j].w; }
    const float r = rsqrtf(wave_sum(s, lane) * (1.f / DM) + EPS);
    float lg[36];
#pragma unroll
    for (int o = 0; o < 36; ++o) lg[o] = 0.f;
#pragma unroll
    for (int j = 0; j < 4; ++j) {
        const float4 g = ((const float4*)gain)[lane + 64 * j];
        float tn[4] = {v[j].x * r * g.x, v[j].y * r * g.y, v[j].z * r * g.z, v[j].w * r * g.w};
        ushort4 o4; o4.x = f2bf(tn[0]); o4.y = f2bf(tn[1]); o4.z = f2bf(tn[2]); o4.w = f2bf(tn[3]);
        ((ushort4*)(t + (size_t)row * DM))[lane + 64 * j] = o4;
#pragma unroll
        for (int i = 0; i < 4; ++i) {
            const int k = (lane + 64 * j) * 4 + i;
            const float4 w4 = ((const float4*)wg)[k];
            lg[0] += tn[i] * w4.x; lg[1] += tn[i] * w4.y; lg[2] += tn[i] * w4.z; lg[3] += tn[i] * w4.w;
#pragma unroll
            for (int e4 = 0; e4 < 8; ++e4) { const float4 w = ((const float4*)we)[k * 8 + e4];
                lg[4 + e4 * 4 + 0] += tn[i] * w.x; lg[4 + e4 * 4 + 1] += tn[i] * w.y; lg[4 + e4 * 4 + 2] += tn[i] * w.z; lg[4 + e4 * 4 + 3] += tn[i] * w.w; }
        }
    }
#pragma unroll
    for (int o = 0; o < 36; ++o) lg[o] = wave_sum(lg[o], lane);
    float gl[4]; float gmx = NEG; int gs = 0;
#pragma unroll
    for (int g = 0; g < 4; ++g) { gl[g] = lg[g] + bg[g]; if (gl[g] > gmx) { gmx = gl[g]; gs = g; } }
    float gz = 0.f;
#pragma unroll
    for (int g = 0; g < 4; ++g) gz += __expf(gl[g] - gmx);
    const float gprob = 1.f / gz;
    float el[8];
#pragma unroll
    for (int e = 0; e < 8; ++e) {
        const float a0 = lg[4 + e] + be[e], a1 = lg[12 + e] + be[8 + e], a2 = lg[20 + e] + be[16 + e], a3 = lg[28 + e] + be[24 + e];
        el[e] = gs == 0 ? a0 : (gs == 1 ? a1 : (gs == 2 ? a2 : a3));
    }
    float m1 = NEG; int i1 = 0;
#pragma unroll
    for (int e = 0; e < 8; ++e) if (el[e] > m1) { m1 = el[e]; i1 = e; }
    float m2 = NEG; int i2 = 0;
#pragma unroll
    for (int e = 0; e < 8; ++e) if (e != i1 && el[e] > m2) { m2 = el[e]; i2 = e; }
    const float p2 = __expf(m2 - m1);
    const float w1 = gprob / (1.f + p2), w2 = gprob * p2 / (1.f + p2);
    if (lane == 0) { const int e1 = gs * 8 + i1, e2 = gs * 8 + i2;
        re[row * 2] = e1; re[row * 2 + 1] = e2; rw[row * 2] = w1; rw[row * 2 + 1] = w2;
        rs[row * 2] = atomicAdd(cnt + e1, 1); rs[row * 2 + 1] = atomicAdd(cnt + e2, 1); }
}
__device__ __forceinline__ void moe_table(const int* cnt, __attribute__((address_space(3))) int* tab, int tid) {
    if (tid < 64) {
        const int lane = tid; const int c = lane < 32 ? cnt[lane] : 0; const int pc = (c + 255) >> 8;
        int x = pc;
#pragma unroll
        for (int o = 1; o < 32; o <<= 1) { const int y = __builtin_amdgcn_ds_bpermute(((lane - o) & 63) << 2, x); if (lane >= o) x += y; }
        const int ex = x - pc;
        if (lane < 32) { tab[lane] = ex * 256; tab[32 + lane] = c; for (int t = 0; t < pc; ++t) tab[128 + ex + t] = lane; }
        if (lane == 31) tab[64] = x;
    }
    __syncthreads();
}

__global__ void __launch_bounds__(NTHR) mega_fwd(Params p_unused) {
    extern __shared__ __attribute__((aligned(16))) unsigned char lds[];
    cg::grid_group grid = cg::this_grid();
    const int G = gridDim.x, bid = blockIdx.x;
    typedef const __attribute__((address_space(4))) Params* cparams_t;
    const cparams_t pp = (cparams_t)__builtin_amdgcn_kernarg_segment_ptr();
#define PHASE_VARS \
    int tid = threadIdx.x; asm volatile("" : "+v"(tid)); \
    cparams_t pq = pp; asm volatile("" : "+s"(pq)); \
    const float* xcur = l == 0 ? pq->x_in : pq->out; (void)xcur; \
    const int lane = tid & 63, wave = tid >> 6, half = tid >> 8, tid256 = tid & 255; \
    const int gw = bid * NWAVE + wave, NGW = G * NWAVE; \
    const int gt = bid * NTHR + tid, NGT = G * NTHR; \
    float* ldsf = (float*)lds + half * 4096; \
    (void)lane; (void)tid256; (void)gw; (void)NGW; (void)gt; (void)NGT; (void)ldsf;

    for (int l = 0; l < DEPTH; ++l) {
        {   PHASE_VARS
        {   lds_f32* scr = (lds_f32*)lds + wave * (64 * 33);
            for (int it = gw; it < (DM / 64) * (LDP / 32); it += NGW) transpose_item<true>(pq->w_in + (size_t)l * DM * IN_COLS, DM, IN_COLS, LDP, W_WIN_T, scr, it, lane);
            for (int it = gw; it < (DM / 64) * (DM / 32); it += NGW) transpose_item<false>(pq->w_out + (size_t)l * DM * DM, DM, DM, DM, W_WOUT_T, scr, it, lane); }
        if (bid == 0 && tid < 32) W_CNT[tid] = 0;
        for (int row = gw; row < MT; row += NGW) norm_row(xcur, pq->norm_mix + l * DM, W_TB, row, lane);
        }
        grid.sync();
        {   PHASE_VARS
        {   pg8::Gemm g{W_TB, W_WIN_T, MT, LDP, DM}; pg8::StaticOrder S; S.init(MT, LDP, G, bid);
            pg8::EpiBf16<0> E{W_P, LDP, nullptr, 0, 0, 1.f};
            pg8::gemm_phase<pg8::EpiBf16<0>, pg8::StaticOrder, true, true>((PG8_LAS unsigned char*)lds, g, S, E); }
        }
        grid.sync();
        {   PHASE_VARS
        for (int i = gt; i < MT * 8; i += NGT) group_norm_item<32>(W_P, PC_AQ, 8, pq->diff_q_gain + l * 32, 0.17677669529663687f, W_DQ, 256, i);
        for (int i = gt; i < MT * 8; i += NGT) group_norm_item<32>(W_P, PC_AK, 8, pq->diff_k_gain + l * 32, 1.f, W_DK, 256, i);
        for (int i = gt; i < MT * 4; i += NGT) group_norm_item<64>(W_P, PC_DQ, 4, pq->nsa_q_gain + l * 64, 0.125f, W_NQ, 256, i);
        for (int i = gt; i < MT; i += NGT) group_norm_item<64>(W_P, PC_KS, 1, pq->nsa_k_gain + (l * 3 + 1) * 64, 1.f, W_KSN, 64, i);
        for (int i = gt; i < MT; i += NGT) group_norm_item<64>(W_P, PC_KW, 1, pq->nsa_k_gain + (l * 3 + 2) * 64, 1.f, W_KWN, 64, i);
        for (int it = bid; it < 2 * NB * NCMP / 2; it += G) { const int vb = it * 2 + half;
            nsa_compress_vb(W_P, pq->nsa_cmp_pos + l * 2 * 32 * 64, pq->nsa_cmp_w1 + (size_t)l * 2 * 2048 * 64, pq->nsa_cmp_w2 + l * 2 * 64 * 64, pq->nsa_k_gain + (l * 3 + 0) * 64, W_CMP, vb, tid256, ldsf); }
        }
        grid.sync();
        {   PHASE_VARS
        if (gw < 16) mlstm_rec_item(W_P, pq->mlstm_conv + l * 4 * 512, pq->mlstm_gate_bias + l * 8, pq->mlstm_out_gain + l * 256, W_MIXED, gw, lane);
        else if (gw < 32) hgrn_rec_item(W_P, pq->hgrn_lb, l, pq->hgrn_out_gain + l * 256, W_MIXED, gw - 16, lane);
        for (int it = gw; it < 2048; it += NGW) diff_attn_item(W_DQ, W_DK, W_P, W_DO, it, lane);
        for (int it = gw; it < 256; it += NGW) nsa_cmp_attn_item(W_NQ, W_CMP, W_OCMP, W_IMP, it, lane);
        }
        grid.sync();
        {   PHASE_VARS
        const float lam_init = 0.8f - 0.6f * __expf(-0.3f * (float)l);
        for (int i = gt; i < MT * 4; i += NGT) diff_combine_item(W_DO, pq->diff_lambda + l * 128, pq->diff_sub_gain + l * 256, lam_init, W_MIXED, i);
        for (int i = gt; i < MT; i += NGT) nsa_topk_item(W_IMP, W_SELMASK, i);
        }
        grid.sync();
        {   PHASE_VARS
        for (int it = gw; it < 1024; it += NGW) nsa_branch_item<0>(W_NQ, W_KSN, W_P, W_SELMASK, W_OSEL, it, lane);
        for (int it = gw; it < 1024; it += NGW) nsa_branch_item<1>(W_NQ, W_KWN, W_P, W_SELMASK, W_OWIN, it, lane);
        }
        grid.sync();
        {   PHASE_VARS
        for (int i = gt; i < MT * 4; i += NGT) nsa_combine_item(W_P, W_OCMP, W_OSEL, W_OWIN, pq->nsa_out_gain + l * 256, W_MIXED, i);
        }
        grid.sync();
        {   PHASE_VARS
        {   pg8::Gemm g{W_MIXED, W_WOUT_T, MT, DM, DM}; pg8::StaticOrder S; S.init(MT, DM, G, bid);
            pg8::EpiResF32 E{xcur, pq->out, DM};
            pg8::gemm_phase<pg8::EpiResF32, pg8::StaticOrder, true, true>((PG8_LAS unsigned char*)lds, g, S, E); }
        }
        grid.sync();
        {   PHASE_VARS
        for (int row = gw; row < MT; row += NGW)
            moe_route_row(pq->out, pq->norm_ffn + l * DM, pq->moe_w_group + l * DM * 4, pq->moe_b_group + l * 4, pq->moe_w_expert + l * DM * 32, pq->moe_b_expert + l * 32, W_TB, W_RE, W_RW, W_RS, W_CNT, row, lane);
        {   lds_f32* scr = (lds_f32*)lds + wave * (64 * 33);
            for (int it = gw; it < 32 * 256; it += NGW) { const int e = it >> 8, r = it & 255, kb = r >> 4, nb = r & 15;
                const int j = nb >> 3, hf = (nb >> 2) & 1, cb = nb & 3;
                const float* W = (hf ? pq->moe_w_up : pq->moe_w_gate) + ((size_t)l * 32 + e) * DM * 256;
                transpose_item<false>(W + j * 128 + cb * 32, DM, 256, 32, W_WGU_T + ((size_t)e * 512 + nb * 32) * DM, scr, kb, lane); }
            for (int it = gw; it < 32 * 128; it += NGW) { const int e = it >> 7, r = it & 127;
                transpose_item<false>(pq->moe_w_down + ((size_t)l * 32 + e) * 256 * DM, 256, DM, DM, W_WD_T + (size_t)e * DM * 256, scr, r, lane); }
        }
        }
        grid.sync();
        {   PHASE_VARS
        __attribute__((address_space(3))) int* tab = (__attribute__((address_space(3))) int*)(lds + 131072);
        moe_table(W_CNT, tab, tid);
        for (int row = gw; row < MT; row += NGW) {
            const uint4* src = (const uint4*)(W_TB + (size_t)row * DM);
            const uint4 v0 = src[lane], v1 = src[lane + 64];
#pragma unroll
            for (int i = 0; i < 2; ++i) { const int e = W_RE[row * 2 + i], r = tab[e] + W_RS[row * 2 + i];
                uint4* dst = (uint4*)(W_ASORT + (size_t)r * DM); dst[lane] = v0; dst[lane + 64] = v1;
                if (lane == 0) { W_ROWTOK[r] = row; W_ROWW[r] = W_RW[row * 2 + i]; } }
        }
        if (bid == 0) for (int e = wave; e < 32; e += NWAVE) { const int r0 = tab[e] + tab[32 + e], r1 = tab[e] + ((tab[32 + e] + 255) & ~255);
            for (int r = r0 + lane; r < r1; r += 64) { W_ROWTOK[r] = -1; W_ROWW[r] = 0.f; } }
        }
        grid.sync();
        {   PHASE_VARS
        __attribute__((address_space(3))) int* tab = (__attribute__((address_space(3))) int*)(lds + 131072);
        moe_table(W_CNT, tab, tid);
        {   pg8::Gemm g{W_ASORT, W_WGU_T, MOE_ROWS_MAX, 32 * 512, DM}; pg8::MoeOrder S{G, bid, tab[64], 2, tab + 128};
            pg8::EpiSwiglu E{W_HS, W_ROWW};
            pg8::gemm_phase<pg8::EpiSwiglu, pg8::MoeOrder, true, true>((PG8_LAS unsigned char*)lds, g, S, E); }
        }
        grid.sync();
        {   PHASE_VARS
        __attribute__((address_space(3))) int* tab = (__attribute__((address_space(3))) int*)(lds + 131072);
        moe_table(W_CNT, tab, tid);
        {   pg8::Gemm g{W_HS, W_WD_T, MOE_ROWS_MAX, 32 * DM, 256}; pg8::MoeOrder S{G, bid, tab[64], 4, tab + 128};
            pg8::EpiScatterAdd E{pq->out, W_ROWTOK};
            pg8::gemm_phase<pg8::EpiScatterAdd, pg8::MoeOrder, true, true>((PG8_LAS unsigned char*)lds, g, S, E); }
        }
        grid.sync();
    }
}
}

extern "C" void kernel_launch(void* const* d_in, const int* in_sizes, int n_in, void* d_out, int out_size, void* d_ws, size_t ws_size, hipStream_t stream) {
    Params p{};
    p.x_in = (const float*)d_in[0]; p.norm_mix = (const float*)d_in[1]; p.norm_ffn = (const float*)d_in[2]; p.w_in = (const float*)d_in[3]; p.w_out = (const float*)d_in[4];
    p.diff_q_gain = (const float*)d_in[5]; p.diff_k_gain = (const float*)d_in[6]; p.diff_lambda = (const float*)d_in[7]; p.diff_sub_gain = (const float*)d_in[8];
    p.mlstm_conv = (const float*)d_in[9]; p.mlstm_gate_bias = (const float*)d_in[10]; p.mlstm_out_gain = (const float*)d_in[11]; p.hgrn_lb = (const float*)d_in[12];
    p.hgrn_out_gain = (const float*)d_in[13]; p.nsa_cmp_pos = (const float*)d_in[14]; p.nsa_cmp_w1 = (const float*)d_in[15]; p.nsa_cmp_w2 = (const float*)d_in[16];
    p.nsa_q_gain = (const float*)d_in[17]; p.nsa_k_gain = (const float*)d_in[18]; p.nsa_out_gain = (const float*)d_in[19];
    p.moe_w_group = (const float*)d_in[20]; p.moe_b_group = (const float*)d_in[21]; p.moe_w_expert = (const float*)d_in[22]; p.moe_b_expert = (const float*)d_in[23];
    p.moe_w_gate = (const float*)d_in[24]; p.moe_w_up = (const float*)d_in[25]; p.moe_w_down = (const float*)d_in[26];
    p.out = (float*)d_out;

    p.ws = (char*)d_ws;
    if (WS_END > ws_size) { fprintf(stderr, "kernel_launch: workspace too small: need %zu, have %zu\n", (size_t)WS_END, ws_size); return; }

    static int grid_blocks = 0;
    if (!grid_blocks) {
        int dev = 0, cus = 0, per_cu = 0;
        hipGetDevice(&dev);
        hipDeviceGetAttribute(&cus, hipDeviceAttributeMultiprocessorCount, dev);
        hipFuncSetAttribute((const void*)mega_fwd, hipFuncAttributeMaxDynamicSharedMemorySize, LDS_BYTES);
        hipOccupancyMaxActiveBlocksPerMultiprocessor(&per_cu, (const void*)mega_fwd, NTHR, LDS_BYTES);
        if (per_cu < 1) per_cu = 1;
        if (per_cu > 1) per_cu = 1;
        grid_blocks = cus * per_cu;
    }
    void* args[] = {&p};
    hipError_t e = hipLaunchCooperativeKernel((const void*)mega_fwd, dim3(grid_blocks), dim3(NTHR), args, LDS_BYTES, stream);
    if (e != hipSuccess) fprintf(stderr, "cooperative launch failed: %s (grid %d)\n", hipGetErrorString(e), grid_blocks);
}
```

```cpp
#include <hip/hip_runtime.h>
#include <hip/hip_cooperative_groups.h>
#include <stdint.h>
#include <cstdio>
namespace cg = cooperative_groups;

namespace {
constexpr int DM = 1024, NB = 4, SEQ = 4096, DEPTH = 2, MT = NB * SEQ;
constexpr int IN_COLS = 3476, LDP = 3584;
constexpr float EPS = 1e-6f, NEG = -1e30f;
constexpr int PC_AQ = 0, PC_AK = 256, PC_AV = 512, PC_BQ = 768, PC_BK = 1024, PC_BV = 1280, PC_BO = 1536, PC_CQ = 1792, PC_CF = 2048,
              PC_CI = 2304, PC_CG = 2560, PC_DQ = 2816, PC_KC = 3072, PC_VC = 3136, PC_KS = 3200, PC_VS = 3264, PC_KW = 3328, PC_VW = 3392,
              PC_BI = 3456, PC_BF = 3460, PC_DG = 3464;
constexpr int NCMP = 255;
constexpr int NTHR = 512, NWAVE = 8;
constexpr int LDS_BYTES = 147456;

typedef unsigned short bf16_t;
__device__ __forceinline__ float bf2f(bf16_t v) { return __uint_as_float(((unsigned)v) << 16); }
__device__ __forceinline__ bf16_t f2bf(float f) { unsigned u = __float_as_uint(f); return (bf16_t)((u + 0x7fffu + ((u >> 16) & 1u)) >> 16); }
__device__ __forceinline__ int src_col(int c) { return c < 1536 ? c : (c < 3456 ? c + 8 : (c < 3460 ? c - 3456 + 1536 : (c < 3464 ? c - 3460 + 1540 : c))); }
__device__ __forceinline__ float sigmoidf_(float x) { return 1.f / (1.f + __expf(-x)); }
__device__ __forceinline__ float siluf_(float x) { return x / (1.f + __expf(-x)); }
__device__ __forceinline__ float wave_sum(float v, int lane) {
#pragma unroll
    for (int o = 1; o < 64; o <<= 1) v += __int_as_float(__builtin_amdgcn_ds_bpermute((lane ^ o) << 2, __float_as_int(v)));
    return v;
}
__device__ __forceinline__ float rdlane(float v, int k) { return __int_as_float(__builtin_amdgcn_readlane(__float_as_int(v), k)); }

namespace pg8 {
#define PG8_LAS __attribute__((address_space(3)))
typedef unsigned short bf16_t;
typedef short bf16x8 __attribute__((ext_vector_type(8)));
typedef float f32x4 __attribute__((ext_vector_type(4)));
typedef unsigned u32x4 __attribute__((ext_vector_type(4)));
constexpr int BM = 256, BK = 64, HALF = 128, HTB = HALF * BK * 2  , STAGE_BYTES = 8 * HTB, NXCD = 8, WGM = 8;

__host__ __device__ __forceinline__ int lds_byte(int r, int c) { const int st = (r >> 4) * 2 + (c >> 5), rr = r & 15, cc = c & 31, ob = rr * 64 + cc * 2; return st * 1024 + (ob ^ (((ob >> 9) & 1) << 5)); }
__host__ __device__ __forceinline__ void stage_rc(int b, int& R, int& C) { const int st = b / 1024, sb = b % 1024, swz = sb ^ (((sb >> 9) & 1) << 5); R = (st >> 1) * 16 + swz / 64; C = (st & 1) * 32 + (swz % 64) / 2; }
__host__ __device__ __forceinline__ int perm32(int rho) { const int n = rho >> 4, i = rho & 15; return 8 * (i >> 2) + 4 * n + (i & 3); }

struct Unit { int pm, pn; };
struct Gemm { const bf16_t* A; const bf16_t* Bt; int M, N, K; };

struct StaticOrder {
    int nM, nN, nwg, G, c;
    __host__ __device__ void init(int M, int N, int G_, int c_) { nM = M / BM; nN = N / BM; nwg = nM * nN; G = G_; c = c_; }
    __host__ __device__ bool next(int i, Unit& u) const {
        const long L = (long)i * G + c; if (L >= nwg) return false;
        int wgid = (int)L; { const int q = nwg / NXCD, r = nwg % NXCD, xcd = wgid % NXCD, off = wgid / NXCD; wgid = (xcd < r ? xcd * (q + 1) : r * (q + 1) + (xcd - r) * q) + off; }
        const int nig = WGM * nN, gid = wgid / nig, fm = gid * WGM, gsz = (nM - fm) < WGM ? (nM - fm) : WGM;
        u.pm = fm + ((wgid % nig) % gsz); u.pn = (wgid % nig) / gsz; return true;
    }
    __device__ __forceinline__ void a_ready(const Unit&) const {}
    __device__ __forceinline__ void done(const Unit&) const {}
};

__device__ __forceinline__ unsigned cvt_pk_bf16(float lo, float hi) { unsigned r; asm volatile("v_cvt_pk_bf16_f32 %0, %1, %2" : "=v"(r) : "v"(lo), "v"(hi)); return r; }
template <int ACT  > struct EpiBf16 {
    static constexpr bool PERM = true, AFTER_DRAIN = false; static_assert(ACT == 0, "EpiBf16: only ACT 0 here");
    bf16_t* O; int ldc; const float* bias; int split_cols; size_t split_stride; float scale0;
    __device__ __forceinline__ void operator()(const f32x4 (&acc)[2][2][4][2], const Unit& u, int wr, int wc, int fr, int fq) const {
        const int row0 = u.pm * BM + wr * 64 + fr; int colt = u.pn * BM; bf16_t* base = O;
        float sc = 1.f; if (split_cols) { const int t = colt / split_cols; base += (size_t)t * split_stride; colt -= t * split_cols; if (t == 0) sc = scale0; }
        const int col0 = colt + wc * 32 + 8 * fq, bcol0 = u.pn * BM + wc * 32 + 8 * fq;
        f32x4 bv[2][2];
#pragma unroll
        for (int bj = 0; bj < 2; ++bj)
#pragma unroll
            for (int n = 0; n < 2; ++n) bv[bj][n] = bias ? *(const f32x4*)(bias + bcol0 + bj * HALF + 4 * n) : (f32x4){0.f, 0.f, 0.f, 0.f};
#pragma unroll
        for (int ai = 0; ai < 2; ++ai)
#pragma unroll
            for (int m = 0; m < 4; ++m) { bf16_t* rowp = base + (size_t)(row0 + ai * HALF + m * 16) * ldc + col0;
#pragma unroll
                for (int bj = 0; bj < 2; ++bj) { f32x4 v0 = acc[ai][bj][m][0] + bv[bj][0], v1 = acc[ai][bj][m][1] + bv[bj][1];
                    v0 = v0 * sc; v1 = v1 * sc; u32x4 w; w.x = cvt_pk_bf16(v0[0], v0[1]); w.y = cvt_pk_bf16(v0[2], v0[3]); w.z = cvt_pk_bf16(v1[0], v1[1]); w.w = cvt_pk_bf16(v1[2], v1[3]);
                    *(u32x4*)(rowp + bj * HALF) = w; } }
    }
};


struct EpiResF32 {
    static constexpr bool PERM = false, AFTER_DRAIN = false;
    const float* base; float* out; int ldc;
    __device__ __forceinline__ void operator()(const f32x4 (&acc)[2][2][4][2], const Unit& u, int wr, int wc, int fr, int fq) const {
        const int col0 = u.pn * BM + wc * 32 + 4 * fq;
#pragma unroll
        for (int ai = 0; ai < 2; ++ai)
#pragma unroll
            for (int m = 0; m < 4; ++m) { const size_t off = (size_t)(u.pm * BM + ai * HALF + wr * 64 + m * 16 + fr) * ldc + col0;
#pragma unroll
                for (int bj = 0; bj < 2; ++bj)
#pragma unroll
                    for (int n = 0; n < 2; ++n) { const f32x4 bs = *(const f32x4*)(base + off + bj * HALF + n * 16); *(f32x4*)(out + off + bj * HALF + n * 16) = bs + acc[ai][bj][m][n]; } }
    }
};

struct EpiSwiglu {
    static constexpr bool PERM = true, AFTER_DRAIN = false;
    bf16_t* H; const float* row_w;
    __device__ __forceinline__ void operator()(const f32x4 (&acc)[2][2][4][2], const Unit& u, int wr, int wc, int fr, int fq) const {
        const int row0 = u.pm * BM + wr * 64 + fr, col0 = (u.pn & 1) * HALF + wc * 32 + 8 * fq;
#pragma unroll
        for (int ai = 0; ai < 2; ++ai)
#pragma unroll
            for (int m = 0; m < 4; ++m) { const int row = row0 + ai * HALF + m * 16; const float w = row_w[row];
                float h[8];
#pragma unroll
                for (int n = 0; n < 2; ++n)
#pragma unroll
                    for (int i = 0; i < 4; ++i) { const float g = acc[ai][0][m][n][i], up = acc[ai][1][m][n][i]; h[n * 4 + i] = g / (1.f + __expf(-g)) * up * w; }
                u32x4 o; o.x = cvt_pk_bf16(h[0], h[1]); o.y = cvt_pk_bf16(h[2], h[3]); o.z = cvt_pk_bf16(h[4], h[5]); o.w = cvt_pk_bf16(h[6], h[7]);
                *(u32x4*)(H + (size_t)row * 256 + col0) = o; }
    }
};
struct EpiScatterAdd {
    static constexpr bool PERM = false, AFTER_DRAIN = false;
    float* out; const int* row_tok;
    __device__ __forceinline__ void operator()(const f32x4 (&acc)[2][2][4][2], const Unit& u, int wr, int wc, int fr, int fq) const {
        const int col0 = (u.pn & 3) * BM + wc * 32 + 4 * fq;
#pragma unroll
        for (int ai = 0; ai < 2; ++ai)
#pragma unroll
            for (int m = 0; m < 4; ++m) { const int tok = row_tok[u.pm * BM + ai * HALF + wr * 64 + m * 16 + fr];
                if (tok >= 0) { float* o = out + (size_t)tok * 1024 + col0;
#pragma unroll
                    for (int bj = 0; bj < 2; ++bj)
#pragma unroll
                        for (int n = 0; n < 2; ++n)
#pragma unroll
                            for (int i = 0; i < 4; ++i) unsafeAtomicAdd(o + bj * HALF + n * 16 + i, acc[ai][bj][m][n][i]); } }
    }
};
struct MoeOrder {
    int G, c, ntiles, nsub; const PG8_LAS int* tile_e;
    __device__ __forceinline__ bool next(int i, Unit& u) const {
        const int L = i * G + c; if (L >= ntiles * nsub) return false;
        const int T = L / nsub, j = L - T * nsub; u.pm = T; u.pn = tile_e[T] * nsub + j; return true;
    }
    __device__ __forceinline__ void a_ready(const Unit&) const {}
    __device__ __forceinline__ void done(const Unit&) const {}
};
template <class Epi, class Sched, bool ALIGN_EPI = false, bool SP2 = false>
__device__ __forceinline__ void gemm_phase(PG8_LAS unsigned char* lds, const Gemm g, const Sched& S, const Epi& E) {
    int tid_ = threadIdx.x; asm volatile("" : "+v"(tid_));
    const int tid = tid_, wid = __builtin_amdgcn_readfirstlane(tid >> 6), lane = tid & 63, wr = wid >> 2, wc = wid & 3, fr = lane & 15, fq = lane >> 4;
    const int K = g.K, nt = K / BK;
    unsigned voffA[2], voffB[2];
#pragma unroll
    for (int i = 0; i < 2; ++i) { int R, C; stage_rc(tid * 16 + i * 8192, R, C); const int Rb = Epi::PERM ? ((R & ~31) + perm32(R & 31)) : R;
        voffA[i] = (unsigned)(R * K + C) * 2u; voffB[i] = (unsigned)(Rb * K + C) * 2u; }
    const size_t kstep = (size_t)(BK * 2);
    const size_t hstep = (size_t)HALF * K * 2;
    const size_t tstep = 2 * hstep;
    const unsigned ldsw = (unsigned)wid * 1024u;
    const int aoff = lds_byte(wr * 64 + fr, fq * 8), boff = lds_byte(wc * 32 + fr, fq * 8);
#define PG8_SA(b, h) (((b) * 2 + (h)) * HTB)
#define PG8_SB(b, h) ((4 + (b) * 2 + (h)) * HTB)
#define PG8_STAGE(bufoff, gbase, voff) do { _Pragma("unroll") for (int _i = 0; _i < 2; ++_i) \
        __builtin_amdgcn_global_load_lds((const unsigned*)((const char*)(gbase) + (voff)[_i]), (PG8_LAS unsigned*)(lds + (bufoff) + ldsw + _i * 8192), 16, 0, 0); } while (0)
#define PG8_LDA(dst, b, h) do { _Pragma("unroll") for (int m = 0; m < 4; ++m) _Pragma("unroll") for (int k = 0; k < 2; ++k) dst[m][k] = *(const PG8_LAS bf16x8*)(lds + PG8_SA(b, h) + aoff + m * 2048 + k * 1024); } while (0)
#define PG8_LDB(dst, b, h) do { _Pragma("unroll") for (int n = 0; n < 2; ++n) _Pragma("unroll") for (int k = 0; k < 2; ++k) dst[n][k] = *(const PG8_LAS bf16x8*)(lds + PG8_SB(b, h) + boff + n * 2048 + k * 1024); } while (0)
#define PG8_MMA(ai, bj, At, Bt) do { __builtin_amdgcn_s_setprio(1); _Pragma("unroll") for (int m = 0; m < 4; ++m) _Pragma("unroll") for (int n = 0; n < 2; ++n) _Pragma("unroll") for (int k = 0; k < 2; ++k) \
        acc[ai][bj][m][n] = __builtin_amdgcn_mfma_f32_16x16x32_bf16(Bt[n][k], At[m][k], acc[ai][bj][m][n], 0, 0, 0); __builtin_amdgcn_s_setprio(0); } while (0)
#define PG8_WAIT_V(n) asm volatile("s_waitcnt vmcnt(" #n ")" ::: "memory")
#define PG8_WAIT_L(n) asm volatile("s_waitcnt lgkmcnt(" #n ")" ::: "memory")
#define PG8_BAR __builtin_amdgcn_s_barrier()
#define PG8_SCHED __builtin_amdgcn_sched_barrier(0)
    Unit cur, nxt; int ui = 0;
    if (!S.next(0, cur)) return;
    f32x4 acc[2][2][4][2];
#pragma unroll
    for (int a = 0; a < 2; ++a)
#pragma unroll
        for (int b = 0; b < 2; ++b)
#pragma unroll
            for (int m = 0; m < 4; ++m)
#pragma unroll
                for (int n = 0; n < 2; ++n) acc[a][b][m][n] = (f32x4){0.f, 0.f, 0.f, 0.f};
    bf16x8 At[4][2], B0[2][2], B1[2][2];
    const char* cA = (const char*)g.A + (size_t)cur.pm * tstep; const char* cB = (const char*)g.Bt + (size_t)cur.pn * tstep;
    S.a_ready(cur);
    if constexpr (SP2) {
        PG8_STAGE(PG8_SB(0, 0), cB, voffB); PG8_STAGE(PG8_SB(0, 1), cB + hstep, voffB); PG8_STAGE(PG8_SA(0, 0), cA, voffA); PG8_STAGE(PG8_SA(0, 1), cA + hstep, voffA);
        if (wr == 1) PG8_BAR;
        PG8_WAIT_V(2); PG8_BAR;
        PG8_STAGE(PG8_SB(1, 0), cB + kstep, voffB); PG8_STAGE(PG8_SA(1, 0), cA + kstep, voffA); PG8_STAGE(PG8_SB(1, 1), cB + hstep + kstep, voffB);
        PG8_WAIT_V(6); PG8_BAR;
    } else {
        PG8_STAGE(PG8_SB(0, 0), cB, voffB); PG8_STAGE(PG8_SA(0, 0), cA, voffA); PG8_STAGE(PG8_SB(0, 1), cB + hstep, voffB); PG8_STAGE(PG8_SA(0, 1), cA + hstep, voffA);
        if (wr == 1) PG8_BAR;
        PG8_WAIT_V(4); PG8_BAR;
        PG8_STAGE(PG8_SB(1, 0), cB + kstep, voffB); PG8_STAGE(PG8_SA(1, 0), cA + kstep, voffA); PG8_STAGE(PG8_SB(1, 1), cB + hstep + kstep, voffB);
        PG8_WAIT_V(6); PG8_BAR;
    }
    for (;;) {
        const bool has_next = S.next(ui + 1, nxt);
        const char* nA = has_next ? (const char*)g.A + (size_t)nxt.pm * tstep : cA; const char* nB = has_next ? (const char*)g.Bt + (size_t)nxt.pn * tstep : cB;
        for (int t = 0; t < nt; t += 2) {
            const bool last = (t == nt - 2);
            const char* a1 = cA + (size_t)(t + 1) * kstep;
            const char* a2 = last ? nA : cA + (size_t)(t + 2) * kstep; const char* b2 = last ? nB : cB + (size_t)(t + 2) * kstep;
            const char* a3 = a2 + kstep; const char* b3 = b2 + kstep;
            if (last && has_next) S.a_ready(nxt);
            if constexpr (SP2) {
            PG8_LDB(B0, 0, 0); PG8_LDB(B1, 0, 1); PG8_SCHED; PG8_LDA(At, 0, 0); PG8_STAGE(PG8_SA(1, 1), a1 + hstep, voffA);
            PG8_WAIT_V(8); PG8_WAIT_L(0); PG8_BAR; PG8_MMA(0, 0, At, B0); PG8_MMA(0, 1, At, B1); PG8_BAR; PG8_SCHED;
            PG8_LDA(At, 0, 1); PG8_STAGE(PG8_SB(0, 0), b2, voffB); PG8_STAGE(PG8_SB(0, 1), b2 + hstep, voffB); PG8_STAGE(PG8_SA(0, 0), a2, voffA);
            PG8_WAIT_V(8); PG8_WAIT_L(0); PG8_BAR; PG8_MMA(1, 0, At, B0); PG8_MMA(1, 1, At, B1); PG8_BAR; PG8_SCHED;
            PG8_LDB(B0, 1, 0); PG8_LDB(B1, 1, 1); PG8_SCHED; PG8_LDA(At, 1, 0); PG8_STAGE(PG8_SA(0, 1), a2 + hstep, voffA);
            PG8_WAIT_V(8); PG8_WAIT_L(0); PG8_BAR; PG8_MMA(0, 0, At, B0); PG8_MMA(0, 1, At, B1); PG8_BAR; PG8_SCHED;
            PG8_LDA(At, 1, 1); PG8_STAGE(PG8_SB(1, 0), b3, voffB); PG8_STAGE(PG8_SB(1, 1), b3 + hstep, voffB); PG8_STAGE(PG8_SA(1, 0), a3, voffA);
            PG8_WAIT_V(8); PG8_WAIT_L(0); PG8_BAR; PG8_MMA(1, 0, At, B0); PG8_MMA(1, 1, At, B1); PG8_BAR; PG8_SCHED;
            } else {
            PG8_LDB(B0, 0, 0); PG8_SCHED; PG8_LDA(At, 0, 0); PG8_STAGE(PG8_SA(1, 1), a1 + hstep, voffA);
            PG8_WAIT_L(8); PG8_BAR; PG8_WAIT_L(0); PG8_MMA(0, 0, At, B0); PG8_BAR; PG8_SCHED;
            PG8_LDB(B1, 0, 1); PG8_STAGE(PG8_SB(0, 0), b2, voffB);
            PG8_BAR; PG8_WAIT_L(0); PG8_MMA(0, 1, At, B1); PG8_BAR;
            PG8_LDA(At, 0, 1); PG8_STAGE(PG8_SA(0, 0), a2, voffA);
            PG8_BAR; PG8_WAIT_L(0); PG8_MMA(1, 0, At, B0); PG8_BAR; PG8_SCHED;
            PG8_STAGE(PG8_SB(0, 1), b2 + hstep, voffB);
            PG8_WAIT_V(6); PG8_BAR; PG8_MMA(1, 1, At, B1); PG8_BAR;
            PG8_LDB(B0, 1, 0); PG8_SCHED; PG8_LDA(At, 1, 0); PG8_STAGE(PG8_SA(0, 1), a2 + hstep, voffA);
            PG8_WAIT_L(8); PG8_BAR; PG8_WAIT_L(0); PG8_MMA(0, 0, At, B0); PG8_BAR; PG8_SCHED;
            PG8_LDB(B1, 1, 1); PG8_STAGE(PG8_SB(1, 0), b3, voffB);
            PG8_BAR; PG8_WAIT_L(0); PG8_MMA(0, 1, At, B1); PG8_BAR;
            PG8_LDA(At, 1, 1); PG8_STAGE(PG8_SA(1, 0), a3, voffA);
            PG8_BAR; PG8_WAIT_L(0); PG8_MMA(1, 0, At, B0); PG8_BAR; PG8_SCHED;
            PG8_STAGE(PG8_SB(1, 1), b3 + hstep, voffB);
            PG8_WAIT_V(6); PG8_BAR; PG8_MMA(1, 1, At, B1); PG8_BAR;
            }
        }
        if constexpr (ALIGN_EPI) { if (wr == 0) PG8_BAR; }
        if constexpr (!Epi::AFTER_DRAIN) { E(acc, cur, wr, wc, fr, fq); S.done(cur); }
        if (!has_next) break;
#pragma unroll
        for (int a = 0; a < 2; ++a)
#pragma unroll
            for (int b = 0; b < 2; ++b)
#pragma unroll
                for (int m = 0; m < 4; ++m)
#pragma unroll
                    for (int n = 0; n < 2; ++n) acc[a][b][m][n] = (f32x4){0.f, 0.f, 0.f, 0.f};
        cur = nxt; cA = nA; cB = nB; ++ui;
        if constexpr (ALIGN_EPI) { if (wr == 1) PG8_BAR; }
    }
    PG8_WAIT_V(0);
    if constexpr (!ALIGN_EPI) { if (wr == 0) PG8_BAR; }
    PG8_BAR;
    if constexpr (Epi::AFTER_DRAIN) { E.fused(acc, cur, wr, wc, fr, fq, lds, wid, lane); S.done(cur); }
#undef PG8_SA
#undef PG8_SB
#undef PG8_STAGE
#undef PG8_LDA
#undef PG8_LDB
#undef PG8_MMA
#undef PG8_WAIT_V
#undef PG8_WAIT_L
#undef PG8_BAR
#undef PG8_SCHED
}
}


namespace fa {
#define FA_LAS __attribute__((address_space(3)))
typedef short bf16x8 __attribute__((ext_vector_type(8)));
typedef float f32x16 __attribute__((ext_vector_type(16)));
typedef float f32x2_t __attribute__((ext_vector_type(2)));
typedef __bf16 bf16x2_t __attribute__((ext_vector_type(2)));
typedef unsigned u32x4 __attribute__((ext_vector_type(4)));
__device__ __forceinline__ unsigned cvtpk(float lo, float hi) { f32x2_t v = {lo, hi}; bf16x2_t b = __builtin_convertvector(v, bf16x2_t); return __builtin_bit_cast(unsigned, b); }
__device__ __forceinline__ float xhalf(float v, int lane) { return __int_as_float(__builtin_amdgcn_ds_bpermute((lane ^ 32) << 2, __float_as_int(v))); }
struct Tile { const bf16_t* kg; const bf16_t* vg; int key0; };
template <int KS, int KIND, class TileFn>
__device__ __forceinline__ void attn_unit(FA_LAS unsigned char* lds, int tid, int ntiles, const TileFn& tile_of, const bf16_t* qrow, int qpos, float slope2,
                                          unsigned long long selbits, float* orow) {
    constexpr int KBYTES = 2 * KS * 1024;
    constexpr float NEGF = -1e30f;
    const int lane = tid & 63, r32 = lane & 31, hi = lane >> 5;
    bf16x8 qf[KS];
#pragma unroll
    for (int ks = 0; ks < KS; ++ks) qf[ks] = *(const bf16x8*)(qrow + 16 * ks + 8 * hi);
    f32x16 o0, o1;
#pragma unroll
    for (int r = 0; r < 16; ++r) { o0[r] = 0.f; o1[r] = 0.f; }
    float m = NEGF, l = 0.f;
    const bool kload = tid * 16 < KBYTES;
    Tile T = tile_of(0);
    {   u32x4 kreg = {0u, 0u, 0u, 0u};
        if (kload) kreg = *(const u32x4*)((const char*)T.kg + tid * 16);
        const u32x4 vreg = *(const u32x4*)((const char*)T.vg + tid * 16);
        if (kload) *(FA_LAS u32x4*)(lds + tid * 16) = kreg;
        *(FA_LAS u32x4*)(lds + 8192 + tid * 16) = vreg; }
    __syncthreads();
    for (int i = 0; i < ntiles; ++i) {
        const bool more = i + 1 < ntiles;
        Tile Tn = T; u32x4 kreg = {0u, 0u, 0u, 0u}, vreg = {0u, 0u, 0u, 0u};
        if (more) { Tn = tile_of(i + 1); if (kload) kreg = *(const u32x4*)((const char*)Tn.kg + tid * 16); vreg = *(const u32x4*)((const char*)Tn.vg + tid * 16); }
        const FA_LAS unsigned char* Kl = lds + (i & 1) * 16384; const FA_LAS unsigned char* Vl = Kl + 8192;
        const int key0 = T.key0;
        bool act, full; int lim; float base, slopek;
        if (KIND == 3) { const int nv = qpos >= 31 ? ((qpos - 31) >> 4) + 1 : 0; lim = nv - 1 - key0 - 4 * hi; act = key0 < nv; full = key0 + 63 < nv;
                         slopek = slope2 * 16.f; base = slope2 * (float)(16 * (key0 + 4 * hi) + 31 - qpos); }
        else { lim = qpos - key0 - 4 * hi; act = key0 <= qpos; full = key0 + 63 <= qpos; slopek = slope2; base = slope2 * (float)(key0 + 4 * hi - qpos);
               if (KIND == 1) { const bool bit = (selbits >> (key0 >> 6)) & 1ull; act = act && bit; full = full && bit; }
               if (KIND == 2) { act = act && (key0 + 63 > qpos - 512); full = full && (key0 > qpos - 512); } }
        if (__builtin_amdgcn_ballot_w64(act) != 0ull) {
            const bool allfull = __builtin_amdgcn_ballot_w64(full) == ~0ull;
            f32x16 s0, s1;
#pragma unroll
            for (int r = 0; r < 16; ++r) { s0[r] = 0.f; s1[r] = 0.f; }
#pragma unroll
            for (int ks = 0; ks < KS; ++ks) {
                const bf16x8 a0 = *(const FA_LAS bf16x8*)(Kl + (ks * 32 + r32) * 32 + hi * 16);
                const bf16x8 a1 = *(const FA_LAS bf16x8*)(Kl + ((KS + ks) * 32 + r32) * 32 + hi * 16);
                s0 = __builtin_amdgcn_mfma_f32_32x32x16_bf16(a0, qf[ks], s0, 0, 0, 0);
                s1 = __builtin_amdgcn_mfma_f32_32x32x16_bf16(a1, qf[ks], s1, 0, 0, 0);
            }
#pragma unroll
            for (int r = 0; r < 16; ++r) { const int c0 = (r & 3) + 8 * (r >> 2);
                s0[r] += __builtin_fmaf(slopek, (float)c0, base); s1[r] += __builtin_fmaf(slopek, (float)(c0 + 32), base); }
            if (!allfull) {
                const bool bit = KIND == 1 ? (bool)((selbits >> (key0 >> 6)) & 1ull) : true;
#pragma unroll
                for (int r = 0; r < 16; ++r) { const int c0 = (r & 3) + 8 * (r >> 2);
                    bool v0 = bit && (c0 <= lim), v1 = bit && (c0 + 32 <= lim);
                    if (KIND == 2) { v0 = v0 && (c0 > lim - 512); v1 = v1 && (c0 + 32 > lim - 512); }
                    s0[r] = v0 ? s0[r] : NEGF; s1[r] = v1 ? s1[r] : NEGF; }
            }
            float mx = __builtin_fmaxf(s0[0], s1[0]);
#pragma unroll
            for (int r = 1; r < 16; ++r) mx = __builtin_fmaxf(mx, __builtin_fmaxf(s0[r], s1[r]));
            mx = __builtin_fmaxf(mx, xhalf(mx, lane));
            const float mn = __builtin_fmaxf(m, mx), alpha = __builtin_amdgcn_exp2f(m - mn);
            m = mn;
            float psum = 0.f;
#pragma unroll
            for (int r = 0; r < 16; ++r) { float p0 = __builtin_amdgcn_exp2f(s0[r] - mn), p1 = __builtin_amdgcn_exp2f(s1[r] - mn);
                if (!allfull) { p0 = s0[r] > -1e29f ? p0 : 0.f; p1 = s1[r] > -1e29f ? p1 : 0.f; }
                s0[r] = p0; s1[r] = p1; psum += p0 + p1; }
            l = l * alpha + psum;
            if (__builtin_amdgcn_ballot_w64(alpha != 1.f) != 0ull) {
#pragma unroll
                for (int r = 0; r < 16; ++r) { o0[r] *= alpha; o1[r] *= alpha; } }
#pragma unroll
            for (int kb = 0; kb < 2; ++kb)
#pragma unroll
                for (int sp = 0; sp < 2; ++sp) {
                    u32x4 pw;
                    if (kb == 0) { pw.x = cvtpk(s0[8 * sp + 0], s0[8 * sp + 1]); pw.y = cvtpk(s0[8 * sp + 2], s0[8 * sp + 3]); pw.z = cvtpk(s0[8 * sp + 4], s0[8 * sp + 5]); pw.w = cvtpk(s0[8 * sp + 6], s0[8 * sp + 7]); }
                    else         { pw.x = cvtpk(s1[8 * sp + 0], s1[8 * sp + 1]); pw.y = cvtpk(s1[8 * sp + 2], s1[8 * sp + 3]); pw.z = cvtpk(s1[8 * sp + 4], s1[8 * sp + 5]); pw.w = cvtpk(s1[8 * sp + 6], s1[8 * sp + 7]); }
                    const bf16x8 pf = __builtin_bit_cast(bf16x8, pw);
                    const bf16x8 v0 = *(const FA_LAS bf16x8*)(Vl + (((kb * 2 + sp) * 2 + 0) * 32 + r32) * 32 + hi * 16);
                    const bf16x8 v1 = *(const FA_LAS bf16x8*)(Vl + (((kb * 2 + sp) * 2 + 1) * 32 + r32) * 32 + hi * 16);
                    o0 = __builtin_amdgcn_mfma_f32_32x32x16_bf16(v0, pf, o0, 0, 0, 0);
                    o1 = __builtin_amdgcn_mfma_f32_32x32x16_bf16(v1, pf, o1, 0, 0, 0);
                }
        }
        if (more) { FA_LAS unsigned char* nb = lds + ((i + 1) & 1) * 16384;
            if (kload) *(FA_LAS u32x4*)(nb + tid * 16) = kreg;
            *(FA_LAS u32x4*)(nb + 8192 + tid * 16) = vreg; }
        __syncthreads();
        T = Tn;
    }
    const float lt = l + xhalf(l, lane); const float il = lt > 0.f ? 1.f / lt : 0.f;
#pragma unroll
    for (int g = 0; g < 4; ++g) {
        const int d = 8 * g + 4 * hi;
        *(float4*)(orow + d) = make_float4(o0[4 * g] * il, o0[4 * g + 1] * il, o0[4 * g + 2] * il, o0[4 * g + 3] * il);
        *(float4*)(orow + 32 + d) = make_float4(o1[4 * g] * il, o1[4 * g + 1] * il, o1[4 * g + 2] * il, o1[4 * g + 3] * il);
    }
}
}

struct Params {
    const float* x_in; const float* norm_mix; const float* norm_ffn; const float* w_in; const float* w_out;
    const float* diff_q_gain; const float* diff_k_gain; const float* diff_lambda; const float* diff_sub_gain;
    const float* mlstm_conv; const float* mlstm_gate_bias; const float* mlstm_out_gain; const float* hgrn_lb; const float* hgrn_out_gain;
    const float* nsa_cmp_pos; const float* nsa_cmp_w1; const float* nsa_cmp_w2; const float* nsa_q_gain; const float* nsa_k_gain; const float* nsa_out_gain;
    const float* moe_w_group; const float* moe_b_group; const float* moe_w_expert; const float* moe_b_expert;
    const float* moe_w_gate; const float* moe_w_up; const float* moe_w_down;
    float* out; char* ws;
};


constexpr size_t al256(size_t x) { return (x + 255) & ~(size_t)255; }
constexpr size_t WS_P = 0;
constexpr size_t WS_TB = WS_P + al256((size_t)MT * LDP * 2);
constexpr size_t WS_MIXED = WS_TB + al256((size_t)MT * DM * 2);
constexpr size_t WS_DQ = WS_MIXED + al256((size_t)MT * DM * 2);
constexpr size_t WS_DK = WS_DQ + al256((size_t)MT * 256 * 4);
constexpr size_t WS_NQ = WS_DK + al256((size_t)MT * 256 * 4);
constexpr size_t WS_KSN = WS_NQ + al256((size_t)MT * 256 * 4);
constexpr size_t WS_KWN = WS_KSN + al256((size_t)MT * 64 * 4);
constexpr size_t WS_CMP = WS_KWN + al256((size_t)MT * 64 * 4);
constexpr size_t WS_OCMP = WS_CMP + al256((size_t)2 * NB * NCMP * 64 * 4);
constexpr size_t WS_IMP = WS_OCMP + al256((size_t)MT * 256 * 4);
constexpr size_t WS_SELMASK = WS_IMP + al256((size_t)MT * 64 * 4);
constexpr size_t WS_RE = WS_SELMASK + al256((size_t)MT * 8);
constexpr size_t WS_RW = WS_RE + al256((size_t)MT * 2 * 4);
constexpr size_t WS_RS = WS_RW + al256((size_t)MT * 2 * 4);
constexpr int MOE_ROWS_MAX = 2 * MT + 32 * 256;
constexpr size_t WS_ROWTOK = WS_RS + al256((size_t)MT * 2 * 4);
constexpr size_t WS_ROWW = WS_ROWTOK + al256((size_t)MOE_ROWS_MAX * 4);
constexpr size_t WS_CNT = WS_ROWW + al256((size_t)MOE_ROWS_MAX * 4);
constexpr size_t WS_WIN_T = WS_CNT + 256;
constexpr size_t WS_WOUT_T = WS_WIN_T + al256((size_t)LDP * DM * 2);
constexpr size_t WS_END = WS_WOUT_T + al256((size_t)DM * DM * 2);
static_assert((size_t)32 * 512 * DM * 2 + (size_t)32 * DM * 256 * 2 + (size_t)MOE_ROWS_MAX * 256 * 2 <= WS_TB, "MoE weight copies + H overlay P");
static_assert(WS_MIXED + (size_t)MOE_ROWS_MAX * DM * 2 <= WS_SELMASK, "sorted activations overlay mixed..imp");
#define W_P ((bf16_t*)(pq->ws + WS_P))
#define W_TB ((bf16_t*)(pq->ws + WS_TB))
#define W_MIXED ((bf16_t*)(pq->ws + WS_MIXED))
#define W_DQ ((float*)(pq->ws + WS_DQ))
#define W_DK ((float*)(pq->ws + WS_DK))
#define W_QBF ((bf16_t*)(pq->ws + WS_DQ))
#define W_DKF ((bf16_t*)(pq->ws + WS_DK))
#define W_DVF ((bf16_t*)(pq->ws + WS_DK + (size_t)MT * 256 * 2))
#define W_DO ((float*)(pq->ws + WS_TB))
#define W_NQ ((float*)(pq->ws + WS_NQ))
#define W_KSN ((float*)(pq->ws + WS_KSN))
#define W_KWN ((float*)(pq->ws + WS_KWN))
#define W_CMP ((float*)(pq->ws + WS_CMP))
#define W_OCMP ((float*)(pq->ws + WS_OCMP))
#define W_IMP ((float*)(pq->ws + WS_IMP))
#define W_OSEL W_DQ
#define W_OWIN W_DK
#define W_SELMASK ((unsigned long long*)(pq->ws + WS_SELMASK))
#define W_RE ((int*)(pq->ws + WS_RE))
#define W_RW ((float*)(pq->ws + WS_RW))
#define W_RS ((int*)(pq->ws + WS_RS))
#define W_ROWTOK ((int*)(pq->ws + WS_ROWTOK))
#define W_ROWW ((float*)(pq->ws + WS_ROWW))
#define W_CNT ((int*)(pq->ws + WS_CNT))
#define W_WGU_T ((bf16_t*)(pq->ws + WS_P))
#define W_WD_T ((bf16_t*)(pq->ws + WS_P + (size_t)32 * 512 * DM * 2))
#define W_HS ((bf16_t*)(pq->ws + WS_P + (size_t)32 * 512 * DM * 2 + (size_t)32 * DM * 256 * 2))
#define W_ASORT ((bf16_t*)(pq->ws + WS_MIXED))
#define W_WIN_T ((bf16_t*)(pq->ws + WS_WIN_T))
#define W_WOUT_T ((bf16_t*)(pq->ws + WS_WOUT_T))

__device__ __forceinline__ void norm_row(const float* x, const float* gain, bf16_t* t, int row, int lane) {
    const float4* xr = (const float4*)(x + (size_t)row * DM);
    float4 v[4]; float s = 0.f;
#pragma unroll
    for (int j = 0; j < 4; ++j) { v[j] = xr[lane + 64 * j]; s += v[j].x * v[j].x + v[j].y * v[j].y + v[j].z * v[j].z + v[j].w * v[j].w; }
    const float r = rsqrtf(wave_sum(s, lane) * (1.f / DM) + EPS);
#pragma unroll
    for (int j = 0; j < 4; ++j) {
        const float4 g = ((const float4*)gain)[lane + 64 * j];
        ushort4 o; o.x = f2bf(v[j].x * r * g.x); o.y = f2bf(v[j].y * r * g.y); o.z = f2bf(v[j].z * r * g.z); o.w = f2bf(v[j].w * r * g.w);
        ((ushort4*)(t + (size_t)row * DM))[lane + 64 * j] = o;
    }
}


typedef __attribute__((address_space(3))) float lds_f32;
typedef unsigned v4u_t __attribute__((ext_vector_type(4)));
__device__ __forceinline__ unsigned pk2bf(float lo, float hi) { return (unsigned)f2bf(lo) | ((unsigned)f2bf(hi) << 16); }
template <bool MAP>
__device__ __forceinline__ void transpose_item(const float* W, int K, int Nsrc, int Nnew, bf16_t* WT, lds_f32* scr, int item, int lane) {
    const int nblk = Nnew / 32, kb = item / nblk, nb = item % nblk, k0 = 64 * kb, n0 = 32 * nb;
    const int n = n0 + (lane & 31); const int sc = MAP ? src_col(n) : n; const bool ok = MAP ? (n < IN_COLS) : true;
#pragma unroll 8
    for (int i = 0; i < 32; ++i) { const int kk = 2 * i + (lane >> 5); scr[kk * 33 + (lane & 31)] = ok ? W[(size_t)(k0 + kk) * Nsrc + sc] : 0.f; }
    asm volatile("s_waitcnt lgkmcnt(0)" ::: "memory");
    const int c = lane & 7;
#pragma unroll
    for (int j = 0; j < 4; ++j) { const int nn = (lane >> 3) + 8 * j; const lds_f32* sp = scr + (8 * c) * 33 + nn;
        v4u_t o; o.x = pk2bf(sp[0 * 33], sp[1 * 33]); o.y = pk2bf(sp[2 * 33], sp[3 * 33]); o.z = pk2bf(sp[4 * 33], sp[5 * 33]); o.w = pk2bf(sp[6 * 33], sp[7 * 33]);
        *(v4u_t*)(WT + (size_t)(n0 + nn) * K + k0 + 8 * c) = o; }
    asm volatile("s_waitcnt lgkmcnt(0)" ::: "memory");
}

template <int G>
__device__ __forceinline__ void group_norm_item(const bf16_t* P, int col0, int ngroups, const float* gain, float scale, float* out, int ldo, int idx) {
    const int m = idx / ngroups, g = idx % ngroups;
    const bf16_t* p = P + (size_t)m * LDP + col0 + g * G;
    float v[G]; float s = 0.f;
#pragma unroll
    for (int d = 0; d < G; ++d) { v[d] = bf2f(p[d]); s += v[d] * v[d]; }
    const float r = rsqrtf(s * (1.f / G) + EPS) * scale;
#pragma unroll
    for (int d = 0; d < G; ++d) out[(size_t)m * ldo + g * G + d] = v[d] * r * gain[d];
}


constexpr float LOG2E = 1.4426950408889634f;
__device__ __forceinline__ void diff_prep_qk(const bf16_t* P, const float* qgain, const float* kgain, bf16_t* Qbf, bf16_t* Kf, int idx) {
    const int m = idx >> 3, g = idx & 7;
    {   const uint4* p = (const uint4*)(P + (size_t)m * LDP + PC_AQ + g * 32); float v[32]; float ss = 0.f;
#pragma unroll
        for (int i = 0; i < 4; ++i) { const uint4 u = p[i]; const unsigned w[4] = {u.x, u.y, u.z, u.w};
#pragma unroll
            for (int j = 0; j < 4; ++j) { v[i * 8 + 2 * j] = __uint_as_float(w[j] << 16); v[i * 8 + 2 * j + 1] = __uint_as_float(w[j] & 0xffff0000u); } }
#pragma unroll
        for (int d = 0; d < 32; ++d) ss += v[d] * v[d];
        const float r = rsqrtf(ss * (1.f / 32) + EPS) * (0.17677669529663687f * LOG2E);
        uint4* o = (uint4*)(Qbf + (size_t)m * 256 + g * 32);
#pragma unroll
        for (int i = 0; i < 4; ++i) { uint4 u; u.x = pk2bf(v[i * 8 + 0] * r * qgain[i * 8 + 0], v[i * 8 + 1] * r * qgain[i * 8 + 1]); u.y = pk2bf(v[i * 8 + 2] * r * qgain[i * 8 + 2], v[i * 8 + 3] * r * qgain[i * 8 + 3]);
            u.z = pk2bf(v[i * 8 + 4] * r * qgain[i * 8 + 4], v[i * 8 + 5] * r * qgain[i * 8 + 5]); u.w = pk2bf(v[i * 8 + 6] * r * qgain[i * 8 + 6], v[i * 8 + 7] * r * qgain[i * 8 + 7]); o[i] = u; } }
    {   const uint4* p = (const uint4*)(P + (size_t)m * LDP + PC_AK + g * 32); float v[32]; float ss = 0.f;
#pragma unroll
        for (int i = 0; i < 4; ++i) { const uint4 u = p[i]; const unsigned w[4] = {u.x, u.y, u.z, u.w};
#pragma unroll
            for (int j = 0; j < 4; ++j) { v[i * 8 + 2 * j] = __uint_as_float(w[j] << 16); v[i * 8 + 2 * j + 1] = __uint_as_float(w[j] & 0xffff0000u); } }
#pragma unroll
        for (int d = 0; d < 32; ++d) ss += v[d] * v[d];
        const float r = rsqrtf(ss * (1.f / 32) + EPS);
        const int b = m / SEQ, t = m % SEQ, tile = t >> 6, kb = (t >> 5) & 1, rr = t & 31;
#pragma unroll
        for (int i = 0; i < 4; ++i) { uint4 u; u.x = pk2bf(v[i * 8 + 0] * r * kgain[i * 8 + 0], v[i * 8 + 1] * r * kgain[i * 8 + 1]); u.y = pk2bf(v[i * 8 + 2] * r * kgain[i * 8 + 2], v[i * 8 + 3] * r * kgain[i * 8 + 3]);
            u.z = pk2bf(v[i * 8 + 4] * r * kgain[i * 8 + 4], v[i * 8 + 5] * r * kgain[i * 8 + 5]); u.w = pk2bf(v[i * 8 + 6] * r * kgain[i * 8 + 6], v[i * 8 + 7] * r * kgain[i * 8 + 7]);
            const int ks = i >> 1, hh = i & 1;
            *(uint4*)(Kf + ((((((size_t)(b * 8 + g) * 64 + tile) * 2 + kb) * 2 + ks) * 32 + rr) * 2 + hh) * 8) = u; } }
}
__device__ __forceinline__ void vfrag_item(const bf16_t* P, int pcol, int hstride, int nheads, bf16_t* Vf, int idx) {
    const int hh = idx & 1, d32 = (idx >> 1) & 31, dblk = (idx >> 6) & 1, sp = (idx >> 7) & 1, kb = (idx >> 8) & 1, tile = (idx >> 9) & 63;
    const int bh = idx >> 15, h = bh % nheads, b = bh / nheads;
    const int key0 = 64 * tile + 32 * kb + 16 * sp + 4 * hh, col = pcol + h * hstride + dblk * 32 + d32;
    unsigned short e[8];
#pragma unroll
    for (int j = 0; j < 8; ++j) e[j] = P[(size_t)(b * SEQ + key0 + 8 * (j >> 2) + (j & 3)) * LDP + col];
    uint4 u; u.x = e[0] | ((unsigned)e[1] << 16); u.y = e[2] | ((unsigned)e[3] << 16); u.z = e[4] | ((unsigned)e[5] << 16); u.w = e[6] | ((unsigned)e[7] << 16);
    *(uint4*)(Vf + (size_t)idx * 8) = u;
}

__device__ __forceinline__ void diff_combine_item(const float* O, const float* lamv, const float* subg, float lam_init, bf16_t* mixed, int idx) {
    const int m = idx >> 2, h = idx & 3;
    float d01 = 0.f, d23 = 0.f;
    for (int i = 0; i < 32; ++i) { d01 += lamv[i] * lamv[32 + i]; d23 += lamv[64 + i] * lamv[96 + i]; }
    const float lam = __expf(d01) - __expf(d23) + lam_init;
    const float* o0 = O + ((size_t)m * 8 + h * 2) * 64; const float* o1 = o0 + 64;
    float v[64]; float s = 0.f;
#pragma unroll
    for (int e = 0; e < 64; ++e) { v[e] = o0[e] - lam * o1[e]; s += v[e] * v[e]; }
    const float r = rsqrtf(s * (1.f / 64) + EPS) * (1.f - lam_init);
#pragma unroll
    for (int e = 0; e < 64; ++e) mixed[(size_t)m * DM + h * 64 + e] = f2bf(v[e] * r * subg[h * 64 + e]);
}

__device__ __forceinline__ void mlstm_rec_item(const bf16_t* P, const float* cw, const float* gbias, const float* outg, bf16_t* mixed, int item, int lane) {
    const int b = item >> 2, h = item & 3;
    float C[64]; float nvec = 0.f;
#pragma unroll
    for (int k = 0; k < 64; ++k) C[k] = 0.f;
    const float bi = gbias[h], bfz = gbias[4 + h], og = outg[h * 64 + lane];
    for (int t = 0; t < SEQ; ++t) {
        const size_t m = (size_t)b * SEQ + t;
        float qv = 0.f, kv = 0.f;
#pragma unroll
        for (int k = 0; k < 4; ++k) { const int tt = t - 3 + k; if (tt >= 0) {
            qv += cw[k * 512 + h * 64 + lane] * bf2f(P[(m - 3 + k) * LDP + PC_BQ + h * 64 + lane]);
            kv += cw[k * 512 + 256 + h * 64 + lane] * bf2f(P[(m - 3 + k) * LDP + PC_BK + h * 64 + lane]); } }
        qv = siluf_(qv) * 0.125f; kv = siluf_(kv);
        const float ve = bf2f(P[m * LDP + PC_BV + h * 64 + lane]);
        const float ipre = bf2f(P[m * LDP + PC_BI + h]) + bi, fpre = bf2f(P[m * LDP + PC_BF + h]) + bfz;
        const float f = sigmoidf_(fpre), ei = __expf(ipre);
        const float kse = kv * ei;
        float num = 0.f;
        nvec = f * nvec + kse;
        const float den = wave_sum(qv * nvec, lane);
#pragma unroll
        for (int k = 0; k < 64; ++k) {
            const float sk = rdlane(kse, k), sq = rdlane(qv, k);
            C[k] = f * C[k] + sk * ve;
            num += sq * C[k];
        }
        const float hv = num / fmaxf(fabsf(den), 1.f);
        const float r = rsqrtf(wave_sum(hv * hv, lane) * (1.f / 64) + EPS);
        const float go = sigmoidf_(bf2f(P[m * LDP + PC_BO + h * 64 + lane]));
        mixed[m * DM + 256 + h * 64 + lane] = f2bf(hv * r * og * go);
    }
}
__device__ __forceinline__ void hgrn_rec_item(const bf16_t* P, const float* lbp, int layer, const float* outg, bf16_t* mixed, int item, int lane) {
    const int b = item >> 2, h = item & 3;
    float S[64];
#pragma unroll
    for (int k = 0; k < 64; ++k) S[k] = 0.f;
    float lb = 0.f;
    if (layer == 1) lb = sigmoidf_(lbp[256 + h * 64 + lane] - lbp[h * 64 + lane]);
    const float og = outg[h * 64 + lane];
    for (int t = 0; t < SEQ; ++t) {
        const size_t m = (size_t)b * SEQ + t;
        const float z = bf2f(P[m * LDP + PC_CF + h * 64 + lane]);
        const float f = lb + (1.f - lb) * sigmoidf_(z), kk = 1.f - f;
        const float qv = siluf_(bf2f(P[m * LDP + PC_CQ + h * 64 + lane]));
        const float ve = bf2f(P[m * LDP + PC_CI + h * 64 + lane]);
        float o = 0.f;
#pragma unroll
        for (int k = 0; k < 64; ++k) {
            const float sa = rdlane(f, k), sk = rdlane(kk, k), sq = rdlane(qv, k);
            S[k] = sa * S[k] + sk * ve; o += sq * S[k];
        }
        const float r = rsqrtf(wave_sum(o * o, lane) * (1.f / 64) + EPS);
        const float gg = sigmoidf_(bf2f(P[m * LDP + PC_CG + h * 64 + lane]));
        mixed[m * DM + 512 + h * 64 + lane] = f2bf(o * r * og * gg);
    }
}

__device__ __forceinline__ void nsa_compress_vb(const bf16_t* P, const float* pos, const float* w1, const float* w2, const float* kgain0, float* cmp, int vb, int tid, float* ldsf) {
    float (*red)[64] = (float (*)[64])ldsf; float* hid = ldsf + 256;
    const int n = vb % NCMP, b = (vb / NCMP) % NB, j = vb / (NCMP * NB);
    const int o = tid & 63, part = tid >> 6;
    const int pc = j == 0 ? PC_KC : PC_VC;
    float acc = 0.f;
    for (int l = part * 8; l < part * 8 + 8; ++l) {
        const bf16_t* row = P + (size_t)(b * SEQ + 16 * n + l) * LDP + pc;
        for (int d = 0; d < 64; ++d) acc += (bf2f(row[d]) + pos[(j * 32 + l) * 64 + d]) * w1[((size_t)j * 2048 + l * 64 + d) * 64 + o];
    }
    red[part][o] = acc; __syncthreads();
    if (part == 0) {
        const float x = red[0][o] + red[1][o] + red[2][o] + red[3][o];
        hid[o] = 0.5f * x * (1.f + tanhf(0.7978845608028654f * (x + 0.044715f * x * x * x)));
    }
    __syncthreads();
    if (part == 0) {
        float y = 0.f;
        for (int i = 0; i < 64; ++i) y += hid[i] * w2[(j * 64 + i) * 64 + o];
        if (j == 0) { const float r = rsqrtf(wave_sum(y * y, o) * (1.f / 64) + EPS); y = y * r * kgain0[o]; }
        cmp[(((size_t)j * NB + b) * NCMP + n) * 64 + o] = y;
    }
    __syncthreads();
}
__device__ __forceinline__ void nsa_cmp_attn_item(const float* qn, const float* cmp, float* ocmp, float* imp, int item, int lane) {
    const int m = item * 64 + lane; const int b = m / SEQ, t = m % SEQ;
    const float* kc = cmp + (size_t)b * NCMP * 64; const float* vc = cmp + ((size_t)NB + b) * NCMP * 64;
    float* im = imp + (size_t)m * 64;
    for (int j = 0; j < 64; ++j) im[j] = 0.f;
    const int nv = t >= 31 ? (t - 31) / 16 + 1 : 0;
#pragma unroll 1
    for (int h = 0; h < 4; ++h) {
        const float slope = exp2f(-(float)(2 * h + 2));
        float q[64], o[64];
#pragma unroll
        for (int d = 0; d < 64; ++d) { q[d] = qn[(size_t)m * 256 + h * 64 + d]; o[d] = 0.f; }
        float mx = NEG;
#pragma unroll 1
        for (int n = 0; n < nv; ++n) { float s = 0.f;
#pragma unroll
            for (int d = 0; d < 32; ++d) s += q[d] * kc[n * 64 + d];
            asm volatile("" ::: "memory");
#pragma unroll
            for (int d = 32; d < 64; ++d) s += q[d] * kc[n * 64 + d];
            asm volatile("" ::: "memory");
            s -= slope * (float)(t - (16 * n + 31)); mx = fmaxf(mx, s); }
        float l = 0.f;
#pragma unroll 1
        for (int n = 0; n < nv; ++n) { float s = 0.f;
#pragma unroll
            for (int d = 0; d < 32; ++d) s += q[d] * kc[n * 64 + d];
            asm volatile("" ::: "memory");
#pragma unroll
            for (int d = 32; d < 64; ++d) s += q[d] * kc[n * 64 + d];
            asm volatile("" ::: "memory");
            s -= slope * (float)(t - (16 * n + 31)); l += __expf(s - mx); }
        const float il = nv > 0 ? 1.f / l : 0.f;
#pragma unroll 1
        for (int n = 0; n < nv; ++n) { float s = 0.f;
#pragma unroll
            for (int d = 0; d < 32; ++d) s += q[d] * kc[n * 64 + d];
            asm volatile("" ::: "memory");
#pragma unroll
            for (int d = 32; d < 64; ++d) s += q[d] * kc[n * 64 + d];
            asm volatile("" ::: "memory");
            s -= slope * (float)(t - (16 * n + 31));
            const float p = __expf(s - mx) * il;
            asm volatile("" ::: "memory");
#pragma unroll
            for (int d = 0; d < 32; ++d) o[d] += p * vc[n * 64 + d];
            asm volatile("" ::: "memory");
#pragma unroll
            for (int d = 32; d < 64; ++d) o[d] += p * vc[n * 64 + d];
            asm volatile("" ::: "memory");
            const int jb = n >> 2, r = n & 3;
            if (r < 3) im[jb] += p; else { im[jb] += 0.5f * p; if (jb + 1 < 64) im[jb + 1] += 0.5f * p; }
        }
#pragma unroll
        for (int d = 0; d < 64; ++d) ocmp[((size_t)m * 4 + h) * 64 + d] = o[d];
    }
}
__device__ __forceinline__ void nsa_topk_item(const float* imp, unsigned long long* selmask, int m) {
    const int t = m % SEQ, qb = t >> 6;
    const float* im = imp + (size_t)m * 64;
    unsigned long long mask = 0ull;
    for (int j = 0; j < 64; ++j) {
        float vj = j <= qb ? im[j] : -1.f; if (j == 0 || j == qb || j == qb - 1) vj = 2.f;
        int rank = 0;
        for (int i = 0; i < 64; ++i) {
            float vi = i <= qb ? im[i] : -1.f; if (i == 0 || i == qb || i == qb - 1) vi = 2.f;
            rank += (vi > vj || (vi == vj && i < j)) ? 1 : 0;
        }
        if (rank < 16) mask |= 1ull << j;
    }
    selmask[m] = mask;
}
template <int KIND>
__device__ __forceinline__ void nsa_branch_item(const float* qn, const float* kn, const bf16_t* P, const unsigned long long* selmask, float* obr, int item, int lane) {
    const int h = item & 3, m = (item >> 2) * 64 + lane; const int b = m / SEQ, t = m % SEQ;
    const float slope = exp2f(-(float)(2 * h + 2));
    float q[64], o[64];
#pragma unroll
    for (int d = 0; d < 64; ++d) { q[d] = qn[(size_t)m * 256 + h * 64 + d]; o[d] = 0.f; }
    float mrun = NEG, l = 0.f;
    const int pcv = KIND == 0 ? PC_VS : PC_VW;
    if (KIND == 0) {
        const unsigned long long mask = selmask[m];
        for (int jb = 0; jb < 64; ++jb) {
            if (!((mask >> jb) & 1ull)) continue;
            for (int i = 0; i < 64; ++i) {
                const int kp = jb * 64 + i; if (kp > t) break;
                const float* kr = kn + (size_t)(b * SEQ + kp) * 64; float s = 0.f;
#pragma unroll
                for (int d = 0; d < 64; ++d) s += q[d] * kr[d];
                s -= slope * (float)(t - kp);
                const float mn = fmaxf(mrun, s), al = __expf(mrun - mn), p = __expf(s - mn);
                l = l * al + p; mrun = mn;
                const bf16_t* vr = P + (size_t)(b * SEQ + kp) * LDP + pcv;
#pragma unroll
                for (int d = 0; d < 64; ++d) o[d] = o[d] * al + p * bf2f(vr[d]);
            }
        }
    } else {
        const int k0 = t - 511 > 0 ? t - 511 : 0;
        for (int kp = k0; kp <= t; ++kp) {
            const float* kr = kn + (size_t)(b * SEQ + kp) * 64; float s = 0.f;
#pragma unroll
            for (int d = 0; d < 64; ++d) s += q[d] * kr[d];
            s -= slope * (float)(t - kp);
            const float mn = fmaxf(mrun, s), al = __expf(mrun - mn), p = __expf(s - mn);
            l = l * al + p; mrun = mn;
            const bf16_t* vr = P + (size_t)(b * SEQ + kp) * LDP + pcv;
#pragma unroll
            for (int d = 0; d < 64; ++d) o[d] = o[d] * al + p * bf2f(vr[d]);
        }
    }
    const float il = 1.f / l;
#pragma unroll
    for (int d = 0; d < 64; ++d) obr[((size_t)m * 4 + h) * 64 + d] = o[d] * il;
}
__device__ __forceinline__ void nsa_combine_item(const bf16_t* P, const float* ocmp, const float* osel, const float* owin, const float* outg, bf16_t* mixed, int idx) {
    const int m = idx >> 2, h = idx & 3;
    const float g0 = sigmoidf_(bf2f(P[(size_t)m * LDP + PC_DG + h * 3 + 0])), g1 = sigmoidf_(bf2f(P[(size_t)m * LDP + PC_DG + h * 3 + 1])),
                g2 = sigmoidf_(bf2f(P[(size_t)m * LDP + PC_DG + h * 3 + 2]));
    const size_t base = ((size_t)m * 4 + h) * 64;
    float v[64]; float s = 0.f;
#pragma unroll
    for (int d = 0; d < 64; ++d) { v[d] = g0 * ocmp[base + d] + g1 * osel[base + d] + g2 * owin[base + d]; s += v[d] * v[d]; }
    const float r = rsqrtf(s * (1.f / 64) + EPS);
#pragma unroll
    for (int d = 0; d < 64; ++d) mixed[(size_t)m * DM + 768 + h * 64 + d] = f2bf(v[d] * r * outg[h * 64 + d]);
}

__device__ __forceinline__ void moe_route_row(const float* x, const float* gain, const float* wg, const float* bg, const float* we, const float* be, bf16_t* t, int* re, float* rw, int* rs, int* cnt,
                                              int row, int lane) {
    const float4* xr = (const float4*)(x + (size_t)row * DM);
    float4 v[4]; float s = 0.f;
#pragma unroll
    for (int j = 0; j < 4; ++j) { v[j] = xr[lane + 64 * j]; s += v[j].x * v[j].x + v[j].y * v[j].y + v[j].z * v[j].z + v[j].w * v[j].w; }
    const float r = rsqrtf(wave_sum(s, lane) * (1.f / DM) + EPS);
    float lg[36];
#pragma unroll
    for (int o = 0; o < 36; ++o) lg[o] = 0.f;
#pragma unroll
    for (int j = 0; j < 4; ++j) {
        const float4 g = ((const float4*)gain)[lane + 64 * j];
        float tn[4] = {v[j].x * r * g.x, v[j].y * r * g.y, v[j].z * r * g.z, v[j].w * r * g.w};
        ushort4 o4; o4.x = f2bf(tn[0]); o4.y = f2bf(tn[1]); o4.z = f2bf(tn[2]); o4.w = f2bf(tn[3]);
        ((ushort4*)(t + (size_t)row * DM))[lane + 64 * j] = o4;
#pragma unroll
        for (int i = 0; i < 4; ++i) {
            const int k = (lane + 64 * j) * 4 + i;
            const float4 w4 = ((const float4*)wg)[k];
            lg[0] += tn[i] * w4.x; lg[1] += tn[i] * w4.y; lg[2] += tn[i] * w4.z; lg[3] += tn[i] * w4.w;
#pragma unroll
            for (int e4 = 0; e4 < 8; ++e4) { const float4 w = ((const float4*)we)[k * 8 + e4];
                lg[4 + e4 * 4 + 0] += tn[i] * w.x; lg[4 + e4 * 4 + 1] += tn[i] * w.y; lg[4 + e4 * 4 + 2] += tn[i] * w.z; lg[4 + e4 * 4 + 3] += tn[i] * w.w; }
        }
    }
#pragma unroll
    for (int o = 0; o < 36; ++o) lg[o] = wave_sum(lg[o], lane);
    float gl[4]; float gmx = NEG; int gs = 0;
#pragma unroll
    for (int g = 0; g < 4; ++g) { gl[g] = lg[g] + bg[g]; if (gl[g] > gmx) { gmx = gl[g]; gs = g; } }
    float gz = 0.f;
#pragma unroll
    for (int g = 0; g < 4; ++g) gz += __expf(gl[g] - gmx);
    const float gprob = 1.f / gz;
    float el[8];
#pragma unroll
    for (int e = 0; e < 8; ++e) {
        const float a0 = lg[4 + e] + be[e], a1 = lg[12 + e] + be[8 + e], a2 = lg[20 + e] + be[16 + e], a3 = lg[28 + e] + be[24 + e];
        el[e] = gs == 0 ? a0 : (gs == 1 ? a1 : (gs == 2 ? a2 : a3));
    }
    float m1 = NEG; int i1 = 0;
#pragma unroll
    for (int e = 0; e < 8; ++e) if (el[e] > m1) { m1 = el[e]; i1 = e; }
    float m2 = NEG; int i2 = 0;
#pragma unroll
    for (int e = 0; e < 8; ++e) if (e != i1 && el[e] > m2) { m2 = el[e]; i2 = e; }
    const float p2 = __expf(m2 - m1);
    const float w1 = gprob / (1.f + p2), w2 = gprob * p2 / (1.f + p2);
    if (lane == 0) { const int e1 = gs * 8 + i1, e2 = gs * 8 + i2;
        re[row * 2] = e1; re[row * 2 + 1] = e2; rw[row * 2] = w1; rw[row * 2 + 1] = w2;
        rs[row * 2] = atomicAdd(cnt + e1, 1); rs[row * 2 + 1] = atomicAdd(cnt + e2, 1); }
}
__device__ __forceinline__ void moe_table(const int* cnt, __attribute__((address_space(3))) int* tab, int tid) {
    if (tid < 64) {
        const int lane = tid; const int c = lane < 32 ? cnt[lane] : 0; const int pc = (c + 255) >> 8;
        int x = pc;
#pragma unroll
        for (int o = 1; o < 32; o <<= 1) { const int y = __builtin_amdgcn_ds_bpermute(((lane - o) & 63) << 2, x); if (lane >= o) x += y; }
        const int ex = x - pc;
        if (lane < 32) { tab[lane] = ex * 256; tab[32 + lane] = c; for (int t = 0; t < pc; ++t) tab[128 + ex + t] = lane; }
        if (lane == 31) tab[64] = x;
    }
    __syncthreads();
}

__global__ void __launch_bounds__(NTHR) mega_fwd(Params p_unused) {
    extern __shared__ __attribute__((aligned(16))) unsigned char lds[];
    cg::grid_group grid = cg::this_grid();
    const int G = gridDim.x, bid = blockIdx.x;
    typedef const __attribute__((address_space(4))) Params* cparams_t;
    const cparams_t pp = (cparams_t)__builtin_amdgcn_kernarg_segment_ptr();
#define PHASE_VARS \
    int tid = threadIdx.x; asm volatile("" : "+v"(tid)); \
    cparams_t pq = pp; asm volatile("" : "+s"(pq)); \
    const float* xcur = l == 0 ? pq->x_in : pq->out; (void)xcur; \
    const int lane = tid & 63, wave = tid >> 6, half = tid >> 8, tid256 = tid & 255; \
    const int gw = bid * NWAVE + wave, NGW = G * NWAVE; \
    const int gt = bid * NTHR + tid, NGT = G * NTHR; \
    float* ldsf = (float*)lds + half * 4096; \
    (void)lane; (void)tid256; (void)gw; (void)NGW; (void)gt; (void)NGT; (void)ldsf;

    for (int l = 0; l < DEPTH; ++l) {
        {   PHASE_VARS
        {   lds_f32* scr = (lds_f32*)lds + wave * (64 * 33);
            for (int it = gw; it < (DM / 64) * (LDP / 32); it += NGW) transpose_item<true>(pq->w_in + (size_t)l * DM * IN_COLS, DM, IN_COLS, LDP, W_WIN_T, scr, it, lane);
            for (int it = gw; it < (DM / 64) * (DM / 32); it += NGW) transpose_item<false>(pq->w_out + (size_t)l * DM * DM, DM, DM, DM, W_WOUT_T, scr, it, lane); }
        if (bid == 0 && tid < 32) W_CNT[tid] = 0;
        for (int row = gw; row < MT; row += NGW) norm_row(xcur, pq->norm_mix + l * DM, W_TB, row, lane);
        }
        grid.sync();
        {   PHASE_VARS
        {   pg8::Gemm g{W_TB, W_WIN_T, MT, LDP, DM}; pg8::StaticOrder S; S.init(MT, LDP, G, bid);
            pg8::EpiBf16<0> E{W_P, LDP, nullptr, 0, 0, 1.f};
            pg8::gemm_phase<pg8::EpiBf16<0>, pg8::StaticOrder, true, true>((PG8_LAS unsigned char*)lds, g, S, E); }
        }
        grid.sync();
        {   PHASE_VARS
        for (int i = gt; i < MT * 8; i += NGT) diff_prep_qk(W_P, pq->diff_q_gain + l * 32, pq->diff_k_gain + l * 32, W_QBF, W_DKF, i);
        for (int i = gt; i < NB * 4 * 64 * 512; i += NGT) vfrag_item(W_P, PC_AV, 64, 4, W_DVF, i);
        for (int i = gt; i < MT * 4; i += NGT) group_norm_item<64>(W_P, PC_DQ, 4, pq->nsa_q_gain + l * 64, 0.125f, W_NQ, 256, i);
        for (int i = gt; i < MT; i += NGT) group_norm_item<64>(W_P, PC_KS, 1, pq->nsa_k_gain + (l * 3 + 1) * 64, 1.f, W_KSN, 64, i);
        for (int i = gt; i < MT; i += NGT) group_norm_item<64>(W_P, PC_KW, 1, pq->nsa_k_gain + (l * 3 + 2) * 64, 1.f, W_KWN, 64, i);
        for (int it = bid; it < 2 * NB * NCMP / 2; it += G) { const int vb = it * 2 + half;
            nsa_compress_vb(W_P, pq->nsa_cmp_pos + l * 2 * 32 * 64, pq->nsa_cmp_w1 + (size_t)l * 2 * 2048 * 64, pq->nsa_cmp_w2 + l * 2 * 64 * 64, pq->nsa_k_gain + (l * 3 + 0) * 64, W_CMP, vb, tid256, ldsf); }
        }
        grid.sync();
        {   PHASE_VARS
        if (gw < 16) mlstm_rec_item(W_P, pq->mlstm_conv + l * 4 * 512, pq->mlstm_gate_bias + l * 8, pq->mlstm_out_gain + l * 256, W_MIXED, gw, lane);
        else if (gw < 32) hgrn_rec_item(W_P, pq->hgrn_lb, l, pq->hgrn_out_gain + l * 256, W_MIXED, gw - 16, lane);
        {
            const int vcu = (G & 7) == 0 ? (bid & 7) * (G >> 3) + (bid >> 3) : bid;
            for (int pr = vcu; pr < 256; pr += G) {
                const int combo = pr >> 3, sidx = pr & 7, c = combo & 1, h = (combo >> 1) & 3, b = combo >> 3;
                const bf16_t* kbase = W_DKF + (size_t)((b * 4 + h) * 2 + c) * 64 * 2048; const bf16_t* vbase = W_DVF + (size_t)(b * 4 + h) * 64 * 4096;
                auto tile_of = [=](int i) { fa::Tile T; T.kg = kbase + (size_t)i * 2048; T.vg = vbase + (size_t)i * 4096; T.key0 = i * 64; return T; };
                const float slope2 = exp2f(-(float)(2 * h + 1)) * LOG2E;
#pragma unroll 1
                for (int u = 0; u < 2; ++u) { const int qb = u == 0 ? 15 - sidx : sidx;
                    const int t = qb * 256 + wave * 32 + (lane & 31); const size_t m = (size_t)b * SEQ + t;
                    fa::attn_unit<2, 0>((FA_LAS unsigned char*)lds, tid, 4 * (qb + 1), tile_of, W_QBF + m * 256 + h * 64 + c * 32, t, slope2, 0ull, W_DO + (m * 8 + h * 2 + c) * 64); }
            }
        }
        for (int it = gw; it < 256; it += NGW) nsa_cmp_attn_item(W_NQ, W_CMP, W_OCMP, W_IMP, it, lane);
        }
        grid.sync();
        {   PHASE_VARS
        const float lam_init = 0.8f - 0.6f * __expf(-0.3f * (float)l);
        for (int i = gt; i < MT * 4; i += NGT) diff_combine_item(W_DO, pq->diff_lambda + l * 128, pq->diff_sub_gain + l * 256, lam_init, W_MIXED, i);
        for (int i = gt; i < MT; i += NGT) nsa_topk_item(W_IMP, W_SELMASK, i);
        }
        grid.sync();
        {   PHASE_VARS
        for (int it = gw; it < 1024; it += NGW) nsa_branch_item<0>(W_NQ, W_KSN, W_P, W_SELMASK, W_OSEL, it, lane);
        for (int it = gw; it < 1024; it += NGW) nsa_branch_item<1>(W_NQ, W_KWN, W_P, W_SELMASK, W_OWIN, it, lane);
        }
        grid.sync();
        {   PHASE_VARS
        for (int i = gt; i < MT * 4; i += NGT) nsa_combine_item(W_P, W_OCMP, W_OSEL, W_OWIN, pq->nsa_out_gain + l * 256, W_MIXED, i);
        }
        grid.sync();
        {   PHASE_VARS
        {   pg8::Gemm g{W_MIXED, W_WOUT_T, MT, DM, DM}; pg8::StaticOrder S; S.init(MT, DM, G, bid);
            pg8::EpiResF32 E{xcur, pq->out, DM};
            pg8::gemm_phase<pg8::EpiResF32, pg8::StaticOrder, true, true>((PG8_LAS unsigned char*)lds, g, S, E); }
        }
        grid.sync();
        {   PHASE_VARS
        for (int row = gw; row < MT; row += NGW)
            moe_route_row(pq->out, pq->norm_ffn + l * DM, pq->moe_w_group + l * DM * 4, pq->moe_b_group + l * 4, pq->moe_w_expert + l * DM * 32, pq->moe_b_expert + l * 32, W_TB, W_RE, W_RW, W_RS, W_CNT, row, lane);
        {   lds_f32* scr = (lds_f32*)lds + wave * (64 * 33);
            for (int it = gw; it < 32 * 256; it += NGW) { const int e = it >> 8, r = it & 255, kb = r >> 4, nb = r & 15;
                const int j = nb >> 3, hf = (nb >> 2) & 1, cb = nb & 3;
                const float* W = (hf ? pq->moe_w_up : pq->moe_w_gate) + ((size_t)l * 32 + e) * DM * 256;
                transpose_item<false>(W + j * 128 + cb * 32, DM, 256, 32, W_WGU_T + ((size_t)e * 512 + nb * 32) * DM, scr, kb, lane); }
            for (int it = gw; it < 32 * 128; it += NGW) { const int e = it >> 7, r = it & 127;
                transpose_item<false>(pq->moe_w_down + ((size_t)l * 32 + e) * 256 * DM, 256, DM, DM, W_WD_T + (size_t)e * DM * 256, scr, r, lane); }
        }
        }
        grid.sync();
        {   PHASE_VARS
        __attribute__((address_space(3))) int* tab = (__attribute__((address_space(3))) int*)(lds + 131072);
        moe_table(W_CNT, tab, tid);
        for (int row = gw; row < MT; row += NGW) {
            const uint4* src = (const uint4*)(W_TB + (size_t)row * DM);
            const uint4 v0 = src[lane], v1 = src[lane + 64];
#pragma unroll
            for (int i = 0; i < 2; ++i) { const int e = W_RE[row * 2 + i], r = tab[e] + W_RS[row * 2 + i];
                uint4* dst = (uint4*)(W_ASORT + (size_t)r * DM); dst[lane] = v0; dst[lane + 64] = v1;
                if (lane == 0) { W_ROWTOK[r] = row; W_ROWW[r] = W_RW[row * 2 + i]; } }
        }
        if (bid == 0) for (int e = wave; e < 32; e += NWAVE) { const int r0 = tab[e] + tab[32 + e], r1 = tab[e] + ((tab[32 + e] + 255) & ~255);
            for (int r = r0 + lane; r < r1; r += 64) { W_ROWTOK[r] = -1; W_ROWW[r] = 0.f; } }
        }
        grid.sync();
        {   PHASE_VARS
        __attribute__((address_space(3))) int* tab = (__attribute__((address_space(3))) int*)(lds + 131072);
        moe_table(W_CNT, tab, tid);
        {   pg8::Gemm g{W_ASORT, W_WGU_T, MOE_ROWS_MAX, 32 * 512, DM}; pg8::MoeOrder S{G, bid, tab[64], 2, tab + 128};
            pg8::EpiSwiglu E{W_HS, W_ROWW};
            pg8::gemm_phase<pg8::EpiSwiglu, pg8::MoeOrder, true, true>((PG8_LAS unsigned char*)lds, g, S, E); }
        }
        grid.sync();
        {   PHASE_VARS
        __attribute__((address_space(3))) int* tab = (__attribute__((address_space(3))) int*)(lds + 131072);
        moe_table(W_CNT, tab, tid);
        {   pg8::Gemm g{W_HS, W_WD_T, MOE_ROWS_MAX, 32 * DM, 256}; pg8::MoeOrder S{G, bid, tab[64], 4, tab + 128};
            pg8::EpiScatterAdd E{pq->out, W_ROWTOK};
            pg8::gemm_phase<pg8::EpiScatterAdd, pg8::MoeOrder, true, true>((PG8_LAS unsigned char*)lds, g, S, E); }
        }
        grid.sync();
    }
}
}

extern "C" void kernel_launch(void* const* d_in, const int* in_sizes, int n_in, void* d_out, int out_size, void* d_ws, size_t ws_size, hipStream_t stream) {
    Params p{};
    p.x_in = (const float*)d_in[0]; p.norm_mix = (const float*)d_in[1]; p.norm_ffn = (const float*)d_in[2]; p.w_in = (const float*)d_in[3]; p.w_out = (const float*)d_in[4];
    p.diff_q_gain = (const float*)d_in[5]; p.diff_k_gain = (const float*)d_in[6]; p.diff_lambda = (const float*)d_in[7]; p.diff_sub_gain = (const float*)d_in[8];
    p.mlstm_conv = (const float*)d_in[9]; p.mlstm_gate_bias = (const float*)d_in[10]; p.mlstm_out_gain = (const float*)d_in[11]; p.hgrn_lb = (const float*)d_in[12];
    p.hgrn_out_gain = (const float*)d_in[13]; p.nsa_cmp_pos = (const float*)d_in[14]; p.nsa_cmp_w1 = (const float*)d_in[15]; p.nsa_cmp_w2 = (const float*)d_in[16];
    p.nsa_q_gain = (const float*)d_in[17]; p.nsa_k_gain = (const float*)d_in[18]; p.nsa_out_gain = (const float*)d_in[19];
    p.moe_w_group = (const float*)d_in[20]; p.moe_b_group = (const float*)d_in[21]; p.moe_w_expert = (const float*)d_in[22]; p.moe_b_expert = (const float*)d_in[23];
    p.moe_w_gate = (const float*)d_in[24]; p.moe_w_up = (const float*)d_in[25]; p.moe_w_down = (const float*)d_in[26];
    p.out = (float*)d_out;

    p.ws = (char*)d_ws;
    if (WS_END > ws_size) { fprintf(stderr, "kernel_launch: workspace too small: need %zu, have %zu\n", (size_t)WS_END, ws_size); return; }

    static int grid_blocks = 0;
    if (!grid_blocks) {
        int dev = 0, cus = 0, per_cu = 0;
        hipGetDevice(&dev);
        hipDeviceGetAttribute(&cus, hipDeviceAttributeMultiprocessorCount, dev);
        hipFuncSetAttribute((const void*)mega_fwd, hipFuncAttributeMaxDynamicSharedMemorySize, LDS_BYTES);
        hipOccupancyMaxActiveBlocksPerMultiprocessor(&per_cu, (const void*)mega_fwd, NTHR, LDS_BYTES);
        if (per_cu < 1) per_cu = 1;
        if (per_cu > 1) per_cu = 1;
        grid_blocks = cus * per_cu;
    }
    void* args[] = {&p};
    hipError_t e = hipLaunchCooperativeKernel((const void*)mega_fwd, dim3(grid_blocks), dim3(NTHR), args, LDS_BYTES, stream);
    if (e != hipSuccess) fprintf(stderr, "cooperative launch failed: %s (grid %d)\n", hipGetErrorString(e), grid_blocks);
}
```

```cpp
#include <hip/hip_runtime.h>
#include <hip/hip_cooperative_groups.h>
#include <stdint.h>
#include <cstdio>
namespace cg = cooperative_groups;

namespace {
constexpr int DM = 1024, NB = 4, SEQ = 4096, DEPTH = 2, MT = NB * SEQ;
constexpr int IN_COLS = 3476, LDP = 3584;
constexpr float EPS = 1e-6f, NEG = -1e30f;
constexpr int PC_AQ = 0, PC_AK = 256, PC_AV = 512, PC_BQ = 768, PC_BK = 1024, PC_BV = 1280, PC_BO = 1536, PC_CQ = 1792, PC_CF = 2048,
              PC_CI = 2304, PC_CG = 2560, PC_DQ = 2816, PC_KC = 3072, PC_VC = 3136, PC_KS = 3200, PC_VS = 3264, PC_KW = 3328, PC_VW = 3392,
              PC_BI = 3456, PC_BF = 3460, PC_DG = 3464;
constexpr int NCMP = 255;
constexpr int NTHR = 512, NWAVE = 8;
constexpr int LDS_BYTES = 147456;

typedef unsigned short bf16_t;
__device__ __forceinline__ float bf2f(bf16_t v) { return __uint_as_float(((unsigned)v) << 16); }
__device__ __forceinline__ bf16_t f2bf(float f) { unsigned u = __float_as_uint(f); return (bf16_t)((u + 0x7fffu + ((u >> 16) & 1u)) >> 16); }
__device__ __forceinline__ unsigned pk2bf(float lo, float hi) { return (unsigned)f2bf(lo) | ((unsigned)f2bf(hi) << 16); }
__device__ __forceinline__ int src_col(int c) { return c < 1536 ? c : (c < 3456 ? c + 8 : (c < 3460 ? c - 3456 + 1536 : (c < 3464 ? c - 3460 + 1540 : c))); }
__device__ __forceinline__ float sigmoidf_(float x) { return 1.f / (1.f + __expf(-x)); }
__device__ __forceinline__ float siluf_(float x) { return x / (1.f + __expf(-x)); }
__device__ __forceinline__ float wave_sum(float v, int lane) {
#pragma unroll
    for (int o = 1; o < 64; o <<= 1) v += __int_as_float(__builtin_amdgcn_ds_bpermute((lane ^ o) << 2, __float_as_int(v)));
    return v;
}
__device__ __forceinline__ float rdlane(float v, int k) { return __int_as_float(__builtin_amdgcn_readlane(__float_as_int(v), k)); }

namespace pg8 {
#define PG8_LAS __attribute__((address_space(3)))
typedef unsigned short bf16_t;
typedef short bf16x8 __attribute__((ext_vector_type(8)));
typedef float f32x4 __attribute__((ext_vector_type(4)));
typedef unsigned u32x4 __attribute__((ext_vector_type(4)));
constexpr int BM = 256, BK = 64, HALF = 128, HTB = HALF * BK * 2  , STAGE_BYTES = 8 * HTB, NXCD = 8, WGM = 8;

__host__ __device__ __forceinline__ int lds_byte(int r, int c) { const int st = (r >> 4) * 2 + (c >> 5), rr = r & 15, cc = c & 31, ob = rr * 64 + cc * 2; return st * 1024 + (ob ^ (((ob >> 9) & 1) << 5)); }
__host__ __device__ __forceinline__ void stage_rc(int b, int& R, int& C) { const int st = b / 1024, sb = b % 1024, swz = sb ^ (((sb >> 9) & 1) << 5); R = (st >> 1) * 16 + swz / 64; C = (st & 1) * 32 + (swz % 64) / 2; }
__host__ __device__ __forceinline__ int perm32(int rho) { const int n = rho >> 4, i = rho & 15; return 8 * (i >> 2) + 4 * n + (i & 3); }

struct Unit { int pm, pn; };
struct Gemm { const bf16_t* A; const bf16_t* Bt; int M, N, K; };

struct StaticOrder {
    int nM, nN, nwg, G, c;
    __host__ __device__ void init(int M, int N, int G_, int c_) { nM = M / BM; nN = N / BM; nwg = nM * nN; G = G_; c = c_; }
    __host__ __device__ bool next(int i, Unit& u) const {
        const long L = (long)i * G + c; if (L >= nwg) return false;
        int wgid = (int)L; { const int q = nwg / NXCD, r = nwg % NXCD, xcd = wgid % NXCD, off = wgid / NXCD; wgid = (xcd < r ? xcd * (q + 1) : r * (q + 1) + (xcd - r) * q) + off; }
        const int nig = WGM * nN, gid = wgid / nig, fm = gid * WGM, gsz = (nM - fm) < WGM ? (nM - fm) : WGM;
        u.pm = fm + ((wgid % nig) % gsz); u.pn = (wgid % nig) / gsz; return true;
    }
    __device__ __forceinline__ void a_ready(const Unit&) const {}
    __device__ __forceinline__ void done(const Unit&) const {}
};

__device__ __forceinline__ unsigned cvt_pk_bf16(float lo, float hi) { unsigned r; asm volatile("v_cvt_pk_bf16_f32 %0, %1, %2" : "=v"(r) : "v"(lo), "v"(hi)); return r; }
template <int ACT  > struct EpiBf16 {
    static constexpr bool PERM = true, AFTER_DRAIN = false; static_assert(ACT == 0, "EpiBf16: only ACT 0 here");
    bf16_t* O; int ldc; const float* bias; int split_cols; size_t split_stride; float scale0;
    __device__ __forceinline__ void operator()(const f32x4 (&acc)[2][2][4][2], const Unit& u, int wr, int wc, int fr, int fq) const {
        const int row0 = u.pm * BM + wr * 64 + fr; int colt = u.pn * BM; bf16_t* base = O;
        float sc = 1.f; if (split_cols) { const int t = colt / split_cols; base += (size_t)t * split_stride; colt -= t * split_cols; if (t == 0) sc = scale0; }
        const int col0 = colt + wc * 32 + 8 * fq, bcol0 = u.pn * BM + wc * 32 + 8 * fq;
        f32x4 bv[2][2];
#pragma unroll
        for (int bj = 0; bj < 2; ++bj)
#pragma unroll
            for (int n = 0; n < 2; ++n) bv[bj][n] = bias ? *(const f32x4*)(bias + bcol0 + bj * HALF + 4 * n) : (f32x4){0.f, 0.f, 0.f, 0.f};
#pragma unroll
        for (int ai = 0; ai < 2; ++ai)
#pragma unroll
            for (int m = 0; m < 4; ++m) { bf16_t* rowp = base + (size_t)(row0 + ai * HALF + m * 16) * ldc + col0;
#pragma unroll
                for (int bj = 0; bj < 2; ++bj) { f32x4 v0 = acc[ai][bj][m][0] + bv[bj][0], v1 = acc[ai][bj][m][1] + bv[bj][1];
                    v0 = v0 * sc; v1 = v1 * sc; u32x4 w; w.x = cvt_pk_bf16(v0[0], v0[1]); w.y = cvt_pk_bf16(v0[2], v0[3]); w.z = cvt_pk_bf16(v1[0], v1[1]); w.w = cvt_pk_bf16(v1[2], v1[3]);
                    *(u32x4*)(rowp + bj * HALF) = w; } }
    }
};


struct EpiResF32 {
    static constexpr bool PERM = false, AFTER_DRAIN = false;
    const float* base; float* out; int ldc;
    __device__ __forceinline__ void operator()(const f32x4 (&acc)[2][2][4][2], const Unit& u, int wr, int wc, int fr, int fq) const {
        const int col0 = u.pn * BM + wc * 32 + 4 * fq;
#pragma unroll
        for (int ai = 0; ai < 2; ++ai)
#pragma unroll
            for (int m = 0; m < 4; ++m) { const size_t off = (size_t)(u.pm * BM + ai * HALF + wr * 64 + m * 16 + fr) * ldc + col0;
#pragma unroll
                for (int bj = 0; bj < 2; ++bj)
#pragma unroll
                    for (int n = 0; n < 2; ++n) { const f32x4 bs = *(const f32x4*)(base + off + bj * HALF + n * 16); *(f32x4*)(out + off + bj * HALF + n * 16) = bs + acc[ai][bj][m][n]; } }
    }
};

struct EpiSwiglu {
    static constexpr bool PERM = true, AFTER_DRAIN = false;
    bf16_t* H; const float* row_w;
    __device__ __forceinline__ void operator()(const f32x4 (&acc)[2][2][4][2], const Unit& u, int wr, int wc, int fr, int fq) const {
        const int row0 = u.pm * BM + wr * 64 + fr, col0 = (u.pn & 1) * HALF + wc * 32 + 8 * fq;
#pragma unroll
        for (int ai = 0; ai < 2; ++ai)
#pragma unroll
            for (int m = 0; m < 4; ++m) { const int row = row0 + ai * HALF + m * 16; const float w = row_w[row];
                float h[8];
#pragma unroll
                for (int n = 0; n < 2; ++n)
#pragma unroll
                    for (int i = 0; i < 4; ++i) { const float g = acc[ai][0][m][n][i], up = acc[ai][1][m][n][i]; h[n * 4 + i] = g / (1.f + __expf(-g)) * up * w; }
                u32x4 o; o.x = cvt_pk_bf16(h[0], h[1]); o.y = cvt_pk_bf16(h[2], h[3]); o.z = cvt_pk_bf16(h[4], h[5]); o.w = cvt_pk_bf16(h[6], h[7]);
                *(u32x4*)(H + (size_t)row * 256 + col0) = o; asm volatile("" ::: "memory"); }
    }
};
struct EpiScatterStore {
    static constexpr bool PERM = true, AFTER_DRAIN = false;
    bf16_t* Y; const int* row_tok;
    __device__ __forceinline__ void operator()(const f32x4 (&acc)[2][2][4][2], const Unit& u, int wr, int wc, int fr, int fq) const {
        const int col0 = (u.pn & 3) * BM + wc * 32 + 8 * fq;
#pragma unroll
        for (int ai = 0; ai < 2; ++ai)
#pragma unroll
            for (int m = 0; m < 4; ++m) { const int t2 = row_tok[u.pm * BM + ai * HALF + wr * 64 + m * 16 + fr];
                if (t2 >= 0) { const unsigned o = (unsigned)t2 * 1024u + (unsigned)col0;
#pragma unroll
                    for (int bj = 0; bj < 2; ++bj) { const f32x4 v0 = acc[ai][bj][m][0], v1 = acc[ai][bj][m][1];
                        u32x4 w; w.x = cvt_pk_bf16(v0[0], v0[1]); w.y = cvt_pk_bf16(v0[2], v0[3]); w.z = cvt_pk_bf16(v1[0], v1[1]); w.w = cvt_pk_bf16(v1[2], v1[3]);
                        *(u32x4*)(Y + (o + (unsigned)(bj * HALF))) = w; } }
                asm volatile("" ::: "memory"); }
    }
};
struct MoeOrder {
    int G, c, ntiles, nsub; const PG8_LAS int* tile_e;
    __device__ __forceinline__ bool next(int i, Unit& u) const {
        const int L = i * G + c; if (L >= ntiles * nsub) return false;
        const int T = L / nsub, j = L - T * nsub; u.pm = T; u.pn = tile_e[T] * nsub + j; return true;
    }
    __device__ __forceinline__ void a_ready(const Unit&) const {}
    __device__ __forceinline__ void done(const Unit&) const {}
};
template <class Epi, class Sched, bool ALIGN_EPI = false, bool SP2 = false>
__device__ __forceinline__ void gemm_phase(PG8_LAS unsigned char* lds, const Gemm g, const Sched& S, const Epi& E) {
    int tid_ = threadIdx.x; asm volatile("" : "+v"(tid_));
    const int tid = tid_, wid = __builtin_amdgcn_readfirstlane(tid >> 6), lane = tid & 63, wr = wid >> 2, wc = wid & 3, fr = lane & 15, fq = lane >> 4;
    const int K = g.K, nt = K / BK;
    unsigned voffA[2], voffB[2];
#pragma unroll
    for (int i = 0; i < 2; ++i) { int R, C; stage_rc(tid * 16 + i * 8192, R, C); const int Rb = Epi::PERM ? ((R & ~31) + perm32(R & 31)) : R;
        voffA[i] = (unsigned)(R * K + C) * 2u; voffB[i] = (unsigned)(Rb * K + C) * 2u; }
    const size_t kstep = (size_t)(BK * 2);
    const size_t hstep = (size_t)HALF * K * 2;
    const size_t tstep = 2 * hstep;
    const unsigned ldsw = (unsigned)wid * 1024u;
    const int aoff = lds_byte(wr * 64 + fr, fq * 8), boff = lds_byte(wc * 32 + fr, fq * 8);
#define PG8_SA(b, h) (((b) * 2 + (h)) * HTB)
#define PG8_SB(b, h) ((4 + (b) * 2 + (h)) * HTB)
#define PG8_STAGE(bufoff, gbase, voff) do { _Pragma("unroll") for (int _i = 0; _i < 2; ++_i) \
        __builtin_amdgcn_global_load_lds((const unsigned*)((const char*)(gbase) + (voff)[_i]), (PG8_LAS unsigned*)(lds + (bufoff) + ldsw + _i * 8192), 16, 0, 0); } while (0)
#define PG8_LDA(dst, b, h) do { _Pragma("unroll") for (int m = 0; m < 4; ++m) _Pragma("unroll") for (int k = 0; k < 2; ++k) dst[m][k] = *(const PG8_LAS bf16x8*)(lds + PG8_SA(b, h) + aoff + m * 2048 + k * 1024); } while (0)
#define PG8_LDB(dst, b, h) do { _Pragma("unroll") for (int n = 0; n < 2; ++n) _Pragma("unroll") for (int k = 0; k < 2; ++k) dst[n][k] = *(const PG8_LAS bf16x8*)(lds + PG8_SB(b, h) + boff + n * 2048 + k * 1024); } while (0)
#define PG8_MMA(ai, bj, At, Bt) do { __builtin_amdgcn_s_setprio(1); _Pragma("unroll") for (int m = 0; m < 4; ++m) _Pragma("unroll") for (int n = 0; n < 2; ++n) _Pragma("unroll") for (int k = 0; k < 2; ++k) \
        acc[ai][bj][m][n] = __builtin_amdgcn_mfma_f32_16x16x32_bf16(Bt[n][k], At[m][k], acc[ai][bj][m][n], 0, 0, 0); __builtin_amdgcn_s_setprio(0); } while (0)
#define PG8_WAIT_V(n) asm volatile("s_waitcnt vmcnt(" #n ")" ::: "memory")
#define PG8_WAIT_L(n) asm volatile("s_waitcnt lgkmcnt(" #n ")" ::: "memory")
#define PG8_BAR __builtin_amdgcn_s_barrier()
#define PG8_SCHED __builtin_amdgcn_sched_barrier(0)
    Unit cur, nxt; int ui = 0;
    if (!S.next(0, cur)) return;
    f32x4 acc[2][2][4][2];
#pragma unroll
    for (int a = 0; a < 2; ++a)
#pragma unroll
        for (int b = 0; b < 2; ++b)
#pragma unroll
            for (int m = 0; m < 4; ++m)
#pragma unroll
                for (int n = 0; n < 2; ++n) acc[a][b][m][n] = (f32x4){0.f, 0.f, 0.f, 0.f};
    bf16x8 At[4][2], B0[2][2], B1[2][2];
    const char* cA = (const char*)g.A + (size_t)cur.pm * tstep; const char* cB = (const char*)g.Bt + (size_t)cur.pn * tstep;
    S.a_ready(cur);
    if constexpr (SP2) {
        PG8_STAGE(PG8_SB(0, 0), cB, voffB); PG8_STAGE(PG8_SB(0, 1), cB + hstep, voffB); PG8_STAGE(PG8_SA(0, 0), cA, voffA); PG8_STAGE(PG8_SA(0, 1), cA + hstep, voffA);
        if (wr == 1) PG8_BAR;
        PG8_WAIT_V(2); PG8_BAR;
        PG8_STAGE(PG8_SB(1, 0), cB + kstep, voffB); PG8_STAGE(PG8_SA(1, 0), cA + kstep, voffA); PG8_STAGE(PG8_SB(1, 1), cB + hstep + kstep, voffB);
        PG8_WAIT_V(6); PG8_BAR;
    } else {
        PG8_STAGE(PG8_SB(0, 0), cB, voffB); PG8_STAGE(PG8_SA(0, 0), cA, voffA); PG8_STAGE(PG8_SB(0, 1), cB + hstep, voffB); PG8_STAGE(PG8_SA(0, 1), cA + hstep, voffA);
        if (wr == 1) PG8_BAR;
        PG8_WAIT_V(4); PG8_BAR;
        PG8_STAGE(PG8_SB(1, 0), cB + kstep, voffB); PG8_STAGE(PG8_SA(1, 0), cA + kstep, voffA); PG8_STAGE(PG8_SB(1, 1), cB + hstep + kstep, voffB);
        PG8_WAIT_V(6); PG8_BAR;
    }
    for (;;) {
        const bool has_next = S.next(ui + 1, nxt);
        const char* nA = has_next ? (const char*)g.A + (size_t)nxt.pm * tstep : cA; const char* nB = has_next ? (const char*)g.Bt + (size_t)nxt.pn * tstep : cB;
        for (int t = 0; t < nt; t += 2) {
            const bool last = (t == nt - 2);
            const char* a1 = cA + (size_t)(t + 1) * kstep;
            const char* a2 = last ? nA : cA + (size_t)(t + 2) * kstep; const char* b2 = last ? nB : cB + (size_t)(t + 2) * kstep;
            const char* a3 = a2 + kstep; const char* b3 = b2 + kstep;
            if (last && has_next) S.a_ready(nxt);
            if constexpr (SP2) {
            PG8_LDB(B0, 0, 0); PG8_LDB(B1, 0, 1); PG8_SCHED; PG8_LDA(At, 0, 0); PG8_STAGE(PG8_SA(1, 1), a1 + hstep, voffA);
            PG8_WAIT_V(8); PG8_WAIT_L(0); PG8_BAR; PG8_MMA(0, 0, At, B0); PG8_MMA(0, 1, At, B1); PG8_BAR; PG8_SCHED;
            PG8_LDA(At, 0, 1); PG8_STAGE(PG8_SB(0, 0), b2, voffB); PG8_STAGE(PG8_SB(0, 1), b2 + hstep, voffB); PG8_STAGE(PG8_SA(0, 0), a2, voffA);
            PG8_WAIT_V(8); PG8_WAIT_L(0); PG8_BAR; PG8_MMA(1, 0, At, B0); PG8_MMA(1, 1, At, B1); PG8_BAR; PG8_SCHED;
            PG8_LDB(B0, 1, 0); PG8_LDB(B1, 1, 1); PG8_SCHED; PG8_LDA(At, 1, 0); PG8_STAGE(PG8_SA(0, 1), a2 + hstep, voffA);
            PG8_WAIT_V(8); PG8_WAIT_L(0); PG8_BAR; PG8_MMA(0, 0, At, B0); PG8_MMA(0, 1, At, B1); PG8_BAR; PG8_SCHED;
            PG8_LDA(At, 1, 1); PG8_STAGE(PG8_SB(1, 0), b3, voffB); PG8_STAGE(PG8_SB(1, 1), b3 + hstep, voffB); PG8_STAGE(PG8_SA(1, 0), a3, voffA);
            PG8_WAIT_V(8); PG8_WAIT_L(0); PG8_BAR; PG8_MMA(1, 0, At, B0); PG8_MMA(1, 1, At, B1); PG8_BAR; PG8_SCHED;
            } else {
            PG8_LDB(B0, 0, 0); PG8_SCHED; PG8_LDA(At, 0, 0); PG8_STAGE(PG8_SA(1, 1), a1 + hstep, voffA);
            PG8_WAIT_L(8); PG8_BAR; PG8_WAIT_L(0); PG8_MMA(0, 0, At, B0); PG8_BAR; PG8_SCHED;
            PG8_LDB(B1, 0, 1); PG8_STAGE(PG8_SB(0, 0), b2, voffB);
            PG8_BAR; PG8_WAIT_L(0); PG8_MMA(0, 1, At, B1); PG8_BAR;
            PG8_LDA(At, 0, 1); PG8_STAGE(PG8_SA(0, 0), a2, voffA);
            PG8_BAR; PG8_WAIT_L(0); PG8_MMA(1, 0, At, B0); PG8_BAR; PG8_SCHED;
            PG8_STAGE(PG8_SB(0, 1), b2 + hstep, voffB);
            PG8_WAIT_V(6); PG8_BAR; PG8_MMA(1, 1, At, B1); PG8_BAR;
            PG8_LDB(B0, 1, 0); PG8_SCHED; PG8_LDA(At, 1, 0); PG8_STAGE(PG8_SA(0, 1), a2 + hstep, voffA);
            PG8_WAIT_L(8); PG8_BAR; PG8_WAIT_L(0); PG8_MMA(0, 0, At, B0); PG8_BAR; PG8_SCHED;
            PG8_LDB(B1, 1, 1); PG8_STAGE(PG8_SB(1, 0), b3, voffB);
            PG8_BAR; PG8_WAIT_L(0); PG8_MMA(0, 1, At, B1); PG8_BAR;
            PG8_LDA(At, 1, 1); PG8_STAGE(PG8_SA(1, 0), a3, voffA);
            PG8_BAR; PG8_WAIT_L(0); PG8_MMA(1, 0, At, B0); PG8_BAR; PG8_SCHED;
            PG8_STAGE(PG8_SB(1, 1), b3 + hstep, voffB);
            PG8_WAIT_V(6); PG8_BAR; PG8_MMA(1, 1, At, B1); PG8_BAR;
            }
        }
        if constexpr (ALIGN_EPI) { if (wr == 0) PG8_BAR; }
        if constexpr (!Epi::AFTER_DRAIN) {
            int t2 = threadIdx.x; asm volatile("" : "+v"(t2)); const int l2 = t2 & 63;
            E(acc, cur, wr, wc, l2 & 15, l2 >> 4); S.done(cur); }
        if (!has_next) break;
#pragma unroll
        for (int a = 0; a < 2; ++a)
#pragma unroll
            for (int b = 0; b < 2; ++b)
#pragma unroll
                for (int m = 0; m < 4; ++m)
#pragma unroll
                    for (int n = 0; n < 2; ++n) acc[a][b][m][n] = (f32x4){0.f, 0.f, 0.f, 0.f};
        cur = nxt; cA = nA; cB = nB; ++ui;
        if constexpr (ALIGN_EPI) { if (wr == 1) PG8_BAR; }
    }
    PG8_WAIT_V(0);
    if constexpr (!ALIGN_EPI) { if (wr == 0) PG8_BAR; }
    PG8_BAR;
    if constexpr (Epi::AFTER_DRAIN) { E.fused(acc, cur, wr, wc, fr, fq, lds, wid, lane); S.done(cur); }
#undef PG8_SA
#undef PG8_SB
#undef PG8_STAGE
#undef PG8_LDA
#undef PG8_LDB
#undef PG8_MMA
#undef PG8_WAIT_V
#undef PG8_WAIT_L
#undef PG8_BAR
#undef PG8_SCHED
}
}


namespace fa {
#define FA_LAS __attribute__((address_space(3)))
typedef short bf16x8 __attribute__((ext_vector_type(8)));
typedef float f32x16 __attribute__((ext_vector_type(16)));
typedef float f32x2_t __attribute__((ext_vector_type(2)));
typedef __bf16 bf16x2_t __attribute__((ext_vector_type(2)));
typedef unsigned u32x4 __attribute__((ext_vector_type(4)));
__device__ __forceinline__ unsigned cvtpk(float lo, float hi) { f32x2_t v = {lo, hi}; bf16x2_t b = __builtin_convertvector(v, bf16x2_t); return __builtin_bit_cast(unsigned, b); }
__device__ __forceinline__ float xhalf(float v, int lane) { return __int_as_float(__builtin_amdgcn_ds_bpermute((lane ^ 32) << 2, __float_as_int(v))); }
struct Tile { const bf16_t* kg; const bf16_t* vg; int key0; };
template <int KS, int KIND, class TileFn>
__device__ __forceinline__ void attn_unit(FA_LAS unsigned char* lds, int tid, int ntiles, const TileFn& tile_of, const bf16_t* qrow, int qpos, float slope2,
                                          unsigned long long selbits, float* orow, float& m_out, float& l_out) {
    constexpr int KBYTES = 2 * KS * 1024;
    constexpr float NEGF = -1e30f;
    const int lane = tid & 63, r32 = lane & 31, hi = lane >> 5;
    bf16x8 qf[KS];
#pragma unroll
    for (int ks = 0; ks < KS; ++ks) qf[ks] = *(const bf16x8*)(qrow + 16 * ks + 8 * hi);
    f32x16 o0, o1;
#pragma unroll
    for (int r = 0; r < 16; ++r) { o0[r] = 0.f; o1[r] = 0.f; }
    float m = NEGF, l = 0.f;
    const bool kload = tid * 16 < KBYTES;
    const int nv = KIND == 3 ? (qpos >= 31 ? ((qpos - 31) >> 4) + 1 : 0) : 0;
    Tile T = tile_of(0);
    {   u32x4 kreg = {0u, 0u, 0u, 0u};
        if (kload) kreg = *(const u32x4*)((const char*)T.kg + tid * 16);
        const u32x4 vreg = *(const u32x4*)((const char*)T.vg + tid * 16);
        if (kload) *(FA_LAS u32x4*)(lds + tid * 16) = kreg;
        *(FA_LAS u32x4*)(lds + 8192 + tid * 16) = vreg; }
    __syncthreads();
    for (int i = 0; i < ntiles; ++i) {
        const bool more = i + 1 < ntiles;
        Tile Tn = T; u32x4 kreg = {0u, 0u, 0u, 0u}, vreg = {0u, 0u, 0u, 0u};
        if (more) { Tn = tile_of(i + 1); if (kload) kreg = *(const u32x4*)((const char*)Tn.kg + tid * 16); vreg = *(const u32x4*)((const char*)Tn.vg + tid * 16); }
        const FA_LAS unsigned char* Kl = lds + (i & 1) * 16384; const FA_LAS unsigned char* Vl = Kl + 8192;
        const int key0 = T.key0;
        bool act, full; int lim; float base, slopek;
        if (KIND == 3) { lim = nv - 1 - key0 - 4 * hi; act = key0 < nv; full = key0 + 63 < nv;
                         slopek = slope2 * 16.f; base = slope2 * (float)(16 * (key0 + 4 * hi) + 31 - qpos); }
        else { lim = qpos - key0 - 4 * hi; act = key0 <= qpos; full = key0 + 63 <= qpos; slopek = slope2; base = slope2 * (float)(key0 + 4 * hi - qpos);
               if (KIND == 1) { const bool bit = (selbits >> (key0 >> 6)) & 1ull; act = act && bit; full = full && bit; if (!bit) lim = -100000; }
               if (KIND == 2) { act = act && (key0 + 63 > qpos - 512); full = full && (key0 > qpos - 512); } }
        if (__builtin_amdgcn_ballot_w64(act) != 0ull) {
            const bool allfull = __builtin_amdgcn_ballot_w64(full) == ~0ull;
            f32x16 s0, s1;
#pragma unroll
            for (int r = 0; r < 16; ++r) { s0[r] = 0.f; s1[r] = 0.f; }
#pragma unroll
            for (int ks = 0; ks < KS; ++ks) {
                const bf16x8 a0 = *(const FA_LAS bf16x8*)(Kl + (ks * 32 + r32) * 32 + hi * 16);
                const bf16x8 a1 = *(const FA_LAS bf16x8*)(Kl + ((KS + ks) * 32 + r32) * 32 + hi * 16);
                s0 = __builtin_amdgcn_mfma_f32_32x32x16_bf16(a0, qf[ks], s0, 0, 0, 0);
                s1 = __builtin_amdgcn_mfma_f32_32x32x16_bf16(a1, qf[ks], s1, 0, 0, 0);
            }
#pragma unroll
            for (int r = 0; r < 16; ++r) { const int c0 = (r & 3) + 8 * (r >> 2);
                s0[r] += __builtin_fmaf(slopek, (float)c0, base); s1[r] += __builtin_fmaf(slopek, (float)(c0 + 32), base); }
            if (!allfull) {
#pragma unroll
                for (int r = 0; r < 16; ++r) { const int c0 = (r & 3) + 8 * (r >> 2);
                    int p0 = min(lim - c0, 0), p1 = min(lim - c0 - 32, 0);
                    if (KIND == 2) { p0 += min(c0 - lim + 511, 0); p1 += min(c0 + 32 - lim + 511, 0); }
                    s0[r] = __builtin_fmaf((float)p0, 1e30f, s0[r]); s1[r] = __builtin_fmaf((float)p1, 1e30f, s1[r]); }
            }
            float mx = __builtin_fmaxf(s0[0], s1[0]);
#pragma unroll
            for (int r = 1; r < 16; ++r) mx = __builtin_fmaxf(mx, __builtin_fmaxf(s0[r], s1[r]));
            mx = __builtin_fmaxf(mx, xhalf(mx, lane));
            const float mn = __builtin_fmaxf(m, mx), alpha = __builtin_amdgcn_exp2f(m - mn);
            m = mn;
            float psum = 0.f;
#pragma unroll
            for (int r = 0; r < 16; ++r) { const float p0 = __builtin_amdgcn_exp2f(s0[r] - mn), p1 = __builtin_amdgcn_exp2f(s1[r] - mn);
                s0[r] = p0; s1[r] = p1; psum += p0 + p1; }
            l = l * alpha + psum;
            if (__builtin_amdgcn_ballot_w64(alpha != 1.f) != 0ull) {
#pragma unroll
                for (int r = 0; r < 16; ++r) { o0[r] *= alpha; o1[r] *= alpha; } }
#pragma unroll
            for (int kb = 0; kb < 2; ++kb)
#pragma unroll
                for (int sp = 0; sp < 2; ++sp) {
                    u32x4 pw;
                    if (kb == 0) { pw.x = cvtpk(s0[8 * sp + 0], s0[8 * sp + 1]); pw.y = cvtpk(s0[8 * sp + 2], s0[8 * sp + 3]); pw.z = cvtpk(s0[8 * sp + 4], s0[8 * sp + 5]); pw.w = cvtpk(s0[8 * sp + 6], s0[8 * sp + 7]); }
                    else         { pw.x = cvtpk(s1[8 * sp + 0], s1[8 * sp + 1]); pw.y = cvtpk(s1[8 * sp + 2], s1[8 * sp + 3]); pw.z = cvtpk(s1[8 * sp + 4], s1[8 * sp + 5]); pw.w = cvtpk(s1[8 * sp + 6], s1[8 * sp + 7]); }
                    const bf16x8 pf = __builtin_bit_cast(bf16x8, pw);
                    const bf16x8 v0 = *(const FA_LAS bf16x8*)(Vl + (((kb * 2 + sp) * 2 + 0) * 32 + r32) * 32 + hi * 16);
                    const bf16x8 v1 = *(const FA_LAS bf16x8*)(Vl + (((kb * 2 + sp) * 2 + 1) * 32 + r32) * 32 + hi * 16);
                    o0 = __builtin_amdgcn_mfma_f32_32x32x16_bf16(v0, pf, o0, 0, 0, 0);
                    o1 = __builtin_amdgcn_mfma_f32_32x32x16_bf16(v1, pf, o1, 0, 0, 0);
                }
        }
        if (more) { FA_LAS unsigned char* nb = lds + ((i + 1) & 1) * 16384;
            if (kload) *(FA_LAS u32x4*)(nb + tid * 16) = kreg;
            *(FA_LAS u32x4*)(nb + 8192 + tid * 16) = vreg; }
        __syncthreads();
        T = Tn;
    }
    const float lt = l + xhalf(l, lane);
    const bool rowvalid = KIND == 3 ? nv > 0 : true;
    const float il = rowvalid ? 1.f / lt : 0.f;
    m_out = m; l_out = lt;
#pragma unroll
    for (int g = 0; g < 4; ++g) {
        const int d = 8 * g + 4 * hi;
        *(float4*)(orow + d) = make_float4(o0[4 * g] * il, o0[4 * g + 1] * il, o0[4 * g + 2] * il, o0[4 * g + 3] * il);
        *(float4*)(orow + 32 + d) = make_float4(o1[4 * g] * il, o1[4 * g + 1] * il, o1[4 * g + 2] * il, o1[4 * g + 3] * il);
    }
}
}


namespace scan {
typedef short bf16x8 __attribute__((ext_vector_type(8)));
typedef float f32x16 __attribute__((ext_vector_type(16)));
__device__ __forceinline__ int spos(int s) { const int s16 = s & 15; return (s & ~15) + 8 * ((s16 >> 2) & 1) + (((s16 >> 3) << 2) | (s16 & 3)); }
__device__ __forceinline__ float xhalf(float v, int lane) { return __int_as_float(__builtin_amdgcn_ds_bpermute((lane ^ 32) << 2, __float_as_int(v))); }
constexpr size_t A8 = (size_t)MT * 256 * 2, SM = (size_t)1024 * 64 * 4;
template <int MIX> struct BufsT {
    char* r1; char* r2;
    static constexpr size_t R1OFF = MIX == 0 ? 0 : 6 * A8 + 5 * SM;
    __device__ __forceinline__ bf16_t* QA() const { return (bf16_t*)(r1 + R1OFF); }
    __device__ __forceinline__ bf16_t* KA() const { return (bf16_t*)(r1 + R1OFF + A8); }
    __device__ __forceinline__ bf16_t* KAT() const { return (bf16_t*)(r1 + R1OFF + 2 * A8); }
    __device__ __forceinline__ char* rest() const { return MIX == 0 ? r1 + 3 * A8 : r2; }
    __device__ __forceinline__ bf16_t* VT() const { return (bf16_t*)(rest()); }
    __device__ __forceinline__ bf16_t* Ub() const { return (bf16_t*)(rest() + A8); }
    __device__ __forceinline__ bf16_t* Sp() const { return (bf16_t*)(rest() + 2 * A8); }
    __device__ __forceinline__ float* Un() const { return (float*)(rest() + 3 * A8); }
    __device__ __forceinline__ float* np() const { return (float*)(rest() + 3 * A8 + SM); }
    __device__ __forceinline__ float* dL() const { return (float*)(rest() + 3 * A8 + 2 * SM); }
    __device__ __forceinline__ float* dmid() const { return (float*)(rest() + 3 * A8 + 3 * SM); }
    __device__ __forceinline__ float* dLm() const { return (float*)(rest() + 3 * A8 + 4 * SM); }
};

template <int MIX>
__device__ __forceinline__ void prep_k(const bf16_t* P, const float* convw, const float* gbias, const float* lbp, int layer, const BufsT<MIX>& B, int idx) {
    const int k = idx & 63, ci = idx >> 6, h = ci & 3, chunk = ci >> 2, c = chunk & 63;
    const size_t m0 = (size_t)chunk * 64;
    float lb = 0.f, bi = 0.f, bfz = 0.f;
    if (MIX == 1) { if (layer == 1) lb = sigmoidf_(lbp[256 + h * 64 + k] - lbp[h * 64 + k]); }
    else { bi = gbias[h]; bfz = gbias[4 + h]; }
    float bs = 0.f, bmid = 0.f;
    for (int s = 0; s < 64; ++s) {
        float lf;
        if (MIX == 1) { const float z = bf2f(P[(m0 + s) * LDP + PC_CF + h * 64 + k]); lf = __logf(lb + (1.f - lb) * sigmoidf_(z)); }
        else { const float x = bf2f(P[(m0 + s) * LDP + PC_BF + h]) + bfz; lf = -log1pf(__expf(-x)); }
        bs += lf; if (s == 31) bmid = bs;
    }
    const float bL = bs;
    bs = 0.f;
    for (int s = 0; s < 64; ++s) {
        const size_t m = m0 + s;
        float lf, qraw, kraw;
        if (MIX == 1) {
            const float z = bf2f(P[m * LDP + PC_CF + h * 64 + k]); const float f = lb + (1.f - lb) * sigmoidf_(z);
            lf = __logf(f); kraw = 1.f - f; qraw = siluf_(bf2f(P[m * LDP + PC_CQ + h * 64 + k]));
        } else {
            const float x = bf2f(P[m * LDP + PC_BF + h]) + bfz; lf = -log1pf(__expf(-x));
            float qv = 0.f, kv = 0.f; const int t = c * 64 + s;
#pragma unroll
            for (int j = 0; j < 4; ++j) { if (t - 3 + j >= 0) {
                qv += convw[j * 512 + h * 64 + k] * bf2f(P[(m - 3 + j) * LDP + PC_BQ + h * 64 + k]);
                kv += convw[j * 512 + 256 + h * 64 + k] * bf2f(P[(m - 3 + j) * LDP + PC_BK + h * 64 + k]); } }
            qraw = siluf_(qv) * 0.125f;
            kraw = siluf_(kv) * __expf(bf2f(P[m * LDP + PC_BI + h]) + bi);
        }
        bs += lf;
        const float qa = qraw * __expf(bs - bmid), ka = kraw * __expf(bmid - bs);
        const bf16_t kab = f2bf(ka);
        B.QA()[m * 256 + h * 64 + k] = f2bf(qa); B.KA()[m * 256 + h * 64 + k] = kab;
        B.KAT()[((size_t)ci * 64 + k) * 64 + spos(s)] = kab;
    }
    B.dL()[ci * 64 + k] = __expf(bL); B.dmid()[ci * 64 + k] = __expf(bmid); B.dLm()[ci * 64 + k] = __expf(bL - bmid);
}
__device__ __forceinline__ void prep_v(const bf16_t* P, int pcol, bf16_t* VT, int idx) {
    const int e = idx & 63, ci = idx >> 6, h = ci & 3; const size_t m0 = (size_t)(ci >> 2) * 64;
    for (int s = 0; s < 64; ++s) VT[((size_t)ci * 64 + e) * 64 + spos(s)] = P[(m0 + s) * LDP + pcol + h * 64 + e];
}
template <int MIX>
__device__ __forceinline__ void stepA(const BufsT<MIX>& B, int ci, int lane) {
    const int r32 = lane & 31, hi = lane >> 5;
    const bf16_t* vt = B.VT() + (size_t)ci * 4096; const bf16_t* kat = B.KAT() + (size_t)ci * 4096;
    f32x16 acc[2][2];
#pragma unroll
    for (int a = 0; a < 2; ++a)
#pragma unroll
        for (int b = 0; b < 2; ++b)
#pragma unroll
            for (int r = 0; r < 16; ++r) acc[a][b][r] = 0.f;
    float nsum[2] = {0.f, 0.f};
#pragma unroll
    for (int g = 0; g < 4; ++g) {
        bf16x8 a[2], bb[2];
#pragma unroll
        for (int et = 0; et < 2; ++et) a[et] = *(const bf16x8*)(vt + (32 * et + r32) * 64 + 16 * g + 8 * hi);
#pragma unroll
        for (int kt = 0; kt < 2; ++kt) { bb[kt] = *(const bf16x8*)(kat + (32 * kt + r32) * 64 + 16 * g + 8 * hi);
            if (MIX == 0) {
#pragma unroll
                for (int j = 0; j < 8; ++j) nsum[kt] += bf2f((bf16_t)bb[kt][j]); } }
#pragma unroll
        for (int et = 0; et < 2; ++et)
#pragma unroll
            for (int kt = 0; kt < 2; ++kt) acc[et][kt] = __builtin_amdgcn_mfma_f32_32x32x16_bf16(a[et], bb[kt], acc[et][kt], 0, 0, 0);
    }
#pragma unroll
    for (int kt = 0; kt < 2; ++kt) {
        const float dl = B.dLm()[ci * 64 + 32 * kt + r32];
#pragma unroll
        for (int et = 0; et < 2; ++et)
#pragma unroll
            for (int r = 0; r < 16; ++r) { const int e = 32 * et + (r & 3) + 8 * (r >> 2) + 4 * hi; B.Ub()[((size_t)ci * 64 + e) * 64 + 32 * kt + r32] = f2bf(acc[et][kt][r] * dl); }
        if (MIX == 0) { const float ns = nsum[kt] + xhalf(nsum[kt], lane); if (hi == 0) B.Un()[ci * 64 + 32 * kt + r32] = ns * dl; }
    }
}
template <int MIX>
__device__ __forceinline__ void stepB(const BufsT<MIX>& B, int idx) {
    const int k = idx & 63, e = (idx >> 6) % 65, bh = (idx >> 6) / 65, h = bh & 3, b = bh >> 2;
    if (MIX == 1 && e == 64) return;
    float S = 0.f;
    for (int c = 0; c < 64; ++c) {
        const int ci = (b * 64 + c) * 4 + h; const float dm = B.dmid()[ci * 64 + k], dl = B.dL()[ci * 64 + k];
        if (e < 64) { const size_t o = ((size_t)ci * 64 + e) * 64 + k; B.Sp()[o] = f2bf(S * dm); S = dl * S + bf2f(B.Ub()[o]); }
        else { B.np()[ci * 64 + k] = S * dm; S = dl * S + B.Un()[ci * 64 + k]; }
    }
}
template <int MIX>
__device__ __forceinline__ void stepC(const BufsT<MIX>& B, const bf16_t* P, int gatecol, const float* outg, bf16_t* mixed, int mixcol, int ci, int lane) {
    const int r32 = lane & 31, hi = lane >> 5, h = ci & 3; const size_t m0 = (size_t)(ci >> 2) * 64;
    const bf16_t* vt = B.VT() + (size_t)ci * 4096; const bf16_t* sp = B.Sp() + (size_t)ci * 4096;
#pragma unroll 1
    for (int tt = 0; tt < 2; ++tt) {
        bf16x8 qf[4];
#pragma unroll
        for (int ks = 0; ks < 4; ++ks) qf[ks] = *(const bf16x8*)(B.QA() + (m0 + 32 * tt + r32) * 256 + h * 64 + 16 * ks + 8 * hi);
        f32x16 o[2];
#pragma unroll
        for (int r = 0; r < 16; ++r) { o[0][r] = 0.f; o[1][r] = 0.f; }
        float den = 0.f;
        for (int st = 0; st <= tt; ++st) {
            f32x16 pt;
#pragma unroll
            for (int r = 0; r < 16; ++r) pt[r] = 0.f;
#pragma unroll
            for (int ks = 0; ks < 4; ++ks) { const bf16x8 kf = *(const bf16x8*)(B.KA() + (m0 + 32 * st + r32) * 256 + h * 64 + 16 * ks + 8 * hi);
                pt = __builtin_amdgcn_mfma_f32_32x32x16_bf16(kf, qf[ks], pt, 0, 0, 0); }
            if (st == tt) {
#pragma unroll
                for (int r = 0; r < 16; ++r) { const int sl = (r & 3) + 8 * (r >> 2) + 4 * hi; pt[r] = sl <= r32 ? pt[r] : 0.f; } }
            if (MIX == 0) {
#pragma unroll
                for (int r = 0; r < 16; ++r) den += pt[r]; }
#pragma unroll
            for (int s2 = 0; s2 < 2; ++s2) {
                fa::u32x4 pw; pw.x = fa::cvtpk(pt[8 * s2 + 0], pt[8 * s2 + 1]); pw.y = fa::cvtpk(pt[8 * s2 + 2], pt[8 * s2 + 3]); pw.z = fa::cvtpk(pt[8 * s2 + 4], pt[8 * s2 + 5]); pw.w = fa::cvtpk(pt[8 * s2 + 6], pt[8 * s2 + 7]);
                const bf16x8 pf = __builtin_bit_cast(bf16x8, pw);
#pragma unroll
                for (int et = 0; et < 2; ++et) { const bf16x8 vf = *(const bf16x8*)(vt + (32 * et + r32) * 64 + 32 * st + 16 * s2 + 8 * hi);
                    o[et] = __builtin_amdgcn_mfma_f32_32x32x16_bf16(vf, pf, o[et], 0, 0, 0); }
            }
        }
#pragma unroll
        for (int ks = 0; ks < 4; ++ks)
#pragma unroll
            for (int et = 0; et < 2; ++et) { const bf16x8 sf = *(const bf16x8*)(sp + (32 * et + r32) * 64 + 16 * ks + 8 * hi);
                o[et] = __builtin_amdgcn_mfma_f32_32x32x16_bf16(sf, qf[ks], o[et], 0, 0, 0); }
        if (MIX == 0) {
#pragma unroll
            for (int ks = 0; ks < 4; ++ks)
#pragma unroll
                for (int j = 0; j < 8; ++j) den += bf2f((bf16_t)qf[ks][j]) * B.np()[ci * 64 + 16 * ks + 8 * hi + j];
            den += xhalf(den, lane);
            const float sc = 1.f / __builtin_fmaxf(__builtin_fabsf(den), 1.f);
#pragma unroll
            for (int r = 0; r < 16; ++r) { o[0][r] *= sc; o[1][r] *= sc; }
        }
        float ss = 0.f;
#pragma unroll
        for (int r = 0; r < 16; ++r) ss += o[0][r] * o[0][r] + o[1][r] * o[1][r];
        ss += xhalf(ss, lane);
        const float rr = rsqrtf(ss * (1.f / 64) + EPS);
        const size_t m = m0 + 32 * tt + r32;
#pragma unroll
        for (int et = 0; et < 2; ++et)
#pragma unroll
            for (int g = 0; g < 4; ++g) {
                const int e = 32 * et + 8 * g + 4 * hi;
                const uint2 gt2 = *(const uint2*)(P + m * LDP + gatecol + h * 64 + e);
                const float4 og = *(const float4*)(outg + h * 64 + e);
                const float g0 = sigmoidf_(__uint_as_float(gt2.x << 16)), g1 = sigmoidf_(__uint_as_float(gt2.x & 0xffff0000u)),
                            g2 = sigmoidf_(__uint_as_float(gt2.y << 16)), g3 = sigmoidf_(__uint_as_float(gt2.y & 0xffff0000u));
                uint2 w; w.x = pk2bf(o[et][4 * g] * rr * og.x * g0, o[et][4 * g + 1] * rr * og.y * g1); w.y = pk2bf(o[et][4 * g + 2] * rr * og.z * g2, o[et][4 * g + 3] * rr * og.w * g3);
                *(uint2*)(mixed + m * DM + mixcol + h * 64 + e) = w;
            }
    }
}
}

template <int N> struct IntC { static constexpr int value = N; };
struct Params {
    const float* x_in; const float* norm_mix; const float* norm_ffn; const float* w_in; const float* w_out;
    const float* diff_q_gain; const float* diff_k_gain; const float* diff_lambda; const float* diff_sub_gain;
    const float* mlstm_conv; const float* mlstm_gate_bias; const float* mlstm_out_gain; const float* hgrn_lb; const float* hgrn_out_gain;
    const float* nsa_cmp_pos; const float* nsa_cmp_w1; const float* nsa_cmp_w2; const float* nsa_q_gain; const float* nsa_k_gain; const float* nsa_out_gain;
    const float* moe_w_group; const float* moe_b_group; const float* moe_w_expert; const float* moe_b_expert;
    const float* moe_w_gate; const float* moe_w_up; const float* moe_w_down;
    float* out; char* ws;
};


constexpr size_t al256(size_t x) { return (x + 255) & ~(size_t)255; }
constexpr size_t WS_P = 0;
constexpr size_t WS_TB = WS_P + al256((size_t)MT * LDP * 2);
constexpr size_t WS_MIXED = WS_TB + al256((size_t)MT * DM * 2);
constexpr size_t WS_DQ = WS_MIXED + al256((size_t)MT * DM * 2);
constexpr size_t WS_DK = WS_DQ + al256((size_t)MT * 256 * 4);
constexpr size_t WS_NQ = WS_DK + al256((size_t)MT * 256 * 4);
constexpr size_t WS_KSN = WS_NQ + al256((size_t)MT * 256 * 4);
constexpr size_t WS_KWN = WS_KSN + al256((size_t)MT * 64 * 4);
constexpr size_t WS_CMP = WS_KWN + al256((size_t)MT * 64 * 4);
constexpr size_t WS_OCMP = WS_CMP + al256((size_t)2 * NB * NCMP * 64 * 4);
constexpr size_t WS_IMP = WS_OCMP + al256((size_t)MT * 256 * 4);
constexpr size_t WS_SELMASK = WS_IMP + al256((size_t)MT * 64 * 4);
constexpr size_t WS_RE = WS_SELMASK + al256((size_t)MT * 8);
constexpr size_t WS_RW = WS_RE + al256((size_t)MT * 2 * 4);
constexpr size_t WS_RS = WS_RW + al256((size_t)MT * 2 * 4);
constexpr int MOE_ROWS_MAX = 2 * MT + 32 * 256;
constexpr size_t WS_ROWTOK = WS_RS + al256((size_t)MT * 2 * 4);
constexpr size_t WS_ROWW = WS_ROWTOK + al256((size_t)MOE_ROWS_MAX * 4);
constexpr size_t WS_CNT = WS_ROWW + al256((size_t)MOE_ROWS_MAX * 4);
constexpr size_t WS_BAR = WS_CNT + 256;
constexpr size_t WS_WIN_T = WS_BAR + 16384;
constexpr size_t WS_WOUT_T = WS_WIN_T + al256((size_t)LDP * DM * 2);
constexpr size_t WS_END = WS_WOUT_T + al256((size_t)DM * DM * 2);
static_assert((size_t)32 * 512 * DM * 2 + (size_t)32 * DM * 256 * 2 + (size_t)MOE_ROWS_MAX * 256 * 2 <= WS_TB, "MoE weight copies + H overlay P");
static_assert(WS_MIXED + (size_t)MOE_ROWS_MAX * DM * 2 <= WS_SELMASK, "sorted activations overlay mixed..imp");
#define W_P ((bf16_t*)(pq->ws + WS_P))
#define W_TB ((bf16_t*)(pq->ws + WS_TB))
#define W_MIXED ((bf16_t*)(pq->ws + WS_MIXED))
#define W_DQ ((float*)(pq->ws + WS_DQ))
#define W_DK ((float*)(pq->ws + WS_DK))
#define W_QBF ((bf16_t*)(pq->ws + WS_DQ))
#define W_DKF ((bf16_t*)(pq->ws + WS_DK))
#define W_DVF ((bf16_t*)(pq->ws + WS_DK + (size_t)MT * 256 * 2))
#define W_DO ((float*)(pq->ws + WS_TB))
#define W_NQ ((float*)(pq->ws + WS_NQ))
#define W_NQB ((bf16_t*)(pq->ws + WS_NQ))
#define W_KSF ((bf16_t*)(pq->ws + WS_KSN))
#define W_VSF ((bf16_t*)(pq->ws + WS_KSN + (size_t)MT * 64 * 2))
#define W_KWF ((bf16_t*)(pq->ws + WS_KWN))
#define W_VWF ((bf16_t*)(pq->ws + WS_KWN + (size_t)MT * 64 * 2))
#define W_KCF ((bf16_t*)(pq->ws + WS_CMP))
#define W_VCF ((bf16_t*)(pq->ws + WS_CMP + 131072))
#define W_QUEUE ((unsigned*)(pq->ws + WS_BAR + 14336))
#define W_KSN ((float*)(pq->ws + WS_KSN))
#define W_KWN ((float*)(pq->ws + WS_KWN))
#define W_CMP ((float*)(pq->ws + WS_CMP))
#define W_OCMP ((float*)(pq->ws + WS_OCMP))
#define W_IMP ((float*)(pq->ws + WS_IMP))
#define W_OSEL W_DQ
#define W_OWIN W_DK
#define W_SELMASK ((unsigned long long*)(pq->ws + WS_SELMASK))
#define W_RE ((int*)(pq->ws + WS_RE))
#define W_RW ((float*)(pq->ws + WS_RW))
#define W_RS ((int*)(pq->ws + WS_RS))
#define W_ROWTOK ((int*)(pq->ws + WS_ROWTOK))
#define W_ROWW ((float*)(pq->ws + WS_ROWW))
#define W_CNT ((int*)(pq->ws + WS_CNT))
#define W_WGU_T ((bf16_t*)(pq->ws + WS_P))
#define W_WD_T ((bf16_t*)(pq->ws + WS_P + (size_t)32 * 512 * DM * 2))
#define W_HS ((bf16_t*)(pq->ws + WS_P + (size_t)32 * 512 * DM * 2 + (size_t)32 * DM * 256 * 2))
#define W_ASORT ((bf16_t*)(pq->ws + WS_MIXED))
#define W_YMOE ((bf16_t*)(pq->ws + WS_MIXED))

#define SCAN_BUFS(Bm, Bh) scan::BufsT<0> Bm{pq->ws + WS_DQ, pq->ws + WS_TB}; scan::BufsT<1> Bh{pq->ws + WS_DQ, pq->ws + WS_TB};
static_assert(WS_DQ + (size_t)9 * MT * 256 * 2 + (size_t)5 * 1024 * 64 * 4 <= WS_SELMASK, "scan overlay 1");
static_assert((size_t)3 * MT * 256 * 2 + (size_t)5 * 1024 * 64 * 4 <= (size_t)MT * DM * 2, "scan overlay 2");
#define W_WIN_T ((bf16_t*)(pq->ws + WS_WIN_T))
#define W_WOUT_T ((bf16_t*)(pq->ws + WS_WOUT_T))

__device__ __forceinline__ float4 bf4_to_f4(uint2 u) { return make_float4(__uint_as_float(u.x << 16), __uint_as_float(u.x & 0xffff0000u), __uint_as_float(u.y << 16), __uint_as_float(u.y & 0xffff0000u)); }
__device__ __forceinline__ void norm_row(float* x, const float* xsrc, const bf16_t* ymoe, const float* gain, bf16_t* t, int row, int lane) {
    const float4* xr = (const float4*)(xsrc + (size_t)row * DM);
    float4 v[4]; float s = 0.f;
#pragma unroll
    for (int j = 0; j < 4; ++j) { v[j] = xr[lane + 64 * j];
        if (ymoe) { const float4 a = bf4_to_f4(((const uint2*)(ymoe + (size_t)row * 2 * DM))[lane + 64 * j]), b = bf4_to_f4(((const uint2*)(ymoe + ((size_t)row * 2 + 1) * DM))[lane + 64 * j]);
            v[j].x += a.x + b.x; v[j].y += a.y + b.y; v[j].z += a.z + b.z; v[j].w += a.w + b.w; ((float4*)(x + (size_t)row * DM))[lane + 64 * j] = v[j]; }
        s += v[j].x * v[j].x + v[j].y * v[j].y + v[j].z * v[j].z + v[j].w * v[j].w; }
    const float r = rsqrtf(wave_sum(s, lane) * (1.f / DM) + EPS);
#pragma unroll
    for (int j = 0; j < 4; ++j) {
        const float4 g = ((const float4*)gain)[lane + 64 * j];
        ushort4 o; o.x = f2bf(v[j].x * r * g.x); o.y = f2bf(v[j].y * r * g.y); o.z = f2bf(v[j].z * r * g.z); o.w = f2bf(v[j].w * r * g.w);
        ((ushort4*)(t + (size_t)row * DM))[lane + 64 * j] = o;
    }
}


typedef __attribute__((address_space(3))) float lds_f32;
typedef unsigned v4u_t __attribute__((ext_vector_type(4)));
template <bool MAP>
__device__ __forceinline__ void transpose_item(const float* W, int K, int Nsrc, int Nnew, bf16_t* WT, lds_f32* scr, int item, int lane) {
    const int nblk = Nnew / 32, kb = item / nblk, nb = item % nblk, k0 = 64 * kb, n0 = 32 * nb;
    const int n = n0 + (lane & 31); const int sc = MAP ? src_col(n) : n; const bool ok = MAP ? (n < IN_COLS) : true;
#pragma unroll 8
    for (int i = 0; i < 32; ++i) { const int kk = 2 * i + (lane >> 5); scr[kk * 33 + (lane & 31)] = ok ? W[(size_t)(k0 + kk) * Nsrc + sc] : 0.f; }
    asm volatile("s_waitcnt lgkmcnt(0)" ::: "memory");
    const int c = lane & 7;
#pragma unroll
    for (int j = 0; j < 4; ++j) { const int nn = (lane >> 3) + 8 * j; const lds_f32* sp = scr + (8 * c) * 33 + nn;
        v4u_t o; o.x = pk2bf(sp[0 * 33], sp[1 * 33]); o.y = pk2bf(sp[2 * 33], sp[3 * 33]); o.z = pk2bf(sp[4 * 33], sp[5 * 33]); o.w = pk2bf(sp[6 * 33], sp[7 * 33]);
        *(v4u_t*)(WT + (size_t)(n0 + nn) * K + k0 + 8 * c) = o; }
    asm volatile("s_waitcnt lgkmcnt(0)" ::: "memory");
}

constexpr float LOG2E = 1.4426950408889634f;
__device__ __forceinline__ void diff_prep_qk(const bf16_t* P, const float* qgain, const float* kgain, bf16_t* Qbf, bf16_t* Kf, int idx) {
    const int m = idx >> 3, g = idx & 7;
    {   const uint4* p = (const uint4*)(P + (size_t)m * LDP + PC_AQ + g * 32); float v[32]; float ss = 0.f;
#pragma unroll
        for (int i = 0; i < 4; ++i) { const uint4 u = p[i]; const unsigned w[4] = {u.x, u.y, u.z, u.w};
#pragma unroll
            for (int j = 0; j < 4; ++j) { v[i * 8 + 2 * j] = __uint_as_float(w[j] << 16); v[i * 8 + 2 * j + 1] = __uint_as_float(w[j] & 0xffff0000u); } }
#pragma unroll
        for (int d = 0; d < 32; ++d) ss += v[d] * v[d];
        const float r = rsqrtf(ss * (1.f / 32) + EPS) * (0.17677669529663687f * LOG2E);
        uint4* o = (uint4*)(Qbf + (size_t)m * 256 + g * 32);
#pragma unroll
        for (int i = 0; i < 4; ++i) { uint4 u; u.x = pk2bf(v[i * 8 + 0] * r * qgain[i * 8 + 0], v[i * 8 + 1] * r * qgain[i * 8 + 1]); u.y = pk2bf(v[i * 8 + 2] * r * qgain[i * 8 + 2], v[i * 8 + 3] * r * qgain[i * 8 + 3]);
            u.z = pk2bf(v[i * 8 + 4] * r * qgain[i * 8 + 4], v[i * 8 + 5] * r * qgain[i * 8 + 5]); u.w = pk2bf(v[i * 8 + 6] * r * qgain[i * 8 + 6], v[i * 8 + 7] * r * qgain[i * 8 + 7]); o[i] = u; } }
    {   const uint4* p = (const uint4*)(P + (size_t)m * LDP + PC_AK + g * 32); float v[32]; float ss = 0.f;
#pragma unroll
        for (int i = 0; i < 4; ++i) { const uint4 u = p[i]; const unsigned w[4] = {u.x, u.y, u.z, u.w};
#pragma unroll
            for (int j = 0; j < 4; ++j) { v[i * 8 + 2 * j] = __uint_as_float(w[j] << 16); v[i * 8 + 2 * j + 1] = __uint_as_float(w[j] & 0xffff0000u); } }
#pragma unroll
        for (int d = 0; d < 32; ++d) ss += v[d] * v[d];
        const float r = rsqrtf(ss * (1.f / 32) + EPS);
        const int b = m / SEQ, t = m % SEQ, tile = t >> 6, kb = (t >> 5) & 1, rr = t & 31;
#pragma unroll
        for (int i = 0; i < 4; ++i) { uint4 u; u.x = pk2bf(v[i * 8 + 0] * r * kgain[i * 8 + 0], v[i * 8 + 1] * r * kgain[i * 8 + 1]); u.y = pk2bf(v[i * 8 + 2] * r * kgain[i * 8 + 2], v[i * 8 + 3] * r * kgain[i * 8 + 3]);
            u.z = pk2bf(v[i * 8 + 4] * r * kgain[i * 8 + 4], v[i * 8 + 5] * r * kgain[i * 8 + 5]); u.w = pk2bf(v[i * 8 + 6] * r * kgain[i * 8 + 6], v[i * 8 + 7] * r * kgain[i * 8 + 7]);
            const int ks = i >> 1, hh = i & 1;
            *(uint4*)(Kf + ((((((size_t)(b * 8 + g) * 64 + tile) * 2 + kb) * 2 + ks) * 32 + rr) * 2 + hh) * 8) = u; } }
}
__device__ __forceinline__ void vfrag_item(const bf16_t* P, int pcol, int hstride, int nheads, bf16_t* Vf, int idx) {
    const int hh = idx & 1, d32 = (idx >> 1) & 31, dblk = (idx >> 6) & 1, sp = (idx >> 7) & 1, kb = (idx >> 8) & 1, tile = (idx >> 9) & 63;
    const int bh = idx >> 15, h = bh % nheads, b = bh / nheads;
    const int key0 = 64 * tile + 32 * kb + 16 * sp + 4 * hh, col = pcol + h * hstride + dblk * 32 + d32;
    unsigned short e[8];
#pragma unroll
    for (int j = 0; j < 8; ++j) e[j] = P[(size_t)(b * SEQ + key0 + 8 * (j >> 2) + (j & 3)) * LDP + col];
    uint4 u; u.x = e[0] | ((unsigned)e[1] << 16); u.y = e[2] | ((unsigned)e[3] << 16); u.z = e[4] | ((unsigned)e[5] << 16); u.w = e[6] | ((unsigned)e[7] << 16);
    *(uint4*)(Vf + (size_t)idx * 8) = u;
}

__device__ __forceinline__ void diff_combine_item(const float* O, const float* lamv, const float* subg, float lam_init, bf16_t* mixed, int idx) {
    const int m = idx >> 2, h = idx & 3;
    float d01 = 0.f, d23 = 0.f;
    for (int i = 0; i < 32; ++i) { d01 += lamv[i] * lamv[32 + i]; d23 += lamv[64 + i] * lamv[96 + i]; }
    const float lam = __expf(d01) - __expf(d23) + lam_init;
    const float* o0 = O + ((size_t)m * 8 + h * 2) * 64; const float* o1 = o0 + 64;
    float v[64]; float s = 0.f;
#pragma unroll
    for (int e = 0; e < 64; ++e) { v[e] = o0[e] - lam * o1[e]; s += v[e] * v[e]; }
    const float r = rsqrtf(s * (1.f / 64) + EPS) * (1.f - lam_init);
#pragma unroll
    for (int e = 0; e < 64; ++e) mixed[(size_t)m * DM + h * 64 + e] = f2bf(v[e] * r * subg[h * 64 + e]);
}

__device__ __forceinline__ int kcf_off(int n, int d);
__device__ __forceinline__ int vcf_off(int n, int d);
__device__ __forceinline__ void nsa_compress_vb(const bf16_t* P, const float* pos, const float* w1, const float* w2, const float* kgain0, float* cmp, int vb, int tid, float* ldsf) {
    float (*red)[64] = (float (*)[64])ldsf; float* hid = ldsf + 256;
    const int n = vb % NCMP, b = (vb / NCMP) % NB, j = vb / (NCMP * NB);
    const int o = tid & 63, part = tid >> 6;
    const int pc = j == 0 ? PC_KC : PC_VC;
    float acc = 0.f;
    for (int l = part * 8; l < part * 8 + 8; ++l) {
        const bf16_t* row = P + (size_t)(b * SEQ + 16 * n + l) * LDP + pc;
        for (int d = 0; d < 64; ++d) acc += (bf2f(row[d]) + pos[(j * 32 + l) * 64 + d]) * w1[((size_t)j * 2048 + l * 64 + d) * 64 + o];
    }
    red[part][o] = acc; __syncthreads();
    if (part == 0) {
        const float x = red[0][o] + red[1][o] + red[2][o] + red[3][o];
        hid[o] = 0.5f * x * (1.f + tanhf(0.7978845608028654f * (x + 0.044715f * x * x * x)));
    }
    __syncthreads();
    if (part == 0) {
        float y = 0.f;
        for (int i = 0; i < 64; ++i) y += hid[i] * w2[(j * 64 + i) * 64 + o];
        if (j == 0) { const float r = rsqrtf(wave_sum(y * y, o) * (1.f / 64) + EPS); y = y * r * kgain0[o]; }
        bf16_t* dst = (bf16_t*)cmp + (size_t)j * 65536 + (size_t)b * 4 * 4096;
        if (j == 0) dst[kcf_off(n, o)] = f2bf(y); else dst[vcf_off(n, o)] = f2bf(y);
        if (n == NCMP - 1) { if (j == 0) dst[kcf_off(NCMP, o)] = 0; else dst[vcf_off(NCMP, o)] = 0; }
    }
    __syncthreads();
}
__device__ __forceinline__ void nsa_combine_item(const bf16_t* P, const float* ocmp, const float* osel, const float* owin, const float* outg, bf16_t* mixed, int idx) {
    const int m = idx >> 2, h = idx & 3;
    const float g0 = sigmoidf_(bf2f(P[(size_t)m * LDP + PC_DG + h * 3 + 0])), g1 = sigmoidf_(bf2f(P[(size_t)m * LDP + PC_DG + h * 3 + 1])),
                g2 = sigmoidf_(bf2f(P[(size_t)m * LDP + PC_DG + h * 3 + 2]));
    const size_t base = ((size_t)m * 4 + h) * 64;
    float v[64]; float s = 0.f;
#pragma unroll
    for (int d = 0; d < 64; ++d) { v[d] = g0 * ocmp[base + d] + g1 * osel[base + d] + g2 * owin[base + d]; s += v[d] * v[d]; }
    const float r = rsqrtf(s * (1.f / 64) + EPS);
#pragma unroll
    for (int d = 0; d < 64; ++d) mixed[(size_t)m * DM + 768 + h * 64 + d] = f2bf(v[d] * r * outg[h * 64 + d]);
}

__device__ __forceinline__ void moe_route_row(const float* x, const float* gain, const float* wg, const float* bg, const float* we, const float* be, bf16_t* t, int* re, float* rw, int* rs, int* cnt,
                                              int row, int lane) {
    const float4* xr = (const float4*)(x + (size_t)row * DM);
    float4 v[4]; float s = 0.f;
#pragma unroll
    for (int j = 0; j < 4; ++j) { v[j] = xr[lane + 64 * j]; s += v[j].x * v[j].x + v[j].y * v[j].y + v[j].z * v[j].z + v[j].w * v[j].w; }
    const float r = rsqrtf(wave_sum(s, lane) * (1.f / DM) + EPS);
    float lg[36];
#pragma unroll
    for (int o = 0; o < 36; ++o) lg[o] = 0.f;
#pragma unroll
    for (int j = 0; j < 4; ++j) {
        const float4 g = ((const float4*)gain)[lane + 64 * j];
        float tn[4] = {v[j].x * r * g.x, v[j].y * r * g.y, v[j].z * r * g.z, v[j].w * r * g.w};
        ushort4 o4; o4.x = f2bf(tn[0]); o4.y = f2bf(tn[1]); o4.z = f2bf(tn[2]); o4.w = f2bf(tn[3]);
        ((ushort4*)(t + (size_t)row * DM))[lane + 64 * j] = o4;
#pragma unroll
        for (int i = 0; i < 4; ++i) {
            const int k = (lane + 64 * j) * 4 + i;
            const float4 w4 = ((const float4*)wg)[k];
            lg[0] += tn[i] * w4.x; lg[1] += tn[i] * w4.y; lg[2] += tn[i] * w4.z; lg[3] += tn[i] * w4.w;
#pragma unroll
            for (int e4 = 0; e4 < 8; ++e4) { const float4 w = ((const float4*)we)[k * 8 + e4];
                lg[4 + e4 * 4 + 0] += tn[i] * w.x; lg[4 + e4 * 4 + 1] += tn[i] * w.y; lg[4 + e4 * 4 + 2] += tn[i] * w.z; lg[4 + e4 * 4 + 3] += tn[i] * w.w; }
            asm volatile("" ::: "memory");
        }
    }
#pragma unroll
    for (int o = 0; o < 36; ++o) lg[o] = wave_sum(lg[o], lane);
    float gl[4]; float gmx = NEG; int gs = 0;
#pragma unroll
    for (int g = 0; g < 4; ++g) { gl[g] = lg[g] + bg[g]; if (gl[g] > gmx) { gmx = gl[g]; gs = g; } }
    float gz = 0.f;
#pragma unroll
    for (int g = 0; g < 4; ++g) gz += __expf(gl[g] - gmx);
    const float gprob = 1.f / gz;
    float el[8];
#pragma unroll
    for (int e = 0; e < 8; ++e) {
        const float a0 = lg[4 + e] + be[e], a1 = lg[12 + e] + be[8 + e], a2 = lg[20 + e] + be[16 + e], a3 = lg[28 + e] + be[24 + e];
        el[e] = gs == 0 ? a0 : (gs == 1 ? a1 : (gs == 2 ? a2 : a3));
    }
    float m1 = NEG; int i1 = 0;
#pragma unroll
    for (int e = 0; e < 8; ++e) if (el[e] > m1) { m1 = el[e]; i1 = e; }
    float m2 = NEG; int i2 = 0;
#pragma unroll
    for (int e = 0; e < 8; ++e) if (e != i1 && el[e] > m2) { m2 = el[e]; i2 = e; }
    const float p2 = __expf(m2 - m1);
    const float w1 = gprob / (1.f + p2), w2 = gprob * p2 / (1.f + p2);
    if (lane == 0) { const int e1 = gs * 8 + i1, e2 = gs * 8 + i2;
        re[row * 2] = e1; re[row * 2 + 1] = e2; rw[row * 2] = w1; rw[row * 2 + 1] = w2;
        rs[row * 2] = atomicAdd(cnt + e1, 1); rs[row * 2 + 1] = atomicAdd(cnt + e2, 1); }
}

__device__ __forceinline__ void nsa_prep_q(const bf16_t* P, const float* qgain, bf16_t* Qn, int idx) {
    const int m = idx >> 2, h = idx & 3;
    const uint4* p = (const uint4*)(P + (size_t)m * LDP + PC_DQ + h * 64); float v[64]; float ss = 0.f;
#pragma unroll
    for (int i = 0; i < 8; ++i) { const uint4 u = p[i]; const unsigned w[4] = {u.x, u.y, u.z, u.w};
#pragma unroll
        for (int j = 0; j < 4; ++j) { v[i * 8 + 2 * j] = __uint_as_float(w[j] << 16); v[i * 8 + 2 * j + 1] = __uint_as_float(w[j] & 0xffff0000u); } }
#pragma unroll
    for (int d = 0; d < 64; ++d) ss += v[d] * v[d];
    const float r = rsqrtf(ss * (1.f / 64) + EPS) * (0.125f * LOG2E);
    uint4* o = (uint4*)(Qn + (size_t)m * 256 + h * 64);
#pragma unroll
    for (int i = 0; i < 8; ++i) { uint4 u; u.x = pk2bf(v[i * 8 + 0] * r * qgain[i * 8 + 0], v[i * 8 + 1] * r * qgain[i * 8 + 1]); u.y = pk2bf(v[i * 8 + 2] * r * qgain[i * 8 + 2], v[i * 8 + 3] * r * qgain[i * 8 + 3]);
        u.z = pk2bf(v[i * 8 + 4] * r * qgain[i * 8 + 4], v[i * 8 + 5] * r * qgain[i * 8 + 5]); u.w = pk2bf(v[i * 8 + 6] * r * qgain[i * 8 + 6], v[i * 8 + 7] * r * qgain[i * 8 + 7]); o[i] = u; }
}
__device__ __forceinline__ void nsa_prep_k(const bf16_t* P, int pcol, const float* kgain, bf16_t* Kf, int m) {
    const uint4* p = (const uint4*)(P + (size_t)m * LDP + pcol); float v[64]; float ss = 0.f;
#pragma unroll
    for (int i = 0; i < 8; ++i) { const uint4 u = p[i]; const unsigned w[4] = {u.x, u.y, u.z, u.w};
#pragma unroll
        for (int j = 0; j < 4; ++j) { v[i * 8 + 2 * j] = __uint_as_float(w[j] << 16); v[i * 8 + 2 * j + 1] = __uint_as_float(w[j] & 0xffff0000u); } }
#pragma unroll
    for (int d = 0; d < 64; ++d) ss += v[d] * v[d];
    const float r = rsqrtf(ss * (1.f / 64) + EPS);
    const int b = m / SEQ, t = m % SEQ, tile = t >> 6, kb = (t >> 5) & 1, rr = t & 31;
#pragma unroll
    for (int i = 0; i < 8; ++i) { uint4 u; u.x = pk2bf(v[i * 8 + 0] * r * kgain[i * 8 + 0], v[i * 8 + 1] * r * kgain[i * 8 + 1]); u.y = pk2bf(v[i * 8 + 2] * r * kgain[i * 8 + 2], v[i * 8 + 3] * r * kgain[i * 8 + 3]);
        u.z = pk2bf(v[i * 8 + 4] * r * kgain[i * 8 + 4], v[i * 8 + 5] * r * kgain[i * 8 + 5]); u.w = pk2bf(v[i * 8 + 6] * r * kgain[i * 8 + 6], v[i * 8 + 7] * r * kgain[i * 8 + 7]);
        const int ks = i >> 1, hh = i & 1;
        *(uint4*)(Kf + (((((size_t)(b * 64 + tile) * 2 + kb) * 4 + ks) * 32 + rr) * 2 + hh) * 8) = u; }
}
__device__ __forceinline__ int kcf_off(int n, int d) { return ((((((n >> 6) * 2 + ((n >> 5) & 1)) * 4 + (d >> 4)) * 32 + (n & 31)) * 2 + ((d >> 3) & 1)) * 8) + (d & 7); }
__device__ __forceinline__ int vcf_off(int n, int d) { const int s16 = n & 15; return (((((((n >> 6) * 2 + ((n >> 5) & 1)) * 2 + ((n >> 4) & 1)) * 2 + (d >> 5)) * 32 + (d & 31)) * 2 + ((s16 >> 2) & 1)) * 8) + (((s16 >> 3) << 2) | (s16 & 3)); }

__device__ __forceinline__ void nsa_cmp_unit(FA_LAS unsigned char* lds, int tid, const bf16_t* Qn, const bf16_t* Kcf, const bf16_t* Vcf, float* ocmp, unsigned long long* selmask, int b, int qb) {
    const int lane = tid & 63, wave = tid >> 6, r32 = lane & 31, hi = lane >> 5, head = wave >> 1, tl = 32 * (wave & 1) + r32, t = qb * 64 + tl;
    const size_t m = (size_t)b * SEQ + t;
    const float slope2 = exp2f(-(float)(2 * head + 2)) * LOG2E;
    const int ntiles = (4 * qb + 66) >> 6;
    const bf16_t* kb0 = Kcf + (size_t)b * 4 * 4096; const bf16_t* vb0 = Vcf + (size_t)b * 4 * 4096;
    auto tile_of = [=](int i) { fa::Tile T; T.kg = kb0 + (size_t)i * 4096; T.vg = vb0 + (size_t)i * 4096; T.key0 = i * 64; return T; };
    float mfin, lfin;
    fa::attn_unit<4, 3>(lds, tid, ntiles, tile_of, Qn + m * 256 + head * 64, t, slope2, 0ull, ocmp + (m * 4 + head) * 64, mfin, lfin);
    FA_LAS float* impH = (FA_LAS float*)lds;
    for (int i = tid; i < 4 * 64 * 64; i += NTHR) impH[i] = 0.f;
    __syncthreads();
    const int nv = t >= 31 ? ((t - 31) >> 4) + 1 : 0;
    const float il = nv > 0 ? 1.f / lfin : 0.f;
    fa::bf16x8 qf[4];
#pragma unroll
    for (int ks = 0; ks < 4; ++ks) qf[ks] = *(const fa::bf16x8*)(Qn + m * 256 + head * 64 + 16 * ks + 8 * hi);
    float carry = 0.f;
    for (int ti = 0; ti < ntiles; ++ti)
#pragma unroll
        for (int kb = 0; kb < 2; ++kb) {
            fa::f32x16 sc;
#pragma unroll
            for (int r = 0; r < 16; ++r) sc[r] = 0.f;
#pragma unroll
            for (int ks = 0; ks < 4; ++ks) { const fa::bf16x8 a = *(const fa::bf16x8*)(kb0 + (size_t)ti * 4096 + (((kb * 4 + ks) * 32 + r32) * 2 + hi) * 8);
                sc = __builtin_amdgcn_mfma_f32_32x32x16_bf16(a, qf[ks], sc, 0, 0, 0); }
#pragma unroll
            for (int g = 0; g < 4; ++g) {
                const int n0 = 64 * ti + 32 * kb + 8 * g + 4 * hi;
                float p[4];
#pragma unroll
                for (int i = 0; i < 4; ++i) { const int n = n0 + i; const float val = sc[4 * g + i] + slope2 * (float)(16 * n + 31 - t);
                    p[i] = n < nv ? __builtin_amdgcn_exp2f(val - mfin) * il : 0.f; }
                const float a1 = (p[0] + p[1]) + (p[2] + 0.5f * p[3]), a2 = 0.5f * p[3];
                const float recv = fa::xhalf(a2, lane);
                const float val = a1 + (hi ? recv : carry);
                if (!hi) carry = recv;
                impH[(head * 64 + tl) * 64 + (n0 >> 2)] = val;
            }
        }
    __syncthreads();
    for (int tt = 0; tt < 8; ++tt) {
        const int tok = 8 * wave + tt;
        float v = ((impH[(0 * 64 + tok) * 64 + lane] + impH[(1 * 64 + tok) * 64 + lane]) + impH[(2 * 64 + tok) * 64 + lane]) + impH[(3 * 64 + tok) * 64 + lane];
        v = lane <= qb ? v : -1.f;
        if (lane == 0 || lane == qb || lane == qb - 1) v = 2.f;
        int rank = 0;
        for (int i = 0; i < 64; ++i) { const float vi = __int_as_float(__builtin_amdgcn_readlane(__float_as_int(v), i)); rank += (vi > v || (vi == v && i < lane)) ? 1 : 0; }
        const unsigned long long msk = __builtin_amdgcn_ballot_w64(rank < 16);
        if (lane == 0) selmask[(size_t)b * SEQ + qb * 64 + tok] = msk;
    }
    __syncthreads();
}
template <int KIND>
__device__ __forceinline__ void nsa_branch_unit(FA_LAS unsigned char* lds, int tid, const bf16_t* Qn, const bf16_t* Kf, const bf16_t* Vf, const unsigned long long* selmask, float* obr, int b, int qb) {
    const int lane = tid & 63, wave = tid >> 6, head = wave >> 1, tl = 32 * (wave & 1) + (lane & 31), t = qb * 64 + tl;
    const size_t m = (size_t)b * SEQ + t;
    const float slope2 = exp2f(-(float)(2 * head + 2)) * LOG2E;
    const bf16_t* kb0 = Kf + (size_t)b * 64 * 4096; const bf16_t* vb0 = Vf + (size_t)b * 64 * 4096;
    float mo, lo;
    if (KIND == 1) {
        const unsigned long long sel = selmask[m];
        unsigned lo32 = (unsigned)sel, hi32 = (unsigned)(sel >> 32);
#pragma unroll
        for (int o = 1; o < 64; o <<= 1) { lo32 |= (unsigned)__builtin_amdgcn_ds_bpermute((lane ^ o) << 2, (int)lo32); hi32 |= (unsigned)__builtin_amdgcn_ds_bpermute((lane ^ o) << 2, (int)hi32); }
        FA_LAS unsigned* uni = (FA_LAS unsigned*)(lds + 32768);
        FA_LAS unsigned char* tlist = lds + 32768 + 16;
        if (wave < 2 && lane == 0) { uni[wave * 2] = lo32; uni[wave * 2 + 1] = hi32; }
        __syncthreads();
        const unsigned long long U = ((unsigned long long)(uni[1] | uni[3]) << 32) | (unsigned long long)(uni[0] | uni[2]);
        if (tid < 64 && ((U >> tid) & 1ull)) tlist[__builtin_popcountll(U & ((1ull << tid) - 1ull))] = (unsigned char)tid;
        __syncthreads();
        const int ntiles = __builtin_popcountll(U);
        auto tile_of = [=](int i) { const int j = tlist[i]; fa::Tile T; T.kg = kb0 + (size_t)j * 4096; T.vg = vb0 + (size_t)j * 4096; T.key0 = j * 64; return T; };
        fa::attn_unit<4, 1>(lds, tid, ntiles, tile_of, Qn + m * 256 + head * 64, t, slope2, sel, obr + (m * 4 + head) * 64, mo, lo);
    } else {
        const int first = qb >= 8 ? qb - 8 : 0;
        auto tile_of = [=](int i) { const int j = first + i; fa::Tile T; T.kg = kb0 + (size_t)j * 4096; T.vg = vb0 + (size_t)j * 4096; T.key0 = j * 64; return T; };
        fa::attn_unit<4, 2>(lds, tid, qb - first + 1, tile_of, Qn + m * 256 + head * 64, t, slope2, 0ull, obr + (m * 4 + head) * 64, mo, lo);
    }
}

__device__ __forceinline__ void moe_table(const int* cnt, __attribute__((address_space(3))) int* tab, int tid) {
    if (tid < 64) {
        const int lane = tid; const int c = lane < 32 ? cnt[lane] : 0; const int pc = (c + 255) >> 8;
        int x = pc;
#pragma unroll
        for (int o = 1; o < 32; o <<= 1) { const int y = __builtin_amdgcn_ds_bpermute(((lane - o) & 63) << 2, x); if (lane >= o) x += y; }
        const int ex = x - pc;
        if (lane < 32) { tab[lane] = ex * 256; tab[32 + lane] = c; for (int t = 0; t < pc; ++t) tab[128 + ex + t] = lane; }
        if (lane == 31) tab[64] = x;
    }
    __syncthreads();
}

#define XB_TMO      128
#define XB_XCNT(j)  (256  + 64 * (j))
#define XB_XSUB(j)  (1280 + 64 * (j))
#define XB_XGEN(j)  (2304 + 64 * (j))
#define XB_TOP      3328
#define XB_TOPGEN   3392
#define XCD_BAR_WORDS 3456
#define XB_SPIN_CAP (1u << 18)

__device__ __forceinline__ unsigned xb_ld(unsigned* p)              { return __hip_atomic_load(p, __ATOMIC_RELAXED, __HIP_MEMORY_SCOPE_AGENT); }
__device__ __forceinline__ unsigned xb_add(unsigned* p, unsigned v) { return __hip_atomic_fetch_add(p, v, __ATOMIC_RELAXED, __HIP_MEMORY_SCOPE_AGENT); }
__device__ __forceinline__ unsigned xb_xcc_id() { return (unsigned)__builtin_amdgcn_s_getreg((3 << 11) | 20) & 0xFu; }
#define XB_SPIN(cond, bar) do { unsigned _sp = 0; while (cond) { __builtin_amdgcn_s_sleep(1); \
    if ((++_sp & 255u) == 0u) { if (xb_ld(&(bar)[XB_TMO])) break; if (_sp > XB_SPIN_CAP) { atomicAdd(&(bar)[XB_TMO], 1u); break; } } } } while (0)

struct XcdBarrier {
    unsigned* bar; unsigned x;
    volatile __attribute__((address_space(3))) unsigned* st;
};

__device__ __forceinline__ XcdBarrier xcd_barrier_post(unsigned* bar, volatile __attribute__((address_space(3))) unsigned* st) {
    XcdBarrier b; b.bar = bar; b.x = xb_xcc_id(); b.st = st;
    if (threadIdx.x == 0) (void)xb_add(&bar[XB_XCNT(b.x)], 1u);
    return b;
}
__device__ __forceinline__ void xcd_barrier_complete(unsigned* bar, unsigned x, unsigned& nloc, unsigned& nx) {
    const unsigned G = gridDim.x * gridDim.y * gridDim.z;
    unsigned sum, cnt, mine, sp = 0u;
    for (;;) {
        sum = 0u; cnt = 0u; mine = 0u;
#pragma unroll
        for (unsigned j = 0; j < 16; ++j) { const unsigned c = xb_ld(&bar[XB_XCNT(j)]); sum += c; cnt += (c > 0u) ? 1u : 0u; mine = (j == x) ? c : mine; }
        if (sum == G) break;
        __builtin_amdgcn_s_sleep(1);
        if ((++sp & 255u) == 0u) { if (xb_ld(&bar[XB_TMO])) break; if (sp > XB_SPIN_CAP) { atomicAdd(&bar[XB_TMO], 1u); break; } }
    }
    nloc = mine > 0u ? mine : 1u; nx = cnt > 0u ? cnt : 1u;
}

__device__ __forceinline__ void xcd_barrier(const XcdBarrier& b) {
    asm volatile("s_waitcnt vmcnt(0)" ::: "memory");
    __syncthreads();
    if (threadIdx.x == 0) {
        unsigned* bar = b.bar;
        __builtin_amdgcn_s_waitcnt(0);
        unsigned nloc = b.st[0], nx = b.st[1];
        if (nloc == 0u) { xcd_barrier_complete(bar, b.x, nloc, nx); b.st[0] = nloc; b.st[1] = nx; }
        const unsigned old = xb_add(&bar[XB_XSUB(b.x)], 1u);
        const unsigned gen = old / nloc;
        if (old + 1u == (gen + 1u) * nloc) {
            __builtin_amdgcn_fence(__ATOMIC_RELEASE, "agent");
            asm volatile("s_waitcnt vmcnt(0)" ::: "memory");
            const unsigned og = xb_add(&bar[XB_TOP], 1u);
            const unsigned tg = og / nx;
            if (og + 1u == (tg + 1u) * nx) xb_add(&bar[XB_TOPGEN], 1u);
            else XB_SPIN(xb_ld(&bar[XB_TOPGEN]) == tg, bar);
            __builtin_amdgcn_fence(__ATOMIC_ACQUIRE, "agent");
            xb_add(&bar[XB_XGEN(b.x)], 1u);
            asm volatile("s_waitcnt vmcnt(0)" ::: "memory");
        } else {
            XB_SPIN(xb_ld(&bar[XB_XGEN(b.x)]) == gen, bar);
            __builtin_amdgcn_fence(__ATOMIC_ACQUIRE, "agent");
            asm volatile("s_waitcnt vmcnt(0)" ::: "memory");
        }
    }
    __syncthreads();
}


__global__ void __launch_bounds__(NTHR) mega_fwd(Params p_unused) {
    extern __shared__ __attribute__((aligned(16))) unsigned char lds[];
    cg::grid_group grid = cg::this_grid(); grid.sync();
    volatile __attribute__((address_space(3))) unsigned* bar_st = (volatile __attribute__((address_space(3))) unsigned*)(lds + LDS_BYTES - 64);
    if (threadIdx.x < 2) bar_st[threadIdx.x] = 0u;
    __syncthreads();
#ifndef USE_XCD_BARRIER
#define USE_XCD_BARRIER 1
#endif
#if USE_XCD_BARRIER
#define GRID_BARRIER() xcd_barrier(xbar)
#else
#define GRID_BARRIER() grid.sync()
#endif
    XcdBarrier xbar; (void)xbar;
    {   typedef const __attribute__((address_space(4))) Params* cparams0_t; const cparams0_t p0 = (cparams0_t)__builtin_amdgcn_kernarg_segment_ptr();
        xbar = xcd_barrier_post((unsigned*)(p0->ws + WS_BAR), bar_st); }
    typedef const __attribute__((address_space(4))) Params* cparams_t;
    const cparams_t pp = (cparams_t)__builtin_amdgcn_kernarg_segment_ptr();
#define PHASE_VARS \
    int tid = threadIdx.x; asm volatile("" : "+v"(tid)); \
    int bid = blockIdx.x; asm volatile("" : "+s"(bid)); int G = gridDim.x; asm volatile("" : "+s"(G)); int l = layer; asm volatile("" : "+s"(l)); \
    cparams_t pq = pp; asm volatile("" : "+s"(pq)); \
    const float* xcur = l == 0 ? pq->x_in : pq->out; (void)xcur; \
    const int lane = tid & 63, wave = tid >> 6, half = tid >> 8, tid256 = tid & 255; \
    const int gw = bid * NWAVE + wave, NGW = G * NWAVE; \
    const int gt = bid * NTHR + tid, NGT = G * NTHR; \
    float* ldsf = (float*)lds + half * 4096; \
    (void)lane; (void)tid256; (void)gw; (void)NGW; (void)gt; (void)NGT; (void)ldsf;

    auto layer_body = [&](auto LC) __attribute__((always_inline)) {
        constexpr int layer = decltype(LC)::value;
        {   PHASE_VARS
        {   lds_f32* scr = (lds_f32*)lds + wave * (64 * 33);
            for (int it = gw; it < (DM / 64) * (LDP / 32); it += NGW) transpose_item<true>(pq->w_in + (size_t)l * DM * IN_COLS, DM, IN_COLS, LDP, W_WIN_T, scr, it, lane);
            for (int it = gw; it < (DM / 64) * (DM / 32); it += NGW) transpose_item<false>(pq->w_out + (size_t)l * DM * DM, DM, DM, DM, W_WOUT_T, scr, it, lane); }
        if (bid == 0 && tid < 32) W_CNT[tid] = 0;
        for (int row = gw; row < MT; row += NGW) norm_row(pq->out, xcur, l == 0 ? nullptr : W_YMOE, pq->norm_mix + l * DM, W_TB, row, lane);
        }
        GRID_BARRIER();
        {   PHASE_VARS
        {   pg8::Gemm g{W_TB, W_WIN_T, MT, LDP, DM}; pg8::StaticOrder S; S.init(MT, LDP, G, bid);
            pg8::EpiBf16<0> E{W_P, LDP, nullptr, 0, 0, 1.f};
            pg8::gemm_phase<pg8::EpiBf16<0>, pg8::StaticOrder, true, true>((PG8_LAS unsigned char*)lds, g, S, E); }
        }
        GRID_BARRIER();
        {   PHASE_VARS
        SCAN_BUFS(Bm, Bh)
        for (int i = gt; i < 4 * 65536; i += NGT) { const int w = i >> 16, j = i & 65535;
            if (w == 0) scan::prep_k<0>(W_P, pq->mlstm_conv + l * 4 * 512, pq->mlstm_gate_bias + l * 8, nullptr, l, Bm, j);
            else if (w == 1) scan::prep_k<1>(W_P, nullptr, nullptr, pq->hgrn_lb, l, Bh, j);
            else if (w == 2) scan::prep_v(W_P, PC_BV, Bm.VT(), j);
            else scan::prep_v(W_P, PC_CI, Bh.VT(), j); }
        }
        GRID_BARRIER();
        {   PHASE_VARS
        SCAN_BUFS(Bm, Bh)
        for (int it = gw; it < 2048; it += NGW) { if (it < 1024) scan::stepA<0>(Bm, it, lane); else scan::stepA<1>(Bh, it - 1024, lane); }
        }
        GRID_BARRIER();
        {   PHASE_VARS
        SCAN_BUFS(Bm, Bh)
        for (int i = gt; i < 2 * 16 * 65 * 64; i += NGT) { if (i < 16 * 65 * 64) scan::stepB<0>(Bm, i); else scan::stepB<1>(Bh, i - 16 * 65 * 64); }
        }
        GRID_BARRIER();
        {   PHASE_VARS
        SCAN_BUFS(Bm, Bh)
        for (int it = gw; it < 2048; it += NGW) {
            if (it < 1024) scan::stepC<0>(Bm, W_P, PC_BO, pq->mlstm_out_gain + l * 256, W_MIXED, 256, it, lane);
            else scan::stepC<1>(Bh, W_P, PC_CG, pq->hgrn_out_gain + l * 256, W_MIXED, 512, it - 1024, lane); }
        }
        GRID_BARRIER();
        {   PHASE_VARS
        for (int i = gt; i < MT * 8; i += NGT) diff_prep_qk(W_P, pq->diff_q_gain + l * 32, pq->diff_k_gain + l * 32, W_QBF, W_DKF, i);
        for (int i = gt; i < NB * 4 * 64 * 512; i += NGT) vfrag_item(W_P, PC_AV, 64, 4, W_DVF, i);
        for (int i = gt; i < MT * 4; i += NGT) nsa_prep_q(W_P, pq->nsa_q_gain + l * 64, W_NQB, i);
        for (int i = gt; i < 2 * MT; i += NGT) { if (i < MT) nsa_prep_k(W_P, PC_KS, pq->nsa_k_gain + (l * 3 + 1) * 64, W_KSF, i); else nsa_prep_k(W_P, PC_KW, pq->nsa_k_gain + (l * 3 + 2) * 64, W_KWF, i - MT); }
        for (int i = gt; i < 2 * NB * 64 * 512; i += NGT) { if (i < NB * 64 * 512) vfrag_item(W_P, PC_VS, 0, 1, W_VSF, i); else vfrag_item(W_P, PC_VW, 0, 1, W_VWF, i - NB * 64 * 512); }
        for (int it = bid; it < 2 * NB * NCMP / 2; it += G) { const int vb = it * 2 + half;
            nsa_compress_vb(W_P, pq->nsa_cmp_pos + l * 2 * 32 * 64, pq->nsa_cmp_w1 + (size_t)l * 2 * 2048 * 64, pq->nsa_cmp_w2 + l * 2 * 64 * 64, pq->nsa_k_gain + (l * 3 + 0) * 64, W_CMP, vb, tid256, ldsf); }
        }
        GRID_BARRIER();
        {   PHASE_VARS
        {
            const int vcu = (G & 7) == 0 ? (bid & 7) * (G >> 3) + (bid >> 3) : bid;
            for (int pr = vcu; pr < 256; pr += G) {
                const int combo = pr >> 3, sidx = pr & 7, c = combo & 1, h = (combo >> 1) & 3, b = combo >> 3;
                const bf16_t* kbase = W_DKF + (size_t)((b * 4 + h) * 2 + c) * 64 * 2048; const bf16_t* vbase = W_DVF + (size_t)(b * 4 + h) * 64 * 4096;
                auto tile_of = [=](int i) { fa::Tile T; T.kg = kbase + (size_t)i * 2048; T.vg = vbase + (size_t)i * 4096; T.key0 = i * 64; return T; };
                const float slope2 = exp2f(-(float)(2 * h + 1)) * LOG2E;
#pragma unroll 1
                for (int u = 0; u < 2; ++u) { const int qb = u == 0 ? 15 - sidx : sidx;
                    const int t = qb * 256 + wave * 32 + (lane & 31); const size_t m = (size_t)b * SEQ + t;
                    float mo, lo; fa::attn_unit<2, 0>((FA_LAS unsigned char*)lds, tid, 4 * (qb + 1), tile_of, W_QBF + m * 256 + h * 64 + c * 32, t, slope2, 0ull, W_DO + (m * 8 + h * 2 + c) * 64, mo, lo); }
            }
        }
        {   const int vcu = (G & 7) == 0 ? (bid & 7) * (G >> 3) + (bid >> 3) : bid;
            for (int u = vcu; u < 256; u += G) nsa_cmp_unit((FA_LAS unsigned char*)lds, tid, W_NQB, W_KCF, W_VCF, W_OCMP, W_SELMASK, u >> 6, u & 63); }
        }
        GRID_BARRIER();
        {   PHASE_VARS
        const float lam_init = 0.8f - 0.6f * __expf(-0.3f * (float)l);
        for (int i = gt; i < MT * 4; i += NGT) diff_combine_item(W_DO, pq->diff_lambda + l * 128, pq->diff_sub_gain + l * 256, lam_init, W_MIXED, i);
        }
        GRID_BARRIER();
        {   PHASE_VARS
        {
            FA_LAS int* qslot = (FA_LAS int*)(lds + LDS_BYTES - 128);
            for (;;) {
                if (tid == 0) *qslot = (int)atomicAdd(W_QUEUE + l * 64, 1u);
                __syncthreads();
                const int it = *qslot;
                __syncthreads();
                if (it >= 512) break;
                if (it < 256) nsa_branch_unit<1>((FA_LAS unsigned char*)lds, tid, W_NQB, W_KSF, W_VSF, W_SELMASK, W_OSEL, it & 3, 63 - (it >> 2));
                else nsa_branch_unit<2>((FA_LAS unsigned char*)lds, tid, W_NQB, W_KWF, W_VWF, W_SELMASK, W_OWIN, (it - 256) & 3, (it - 256) >> 2);
            }
        }
        }
        GRID_BARRIER();
        {   PHASE_VARS
        for (int i = gt; i < MT * 4; i += NGT) nsa_combine_item(W_P, W_OCMP, W_OSEL, W_OWIN, pq->nsa_out_gain + l * 256, W_MIXED, i);
        }
        GRID_BARRIER();
        {   PHASE_VARS
        {   pg8::Gemm g{W_MIXED, W_WOUT_T, MT, DM, DM}; pg8::StaticOrder S; S.init(MT, DM, G, bid);
            pg8::EpiResF32 E{xcur, pq->out, DM};
            pg8::gemm_phase<pg8::EpiResF32, pg8::StaticOrder, true, true>((PG8_LAS unsigned char*)lds, g, S, E); }
        }
        GRID_BARRIER();
        {   PHASE_VARS
        for (int row = gw; row < MT; row += NGW)
            moe_route_row(pq->out, pq->norm_ffn + l * DM, pq->moe_w_group + l * DM * 4, pq->moe_b_group + l * 4, pq->moe_w_expert + l * DM * 32, pq->moe_b_expert + l * 32, W_TB, W_RE, W_RW, W_RS, W_CNT, row, lane);
        {   lds_f32* scr = (lds_f32*)lds + wave * (64 * 33);
            for (int it = gw; it < 32 * 256; it += NGW) { const int e = it >> 8, r = it & 255, kb = r >> 4, nb = r & 15;
                const int j = nb >> 3, hf = (nb >> 2) & 1, cb = nb & 3;
                const float* W = (hf ? pq->moe_w_up : pq->moe_w_gate) + ((size_t)l * 32 + e) * DM * 256;
                transpose_item<false>(W + j * 128 + cb * 32, DM, 256, 32, W_WGU_T + ((size_t)e * 512 + nb * 32) * DM, scr, kb, lane); }
            for (int it = gw; it < 32 * 128; it += NGW) { const int e = it >> 7, r = it & 127;
                transpose_item<false>(pq->moe_w_down + ((size_t)l * 32 + e) * 256 * DM, 256, DM, DM, W_WD_T + (size_t)e * DM * 256, scr, r, lane); }
        }
        }
        GRID_BARRIER();
        {   PHASE_VARS
        __attribute__((address_space(3))) int* tab = (__attribute__((address_space(3))) int*)(lds + 131072);
        moe_table(W_CNT, tab, tid);
        for (int row = gw; row < MT; row += NGW) {
            const uint4* src = (const uint4*)(W_TB + (size_t)row * DM);
            const uint4 v0 = src[lane], v1 = src[lane + 64];
#pragma unroll
            for (int i = 0; i < 2; ++i) { const int e = W_RE[row * 2 + i], r = tab[e] + W_RS[row * 2 + i];
                uint4* dst = (uint4*)(W_ASORT + (size_t)r * DM); dst[lane] = v0; dst[lane + 64] = v1;
                if (lane == 0) { W_ROWTOK[r] = row * 2 + i; W_ROWW[r] = W_RW[row * 2 + i]; } }
        }
        if (bid == 0) for (int e = wave; e < 32; e += NWAVE) { const int r0 = tab[e] + tab[32 + e], r1 = tab[e] + ((tab[32 + e] + 255) & ~255);
            for (int r = r0 + lane; r < r1; r += 64) { W_ROWTOK[r] = -1; W_ROWW[r] = 0.f; } }
        }
        GRID_BARRIER();
        {   PHASE_VARS
        __attribute__((address_space(3))) int* tab = (__attribute__((address_space(3))) int*)(lds + 131072);
        moe_table(W_CNT, tab, tid);
        {   pg8::Gemm g{W_ASORT, W_WGU_T, MOE_ROWS_MAX, 32 * 512, DM}; pg8::MoeOrder S{G, bid, tab[64], 2, tab + 128};
            pg8::EpiSwiglu E{W_HS, W_ROWW};
            pg8::gemm_phase<pg8::EpiSwiglu, pg8::MoeOrder, true, true>((PG8_LAS unsigned char*)lds, g, S, E); }
        }
        GRID_BARRIER();
        {   PHASE_VARS
        __attribute__((address_space(3))) int* tab = (__attribute__((address_space(3))) int*)(lds + 131072);
        moe_table(W_CNT, tab, tid);
        {   pg8::Gemm g{W_HS, W_WD_T, MOE_ROWS_MAX, 32 * DM, 256}; pg8::MoeOrder S{G, bid, tab[64], 4, tab + 128};
            pg8::EpiScatterStore E{W_YMOE, W_ROWTOK};
            pg8::gemm_phase<pg8::EpiScatterStore, pg8::MoeOrder, true, true>((PG8_LAS unsigned char*)lds, g, S, E); }
        }
        GRID_BARRIER();
    };
    layer_body(IntC<0>{});
    layer_body(IntC<1>{});
    {   const int layer = DEPTH; PHASE_VARS
        for (int i = gt; i < MT * DM / 4; i += NGT) { const int row = i >> 8, c4 = i & 255;
            float4 v = ((const float4*)pq->out)[i];
            const float4 a = bf4_to_f4(((const uint2*)(W_YMOE + (size_t)row * 2 * DM))[c4]), b = bf4_to_f4(((const uint2*)(W_YMOE + ((size_t)row * 2 + 1) * DM))[c4]);
            v.x += a.x + b.x; v.y += a.y + b.y; v.z += a.z + b.z; v.w += a.w + b.w; ((float4*)pq->out)[i] = v; }
    }
}
}

extern "C" void kernel_launch(void* const* d_in, const int* in_sizes, int n_in, void* d_out, int out_size, void* d_ws, size_t ws_size, hipStream_t stream) {
    Params p{};
    p.x_in = (const float*)d_in[0]; p.norm_mix = (const float*)d_in[1]; p.norm_ffn = (const float*)d_in[2]; p.w_in = (const float*)d_in[3]; p.w_out = (const float*)d_in[4];
    p.diff_q_gain = (const float*)d_in[5]; p.diff_k_gain = (const float*)d_in[6]; p.diff_lambda = (const float*)d_in[7]; p.diff_sub_gain = (const float*)d_in[8];
    p.mlstm_conv = (const float*)d_in[9]; p.mlstm_gate_bias = (const float*)d_in[10]; p.mlstm_out_gain = (const float*)d_in[11]; p.hgrn_lb = (const float*)d_in[12];
    p.hgrn_out_gain = (const float*)d_in[13]; p.nsa_cmp_pos = (const float*)d_in[14]; p.nsa_cmp_w1 = (const float*)d_in[15]; p.nsa_cmp_w2 = (const float*)d_in[16];
    p.nsa_q_gain = (const float*)d_in[17]; p.nsa_k_gain = (const float*)d_in[18]; p.nsa_out_gain = (const float*)d_in[19];
    p.moe_w_group = (const float*)d_in[20]; p.moe_b_group = (const float*)d_in[21]; p.moe_w_expert = (const float*)d_in[22]; p.moe_b_expert = (const float*)d_in[23];
    p.moe_w_gate = (const float*)d_in[24]; p.moe_w_up = (const float*)d_in[25]; p.moe_w_down = (const float*)d_in[26];
    p.out = (float*)d_out;

    p.ws = (char*)d_ws;
    if (WS_END > ws_size) { fprintf(stderr, "kernel_launch: workspace too small: need %zu, have %zu\n", (size_t)WS_END, ws_size); return; }

    static int grid_blocks = 0;
    if (!grid_blocks) {
        int dev = 0, cus = 0, per_cu = 0;
        hipGetDevice(&dev);
        hipDeviceGetAttribute(&cus, hipDeviceAttributeMultiprocessorCount, dev);
        hipFuncSetAttribute((const void*)mega_fwd, hipFuncAttributeMaxDynamicSharedMemorySize, LDS_BYTES);
        hipOccupancyMaxActiveBlocksPerMultiprocessor(&per_cu, (const void*)mega_fwd, NTHR, LDS_BYTES);
        if (per_cu < 1) per_cu = 1;
        if (per_cu > 1) per_cu = 1;
        grid_blocks = cus * per_cu;
    }
    hipMemsetAsync((char*)d_ws + WS_BAR, 0, 16384, stream);
    void* args[] = {&p};
    hipError_t e = hipLaunchCooperativeKernel((const void*)mega_fwd, dim3(grid_blocks), dim3(NTHR), args, LDS_BYTES, stream);
    if (e != hipSuccess) fprintf(stderr, "cooperative launch failed: %s (grid %d)\n", hipGetErrorString(e), grid_blocks);
}
```

```cpp
#include <hip/hip_runtime.h>
#include <hip/hip_cooperative_groups.h>
#include <stdint.h>
#include <cstdio>
namespace cg = cooperative_groups;

namespace {
constexpr int DM = 1024, NB = 4, SEQ = 4096, DEPTH = 2, MT = NB * SEQ;
constexpr int IN_COLS = 3476, LDP = 3584;
constexpr float EPS = 1e-6f, NEG = -1e30f;
constexpr int PC_AQ = 0, PC_AK = 256, PC_AV = 512, PC_BQ = 768, PC_BK = 1024, PC_BV = 1280, PC_BO = 1536, PC_CQ = 1792, PC_CF = 2048,
              PC_CI = 2304, PC_CG = 2560, PC_DQ = 2816, PC_KC = 3072, PC_VC = 3136, PC_KS = 3200, PC_VS = 3264, PC_KW = 3328, PC_VW = 3392,
              PC_BI = 3456, PC_BF = 3460, PC_DG = 3464;
constexpr int NCMP = 255;
constexpr int NTHR = 512, NWAVE = 8;
constexpr int LDS_BYTES = 151552;

typedef unsigned short bf16_t;
__device__ __forceinline__ float bf2f(bf16_t v) { return __uint_as_float(((unsigned)v) << 16); }
__device__ __forceinline__ bf16_t f2bf(float f) { unsigned u = __float_as_uint(f); return (bf16_t)((u + 0x7fffu + ((u >> 16) & 1u)) >> 16); }
__device__ __forceinline__ unsigned pk2bf(float lo, float hi) { return (unsigned)f2bf(lo) | ((unsigned)f2bf(hi) << 16); }
__device__ __forceinline__ int src_col(int c) { return c < 1536 ? c : (c < 3456 ? c + 8 : (c < 3460 ? c - 3456 + 1536 : (c < 3464 ? c - 3460 + 1540 : c))); }
__device__ __forceinline__ float sigmoidf_(float x) { return 1.f / (1.f + __expf(-x)); }
__device__ __forceinline__ float siluf_(float x) { return x / (1.f + __expf(-x)); }
__device__ __forceinline__ float wave_sum(float v, int lane) {
#pragma unroll
    for (int o = 1; o < 64; o <<= 1) v += __int_as_float(__builtin_amdgcn_ds_bpermute((lane ^ o) << 2, __float_as_int(v)));
    return v;
}
__device__ __forceinline__ float rdlane(float v, int k) { return __int_as_float(__builtin_amdgcn_readlane(__float_as_int(v), k)); }

namespace pg8 {
#define PG8_LAS __attribute__((address_space(3)))
typedef unsigned short bf16_t;
typedef short bf16x8 __attribute__((ext_vector_type(8)));
typedef float f32x4 __attribute__((ext_vector_type(4)));
typedef unsigned u32x4 __attribute__((ext_vector_type(4)));
constexpr int BM = 256, BK = 64, HALF = 128, HTB = HALF * BK * 2  , STAGE_BYTES = 8 * HTB, NXCD = 8, WGM = 8;

__host__ __device__ __forceinline__ int lds_byte(int r, int c) { const int st = (r >> 4) * 2 + (c >> 5), rr = r & 15, cc = c & 31, ob = rr * 64 + cc * 2; return st * 1024 + (ob ^ (((ob >> 9) & 1) << 5)); }
__host__ __device__ __forceinline__ void stage_rc(int b, int& R, int& C) { const int st = b / 1024, sb = b % 1024, swz = sb ^ (((sb >> 9) & 1) << 5); R = (st >> 1) * 16 + swz / 64; C = (st & 1) * 32 + (swz % 64) / 2; }
__host__ __device__ __forceinline__ int perm32(int rho) { const int n = rho >> 4, i = rho & 15; return 8 * (i >> 2) + 4 * n + (i & 3); }

struct Unit { int pm, pn; };
struct Gemm { const bf16_t* A; const bf16_t* Bt; int M, N, K; };

struct StaticOrder {
    int nM, nN, nwg, G, c;
    __host__ __device__ void init(int M, int N, int G_, int c_) { nM = M / BM; nN = N / BM; nwg = nM * nN; G = G_; c = c_; }
    __host__ __device__ bool next(int i, Unit& u) const {
        const long L = (long)i * G + c; if (L >= nwg) return false;
        int wgid = (int)L; { const int q = nwg / NXCD, r = nwg % NXCD, xcd = wgid % NXCD, off = wgid / NXCD; wgid = (xcd < r ? xcd * (q + 1) : r * (q + 1) + (xcd - r) * q) + off; }
        const int nig = WGM * nN, gid = wgid / nig, fm = gid * WGM, gsz = (nM - fm) < WGM ? (nM - fm) : WGM;
        u.pm = fm + ((wgid % nig) % gsz); u.pn = (wgid % nig) / gsz; return true;
    }
    __device__ __forceinline__ void a_ready(const Unit&) const {}
    __device__ __forceinline__ void done(const Unit&) const {}
};

__device__ __forceinline__ unsigned cvt_pk_bf16(float lo, float hi) { unsigned r; asm volatile("v_cvt_pk_bf16_f32 %0, %1, %2" : "=v"(r) : "v"(lo), "v"(hi)); return r; }
template <int ACT  > struct EpiBf16 {
    static constexpr bool PERM = true, AFTER_DRAIN = false; static_assert(ACT == 0, "EpiBf16: only ACT 0 here");
    bf16_t* O; int ldc; const float* bias; int split_cols; size_t split_stride; float scale0;
    __device__ __forceinline__ void operator()(const f32x4 (&acc)[2][2][4][2], const Unit& u, int wr, int wc, int fr, int fq) const {
        const int row0 = u.pm * BM + wr * 64 + fr; int colt = u.pn * BM; bf16_t* base = O;
        float sc = 1.f; if (split_cols) { const int t = colt / split_cols; base += (size_t)t * split_stride; colt -= t * split_cols; if (t == 0) sc = scale0; }
        const int col0 = colt + wc * 32 + 8 * fq, bcol0 = u.pn * BM + wc * 32 + 8 * fq;
        f32x4 bv[2][2];
#pragma unroll
        for (int bj = 0; bj < 2; ++bj)
#pragma unroll
            for (int n = 0; n < 2; ++n) bv[bj][n] = bias ? *(const f32x4*)(bias + bcol0 + bj * HALF + 4 * n) : (f32x4){0.f, 0.f, 0.f, 0.f};
#pragma unroll
        for (int ai = 0; ai < 2; ++ai)
#pragma unroll
            for (int m = 0; m < 4; ++m) { bf16_t* rowp = base + (size_t)(row0 + ai * HALF + m * 16) * ldc + col0;
#pragma unroll
                for (int bj = 0; bj < 2; ++bj) { f32x4 v0 = acc[ai][bj][m][0] + bv[bj][0], v1 = acc[ai][bj][m][1] + bv[bj][1];
                    v0 = v0 * sc; v1 = v1 * sc; u32x4 w; w.x = cvt_pk_bf16(v0[0], v0[1]); w.y = cvt_pk_bf16(v0[2], v0[3]); w.z = cvt_pk_bf16(v1[0], v1[1]); w.w = cvt_pk_bf16(v1[2], v1[3]);
                    *(u32x4*)(rowp + bj * HALF) = w; } }
    }
};


struct EpiResF32 {
    static constexpr bool PERM = false, AFTER_DRAIN = false;
    const float* base; float* out; int ldc;
    __device__ __forceinline__ void operator()(const f32x4 (&acc)[2][2][4][2], const Unit& u, int wr, int wc, int fr, int fq) const {
        const int col0 = u.pn * BM + wc * 32 + 4 * fq;
#pragma unroll
        for (int ai = 0; ai < 2; ++ai)
#pragma unroll
            for (int m = 0; m < 4; ++m) { const size_t off = (size_t)(u.pm * BM + ai * HALF + wr * 64 + m * 16 + fr) * ldc + col0;
#pragma unroll
                for (int bj = 0; bj < 2; ++bj)
#pragma unroll
                    for (int n = 0; n < 2; ++n) { const f32x4 bs = *(const f32x4*)(base + off + bj * HALF + n * 16); *(f32x4*)(out + off + bj * HALF + n * 16) = bs + acc[ai][bj][m][n]; } }
    }
};

struct EpiSwiglu {
    static constexpr bool PERM = true, AFTER_DRAIN = false;
    bf16_t* H; const float* row_w;
    __device__ __forceinline__ void operator()(const f32x4 (&acc)[2][2][4][2], const Unit& u, int wr, int wc, int fr, int fq) const {
        const int row0 = u.pm * BM + wr * 64 + fr, col0 = (u.pn & 1) * HALF + wc * 32 + 8 * fq;
#pragma unroll
        for (int ai = 0; ai < 2; ++ai)
#pragma unroll
            for (int m = 0; m < 4; ++m) { const int row = row0 + ai * HALF + m * 16; const float w = row_w[row];
                float h[8];
#pragma unroll
                for (int n = 0; n < 2; ++n)
#pragma unroll
                    for (int i = 0; i < 4; ++i) { const float g = acc[ai][0][m][n][i], up = acc[ai][1][m][n][i]; h[n * 4 + i] = g / (1.f + __expf(-g)) * up * w; }
                u32x4 o; o.x = cvt_pk_bf16(h[0], h[1]); o.y = cvt_pk_bf16(h[2], h[3]); o.z = cvt_pk_bf16(h[4], h[5]); o.w = cvt_pk_bf16(h[6], h[7]);
                *(u32x4*)(H + (size_t)row * 256 + col0) = o; asm volatile("" ::: "memory"); }
    }
};
struct EpiScatterStore {
    static constexpr bool PERM = true, AFTER_DRAIN = false;
    bf16_t* Y; const int* row_tok;
    __device__ __forceinline__ void operator()(const f32x4 (&acc)[2][2][4][2], const Unit& u, int wr, int wc, int fr, int fq) const {
        const int col0 = (u.pn & 3) * BM + wc * 32 + 8 * fq;
#pragma unroll
        for (int ai = 0; ai < 2; ++ai)
#pragma unroll
            for (int m = 0; m < 4; ++m) { const int t2 = row_tok[u.pm * BM + ai * HALF + wr * 64 + m * 16 + fr];
                if (t2 >= 0) { const unsigned o = (unsigned)t2 * 1024u + (unsigned)col0;
#pragma unroll
                    for (int bj = 0; bj < 2; ++bj) { const f32x4 v0 = acc[ai][bj][m][0], v1 = acc[ai][bj][m][1];
                        u32x4 w; w.x = cvt_pk_bf16(v0[0], v0[1]); w.y = cvt_pk_bf16(v0[2], v0[3]); w.z = cvt_pk_bf16(v1[0], v1[1]); w.w = cvt_pk_bf16(v1[2], v1[3]);
                        *(u32x4*)(Y + (o + (unsigned)(bj * HALF))) = w; } }
                asm volatile("" ::: "memory"); }
    }
};
struct MoeOrder {
    int G, c, ntiles, nsub; const PG8_LAS int* tile_e;
    __device__ __forceinline__ bool next(int i, Unit& u) const {
        const int L = i * G + c; if (L >= ntiles * nsub) return false;
        const int T = L / nsub, j = L - T * nsub; u.pm = T; u.pn = tile_e[T] * nsub + j; return true;
    }
    __device__ __forceinline__ void a_ready(const Unit&) const {}
    __device__ __forceinline__ void done(const Unit&) const {}
};
template <class Epi, class Sched, bool ALIGN_EPI = false, bool SP2 = false>
__device__ __forceinline__ void gemm_phase(PG8_LAS unsigned char* lds, const Gemm g, const Sched& S, const Epi& E) {
    int tid_ = threadIdx.x; asm volatile("" : "+v"(tid_));
    const int tid = tid_, wid = __builtin_amdgcn_readfirstlane(tid >> 6), lane = tid & 63, wr = wid >> 2, wc = wid & 3, fr = lane & 15, fq = lane >> 4;
    const int K = g.K, nt = K / BK;
    unsigned voffA[2], voffB[2];
#pragma unroll
    for (int i = 0; i < 2; ++i) { int R, C; stage_rc(tid * 16 + i * 8192, R, C); const int Rb = Epi::PERM ? ((R & ~31) + perm32(R & 31)) : R;
        voffA[i] = (unsigned)(R * K + C) * 2u; voffB[i] = (unsigned)(Rb * K + C) * 2u; }
    const size_t kstep = (size_t)(BK * 2);
    const size_t hstep = (size_t)HALF * K * 2;
    const size_t tstep = 2 * hstep;
    const unsigned ldsw = (unsigned)wid * 1024u;
    const int aoff = lds_byte(wr * 64 + fr, fq * 8), boff = lds_byte(wc * 32 + fr, fq * 8);
#define PG8_SA(b, h) (((b) * 2 + (h)) * HTB)
#define PG8_SB(b, h) ((4 + (b) * 2 + (h)) * HTB)
#define PG8_STAGE(bufoff, gbase, voff) do { _Pragma("unroll") for (int _i = 0; _i < 2; ++_i) \
        __builtin_amdgcn_global_load_lds((const unsigned*)((const char*)(gbase) + (voff)[_i]), (PG8_LAS unsigned*)(lds + (bufoff) + ldsw + _i * 8192), 16, 0, 0); } while (0)
#define PG8_LDA(dst, b, h) do { _Pragma("unroll") for (int m = 0; m < 4; ++m) _Pragma("unroll") for (int k = 0; k < 2; ++k) dst[m][k] = *(const PG8_LAS bf16x8*)(lds + PG8_SA(b, h) + aoff + m * 2048 + k * 1024); } while (0)
#define PG8_LDB(dst, b, h) do { _Pragma("unroll") for (int n = 0; n < 2; ++n) _Pragma("unroll") for (int k = 0; k < 2; ++k) dst[n][k] = *(const PG8_LAS bf16x8*)(lds + PG8_SB(b, h) + boff + n * 2048 + k * 1024); } while (0)
#define PG8_MMA(ai, bj, At, Bt) do { __builtin_amdgcn_s_setprio(1); _Pragma("unroll") for (int m = 0; m < 4; ++m) _Pragma("unroll") for (int n = 0; n < 2; ++n) _Pragma("unroll") for (int k = 0; k < 2; ++k) \
        acc[ai][bj][m][n] = __builtin_amdgcn_mfma_f32_16x16x32_bf16(Bt[n][k], At[m][k], acc[ai][bj][m][n], 0, 0, 0); __builtin_amdgcn_s_setprio(0); } while (0)
#define PG8_WAIT_V(n) asm volatile("s_waitcnt vmcnt(" #n ")" ::: "memory")
#define PG8_WAIT_L(n) asm volatile("s_waitcnt lgkmcnt(" #n ")" ::: "memory")
#define PG8_BAR __builtin_amdgcn_s_barrier()
#define PG8_SCHED __builtin_amdgcn_sched_barrier(0)
    Unit cur, nxt; int ui = 0;
    if (!S.next(0, cur)) return;
    f32x4 acc[2][2][4][2];
#pragma unroll
    for (int a = 0; a < 2; ++a)
#pragma unroll
        for (int b = 0; b < 2; ++b)
#pragma unroll
            for (int m = 0; m < 4; ++m)
#pragma unroll
                for (int n = 0; n < 2; ++n) acc[a][b][m][n] = (f32x4){0.f, 0.f, 0.f, 0.f};
    bf16x8 At[4][2], B0[2][2], B1[2][2];
    const char* cA = (const char*)g.A + (size_t)cur.pm * tstep; const char* cB = (const char*)g.Bt + (size_t)cur.pn * tstep;
    S.a_ready(cur);
    if constexpr (SP2) {
        PG8_STAGE(PG8_SB(0, 0), cB, voffB); PG8_STAGE(PG8_SB(0, 1), cB + hstep, voffB); PG8_STAGE(PG8_SA(0, 0), cA, voffA); PG8_STAGE(PG8_SA(0, 1), cA + hstep, voffA);
        if (wr == 1) PG8_BAR;
        PG8_WAIT_V(2); PG8_BAR;
        PG8_STAGE(PG8_SB(1, 0), cB + kstep, voffB); PG8_STAGE(PG8_SA(1, 0), cA + kstep, voffA); PG8_STAGE(PG8_SB(1, 1), cB + hstep + kstep, voffB);
        PG8_WAIT_V(6); PG8_BAR;
    } else {
        PG8_STAGE(PG8_SB(0, 0), cB, voffB); PG8_STAGE(PG8_SA(0, 0), cA, voffA); PG8_STAGE(PG8_SB(0, 1), cB + hstep, voffB); PG8_STAGE(PG8_SA(0, 1), cA + hstep, voffA);
        if (wr == 1) PG8_BAR;
        PG8_WAIT_V(4); PG8_BAR;
        PG8_STAGE(PG8_SB(1, 0), cB + kstep, voffB); PG8_STAGE(PG8_SA(1, 0), cA + kstep, voffA); PG8_STAGE(PG8_SB(1, 1), cB + hstep + kstep, voffB);
        PG8_WAIT_V(6); PG8_BAR;
    }
    for (;;) {
        const bool has_next = S.next(ui + 1, nxt);
        const char* nA = has_next ? (const char*)g.A + (size_t)nxt.pm * tstep : cA; const char* nB = has_next ? (const char*)g.Bt + (size_t)nxt.pn * tstep : cB;
        for (int t = 0; t < nt; t += 2) {
            const bool last = (t == nt - 2);
            const char* a1 = cA + (size_t)(t + 1) * kstep;
            const char* a2 = last ? nA : cA + (size_t)(t + 2) * kstep; const char* b2 = last ? nB : cB + (size_t)(t + 2) * kstep;
            const char* a3 = a2 + kstep; const char* b3 = b2 + kstep;
            if (last && has_next) S.a_ready(nxt);
            if constexpr (SP2) {
            PG8_LDB(B0, 0, 0); PG8_LDB(B1, 0, 1); PG8_SCHED; PG8_LDA(At, 0, 0); PG8_STAGE(PG8_SA(1, 1), a1 + hstep, voffA);
            PG8_WAIT_V(8); PG8_WAIT_L(0); PG8_BAR; PG8_MMA(0, 0, At, B0); PG8_MMA(0, 1, At, B1); PG8_BAR; PG8_SCHED;
            PG8_LDA(At, 0, 1); PG8_STAGE(PG8_SB(0, 0), b2, voffB); PG8_STAGE(PG8_SB(0, 1), b2 + hstep, voffB); PG8_STAGE(PG8_SA(0, 0), a2, voffA);
            PG8_WAIT_V(8); PG8_WAIT_L(0); PG8_BAR; PG8_MMA(1, 0, At, B0); PG8_MMA(1, 1, At, B1); PG8_BAR; PG8_SCHED;
            PG8_LDB(B0, 1, 0); PG8_LDB(B1, 1, 1); PG8_SCHED; PG8_LDA(At, 1, 0); PG8_STAGE(PG8_SA(0, 1), a2 + hstep, voffA);
            PG8_WAIT_V(8); PG8_WAIT_L(0); PG8_BAR; PG8_MMA(0, 0, At, B0); PG8_MMA(0, 1, At, B1); PG8_BAR; PG8_SCHED;
            PG8_LDA(At, 1, 1); PG8_STAGE(PG8_SB(1, 0), b3, voffB); PG8_STAGE(PG8_SB(1, 1), b3 + hstep, voffB); PG8_STAGE(PG8_SA(1, 0), a3, voffA);
            PG8_WAIT_V(8); PG8_WAIT_L(0); PG8_BAR; PG8_MMA(1, 0, At, B0); PG8_MMA(1, 1, At, B1); PG8_BAR; PG8_SCHED;
            } else {
            PG8_LDB(B0, 0, 0); PG8_SCHED; PG8_LDA(At, 0, 0); PG8_STAGE(PG8_SA(1, 1), a1 + hstep, voffA);
            PG8_WAIT_L(8); PG8_BAR; PG8_WAIT_L(0); PG8_MMA(0, 0, At, B0); PG8_BAR; PG8_SCHED;
            PG8_LDB(B1, 0, 1); PG8_STAGE(PG8_SB(0, 0), b2, voffB);
            PG8_BAR; PG8_WAIT_L(0); PG8_MMA(0, 1, At, B1); PG8_BAR;
            PG8_LDA(At, 0, 1); PG8_STAGE(PG8_SA(0, 0), a2, voffA);
            PG8_BAR; PG8_WAIT_L(0); PG8_MMA(1, 0, At, B0); PG8_BAR; PG8_SCHED;
            PG8_STAGE(PG8_SB(0, 1), b2 + hstep, voffB);
            PG8_WAIT_V(6); PG8_BAR; PG8_MMA(1, 1, At, B1); PG8_BAR;
            PG8_LDB(B0, 1, 0); PG8_SCHED; PG8_LDA(At, 1, 0); PG8_STAGE(PG8_SA(0, 1), a2 + hstep, voffA);
            PG8_WAIT_L(8); PG8_BAR; PG8_WAIT_L(0); PG8_MMA(0, 0, At, B0); PG8_BAR; PG8_SCHED;
            PG8_LDB(B1, 1, 1); PG8_STAGE(PG8_SB(1, 0), b3, voffB);
            PG8_BAR; PG8_WAIT_L(0); PG8_MMA(0, 1, At, B1); PG8_BAR;
            PG8_LDA(At, 1, 1); PG8_STAGE(PG8_SA(1, 0), a3, voffA);
            PG8_BAR; PG8_WAIT_L(0); PG8_MMA(1, 0, At, B0); PG8_BAR; PG8_SCHED;
            PG8_STAGE(PG8_SB(1, 1), b3 + hstep, voffB);
            PG8_WAIT_V(6); PG8_BAR; PG8_MMA(1, 1, At, B1); PG8_BAR;
            }
        }
        if constexpr (ALIGN_EPI) { if (wr == 0) PG8_BAR; }
        if constexpr (!Epi::AFTER_DRAIN) {
            int t2 = threadIdx.x; asm volatile("" : "+v"(t2)); const int l2 = t2 & 63;
            E(acc, cur, wr, wc, l2 & 15, l2 >> 4); S.done(cur); }
        if (!has_next) break;
#pragma unroll
        for (int a = 0; a < 2; ++a)
#pragma unroll
            for (int b = 0; b < 2; ++b)
#pragma unroll
                for (int m = 0; m < 4; ++m)
#pragma unroll
                    for (int n = 0; n < 2; ++n) acc[a][b][m][n] = (f32x4){0.f, 0.f, 0.f, 0.f};
        cur = nxt; cA = nA; cB = nB; ++ui;
        if constexpr (ALIGN_EPI) { if (wr == 1) PG8_BAR; }
    }
    PG8_WAIT_V(0);
    if constexpr (!ALIGN_EPI) { if (wr == 0) PG8_BAR; }
    PG8_BAR;
    if constexpr (Epi::AFTER_DRAIN) { E.fused(acc, cur, wr, wc, fr, fq, lds, wid, lane); S.done(cur); }
#undef PG8_SA
#undef PG8_SB
#undef PG8_STAGE
#undef PG8_LDA
#undef PG8_LDB
#undef PG8_MMA
#undef PG8_WAIT_V
#undef PG8_WAIT_L
#undef PG8_BAR
#undef PG8_SCHED
}
}


namespace fa {
#define FA_LAS __attribute__((address_space(3)))
typedef short bf16x8 __attribute__((ext_vector_type(8)));
typedef float f32x16 __attribute__((ext_vector_type(16)));
typedef float f32x2_t __attribute__((ext_vector_type(2)));
typedef __bf16 bf16x2_t __attribute__((ext_vector_type(2)));
typedef unsigned u32x4 __attribute__((ext_vector_type(4)));
__device__ __forceinline__ unsigned cvtpk(float lo, float hi) { f32x2_t v = {lo, hi}; bf16x2_t b = __builtin_convertvector(v, bf16x2_t); return __builtin_bit_cast(unsigned, b); }
__device__ __forceinline__ float xhalf(float v, int lane) { return __int_as_float(__builtin_amdgcn_ds_bpermute((lane ^ 32) << 2, __float_as_int(v))); }
struct Tile { const bf16_t* kg; const bf16_t* vg; int key0; };
template <int KS, int KIND, class TileFn>
__device__ __forceinline__ void attn_unit(FA_LAS unsigned char* lds, int tid, int ntiles, const TileFn& tile_of, const bf16_t* qrow, int qpos, float slope2,
                                          unsigned long long selbits, float* orow, float& m_out, float& l_out) {
    constexpr int KBYTES = 2 * KS * 1024;
    constexpr float NEGF = -1e30f;
    const int lane = tid & 63, r32 = lane & 31, hi = lane >> 5;
    bf16x8 qf[KS];
#pragma unroll
    for (int ks = 0; ks < KS; ++ks) qf[ks] = *(const bf16x8*)(qrow + 16 * ks + 8 * hi);
    f32x16 o0, o1;
#pragma unroll
    for (int r = 0; r < 16; ++r) { o0[r] = 0.f; o1[r] = 0.f; }
    float m = NEGF, l = 0.f;
    const bool kload = tid * 16 < KBYTES;
    const int nv = KIND == 3 ? (qpos >= 31 ? ((qpos - 31) >> 4) + 1 : 0) : 0;
    Tile T = tile_of(0);
    {   u32x4 kreg = {0u, 0u, 0u, 0u};
        if (kload) kreg = *(const u32x4*)((const char*)T.kg + tid * 16);
        const u32x4 vreg = *(const u32x4*)((const char*)T.vg + tid * 16);
        if (kload) *(FA_LAS u32x4*)(lds + tid * 16) = kreg;
        *(FA_LAS u32x4*)(lds + 8192 + tid * 16) = vreg; }
    __syncthreads();
    for (int i = 0; i < ntiles; ++i) {
        const bool more = i + 1 < ntiles;
        Tile Tn = T; u32x4 kreg = {0u, 0u, 0u, 0u}, vreg = {0u, 0u, 0u, 0u};
        if (more) { Tn = tile_of(i + 1); if (kload) kreg = *(const u32x4*)((const char*)Tn.kg + tid * 16); vreg = *(const u32x4*)((const char*)Tn.vg + tid * 16); }
        const FA_LAS unsigned char* Kl = lds + (i & 1) * 16384; const FA_LAS unsigned char* Vl = Kl + 8192;
        const int key0 = T.key0;
        bool act, full; int lim; float base, slopek;
        if (KIND == 3) { lim = nv - 1 - key0 - 4 * hi; act = key0 < nv; full = key0 + 63 < nv;
                         slopek = slope2 * 16.f; base = slope2 * (float)(16 * (key0 + 4 * hi) + 31 - qpos); }
        else { lim = qpos - key0 - 4 * hi; act = key0 <= qpos; full = key0 + 63 <= qpos; slopek = slope2; base = slope2 * (float)(key0 + 4 * hi - qpos);
               if (KIND == 1) { const bool bit = (selbits >> (key0 >> 6)) & 1ull; act = act && bit; full = full && bit; if (!bit) lim = -100000; }
               if (KIND == 2) { act = act && (key0 + 63 > qpos - 512); full = full && (key0 > qpos - 512); } }
        if (__builtin_amdgcn_ballot_w64(act) != 0ull) {
            const bool allfull = __builtin_amdgcn_ballot_w64(full) == ~0ull;
            f32x16 s0, s1;
#pragma unroll
            for (int r = 0; r < 16; ++r) { s0[r] = 0.f; s1[r] = 0.f; }
#pragma unroll
            for (int ks = 0; ks < KS; ++ks) {
                const bf16x8 a0 = *(const FA_LAS bf16x8*)(Kl + (ks * 32 + r32) * 32 + hi * 16);
                const bf16x8 a1 = *(const FA_LAS bf16x8*)(Kl + ((KS + ks) * 32 + r32) * 32 + hi * 16);
                s0 = __builtin_amdgcn_mfma_f32_32x32x16_bf16(a0, qf[ks], s0, 0, 0, 0);
                s1 = __builtin_amdgcn_mfma_f32_32x32x16_bf16(a1, qf[ks], s1, 0, 0, 0);
            }
#pragma unroll
            for (int r = 0; r < 16; ++r) { const int c0 = (r & 3) + 8 * (r >> 2);
                s0[r] += __builtin_fmaf(slopek, (float)c0, base); s1[r] += __builtin_fmaf(slopek, (float)(c0 + 32), base); }
            if (!allfull) {
#pragma unroll
                for (int r = 0; r < 16; ++r) { const int c0 = (r & 3) + 8 * (r >> 2);
                    int p0 = min(lim - c0, 0), p1 = min(lim - c0 - 32, 0);
                    if (KIND == 2) { p0 += min(c0 - lim + 511, 0); p1 += min(c0 + 32 - lim + 511, 0); }
                    s0[r] = __builtin_fmaf((float)p0, 1e30f, s0[r]); s1[r] = __builtin_fmaf((float)p1, 1e30f, s1[r]); }
            }
            float mx = __builtin_fmaxf(s0[0], s1[0]);
#pragma unroll
            for (int r = 1; r < 16; ++r) mx = __builtin_fmaxf(mx, __builtin_fmaxf(s0[r], s1[r]));
            mx = __builtin_fmaxf(mx, xhalf(mx, lane));
            const float mn = __builtin_fmaxf(m, mx), alpha = __builtin_amdgcn_exp2f(m - mn);
            m = mn;
            float psum = 0.f;
#pragma unroll
            for (int r = 0; r < 16; ++r) { const float p0 = __builtin_amdgcn_exp2f(s0[r] - mn), p1 = __builtin_amdgcn_exp2f(s1[r] - mn);
                s0[r] = p0; s1[r] = p1; psum += p0 + p1; }
            l = l * alpha + psum;
            if (__builtin_amdgcn_ballot_w64(alpha != 1.f) != 0ull) {
#pragma unroll
                for (int r = 0; r < 16; ++r) { o0[r] *= alpha; o1[r] *= alpha; } }
#pragma unroll
            for (int kb = 0; kb < 2; ++kb)
#pragma unroll
                for (int sp = 0; sp < 2; ++sp) {
                    u32x4 pw;
                    if (kb == 0) { pw.x = cvtpk(s0[8 * sp + 0], s0[8 * sp + 1]); pw.y = cvtpk(s0[8 * sp + 2], s0[8 * sp + 3]); pw.z = cvtpk(s0[8 * sp + 4], s0[8 * sp + 5]); pw.w = cvtpk(s0[8 * sp + 6], s0[8 * sp + 7]); }
                    else         { pw.x = cvtpk(s1[8 * sp + 0], s1[8 * sp + 1]); pw.y = cvtpk(s1[8 * sp + 2], s1[8 * sp + 3]); pw.z = cvtpk(s1[8 * sp + 4], s1[8 * sp + 5]); pw.w = cvtpk(s1[8 * sp + 6], s1[8 * sp + 7]); }
                    const bf16x8 pf = __builtin_bit_cast(bf16x8, pw);
                    const bf16x8 v0 = *(const FA_LAS bf16x8*)(Vl + (((kb * 2 + sp) * 2 + 0) * 32 + r32) * 32 + hi * 16);
                    const bf16x8 v1 = *(const FA_LAS bf16x8*)(Vl + (((kb * 2 + sp) * 2 + 1) * 32 + r32) * 32 + hi * 16);
                    o0 = __builtin_amdgcn_mfma_f32_32x32x16_bf16(v0, pf, o0, 0, 0, 0);
                    o1 = __builtin_amdgcn_mfma_f32_32x32x16_bf16(v1, pf, o1, 0, 0, 0);
                }
        }
        if (more) { FA_LAS unsigned char* nb = lds + ((i + 1) & 1) * 16384;
            if (kload) *(FA_LAS u32x4*)(nb + tid * 16) = kreg;
            *(FA_LAS u32x4*)(nb + 8192 + tid * 16) = vreg; }
        __syncthreads();
        T = Tn;
    }
    const float lt = l + xhalf(l, lane);
    const bool rowvalid = KIND == 3 ? nv > 0 : true;
    const float il = rowvalid ? 1.f / lt : 0.f;
    m_out = m; l_out = lt;
#pragma unroll
    for (int g = 0; g < 4; ++g) {
        const int d = 8 * g + 4 * hi;
        *(float4*)(orow + d) = make_float4(o0[4 * g] * il, o0[4 * g + 1] * il, o0[4 * g + 2] * il, o0[4 * g + 3] * il);
        *(float4*)(orow + 32 + d) = make_float4(o1[4 * g] * il, o1[4 * g + 1] * il, o1[4 * g + 2] * il, o1[4 * g + 3] * il);
    }
}
}


namespace scan {
typedef short bf16x8 __attribute__((ext_vector_type(8)));
typedef float f32x16 __attribute__((ext_vector_type(16)));
__device__ __forceinline__ int spos(int s) { const int s16 = s & 15; return (s & ~15) + 8 * ((s16 >> 2) & 1) + (((s16 >> 3) << 2) | (s16 & 3)); }
__device__ __forceinline__ float xhalf(float v, int lane) { return __int_as_float(__builtin_amdgcn_ds_bpermute((lane ^ 32) << 2, __float_as_int(v))); }
constexpr size_t A8 = (size_t)MT * 256 * 2, SM = (size_t)1024 * 64 * 4;
template <int MIX> struct BufsT {
    char* r1; char* r2;
    static constexpr size_t R1OFF = MIX == 0 ? 0 : 6 * A8 + 5 * SM;
    __device__ __forceinline__ bf16_t* QA() const { return (bf16_t*)(r1 + R1OFF); }
    __device__ __forceinline__ bf16_t* KA() const { return (bf16_t*)(r1 + R1OFF + A8); }
    __device__ __forceinline__ bf16_t* KAT() const { return (bf16_t*)(r1 + R1OFF + 2 * A8); }
    __device__ __forceinline__ char* rest() const { return MIX == 0 ? r1 + 3 * A8 : r2; }
    __device__ __forceinline__ bf16_t* VT() const { return (bf16_t*)(rest()); }
    __device__ __forceinline__ bf16_t* Ub() const { return (bf16_t*)(rest() + A8); }
    __device__ __forceinline__ bf16_t* Sp() const { return (bf16_t*)(rest() + 2 * A8); }
    __device__ __forceinline__ float* Un() const { return (float*)(rest() + 3 * A8); }
    __device__ __forceinline__ float* np() const { return (float*)(rest() + 3 * A8 + SM); }
    __device__ __forceinline__ float* dL() const { return (float*)(rest() + 3 * A8 + 2 * SM); }
    __device__ __forceinline__ float* dmid() const { return (float*)(rest() + 3 * A8 + 3 * SM); }
    __device__ __forceinline__ float* dLm() const { return (float*)(rest() + 3 * A8 + 4 * SM); }
};

template <int MIX>
__device__ __forceinline__ void prep_k(const bf16_t* P, const float* convw, const float* gbias, const float* lbp, int layer, const BufsT<MIX>& B, int idx) {
    const int k = idx & 63, ci = idx >> 6, h = ci & 3, chunk = ci >> 2, c = chunk & 63;
    const size_t m0 = (size_t)chunk * 64;
    float lb = 0.f, bi = 0.f, bfz = 0.f;
    if (MIX == 1) { if (layer == 1) lb = sigmoidf_(lbp[256 + h * 64 + k] - lbp[h * 64 + k]); }
    else { bi = gbias[h]; bfz = gbias[4 + h]; }
    float bs = 0.f, bmid = 0.f;
    for (int s = 0; s < 64; ++s) {
        float lf;
        if (MIX == 1) { const float z = bf2f(P[(m0 + s) * LDP + PC_CF + h * 64 + k]); lf = __logf(lb + (1.f - lb) * sigmoidf_(z)); }
        else { const float x = bf2f(P[(m0 + s) * LDP + PC_BF + h]) + bfz; lf = -log1pf(__expf(-x)); }
        bs += lf; if (s == 31) bmid = bs;
    }
    const float bL = bs;
    bs = 0.f;
    for (int s = 0; s < 64; ++s) {
        const size_t m = m0 + s;
        float lf, qraw, kraw;
        if (MIX == 1) {
            const float z = bf2f(P[m * LDP + PC_CF + h * 64 + k]); const float f = lb + (1.f - lb) * sigmoidf_(z);
            lf = __logf(f); kraw = 1.f - f; qraw = siluf_(bf2f(P[m * LDP + PC_CQ + h * 64 + k]));
        } else {
            const float x = bf2f(P[m * LDP + PC_BF + h]) + bfz; lf = -log1pf(__expf(-x));
            float qv = 0.f, kv = 0.f; const int t = c * 64 + s;
#pragma unroll
            for (int j = 0; j < 4; ++j) { if (t - 3 + j >= 0) {
                qv += convw[j * 512 + h * 64 + k] * bf2f(P[(m - 3 + j) * LDP + PC_BQ + h * 64 + k]);
                kv += convw[j * 512 + 256 + h * 64 + k] * bf2f(P[(m - 3 + j) * LDP + PC_BK + h * 64 + k]); } }
            qraw = siluf_(qv) * 0.125f;
            kraw = siluf_(kv) * __expf(bf2f(P[m * LDP + PC_BI + h]) + bi);
        }
        bs += lf;
        const float qa = qraw * __expf(bs - bmid), ka = kraw * __expf(bmid - bs);
        const bf16_t kab = f2bf(ka);
        B.QA()[m * 256 + h * 64 + k] = f2bf(qa); B.KA()[m * 256 + h * 64 + k] = kab;
        B.KAT()[((size_t)ci * 64 + k) * 64 + spos(s)] = kab;
    }
    B.dL()[ci * 64 + k] = __expf(bL); B.dmid()[ci * 64 + k] = __expf(bmid); B.dLm()[ci * 64 + k] = __expf(bL - bmid);
}
__device__ __forceinline__ void prep_v(const bf16_t* P, int pcol, bf16_t* VT, int idx) {
    const int e = idx & 63, ci = idx >> 6, h = ci & 3; const size_t m0 = (size_t)(ci >> 2) * 64;
    for (int s = 0; s < 64; ++s) VT[((size_t)ci * 64 + e) * 64 + spos(s)] = P[(m0 + s) * LDP + pcol + h * 64 + e];
}
template <int MIX>
__device__ __forceinline__ void stepA(const BufsT<MIX>& B, int ci, int lane) {
    const int r32 = lane & 31, hi = lane >> 5;
    const bf16_t* vt = B.VT() + (size_t)ci * 4096; const bf16_t* kat = B.KAT() + (size_t)ci * 4096;
    f32x16 acc[2][2];
#pragma unroll
    for (int a = 0; a < 2; ++a)
#pragma unroll
        for (int b = 0; b < 2; ++b)
#pragma unroll
            for (int r = 0; r < 16; ++r) acc[a][b][r] = 0.f;
    float nsum[2] = {0.f, 0.f};
#pragma unroll
    for (int g = 0; g < 4; ++g) {
        bf16x8 a[2], bb[2];
#pragma unroll
        for (int et = 0; et < 2; ++et) a[et] = *(const bf16x8*)(vt + (32 * et + r32) * 64 + 16 * g + 8 * hi);
#pragma unroll
        for (int kt = 0; kt < 2; ++kt) { bb[kt] = *(const bf16x8*)(kat + (32 * kt + r32) * 64 + 16 * g + 8 * hi);
            if (MIX == 0) {
#pragma unroll
                for (int j = 0; j < 8; ++j) nsum[kt] += bf2f((bf16_t)bb[kt][j]); } }
#pragma unroll
        for (int et = 0; et < 2; ++et)
#pragma unroll
            for (int kt = 0; kt < 2; ++kt) acc[et][kt] = __builtin_amdgcn_mfma_f32_32x32x16_bf16(a[et], bb[kt], acc[et][kt], 0, 0, 0);
    }
#pragma unroll
    for (int kt = 0; kt < 2; ++kt) {
        const float dl = B.dLm()[ci * 64 + 32 * kt + r32];
#pragma unroll
        for (int et = 0; et < 2; ++et)
#pragma unroll
            for (int r = 0; r < 16; ++r) { const int e = 32 * et + (r & 3) + 8 * (r >> 2) + 4 * hi; B.Ub()[((size_t)ci * 64 + e) * 64 + 32 * kt + r32] = f2bf(acc[et][kt][r] * dl); }
        if (MIX == 0) { const float ns = nsum[kt] + xhalf(nsum[kt], lane); if (hi == 0) B.Un()[ci * 64 + 32 * kt + r32] = ns * dl; }
    }
}
template <int MIX>
__device__ __forceinline__ void stepB(const BufsT<MIX>& B, int idx) {
    const int k = idx & 63, e = (idx >> 6) % 65, bh = (idx >> 6) / 65, h = bh & 3, b = bh >> 2;
    if (MIX == 1 && e == 64) return;
    float S = 0.f;
    for (int c = 0; c < 64; ++c) {
        const int ci = (b * 64 + c) * 4 + h; const float dm = B.dmid()[ci * 64 + k], dl = B.dL()[ci * 64 + k];
        if (e < 64) { const size_t o = ((size_t)ci * 64 + e) * 64 + k; B.Sp()[o] = f2bf(S * dm); S = dl * S + bf2f(B.Ub()[o]); }
        else { B.np()[ci * 64 + k] = S * dm; S = dl * S + B.Un()[ci * 64 + k]; }
    }
}
template <int MIX>
__device__ __forceinline__ void stepC(const BufsT<MIX>& B, const bf16_t* P, int gatecol, const float* outg, bf16_t* mixed, int mixcol, int ci, int lane) {
    const int r32 = lane & 31, hi = lane >> 5, h = ci & 3; const size_t m0 = (size_t)(ci >> 2) * 64;
    const bf16_t* vt = B.VT() + (size_t)ci * 4096; const bf16_t* sp = B.Sp() + (size_t)ci * 4096;
#pragma unroll 1
    for (int tt = 0; tt < 2; ++tt) {
        bf16x8 qf[4];
#pragma unroll
        for (int ks = 0; ks < 4; ++ks) qf[ks] = *(const bf16x8*)(B.QA() + (m0 + 32 * tt + r32) * 256 + h * 64 + 16 * ks + 8 * hi);
        f32x16 o[2];
#pragma unroll
        for (int r = 0; r < 16; ++r) { o[0][r] = 0.f; o[1][r] = 0.f; }
        float den = 0.f;
        for (int st = 0; st <= tt; ++st) {
            f32x16 pt;
#pragma unroll
            for (int r = 0; r < 16; ++r) pt[r] = 0.f;
#pragma unroll
            for (int ks = 0; ks < 4; ++ks) { const bf16x8 kf = *(const bf16x8*)(B.KA() + (m0 + 32 * st + r32) * 256 + h * 64 + 16 * ks + 8 * hi);
                pt = __builtin_amdgcn_mfma_f32_32x32x16_bf16(kf, qf[ks], pt, 0, 0, 0); }
            if (st == tt) {
#pragma unroll
                for (int r = 0; r < 16; ++r) { const int sl = (r & 3) + 8 * (r >> 2) + 4 * hi; pt[r] = sl <= r32 ? pt[r] : 0.f; } }
            if (MIX == 0) {
#pragma unroll
                for (int r = 0; r < 16; ++r) den += pt[r]; }
#pragma unroll
            for (int s2 = 0; s2 < 2; ++s2) {
                fa::u32x4 pw; pw.x = fa::cvtpk(pt[8 * s2 + 0], pt[8 * s2 + 1]); pw.y = fa::cvtpk(pt[8 * s2 + 2], pt[8 * s2 + 3]); pw.z = fa::cvtpk(pt[8 * s2 + 4], pt[8 * s2 + 5]); pw.w = fa::cvtpk(pt[8 * s2 + 6], pt[8 * s2 + 7]);
                const bf16x8 pf = __builtin_bit_cast(bf16x8, pw);
#pragma unroll
                for (int et = 0; et < 2; ++et) { const bf16x8 vf = *(const bf16x8*)(vt + (32 * et + r32) * 64 + 32 * st + 16 * s2 + 8 * hi);
                    o[et] = __builtin_amdgcn_mfma_f32_32x32x16_bf16(vf, pf, o[et], 0, 0, 0); }
            }
        }
#pragma unroll
        for (int ks = 0; ks < 4; ++ks)
#pragma unroll
            for (int et = 0; et < 2; ++et) { const bf16x8 sf = *(const bf16x8*)(sp + (32 * et + r32) * 64 + 16 * ks + 8 * hi);
                o[et] = __builtin_amdgcn_mfma_f32_32x32x16_bf16(sf, qf[ks], o[et], 0, 0, 0); }
        if (MIX == 0) {
#pragma unroll
            for (int ks = 0; ks < 4; ++ks)
#pragma unroll
                for (int j = 0; j < 8; ++j) den += bf2f((bf16_t)qf[ks][j]) * B.np()[ci * 64 + 16 * ks + 8 * hi + j];
            den += xhalf(den, lane);
            const float sc = 1.f / __builtin_fmaxf(__builtin_fabsf(den), 1.f);
#pragma unroll
            for (int r = 0; r < 16; ++r) { o[0][r] *= sc; o[1][r] *= sc; }
        }
        float ss = 0.f;
#pragma unroll
        for (int r = 0; r < 16; ++r) ss += o[0][r] * o[0][r] + o[1][r] * o[1][r];
        ss += xhalf(ss, lane);
        const float rr = rsqrtf(ss * (1.f / 64) + EPS);
        const size_t m = m0 + 32 * tt + r32;
#pragma unroll
        for (int et = 0; et < 2; ++et)
#pragma unroll
            for (int g = 0; g < 4; ++g) {
                const int e = 32 * et + 8 * g + 4 * hi;
                const uint2 gt2 = *(const uint2*)(P + m * LDP + gatecol + h * 64 + e);
                const float4 og = *(const float4*)(outg + h * 64 + e);
                const float g0 = sigmoidf_(__uint_as_float(gt2.x << 16)), g1 = sigmoidf_(__uint_as_float(gt2.x & 0xffff0000u)),
                            g2 = sigmoidf_(__uint_as_float(gt2.y << 16)), g3 = sigmoidf_(__uint_as_float(gt2.y & 0xffff0000u));
                uint2 w; w.x = pk2bf(o[et][4 * g] * rr * og.x * g0, o[et][4 * g + 1] * rr * og.y * g1); w.y = pk2bf(o[et][4 * g + 2] * rr * og.z * g2, o[et][4 * g + 3] * rr * og.w * g3);
                *(uint2*)(mixed + m * DM + mixcol + h * 64 + e) = w;
            }
    }
}
}

template <int N> struct IntC { static constexpr int value = N; };
struct Params {
    const float* x_in; const float* norm_mix; const float* norm_ffn; const float* w_in; const float* w_out;
    const float* diff_q_gain; const float* diff_k_gain; const float* diff_lambda; const float* diff_sub_gain;
    const float* mlstm_conv; const float* mlstm_gate_bias; const float* mlstm_out_gain; const float* hgrn_lb; const float* hgrn_out_gain;
    const float* nsa_cmp_pos; const float* nsa_cmp_w1; const float* nsa_cmp_w2; const float* nsa_q_gain; const float* nsa_k_gain; const float* nsa_out_gain;
    const float* moe_w_group; const float* moe_b_group; const float* moe_w_expert; const float* moe_b_expert;
    const float* moe_w_gate; const float* moe_w_up; const float* moe_w_down;
    float* out; char* ws;
};


constexpr size_t al256(size_t x) { return (x + 255) & ~(size_t)255; }
constexpr size_t WS_P = 0;
constexpr size_t WS_TB = WS_P + al256((size_t)MT * LDP * 2);
constexpr size_t WS_MIXED = WS_TB + al256((size_t)MT * DM * 2);
constexpr size_t WS_DQ = WS_MIXED + al256((size_t)MT * DM * 2);
constexpr size_t WS_DK = WS_DQ + al256((size_t)MT * 256 * 4);
constexpr size_t WS_NQ = WS_DK + al256((size_t)MT * 256 * 4);
constexpr size_t WS_KSN = WS_NQ + al256((size_t)MT * 256 * 4);
constexpr size_t WS_KWN = WS_KSN + al256((size_t)MT * 64 * 4);
constexpr size_t WS_CMP = WS_KWN + al256((size_t)MT * 64 * 4);
constexpr size_t WS_OCMP = WS_CMP + al256((size_t)2 * NB * NCMP * 64 * 4);
constexpr size_t WS_IMP = WS_OCMP + al256((size_t)MT * 256 * 4);
constexpr size_t WS_SELMASK = WS_IMP + al256((size_t)MT * 64 * 4);
constexpr size_t WS_RE = WS_SELMASK + al256((size_t)MT * 8);
constexpr size_t WS_RW = WS_RE + al256((size_t)MT * 2 * 4);
constexpr size_t WS_RS = WS_RW + al256((size_t)MT * 2 * 4);
constexpr int MOE_ROWS_MAX = 2 * MT + 32 * 256;
constexpr size_t WS_ROWTOK = WS_RS + al256((size_t)MT * 2 * 4);
constexpr size_t WS_ROWW = WS_ROWTOK + al256((size_t)MOE_ROWS_MAX * 4);
constexpr size_t WS_CNT = WS_ROWW + al256((size_t)MOE_ROWS_MAX * 4);
constexpr size_t WS_BAR = WS_CNT + 256;
constexpr size_t WS_WIN_T = WS_BAR + 16384;
constexpr size_t WS_WOUT_T = WS_WIN_T + al256((size_t)LDP * DM * 2);
constexpr size_t WS_W1T = WS_WOUT_T + al256((size_t)DM * DM * 2);
constexpr size_t WS_END = WS_W1T + al256((size_t)2 * 64 * 2048 * 2);
static_assert((size_t)32 * 512 * DM * 2 + (size_t)32 * DM * 256 * 2 + (size_t)MOE_ROWS_MAX * 256 * 2 <= WS_TB, "MoE weight copies + H overlay P");
static_assert(WS_MIXED + (size_t)MOE_ROWS_MAX * DM * 2 <= WS_SELMASK, "sorted activations overlay mixed..imp");
#define W_P ((bf16_t*)(pq->ws + WS_P))
#define W_TB ((bf16_t*)(pq->ws + WS_TB))
#define W_MIXED ((bf16_t*)(pq->ws + WS_MIXED))
#define W_DQ ((float*)(pq->ws + WS_DQ))
#define W_DK ((float*)(pq->ws + WS_DK))
#define W_QBF ((bf16_t*)(pq->ws + WS_DQ))
#define W_DKF ((bf16_t*)(pq->ws + WS_DK))
#define W_DVF ((bf16_t*)(pq->ws + WS_DK + (size_t)MT * 256 * 2))
#define W_DO ((float*)(pq->ws + WS_TB))
#define W_NQ ((float*)(pq->ws + WS_NQ))
#define W_NQB ((bf16_t*)(pq->ws + WS_NQ))
#define W_KSF ((bf16_t*)(pq->ws + WS_KSN))
#define W_VSF ((bf16_t*)(pq->ws + WS_KSN + (size_t)MT * 64 * 2))
#define W_KWF ((bf16_t*)(pq->ws + WS_KWN))
#define W_VWF ((bf16_t*)(pq->ws + WS_KWN + (size_t)MT * 64 * 2))
#define W_KCF ((bf16_t*)(pq->ws + WS_CMP))
#define W_VCF ((bf16_t*)(pq->ws + WS_CMP + 131072))
#define W_QUEUE ((unsigned*)(pq->ws + WS_BAR + 14336))
#define W_KSN ((float*)(pq->ws + WS_KSN))
#define W_KWN ((float*)(pq->ws + WS_KWN))
#define W_CMP ((float*)(pq->ws + WS_CMP))
#define W_OCMP ((float*)(pq->ws + WS_OCMP))
#define W_IMP ((float*)(pq->ws + WS_IMP))
#define W_OSEL W_DQ
#define W_OWIN W_DK
#define W_SELMASK ((unsigned long long*)(pq->ws + WS_SELMASK))
#define W_RE ((int*)(pq->ws + WS_RE))
#define W_RW ((float*)(pq->ws + WS_RW))
#define W_RS ((int*)(pq->ws + WS_RS))
#define W_ROWTOK ((int*)(pq->ws + WS_ROWTOK))
#define W_ROWW ((float*)(pq->ws + WS_ROWW))
#define W_CNT ((int*)(pq->ws + WS_CNT))
#define W_WGU_T ((bf16_t*)(pq->ws + WS_P))
#define W_WD_T ((bf16_t*)(pq->ws + WS_P + (size_t)32 * 512 * DM * 2))
#define W_HS ((bf16_t*)(pq->ws + WS_P + (size_t)32 * 512 * DM * 2 + (size_t)32 * DM * 256 * 2))
#define W_ASORT ((bf16_t*)(pq->ws + WS_MIXED))
#define W_YMOE ((bf16_t*)(pq->ws + WS_MIXED))

#define SCAN_BUFS(Bm, Bh) scan::BufsT<0> Bm{pq->ws + WS_DQ, pq->ws + WS_TB}; scan::BufsT<1> Bh{pq->ws + WS_DQ, pq->ws + WS_TB};
static_assert(WS_DQ + (size_t)9 * MT * 256 * 2 + (size_t)5 * 1024 * 64 * 4 <= WS_SELMASK, "scan overlay 1");
static_assert((size_t)3 * MT * 256 * 2 + (size_t)5 * 1024 * 64 * 4 <= (size_t)MT * DM * 2, "scan overlay 2");
#define W_WIN_T ((bf16_t*)(pq->ws + WS_WIN_T))
#define W_WOUT_T ((bf16_t*)(pq->ws + WS_WOUT_T))
#define W_W1T ((bf16_t*)(pq->ws + WS_W1T))

__device__ __forceinline__ float4 bf4_to_f4(uint2 u) { return make_float4(__uint_as_float(u.x << 16), __uint_as_float(u.x & 0xffff0000u), __uint_as_float(u.y << 16), __uint_as_float(u.y & 0xffff0000u)); }
__device__ __forceinline__ void norm_row(float* x, const float* xsrc, const bf16_t* ymoe, const float* gain, bf16_t* t, int row, int lane) {
    const float4* xr = (const float4*)(xsrc + (size_t)row * DM);
    float4 v[4]; float s = 0.f;
#pragma unroll
    for (int j = 0; j < 4; ++j) { v[j] = xr[lane + 64 * j];
        if (ymoe) { const float4 a = bf4_to_f4(((const uint2*)(ymoe + (size_t)row * 2 * DM))[lane + 64 * j]), b = bf4_to_f4(((const uint2*)(ymoe + ((size_t)row * 2 + 1) * DM))[lane + 64 * j]);
            v[j].x += a.x + b.x; v[j].y += a.y + b.y; v[j].z += a.z + b.z; v[j].w += a.w + b.w; ((float4*)(x + (size_t)row * DM))[lane + 64 * j] = v[j]; }
        s += v[j].x * v[j].x + v[j].y * v[j].y + v[j].z * v[j].z + v[j].w * v[j].w; }
    const float r = rsqrtf(wave_sum(s, lane) * (1.f / DM) + EPS);
#pragma unroll
    for (int j = 0; j < 4; ++j) {
        const float4 g = ((const float4*)gain)[lane + 64 * j];
        ushort4 o; o.x = f2bf(v[j].x * r * g.x); o.y = f2bf(v[j].y * r * g.y); o.z = f2bf(v[j].z * r * g.z); o.w = f2bf(v[j].w * r * g.w);
        ((ushort4*)(t + (size_t)row * DM))[lane + 64 * j] = o;
    }
}


typedef __attribute__((address_space(3))) float lds_f32;
typedef unsigned v4u_t __attribute__((ext_vector_type(4)));
template <bool MAP>
__device__ __forceinline__ void transpose_item(const float* W, int K, int Nsrc, int Nnew, bf16_t* WT, lds_f32* scr, int item, int lane) {
    const int nblk = Nnew / 32, kb = item / nblk, nb = item % nblk, k0 = 64 * kb, n0 = 32 * nb;
    const int n = n0 + (lane & 31); const int sc = MAP ? src_col(n) : n; const bool ok = MAP ? (n < IN_COLS) : true;
#pragma unroll 8
    for (int i = 0; i < 32; ++i) { const int kk = 2 * i + (lane >> 5); scr[kk * 33 + (lane & 31)] = ok ? W[(size_t)(k0 + kk) * Nsrc + sc] : 0.f; }
    asm volatile("s_waitcnt lgkmcnt(0)" ::: "memory");
    const int c = lane & 7;
#pragma unroll
    for (int j = 0; j < 4; ++j) { const int nn = (lane >> 3) + 8 * j; const lds_f32* sp = scr + (8 * c) * 33 + nn;
        v4u_t o; o.x = pk2bf(sp[0 * 33], sp[1 * 33]); o.y = pk2bf(sp[2 * 33], sp[3 * 33]); o.z = pk2bf(sp[4 * 33], sp[5 * 33]); o.w = pk2bf(sp[6 * 33], sp[7 * 33]);
        *(v4u_t*)(WT + (size_t)(n0 + nn) * K + k0 + 8 * c) = o; }
    asm volatile("s_waitcnt lgkmcnt(0)" ::: "memory");
}

constexpr float LOG2E = 1.4426950408889634f;
__device__ __forceinline__ void diff_prep_qk(const bf16_t* P, const float* qgain, const float* kgain, bf16_t* Qbf, bf16_t* Kf, int idx) {
    const int m = idx >> 3, g = idx & 7;
    {   const uint4* p = (const uint4*)(P + (size_t)m * LDP + PC_AQ + g * 32); float v[32]; float ss = 0.f;
#pragma unroll
        for (int i = 0; i < 4; ++i) { const uint4 u = p[i]; const unsigned w[4] = {u.x, u.y, u.z, u.w};
#pragma unroll
            for (int j = 0; j < 4; ++j) { v[i * 8 + 2 * j] = __uint_as_float(w[j] << 16); v[i * 8 + 2 * j + 1] = __uint_as_float(w[j] & 0xffff0000u); } }
#pragma unroll
        for (int d = 0; d < 32; ++d) ss += v[d] * v[d];
        const float r = rsqrtf(ss * (1.f / 32) + EPS) * (0.17677669529663687f * LOG2E);
        uint4* o = (uint4*)(Qbf + (size_t)m * 256 + g * 32);
#pragma unroll
        for (int i = 0; i < 4; ++i) { uint4 u; u.x = pk2bf(v[i * 8 + 0] * r * qgain[i * 8 + 0], v[i * 8 + 1] * r * qgain[i * 8 + 1]); u.y = pk2bf(v[i * 8 + 2] * r * qgain[i * 8 + 2], v[i * 8 + 3] * r * qgain[i * 8 + 3]);
            u.z = pk2bf(v[i * 8 + 4] * r * qgain[i * 8 + 4], v[i * 8 + 5] * r * qgain[i * 8 + 5]); u.w = pk2bf(v[i * 8 + 6] * r * qgain[i * 8 + 6], v[i * 8 + 7] * r * qgain[i * 8 + 7]); o[i] = u; } }
    {   const uint4* p = (const uint4*)(P + (size_t)m * LDP + PC_AK + g * 32); float v[32]; float ss = 0.f;
#pragma unroll
        for (int i = 0; i < 4; ++i) { const uint4 u = p[i]; const unsigned w[4] = {u.x, u.y, u.z, u.w};
#pragma unroll
            for (int j = 0; j < 4; ++j) { v[i * 8 + 2 * j] = __uint_as_float(w[j] << 16); v[i * 8 + 2 * j + 1] = __uint_as_float(w[j] & 0xffff0000u); } }
#pragma unroll
        for (int d = 0; d < 32; ++d) ss += v[d] * v[d];
        const float r = rsqrtf(ss * (1.f / 32) + EPS);
        const int b = m / SEQ, t = m % SEQ, tile = t >> 6, kb = (t >> 5) & 1, rr = t & 31;
#pragma unroll
        for (int i = 0; i < 4; ++i) { uint4 u; u.x = pk2bf(v[i * 8 + 0] * r * kgain[i * 8 + 0], v[i * 8 + 1] * r * kgain[i * 8 + 1]); u.y = pk2bf(v[i * 8 + 2] * r * kgain[i * 8 + 2], v[i * 8 + 3] * r * kgain[i * 8 + 3]);
            u.z = pk2bf(v[i * 8 + 4] * r * kgain[i * 8 + 4], v[i * 8 + 5] * r * kgain[i * 8 + 5]); u.w = pk2bf(v[i * 8 + 6] * r * kgain[i * 8 + 6], v[i * 8 + 7] * r * kgain[i * 8 + 7]);
            const int ks = i >> 1, hh = i & 1;
            *(uint4*)(Kf + ((((((size_t)(b * 8 + g) * 64 + tile) * 2 + kb) * 2 + ks) * 32 + rr) * 2 + hh) * 8) = u; } }
}
__device__ __forceinline__ void vfrag_item(const bf16_t* P, int pcol, int hstride, int nheads, bf16_t* Vf, int idx) {
    const int hh = idx & 1, d32 = (idx >> 1) & 31, dblk = (idx >> 6) & 1, sp = (idx >> 7) & 1, kb = (idx >> 8) & 1, tile = (idx >> 9) & 63;
    const int bh = idx >> 15, h = bh % nheads, b = bh / nheads;
    const int key0 = 64 * tile + 32 * kb + 16 * sp + 4 * hh, col = pcol + h * hstride + dblk * 32 + d32;
    unsigned short e[8];
#pragma unroll
    for (int j = 0; j < 8; ++j) e[j] = P[(size_t)(b * SEQ + key0 + 8 * (j >> 2) + (j & 3)) * LDP + col];
    uint4 u; u.x = e[0] | ((unsigned)e[1] << 16); u.y = e[2] | ((unsigned)e[3] << 16); u.z = e[4] | ((unsigned)e[5] << 16); u.w = e[6] | ((unsigned)e[7] << 16);
    *(uint4*)(Vf + (size_t)idx * 8) = u;
}

__device__ __forceinline__ void diff_combine_item(const float* O, const float* lamv, const float* subg, float lam_init, bf16_t* mixed, int idx) {
    const int m = idx >> 2, h = idx & 3;
    float d01 = 0.f, d23 = 0.f;
    for (int i = 0; i < 32; ++i) { d01 += lamv[i] * lamv[32 + i]; d23 += lamv[64 + i] * lamv[96 + i]; }
    const float lam = __expf(d01) - __expf(d23) + lam_init;
    const float* o0 = O + ((size_t)m * 8 + h * 2) * 64; const float* o1 = o0 + 64;
    float v[64]; float s = 0.f;
#pragma unroll
    for (int e = 0; e < 64; ++e) { v[e] = o0[e] - lam * o1[e]; s += v[e] * v[e]; }
    const float r = rsqrtf(s * (1.f / 64) + EPS) * (1.f - lam_init);
#pragma unroll
    for (int e = 0; e < 64; ++e) mixed[(size_t)m * DM + h * 64 + e] = f2bf(v[e] * r * subg[h * 64 + e]);
}

__device__ __forceinline__ int kcf_off(int n, int d);
__device__ __forceinline__ int vcf_off(int n, int d);
__device__ __forceinline__ void nsa_compress_unit(FA_LAS unsigned char* lds, int tid, const bf16_t* P, const float* pos, const bf16_t* W1T, const float* w2, const float* kgain0, float* cmp, int item) {
    const int lane = tid & 63, wave = tid >> 6, r32 = lane & 31, hi = lane >> 5, j = item >> 5, rt = item & 31;
    const int pc = j == 0 ? PC_KC : PC_VC;
    {   const int R = min(rt * 32 + r32, NB * NCMP - 1), b = R / NCMP, n = R % NCMP;
        fa::f32x16 acc0, acc1;
#pragma unroll
        for (int r = 0; r < 16; ++r) { acc0[r] = 0.f; acc1[r] = 0.f; }
        const bf16_t* arow = P + (size_t)(b * SEQ + 16 * n) * LDP + pc;
#pragma unroll 4
        for (int ksl = 0; ksl < 16; ++ksl) {
            const int kbase = (wave * 16 + ksl) * 16 + 8 * hi, l = kbase >> 6, d = kbase & 63;
            const uint4 raw = *(const uint4*)(arow + (size_t)l * LDP + d);
            const float4 p0 = *(const float4*)(pos + (j * 32 + l) * 64 + d), p1 = *(const float4*)(pos + (j * 32 + l) * 64 + d + 4);
            fa::u32x4 aw;
            aw.x = pk2bf(__uint_as_float(raw.x << 16) + p0.x, __uint_as_float(raw.x & 0xffff0000u) + p0.y); aw.y = pk2bf(__uint_as_float(raw.y << 16) + p0.z, __uint_as_float(raw.y & 0xffff0000u) + p0.w);
            aw.z = pk2bf(__uint_as_float(raw.z << 16) + p1.x, __uint_as_float(raw.z & 0xffff0000u) + p1.y); aw.w = pk2bf(__uint_as_float(raw.w << 16) + p1.z, __uint_as_float(raw.w & 0xffff0000u) + p1.w);
            const fa::bf16x8 af = __builtin_bit_cast(fa::bf16x8, aw);
            const fa::bf16x8 b0 = *(const fa::bf16x8*)(W1T + (size_t)(j * 64 + r32) * 2048 + kbase), b1 = *(const fa::bf16x8*)(W1T + (size_t)(j * 64 + 32 + r32) * 2048 + kbase);
            acc0 = __builtin_amdgcn_mfma_f32_32x32x16_bf16(af, b0, acc0, 0, 0, 0);
            acc1 = __builtin_amdgcn_mfma_f32_32x32x16_bf16(af, b1, acc1, 0, 0, 0);
        }
        FA_LAS float* part = (FA_LAS float*)lds;
#pragma unroll
        for (int r = 0; r < 16; ++r) { const int row = (r & 3) + 8 * (r >> 2) + 4 * hi; part[(wave * 32 + row) * 64 + r32] = acc0[r]; part[(wave * 32 + row) * 64 + 32 + r32] = acc1[r]; }
    }
    __syncthreads();
    const int row = tid >> 4, c4 = (tid & 15) * 4;
    FA_LAS float* hidl = (FA_LAS float*)(lds + 65536);
    {   const FA_LAS float* part = (const FA_LAS float*)lds;
#pragma unroll
        for (int i = 0; i < 4; ++i) { float x = 0.f;
#pragma unroll
            for (int w = 0; w < 8; ++w) x += part[(w * 32 + row) * 64 + c4 + i];
            const float u = 0.7978845608028654f * (x + 0.044715f * x * x * x), th = 1.f - 2.f / (1.f + __expf(2.f * u));
            hidl[row * 64 + c4 + i] = 0.5f * x * (1.f + th); }
    }
    __syncthreads();
    float y[4] = {0.f, 0.f, 0.f, 0.f};
    for (int k = 0; k < 64; ++k) { const float hv = hidl[row * 64 + k]; const float4 w = *(const float4*)(w2 + (j * 64 + k) * 64 + c4);
        y[0] += hv * w.x; y[1] += hv * w.y; y[2] += hv * w.z; y[3] += hv * w.w; }
    if (j == 0) { float ss = y[0] * y[0] + y[1] * y[1] + y[2] * y[2] + y[3] * y[3];
#pragma unroll
        for (int o = 1; o < 16; o <<= 1) ss += __int_as_float(__builtin_amdgcn_ds_bpermute((lane ^ o) << 2, __float_as_int(ss)));
        const float r = rsqrtf(ss * (1.f / 64) + EPS);
#pragma unroll
        for (int i = 0; i < 4; ++i) y[i] = y[i] * r * kgain0[c4 + i]; }
    const int R = rt * 32 + row;
    if (R < NB * NCMP) { const int b = R / NCMP, n = R % NCMP;
        bf16_t* dst = (bf16_t*)cmp + (size_t)j * 65536 + (size_t)b * 4 * 4096;
#pragma unroll
        for (int i = 0; i < 4; ++i) { if (j == 0) dst[kcf_off(n, c4 + i)] = f2bf(y[i]); else dst[vcf_off(n, c4 + i)] = f2bf(y[i]);
            if (n == NCMP - 1) { if (j == 0) dst[kcf_off(NCMP, c4 + i)] = 0; else dst[vcf_off(NCMP, c4 + i)] = 0; } } }
    __syncthreads();
}
__device__ __forceinline__ void nsa_combine_item(const bf16_t* P, const float* ocmp, const float* osel, const float* owin, const float* outg, bf16_t* mixed, int idx) {
    const int m = idx >> 2, h = idx & 3;
    const float g0 = sigmoidf_(bf2f(P[(size_t)m * LDP + PC_DG + h * 3 + 0])), g1 = sigmoidf_(bf2f(P[(size_t)m * LDP + PC_DG + h * 3 + 1])),
                g2 = sigmoidf_(bf2f(P[(size_t)m * LDP + PC_DG + h * 3 + 2]));
    const size_t base = ((size_t)m * 4 + h) * 64;
    float v[64]; float s = 0.f;
#pragma unroll
    for (int d = 0; d < 64; ++d) { v[d] = g0 * ocmp[base + d] + g1 * osel[base + d] + g2 * owin[base + d]; s += v[d] * v[d]; }
    const float r = rsqrtf(s * (1.f / 64) + EPS);
#pragma unroll
    for (int d = 0; d < 64; ++d) mixed[(size_t)m * DM + 768 + h * 64 + d] = f2bf(v[d] * r * outg[h * 64 + d]);
}

__device__ __forceinline__ void moe_route_row(const float* x, const float* gain, const FA_LAS float* wl  , const float* bg, const float* be, bf16_t* t, int* re, float* rw, int* rs, int* cnt,
                                              int row, int lane) {
    const float4* xr = (const float4*)(x + (size_t)row * DM);
    float4 v[4]; float s = 0.f;
#pragma unroll
    for (int j = 0; j < 4; ++j) { v[j] = xr[lane + 64 * j]; s += v[j].x * v[j].x + v[j].y * v[j].y + v[j].z * v[j].z + v[j].w * v[j].w; }
    const float r = rsqrtf(wave_sum(s, lane) * (1.f / DM) + EPS);
    float lg[36];
#pragma unroll
    for (int o = 0; o < 36; ++o) lg[o] = 0.f;
#pragma unroll
    for (int j = 0; j < 4; ++j) {
        const float4 g = ((const float4*)gain)[lane + 64 * j];
        float tn[4] = {v[j].x * r * g.x, v[j].y * r * g.y, v[j].z * r * g.z, v[j].w * r * g.w};
        ushort4 o4; o4.x = f2bf(tn[0]); o4.y = f2bf(tn[1]); o4.z = f2bf(tn[2]); o4.w = f2bf(tn[3]);
        ((ushort4*)(t + (size_t)row * DM))[lane + 64 * j] = o4;
#pragma unroll
        for (int i = 0; i < 4; ++i) {
            const int k = (lane + 64 * j) * 4 + i;
            typedef float f32x4v __attribute__((ext_vector_type(4)));
            const FA_LAS f32x4v* wr = (const FA_LAS f32x4v*)(wl + k * 36);
            const f32x4v w4 = wr[0];
            lg[0] += tn[i] * w4.x; lg[1] += tn[i] * w4.y; lg[2] += tn[i] * w4.z; lg[3] += tn[i] * w4.w;
#pragma unroll
            for (int e4 = 0; e4 < 8; ++e4) { const f32x4v w = wr[1 + e4];
                lg[4 + e4 * 4 + 0] += tn[i] * w.x; lg[4 + e4 * 4 + 1] += tn[i] * w.y; lg[4 + e4 * 4 + 2] += tn[i] * w.z; lg[4 + e4 * 4 + 3] += tn[i] * w.w; }
            asm volatile("" ::: "memory");
        }
    }
#pragma unroll
    for (int o = 0; o < 36; ++o) lg[o] = wave_sum(lg[o], lane);
    float gl[4]; float gmx = NEG; int gs = 0;
#pragma unroll
    for (int g = 0; g < 4; ++g) { gl[g] = lg[g] + bg[g]; if (gl[g] > gmx) { gmx = gl[g]; gs = g; } }
    float gz = 0.f;
#pragma unroll
    for (int g = 0; g < 4; ++g) gz += __expf(gl[g] - gmx);
    const float gprob = 1.f / gz;
    float el[8];
#pragma unroll
    for (int e = 0; e < 8; ++e) {
        const float a0 = lg[4 + e] + be[e], a1 = lg[12 + e] + be[8 + e], a2 = lg[20 + e] + be[16 + e], a3 = lg[28 + e] + be[24 + e];
        el[e] = gs == 0 ? a0 : (gs == 1 ? a1 : (gs == 2 ? a2 : a3));
    }
    float m1 = NEG; int i1 = 0;
#pragma unroll
    for (int e = 0; e < 8; ++e) if (el[e] > m1) { m1 = el[e]; i1 = e; }
    float m2 = NEG; int i2 = 0;
#pragma unroll
    for (int e = 0; e < 8; ++e) if (e != i1 && el[e] > m2) { m2 = el[e]; i2 = e; }
    const float p2 = __expf(m2 - m1);
    const float w1 = gprob / (1.f + p2), w2 = gprob * p2 / (1.f + p2);
    if (lane == 0) { const int e1 = gs * 8 + i1, e2 = gs * 8 + i2;
        re[row * 2] = e1; re[row * 2 + 1] = e2; rw[row * 2] = w1; rw[row * 2 + 1] = w2;
        rs[row * 2] = atomicAdd(cnt + e1, 1); rs[row * 2 + 1] = atomicAdd(cnt + e2, 1); }
}

__device__ __forceinline__ void nsa_prep_q(const bf16_t* P, const float* qgain, bf16_t* Qn, int idx) {
    const int m = idx >> 2, h = idx & 3;
    const uint4* p = (const uint4*)(P + (size_t)m * LDP + PC_DQ + h * 64); float v[64]; float ss = 0.f;
#pragma unroll
    for (int i = 0; i < 8; ++i) { const uint4 u = p[i]; const unsigned w[4] = {u.x, u.y, u.z, u.w};
#pragma unroll
        for (int j = 0; j < 4; ++j) { v[i * 8 + 2 * j] = __uint_as_float(w[j] << 16); v[i * 8 + 2 * j + 1] = __uint_as_float(w[j] & 0xffff0000u); } }
#pragma unroll
    for (int d = 0; d < 64; ++d) ss += v[d] * v[d];
    const float r = rsqrtf(ss * (1.f / 64) + EPS) * (0.125f * LOG2E);
    uint4* o = (uint4*)(Qn + (size_t)m * 256 + h * 64);
#pragma unroll
    for (int i = 0; i < 8; ++i) { uint4 u; u.x = pk2bf(v[i * 8 + 0] * r * qgain[i * 8 + 0], v[i * 8 + 1] * r * qgain[i * 8 + 1]); u.y = pk2bf(v[i * 8 + 2] * r * qgain[i * 8 + 2], v[i * 8 + 3] * r * qgain[i * 8 + 3]);
        u.z = pk2bf(v[i * 8 + 4] * r * qgain[i * 8 + 4], v[i * 8 + 5] * r * qgain[i * 8 + 5]); u.w = pk2bf(v[i * 8 + 6] * r * qgain[i * 8 + 6], v[i * 8 + 7] * r * qgain[i * 8 + 7]); o[i] = u; }
}
__device__ __forceinline__ void nsa_prep_k(const bf16_t* P, int pcol, const float* kgain, bf16_t* Kf, int m) {
    const uint4* p = (const uint4*)(P + (size_t)m * LDP + pcol); float v[64]; float ss = 0.f;
#pragma unroll
    for (int i = 0; i < 8; ++i) { const uint4 u = p[i]; const unsigned w[4] = {u.x, u.y, u.z, u.w};
#pragma unroll
        for (int j = 0; j < 4; ++j) { v[i * 8 + 2 * j] = __uint_as_float(w[j] << 16); v[i * 8 + 2 * j + 1] = __uint_as_float(w[j] & 0xffff0000u); } }
#pragma unroll
    for (int d = 0; d < 64; ++d) ss += v[d] * v[d];
    const float r = rsqrtf(ss * (1.f / 64) + EPS);
    const int b = m / SEQ, t = m % SEQ, tile = t >> 6, kb = (t >> 5) & 1, rr = t & 31;
#pragma unroll
    for (int i = 0; i < 8; ++i) { uint4 u; u.x = pk2bf(v[i * 8 + 0] * r * kgain[i * 8 + 0], v[i * 8 + 1] * r * kgain[i * 8 + 1]); u.y = pk2bf(v[i * 8 + 2] * r * kgain[i * 8 + 2], v[i * 8 + 3] * r * kgain[i * 8 + 3]);
        u.z = pk2bf(v[i * 8 + 4] * r * kgain[i * 8 + 4], v[i * 8 + 5] * r * kgain[i * 8 + 5]); u.w = pk2bf(v[i * 8 + 6] * r * kgain[i * 8 + 6], v[i * 8 + 7] * r * kgain[i * 8 + 7]);
        const int ks = i >> 1, hh = i & 1;
        *(uint4*)(Kf + (((((size_t)(b * 64 + tile) * 2 + kb) * 4 + ks) * 32 + rr) * 2 + hh) * 8) = u; }
}
__device__ __forceinline__ int kcf_off(int n, int d) { return ((((((n >> 6) * 2 + ((n >> 5) & 1)) * 4 + (d >> 4)) * 32 + (n & 31)) * 2 + ((d >> 3) & 1)) * 8) + (d & 7); }
__device__ __forceinline__ int vcf_off(int n, int d) { const int s16 = n & 15; return (((((((n >> 6) * 2 + ((n >> 5) & 1)) * 2 + ((n >> 4) & 1)) * 2 + (d >> 5)) * 32 + (d & 31)) * 2 + ((s16 >> 2) & 1)) * 8) + (((s16 >> 3) << 2) | (s16 & 3)); }

__device__ __forceinline__ void nsa_cmp_unit(FA_LAS unsigned char* lds, int tid, const bf16_t* Qn, const bf16_t* Kcf, const bf16_t* Vcf, float* ocmp, unsigned long long* selmask, int b, int qb) {
    const int lane = tid & 63, wave = tid >> 6, r32 = lane & 31, hi = lane >> 5, head = wave >> 1, tl = 32 * (wave & 1) + r32, t = qb * 64 + tl;
    const size_t m = (size_t)b * SEQ + t;
    const float slope2 = exp2f(-(float)(2 * head + 2)) * LOG2E;
    const int ntiles = (4 * qb + 66) >> 6;
    const bf16_t* kb0 = Kcf + (size_t)b * 4 * 4096; const bf16_t* vb0 = Vcf + (size_t)b * 4 * 4096;
    auto tile_of = [=](int i) { fa::Tile T; T.kg = kb0 + (size_t)i * 4096; T.vg = vb0 + (size_t)i * 4096; T.key0 = i * 64; return T; };
    float mfin, lfin;
    fa::attn_unit<4, 3>(lds, tid, ntiles, tile_of, Qn + m * 256 + head * 64, t, slope2, 0ull, ocmp + (m * 4 + head) * 64, mfin, lfin);
    FA_LAS float* impH = (FA_LAS float*)lds;
    for (int i = tid; i < 4 * 64 * 64; i += NTHR) impH[i] = 0.f;
    __syncthreads();
    const int nv = t >= 31 ? ((t - 31) >> 4) + 1 : 0;
    const float il = nv > 0 ? 1.f / lfin : 0.f;
    fa::bf16x8 qf[4];
#pragma unroll
    for (int ks = 0; ks < 4; ++ks) qf[ks] = *(const fa::bf16x8*)(Qn + m * 256 + head * 64 + 16 * ks + 8 * hi);
    float carry = 0.f;
    for (int ti = 0; ti < ntiles; ++ti)
#pragma unroll
        for (int kb = 0; kb < 2; ++kb) {
            fa::f32x16 sc;
#pragma unroll
            for (int r = 0; r < 16; ++r) sc[r] = 0.f;
#pragma unroll
            for (int ks = 0; ks < 4; ++ks) { const fa::bf16x8 a = *(const fa::bf16x8*)(kb0 + (size_t)ti * 4096 + (((kb * 4 + ks) * 32 + r32) * 2 + hi) * 8);
                sc = __builtin_amdgcn_mfma_f32_32x32x16_bf16(a, qf[ks], sc, 0, 0, 0); }
#pragma unroll
            for (int g = 0; g < 4; ++g) {
                const int n0 = 64 * ti + 32 * kb + 8 * g + 4 * hi;
                float p[4];
#pragma unroll
                for (int i = 0; i < 4; ++i) { const int n = n0 + i; const float val = sc[4 * g + i] + slope2 * (float)(16 * n + 31 - t);
                    p[i] = n < nv ? __builtin_amdgcn_exp2f(val - mfin) * il : 0.f; }
                const float a1 = (p[0] + p[1]) + (p[2] + 0.5f * p[3]), a2 = 0.5f * p[3];
                const float recv = fa::xhalf(a2, lane);
                const float val = a1 + (hi ? recv : carry);
                if (!hi) carry = recv;
                impH[(head * 64 + tl) * 64 + (n0 >> 2)] = val;
            }
        }
    __syncthreads();
    for (int tt = 0; tt < 8; ++tt) {
        const int tok = 8 * wave + tt;
        float v = ((impH[(0 * 64 + tok) * 64 + lane] + impH[(1 * 64 + tok) * 64 + lane]) + impH[(2 * 64 + tok) * 64 + lane]) + impH[(3 * 64 + tok) * 64 + lane];
        v = lane <= qb ? v : -1.f;
        if (lane == 0 || lane == qb || lane == qb - 1) v = 2.f;
        int rank = 0;
        for (int i = 0; i < 64; ++i) { const float vi = __int_as_float(__builtin_amdgcn_readlane(__float_as_int(v), i)); rank += (vi > v || (vi == v && i < lane)) ? 1 : 0; }
        const unsigned long long msk = __builtin_amdgcn_ballot_w64(rank < 16);
        if (lane == 0) selmask[(size_t)b * SEQ + qb * 64 + tok] = msk;
    }
    __syncthreads();
}
template <int KIND>
__device__ __forceinline__ void nsa_branch_unit(FA_LAS unsigned char* lds, int tid, const bf16_t* Qn, const bf16_t* Kf, const bf16_t* Vf, const unsigned long long* selmask, float* obr, int b, int qb) {
    const int lane = tid & 63, wave = tid >> 6, head = wave >> 1, tl = 32 * (wave & 1) + (lane & 31), t = qb * 64 + tl;
    const size_t m = (size_t)b * SEQ + t;
    const float slope2 = exp2f(-(float)(2 * head + 2)) * LOG2E;
    const bf16_t* kb0 = Kf + (size_t)b * 64 * 4096; const bf16_t* vb0 = Vf + (size_t)b * 64 * 4096;
    float mo, lo;
    if (KIND == 1) {
        const unsigned long long sel = selmask[m];
        unsigned lo32 = (unsigned)sel, hi32 = (unsigned)(sel >> 32);
#pragma unroll
        for (int o = 1; o < 64; o <<= 1) { lo32 |= (unsigned)__builtin_amdgcn_ds_bpermute((lane ^ o) << 2, (int)lo32); hi32 |= (unsigned)__builtin_amdgcn_ds_bpermute((lane ^ o) << 2, (int)hi32); }
        FA_LAS unsigned* uni = (FA_LAS unsigned*)(lds + 32768);
        FA_LAS unsigned char* tlist = lds + 32768 + 16;
        if (wave < 2 && lane == 0) { uni[wave * 2] = lo32; uni[wave * 2 + 1] = hi32; }
        __syncthreads();
        const unsigned long long U = ((unsigned long long)(uni[1] | uni[3]) << 32) | (unsigned long long)(uni[0] | uni[2]);
        if (tid < 64 && ((U >> tid) & 1ull)) tlist[__builtin_popcountll(U & ((1ull << tid) - 1ull))] = (unsigned char)tid;
        __syncthreads();
        const int ntiles = __builtin_popcountll(U);
        auto tile_of = [=](int i) { const int j = tlist[i]; fa::Tile T; T.kg = kb0 + (size_t)j * 4096; T.vg = vb0 + (size_t)j * 4096; T.key0 = j * 64; return T; };
        fa::attn_unit<4, 1>(lds, tid, ntiles, tile_of, Qn + m * 256 + head * 64, t, slope2, sel, obr + (m * 4 + head) * 64, mo, lo);
    } else {
        const int first = qb >= 8 ? qb - 8 : 0;
        auto tile_of = [=](int i) { const int j = first + i; fa::Tile T; T.kg = kb0 + (size_t)j * 4096; T.vg = vb0 + (size_t)j * 4096; T.key0 = j * 64; return T; };
        fa::attn_unit<4, 2>(lds, tid, qb - first + 1, tile_of, Qn + m * 256 + head * 64, t, slope2, 0ull, obr + (m * 4 + head) * 64, mo, lo);
    }
}

__device__ __forceinline__ void moe_table(const int* cnt, __attribute__((address_space(3))) int* tab, int tid) {
    if (tid < 64) {
        const int lane = tid; const int c = lane < 32 ? cnt[lane] : 0; const int pc = (c + 255) >> 8;
        int x = pc;
#pragma unroll
        for (int o = 1; o < 32; o <<= 1) { const int y = __builtin_amdgcn_ds_bpermute(((lane - o) & 63) << 2, x); if (lane >= o) x += y; }
        const int ex = x - pc;
        if (lane < 32) { tab[lane] = ex * 256; tab[32 + lane] = c; for (int t = 0; t < pc; ++t) tab[128 + ex + t] = lane; }
        if (lane == 31) tab[64] = x;
    }
    __syncthreads();
}

#define XB_TMO      128
#define XB_XCNT(j)  (256  + 64 * (j))
#define XB_XSUB(j)  (1280 + 64 * (j))
#define XB_XGEN(j)  (2304 + 64 * (j))
#define XB_TOP      3328
#define XB_TOPGEN   3392
#define XCD_BAR_WORDS 3456
#define XB_SPIN_CAP (1u << 18)

__device__ __forceinline__ unsigned xb_ld(unsigned* p)              { return __hip_atomic_load(p, __ATOMIC_RELAXED, __HIP_MEMORY_SCOPE_AGENT); }
__device__ __forceinline__ unsigned xb_add(unsigned* p, unsigned v) { return __hip_atomic_fetch_add(p, v, __ATOMIC_RELAXED, __HIP_MEMORY_SCOPE_AGENT); }
__device__ __forceinline__ unsigned xb_xcc_id() { return (unsigned)__builtin_amdgcn_s_getreg((3 << 11) | 20) & 0xFu; }
#define XB_SPIN(cond, bar) do { unsigned _sp = 0; while (cond) { __builtin_amdgcn_s_sleep(1); \
    if ((++_sp & 255u) == 0u) { if (xb_ld(&(bar)[XB_TMO])) break; if (_sp > XB_SPIN_CAP) { atomicAdd(&(bar)[XB_TMO], 1u); break; } } } } while (0)

struct XcdBarrier {
    unsigned* bar; unsigned x;
    volatile __attribute__((address_space(3))) unsigned* st;
};

__device__ __forceinline__ XcdBarrier xcd_barrier_post(unsigned* bar, volatile __attribute__((address_space(3))) unsigned* st) {
    XcdBarrier b; b.bar = bar; b.x = xb_xcc_id(); b.st = st;
    if (threadIdx.x == 0) (void)xb_add(&bar[XB_XCNT(b.x)], 1u);
    return b;
}
__device__ __forceinline__ void xcd_barrier_complete(unsigned* bar, unsigned x, unsigned& nloc, unsigned& nx) {
    const unsigned G = gridDim.x * gridDim.y * gridDim.z;
    unsigned sum, cnt, mine, sp = 0u;
    for (;;) {
        sum = 0u; cnt = 0u; mine = 0u;
#pragma unroll
        for (unsigned j = 0; j < 16; ++j) { const unsigned c = xb_ld(&bar[XB_XCNT(j)]); sum += c; cnt += (c > 0u) ? 1u : 0u; mine = (j == x) ? c : mine; }
        if (sum == G) break;
        __builtin_amdgcn_s_sleep(1);
        if ((++sp & 255u) == 0u) { if (xb_ld(&bar[XB_TMO])) break; if (sp > XB_SPIN_CAP) { atomicAdd(&bar[XB_TMO], 1u); break; } }
    }
    nloc = mine > 0u ? mine : 1u; nx = cnt > 0u ? cnt : 1u;
}

__device__ __forceinline__ void xcd_barrier(const XcdBarrier& b) {
    asm volatile("s_waitcnt vmcnt(0)" ::: "memory");
    __syncthreads();
    if (threadIdx.x == 0) {
        unsigned* bar = b.bar;
        __builtin_amdgcn_s_waitcnt(0);
        unsigned nloc = b.st[0], nx = b.st[1];
        if (nloc == 0u) { xcd_barrier_complete(bar, b.x, nloc, nx); b.st[0] = nloc; b.st[1] = nx; }
        const unsigned old = xb_add(&bar[XB_XSUB(b.x)], 1u);
        const unsigned gen = old / nloc;
        if (old + 1u == (gen + 1u) * nloc) {
            __builtin_amdgcn_fence(__ATOMIC_RELEASE, "agent");
            asm volatile("s_waitcnt vmcnt(0)" ::: "memory");
            const unsigned og = xb_add(&bar[XB_TOP], 1u);
            const unsigned tg = og / nx;
            if (og + 1u == (tg + 1u) * nx) xb_add(&bar[XB_TOPGEN], 1u);
            else XB_SPIN(xb_ld(&bar[XB_TOPGEN]) == tg, bar);
            __builtin_amdgcn_fence(__ATOMIC_ACQUIRE, "agent");
            xb_add(&bar[XB_XGEN(b.x)], 1u);
            asm volatile("s_waitcnt vmcnt(0)" ::: "memory");
        } else {
            XB_SPIN(xb_ld(&bar[XB_XGEN(b.x)]) == gen, bar);
            __builtin_amdgcn_fence(__ATOMIC_ACQUIRE, "agent");
            asm volatile("s_waitcnt vmcnt(0)" ::: "memory");
        }
    }
    __syncthreads();
}


__global__ void __launch_bounds__(NTHR) mega_fwd(Params p_unused) {
    extern __shared__ __attribute__((aligned(16))) unsigned char lds[];
    cg::grid_group grid = cg::this_grid(); grid.sync();
    volatile __attribute__((address_space(3))) unsigned* bar_st = (volatile __attribute__((address_space(3))) unsigned*)(lds + LDS_BYTES - 64);
    if (threadIdx.x < 2) bar_st[threadIdx.x] = 0u;
    __syncthreads();
#ifndef USE_XCD_BARRIER
#define USE_XCD_BARRIER 1
#endif
#if USE_XCD_BARRIER
#define GRID_BARRIER() xcd_barrier(xbar)
#else
#define GRID_BARRIER() grid.sync()
#endif
    XcdBarrier xbar; (void)xbar;
    {   typedef const __attribute__((address_space(4))) Params* cparams0_t; const cparams0_t p0 = (cparams0_t)__builtin_amdgcn_kernarg_segment_ptr();
        xbar = xcd_barrier_post((unsigned*)(p0->ws + WS_BAR), bar_st); }
    typedef const __attribute__((address_space(4))) Params* cparams_t;
    const cparams_t pp = (cparams_t)__builtin_amdgcn_kernarg_segment_ptr();
#define PHASE_VARS \
    int tid = threadIdx.x; asm volatile("" : "+v"(tid)); \
    int bid = blockIdx.x; asm volatile("" : "+s"(bid)); int G = gridDim.x; asm volatile("" : "+s"(G)); int l = layer; asm volatile("" : "+s"(l)); \
    cparams_t pq = pp; asm volatile("" : "+s"(pq)); \
    const float* xcur = l == 0 ? pq->x_in : pq->out; (void)xcur; \
    const int lane = tid & 63, wave = tid >> 6, half = tid >> 8, tid256 = tid & 255; \
    const int gw = bid * NWAVE + wave, NGW = G * NWAVE; \
    const int gt = bid * NTHR + tid, NGT = G * NTHR; \
    float* ldsf = (float*)lds + half * 4096; \
    (void)lane; (void)tid256; (void)gw; (void)NGW; (void)gt; (void)NGT; (void)ldsf;

    auto layer_body = [&](auto LC) __attribute__((always_inline)) {
        constexpr int layer = decltype(LC)::value;
        {   PHASE_VARS
        {   lds_f32* scr = (lds_f32*)lds + wave * (64 * 33);
            for (int it = gw; it < (DM / 64) * (LDP / 32); it += NGW) transpose_item<true>(pq->w_in + (size_t)l * DM * IN_COLS, DM, IN_COLS, LDP, W_WIN_T, scr, it, lane);
            for (int it = gw; it < (DM / 64) * (DM / 32); it += NGW) transpose_item<false>(pq->w_out + (size_t)l * DM * DM, DM, DM, DM, W_WOUT_T, scr, it, lane);
            for (int it = gw; it < 128; it += NGW) transpose_item<false>(pq->nsa_cmp_w1 + ((size_t)l * 2 + (it >> 6)) * 2048 * 64, 2048, 64, 64, W_W1T + (size_t)(it >> 6) * 64 * 2048, scr, it & 63, lane); }
        if (bid == 0 && tid < 32) W_CNT[tid] = 0;
        for (int row = gw; row < MT; row += NGW) norm_row(pq->out, xcur, l == 0 ? nullptr : W_YMOE, pq->norm_mix + l * DM, W_TB, row, lane);
        }
        GRID_BARRIER();
        {   PHASE_VARS
        {   pg8::Gemm g{W_TB, W_WIN_T, MT, LDP, DM}; pg8::StaticOrder S; S.init(MT, LDP, G, bid);
            pg8::EpiBf16<0> E{W_P, LDP, nullptr, 0, 0, 1.f};
            pg8::gemm_phase<pg8::EpiBf16<0>, pg8::StaticOrder, true, true>((PG8_LAS unsigned char*)lds, g, S, E); }
        }
        GRID_BARRIER();
        {   PHASE_VARS
        SCAN_BUFS(Bm, Bh)
        for (int i = gt; i < 4 * 65536; i += NGT) { const int w = i >> 16, j = i & 65535;
            if (w == 0) scan::prep_k<0>(W_P, pq->mlstm_conv + l * 4 * 512, pq->mlstm_gate_bias + l * 8, nullptr, l, Bm, j);
            else if (w == 1) scan::prep_k<1>(W_P, nullptr, nullptr, pq->hgrn_lb, l, Bh, j);
            else if (w == 2) scan::prep_v(W_P, PC_BV, Bm.VT(), j);
            else scan::prep_v(W_P, PC_CI, Bh.VT(), j); }
        }
        GRID_BARRIER();
        {   PHASE_VARS
        SCAN_BUFS(Bm, Bh)
        for (int it = gw; it < 2048; it += NGW) { if (it < 1024) scan::stepA<0>(Bm, it, lane); else scan::stepA<1>(Bh, it - 1024, lane); }
        }
        GRID_BARRIER();
        {   PHASE_VARS
        SCAN_BUFS(Bm, Bh)
        for (int i = gt; i < 2 * 16 * 65 * 64; i += NGT) { if (i < 16 * 65 * 64) scan::stepB<0>(Bm, i); else scan::stepB<1>(Bh, i - 16 * 65 * 64); }
        }
        GRID_BARRIER();
        {   PHASE_VARS
        SCAN_BUFS(Bm, Bh)
        for (int it = gw; it < 2048; it += NGW) {
            if (it < 1024) scan::stepC<0>(Bm, W_P, PC_BO, pq->mlstm_out_gain + l * 256, W_MIXED, 256, it, lane);
            else scan::stepC<1>(Bh, W_P, PC_CG, pq->hgrn_out_gain + l * 256, W_MIXED, 512, it - 1024, lane); }
        }
        GRID_BARRIER();
        {   PHASE_VARS
        for (int i = gt; i < MT * 8; i += NGT) diff_prep_qk(W_P, pq->diff_q_gain + l * 32, pq->diff_k_gain + l * 32, W_QBF, W_DKF, i);
        for (int i = gt; i < NB * 4 * 64 * 512; i += NGT) vfrag_item(W_P, PC_AV, 64, 4, W_DVF, i);
        for (int i = gt; i < MT * 4; i += NGT) nsa_prep_q(W_P, pq->nsa_q_gain + l * 64, W_NQB, i);
        for (int i = gt; i < 2 * MT; i += NGT) { if (i < MT) nsa_prep_k(W_P, PC_KS, pq->nsa_k_gain + (l * 3 + 1) * 64, W_KSF, i); else nsa_prep_k(W_P, PC_KW, pq->nsa_k_gain + (l * 3 + 2) * 64, W_KWF, i - MT); }
        for (int i = gt; i < 2 * NB * 64 * 512; i += NGT) { if (i < NB * 64 * 512) vfrag_item(W_P, PC_VS, 0, 1, W_VSF, i); else vfrag_item(W_P, PC_VW, 0, 1, W_VWF, i - NB * 64 * 512); }
        for (int it = bid; it < 64; it += G)
            nsa_compress_unit((FA_LAS unsigned char*)lds, tid, W_P, pq->nsa_cmp_pos + l * 2 * 32 * 64, W_W1T, pq->nsa_cmp_w2 + l * 2 * 64 * 64, pq->nsa_k_gain + (l * 3 + 0) * 64, W_CMP, it);
        }
        GRID_BARRIER();
        {   PHASE_VARS
        {
            const int vcu = (G & 7) == 0 ? (bid & 7) * (G >> 3) + (bid >> 3) : bid;
            for (int pr = vcu; pr < 256; pr += G) {
                const int combo = pr >> 3, sidx = pr & 7, c = combo & 1, h = (combo >> 1) & 3, b = combo >> 3;
                const bf16_t* kbase = W_DKF + (size_t)((b * 4 + h) * 2 + c) * 64 * 2048; const bf16_t* vbase = W_DVF + (size_t)(b * 4 + h) * 64 * 4096;
                auto tile_of = [=](int i) { fa::Tile T; T.kg = kbase + (size_t)i * 2048; T.vg = vbase + (size_t)i * 4096; T.key0 = i * 64; return T; };
                const float slope2 = exp2f(-(float)(2 * h + 1)) * LOG2E;
#pragma unroll 1
                for (int u = 0; u < 2; ++u) { const int qb = u == 0 ? 15 - sidx : sidx;
                    const int t = qb * 256 + wave * 32 + (lane & 31); const size_t m = (size_t)b * SEQ + t;
                    float mo, lo; fa::attn_unit<2, 0>((FA_LAS unsigned char*)lds, tid, 4 * (qb + 1), tile_of, W_QBF + m * 256 + h * 64 + c * 32, t, slope2, 0ull, W_DO + (m * 8 + h * 2 + c) * 64, mo, lo); }
            }
        }
        {   const int vcu = (G & 7) == 0 ? (bid & 7) * (G >> 3) + (bid >> 3) : bid;
            for (int u = vcu; u < 256; u += G) nsa_cmp_unit((FA_LAS unsigned char*)lds, tid, W_NQB, W_KCF, W_VCF, W_OCMP, W_SELMASK, u >> 6, u & 63); }
        }
        GRID_BARRIER();
        {   PHASE_VARS
        const float lam_init = 0.8f - 0.6f * __expf(-0.3f * (float)l);
        for (int i = gt; i < MT * 4; i += NGT) diff_combine_item(W_DO, pq->diff_lambda + l * 128, pq->diff_sub_gain + l * 256, lam_init, W_MIXED, i);
        }
        GRID_BARRIER();
        {   PHASE_VARS
        {
            FA_LAS int* qslot = (FA_LAS int*)(lds + LDS_BYTES - 128);
            for (;;) {
                if (tid == 0) *qslot = (int)atomicAdd(W_QUEUE + l * 64, 1u);
                __syncthreads();
                const int it = *qslot;
                __syncthreads();
                if (it >= 512) break;
                if (it < 256) nsa_branch_unit<1>((FA_LAS unsigned char*)lds, tid, W_NQB, W_KSF, W_VSF, W_SELMASK, W_OSEL, it & 3, 63 - (it >> 2));
                else nsa_branch_unit<2>((FA_LAS unsigned char*)lds, tid, W_NQB, W_KWF, W_VWF, W_SELMASK, W_OWIN, (it - 256) & 3, (it - 256) >> 2);
            }
        }
        }
        GRID_BARRIER();
        {   PHASE_VARS
        for (int i = gt; i < MT * 4; i += NGT) nsa_combine_item(W_P, W_OCMP, W_OSEL, W_OWIN, pq->nsa_out_gain + l * 256, W_MIXED, i);
        }
        GRID_BARRIER();
        {   PHASE_VARS
        {   pg8::Gemm g{W_MIXED, W_WOUT_T, MT, DM, DM}; pg8::StaticOrder S; S.init(MT, DM, G, bid);
            pg8::EpiResF32 E{xcur, pq->out, DM};
            pg8::gemm_phase<pg8::EpiResF32, pg8::StaticOrder, true, true>((PG8_LAS unsigned char*)lds, g, S, E); }
        }
        GRID_BARRIER();
        {   PHASE_VARS
        {   lds_f32* scr = (lds_f32*)lds + wave * (64 * 33);
            for (int it = gw; it < 32 * 256; it += NGW) { const int e = it >> 8, r = it & 255, kb = r >> 4, nb = r & 15;
                const int j = nb >> 3, hf = (nb >> 2) & 1, cb = nb & 3;
                const float* W = (hf ? pq->moe_w_up : pq->moe_w_gate) + ((size_t)l * 32 + e) * DM * 256;
                transpose_item<false>(W + j * 128 + cb * 32, DM, 256, 32, W_WGU_T + ((size_t)e * 512 + nb * 32) * DM, scr, kb, lane); }
            for (int it = gw; it < 32 * 128; it += NGW) { const int e = it >> 7, r = it & 127;
                transpose_item<false>(pq->moe_w_down + ((size_t)l * 32 + e) * 256 * DM, 256, DM, DM, W_WD_T + (size_t)e * DM * 256, scr, r, lane); }
        }
        __syncthreads();
        {   FA_LAS float* wl = (FA_LAS float*)lds; const float* wg = pq->moe_w_group + l * DM * 4; const float* we = pq->moe_w_expert + l * DM * 32;
            for (int i = tid; i < DM * 36; i += NTHR) { const int k = i / 36, o = i - k * 36; wl[i] = o < 4 ? wg[k * 4 + o] : we[k * 32 + o - 4]; }
            __syncthreads();
            for (int row = gw; row < MT; row += NGW)
                moe_route_row(pq->out, pq->norm_ffn + l * DM, wl, pq->moe_b_group + l * 4, pq->moe_b_expert + l * 32, W_TB, W_RE, W_RW, W_RS, W_CNT, row, lane);
        }
        }
        GRID_BARRIER();
        {   PHASE_VARS
        __attribute__((address_space(3))) int* tab = (__attribute__((address_space(3))) int*)(lds + 131072);
        moe_table(W_CNT, tab, tid);
        for (int row = gw; row < MT; row += NGW) {
            const uint4* src = (const uint4*)(W_TB + (size_t)row * DM);
            const uint4 v0 = src[lane], v1 = src[lane + 64];
#pragma unroll
            for (int i = 0; i < 2; ++i) { const int e = W_RE[row * 2 + i], r = tab[e] + W_RS[row * 2 + i];
                uint4* dst = (uint4*)(W_ASORT + (size_t)r * DM); dst[lane] = v0; dst[lane + 64] = v1;
                if (lane == 0) { W_ROWTOK[r] = row * 2 + i; W_ROWW[r] = W_RW[row * 2 + i]; } }
        }
        if (bid == 0) for (int e = wave; e < 32; e += NWAVE) { const int r0 = tab[e] + tab[32 + e], r1 = tab[e] + ((tab[32 + e] + 255) & ~255);
            for (int r = r0 + lane; r < r1; r += 64) { W_ROWTOK[r] = -1; W_ROWW[r] = 0.f; } }
        }
        GRID_BARRIER();
        {   PHASE_VARS
        __attribute__((address_space(3))) int* tab = (__attribute__((address_space(3))) int*)(lds + 131072);
        moe_table(W_CNT, tab, tid);
        {   pg8::Gemm g{W_ASORT, W_WGU_T, MOE_ROWS_MAX, 32 * 512, DM}; pg8::MoeOrder S{G, bid, tab[64], 2, tab + 128};
            pg8::EpiSwiglu E{W_HS, W_ROWW};
            pg8::gemm_phase<pg8::EpiSwiglu, pg8::MoeOrder, true, true>((PG8_LAS unsigned char*)lds, g, S, E); }
        }
        GRID_BARRIER();
        {   PHASE_VARS
        __attribute__((address_space(3))) int* tab = (__attribute__((address_space(3))) int*)(lds + 131072);
        moe_table(W_CNT, tab, tid);
        {   pg8::Gemm g{W_HS, W_WD_T, MOE_ROWS_MAX, 32 * DM, 256}; pg8::MoeOrder S{G, bid, tab[64], 4, tab + 128};
            pg8::EpiScatterStore E{W_YMOE, W_ROWTOK};
            pg8::gemm_phase<pg8::EpiScatterStore, pg8::MoeOrder, true, true>((PG8_LAS unsigned char*)lds, g, S, E); }
        }
        GRID_BARRIER();
    };
    layer_body(IntC<0>{});
    layer_body(IntC<1>{});
    {   const int layer = DEPTH; PHASE_VARS
        for (int i = gt; i < MT * DM / 4; i += NGT) { const int row = i >> 8, c4 = i & 255;
            float4 v = ((const float4*)pq->out)[i];
            const float4 a = bf4_to_f4(((const uint2*)(W_YMOE + (size_t)row * 2 * DM))[c4]), b = bf4_to_f4(((const uint2*)(W_YMOE + ((size_t)row * 2 + 1) * DM))[c4]);
            v.x += a.x + b.x; v.y += a.y + b.y; v.z += a.z + b.z; v.w += a.w + b.w; ((float4*)pq->out)[i] = v; }
    }
}
}

extern "C" void kernel_launch(void* const* d_in, const int* in_sizes, int n_in, void* d_out, int out_size, void* d_ws, size_t ws_size, hipStream_t stream) {
    Params p{};
    p.x_in = (const float*)d_in[0]; p.norm_mix = (const float*)d_in[1]; p.norm_ffn = (const float*)d_in[2]; p.w_in = (const float*)d_in[3]; p.w_out = (const float*)d_in[4];
    p.diff_q_gain = (const float*)d_in[5]; p.diff_k_gain = (const float*)d_in[6]; p.diff_lambda = (const float*)d_in[7]; p.diff_sub_gain = (const float*)d_in[8];
    p.mlstm_conv = (const float*)d_in[9]; p.mlstm_gate_bias = (const float*)d_in[10]; p.mlstm_out_gain = (const float*)d_in[11]; p.hgrn_lb = (const float*)d_in[12];
    p.hgrn_out_gain = (const float*)d_in[13]; p.nsa_cmp_pos = (const float*)d_in[14]; p.nsa_cmp_w1 = (const float*)d_in[15]; p.nsa_cmp_w2 = (const float*)d_in[16];
    p.nsa_q_gain = (const float*)d_in[17]; p.nsa_k_gain = (const float*)d_in[18]; p.nsa_out_gain = (const float*)d_in[19];
    p.moe_w_group = (const float*)d_in[20]; p.moe_b_group = (const float*)d_in[21]; p.moe_w_expert = (const float*)d_in[22]; p.moe_b_expert = (const float*)d_in[23];
    p.moe_w_gate = (const float*)d_in[24]; p.moe_w_up = (const float*)d_in[25]; p.moe_w_down = (const float*)d_in[26];
    p.out = (float*)d_out;

    p.ws = (char*)d_ws;
    if (WS_END > ws_size) { fprintf(stderr, "kernel_launch: workspace too small: need %zu, have %zu\n", (size_t)WS_END, ws_size); return; }

    static int grid_blocks = 0;
    if (!grid_blocks) {
        int dev = 0, cus = 0, per_cu = 0;
        hipGetDevice(&dev);
        hipDeviceGetAttribute(&cus, hipDeviceAttributeMultiprocessorCount, dev);
        hipFuncSetAttribute((const void*)mega_fwd, hipFuncAttributeMaxDynamicSharedMemorySize, LDS_BYTES);
        hipOccupancyMaxActiveBlocksPerMultiprocessor(&per_cu, (const void*)mega_fwd, NTHR, LDS_BYTES);
        if (per_cu < 1) per_cu = 1;
        if (per_cu > 1) per_cu = 1;
        grid_blocks = cus * per_cu;
    }
    hipMemsetAsync((char*)d_ws + WS_BAR, 0, 16384, stream);
    void* args[] = {&p};
    hipError_t e = hipLaunchCooperativeKernel((const void*)mega_fwd, dim3(grid_blocks), dim3(NTHR), args, LDS_BYTES, stream);
    if (e != hipSuccess) fprintf(stderr, "cooperative launch failed: %s (grid %d)\n", hipGetErrorString(e), grid_blocks);
}
```

```cpp
#include <hip/hip_runtime.h>
#include <hip/hip_cooperative_groups.h>
#include <stdint.h>
#include <cstdio>
namespace cg = cooperative_groups;

namespace {
constexpr int DM = 1024, NB = 4, SEQ = 4096, DEPTH = 2, MT = NB * SEQ;
constexpr int IN_COLS = 3476, LDP = 3584;
constexpr float EPS = 1e-6f, NEG = -1e30f;
constexpr int PC_AQ = 0, PC_AK = 256, PC_AV = 512, PC_BQ = 768, PC_BK = 1024, PC_BV = 1280, PC_BO = 1536, PC_CQ = 1792, PC_CF = 2048,
              PC_CI = 2304, PC_CG = 2560, PC_DQ = 2816, PC_KC = 3072, PC_VC = 3136, PC_KS = 3200, PC_VS = 3264, PC_KW = 3328, PC_VW = 3392,
              PC_BI = 3456, PC_BF = 3460, PC_DG = 3464;
constexpr int NCMP = 255;
constexpr int NTHR = 512, NWAVE = 8;
constexpr int LDS_BYTES = 151552;

typedef unsigned short bf16_t;
__device__ __forceinline__ float bf2f(bf16_t v) { return __uint_as_float(((unsigned)v) << 16); }
__device__ __forceinline__ bf16_t f2bf(float f) { unsigned u = __float_as_uint(f); return (bf16_t)((u + 0x7fffu + ((u >> 16) & 1u)) >> 16); }
__device__ __forceinline__ unsigned pk2bf(float lo, float hi) { return (unsigned)f2bf(lo) | ((unsigned)f2bf(hi) << 16); }
__device__ __forceinline__ int src_col(int c) { return c < 1536 ? c : (c < 3456 ? c + 8 : (c < 3460 ? c - 3456 + 1536 : (c < 3464 ? c - 3460 + 1540 : c))); }
__device__ __forceinline__ float sigmoidf_(float x) { return 1.f / (1.f + __expf(-x)); }
__device__ __forceinline__ float siluf_(float x) { return x / (1.f + __expf(-x)); }
__device__ __forceinline__ float wave_sum(float v, int lane) {
#pragma unroll
    for (int o = 1; o < 64; o <<= 1) v += __int_as_float(__builtin_amdgcn_ds_bpermute((lane ^ o) << 2, __float_as_int(v)));
    return v;
}
__device__ __forceinline__ float rdlane(float v, int k) { return __int_as_float(__builtin_amdgcn_readlane(__float_as_int(v), k)); }

__device__ __forceinline__ int phase_tid_fwd(const unsigned char* lds_generic);
namespace pg8 {
#define PG8_LAS __attribute__((address_space(3)))
typedef unsigned short bf16_t;
typedef short bf16x8 __attribute__((ext_vector_type(8)));
typedef float f32x4 __attribute__((ext_vector_type(4)));
typedef unsigned u32x4 __attribute__((ext_vector_type(4)));
constexpr int BM = 256, BK = 64, HALF = 128, HTB = HALF * BK * 2  , STAGE_BYTES = 8 * HTB, NXCD = 8, WGM = 8;

__host__ __device__ __forceinline__ int lds_byte(int r, int c) { const int st = (r >> 4) * 2 + (c >> 5), rr = r & 15, cc = c & 31, ob = rr * 64 + cc * 2; return st * 1024 + (ob ^ (((ob >> 9) & 1) << 5)); }
__host__ __device__ __forceinline__ void stage_rc(int b, int& R, int& C) { const int st = b / 1024, sb = b % 1024, swz = sb ^ (((sb >> 9) & 1) << 5); R = (st >> 1) * 16 + swz / 64; C = (st & 1) * 32 + (swz % 64) / 2; }
__host__ __device__ __forceinline__ int perm32(int rho) { const int n = rho >> 4, i = rho & 15; return 8 * (i >> 2) + 4 * n + (i & 3); }

struct Unit { int pm, pn; };
struct Gemm { const bf16_t* A; const bf16_t* Bt; int M, N, K; };

struct StaticOrder {
    int nM, nN, nwg, G, c;
    __host__ __device__ void init(int M, int N, int G_, int c_) { nM = M / BM; nN = N / BM; nwg = nM * nN; G = G_; c = c_; }
    __host__ __device__ bool next(int i, Unit& u) const {
        const long L = (long)i * G + c; if (L >= nwg) return false;
        int wgid = (int)L; { const int q = nwg / NXCD, r = nwg % NXCD, xcd = wgid % NXCD, off = wgid / NXCD; wgid = (xcd < r ? xcd * (q + 1) : r * (q + 1) + (xcd - r) * q) + off; }
        const int nig = WGM * nN, gid = wgid / nig, fm = gid * WGM, gsz = (nM - fm) < WGM ? (nM - fm) : WGM;
        u.pm = fm + ((wgid % nig) % gsz); u.pn = (wgid % nig) / gsz; return true;
    }
    __device__ __forceinline__ void a_ready(const Unit&) const {}
    __device__ __forceinline__ void done(const Unit&) const {}
};

__device__ __forceinline__ unsigned cvt_pk_bf16(float lo, float hi) { unsigned r; asm volatile("v_cvt_pk_bf16_f32 %0, %1, %2" : "=v"(r) : "v"(lo), "v"(hi)); return r; }
template <int ACT  > struct EpiBf16 {
    static constexpr bool PERM = true, AFTER_DRAIN = false, HAS_INIT = false; static_assert(ACT == 0, "EpiBf16: only ACT 0 here");
    bf16_t* O; int ldc; const float* bias; int split_cols; size_t split_stride; float scale0;
    __device__ __forceinline__ void operator()(const f32x4 (&acc)[2][2][4][2], const Unit& u, int wr, int wc, int fr, int fq) const {
        const int row0 = u.pm * BM + wr * 64 + fr; int colt = u.pn * BM; bf16_t* base = O;
        float sc = 1.f; if (split_cols) { const int t = colt / split_cols; base += (size_t)t * split_stride; colt -= t * split_cols; if (t == 0) sc = scale0; }
        const int col0 = colt + wc * 32 + 8 * fq, bcol0 = u.pn * BM + wc * 32 + 8 * fq;
        f32x4 bv[2][2];
#pragma unroll
        for (int bj = 0; bj < 2; ++bj)
#pragma unroll
            for (int n = 0; n < 2; ++n) bv[bj][n] = bias ? *(const f32x4*)(bias + bcol0 + bj * HALF + 4 * n) : (f32x4){0.f, 0.f, 0.f, 0.f};
#pragma unroll
        for (int ai = 0; ai < 2; ++ai)
#pragma unroll
            for (int m = 0; m < 4; ++m) { bf16_t* rowp = base + (size_t)(row0 + ai * HALF + m * 16) * ldc + col0;
#pragma unroll
                for (int bj = 0; bj < 2; ++bj) { f32x4 v0 = acc[ai][bj][m][0] + bv[bj][0], v1 = acc[ai][bj][m][1] + bv[bj][1];
                    v0 = v0 * sc; v1 = v1 * sc; u32x4 w; w.x = cvt_pk_bf16(v0[0], v0[1]); w.y = cvt_pk_bf16(v0[2], v0[3]); w.z = cvt_pk_bf16(v1[0], v1[1]); w.w = cvt_pk_bf16(v1[2], v1[3]);
                    *(u32x4*)(rowp + bj * HALF) = w; } }
    }
};


struct EpiResF32 {
    static constexpr bool PERM = false, AFTER_DRAIN = false, HAS_INIT = true;
    const float* base; float* out; int ldc;
    __device__ __forceinline__ void init(f32x4 (&acc)[2][2][4][2], const Unit& u, int wr, int wc, int fr, int fq) const {
        const int col0 = u.pn * BM + wc * 32 + 4 * fq;
#pragma unroll
        for (int ai = 0; ai < 2; ++ai)
#pragma unroll
            for (int m = 0; m < 4; ++m) { const size_t off = (size_t)(u.pm * BM + ai * HALF + wr * 64 + m * 16 + fr) * ldc + col0;
#pragma unroll
                for (int bj = 0; bj < 2; ++bj)
#pragma unroll
                    for (int n = 0; n < 2; ++n) acc[ai][bj][m][n] = *(const f32x4*)(base + off + bj * HALF + n * 16); }
    }
    __device__ __forceinline__ void operator()(const f32x4 (&acc)[2][2][4][2], const Unit& u, int wr, int wc, int fr, int fq) const {
        const int col0 = u.pn * BM + wc * 32 + 4 * fq;
#pragma unroll
        for (int ai = 0; ai < 2; ++ai)
#pragma unroll
            for (int m = 0; m < 4; ++m) { const size_t off = (size_t)(u.pm * BM + ai * HALF + wr * 64 + m * 16 + fr) * ldc + col0;
#pragma unroll
                for (int bj = 0; bj < 2; ++bj)
#pragma unroll
                    for (int n = 0; n < 2; ++n) *(f32x4*)(out + off + bj * HALF + n * 16) = acc[ai][bj][m][n]; }
    }
};

struct EpiSwiglu {
    static constexpr bool PERM = true, AFTER_DRAIN = false, HAS_INIT = false;
    bf16_t* H; const float* row_w;
    __device__ __forceinline__ void operator()(const f32x4 (&acc)[2][2][4][2], const Unit& u, int wr, int wc, int fr, int fq) const {
        const int row0 = u.pm * BM + wr * 64 + fr, col0 = (u.pn & 1) * HALF + wc * 32 + 8 * fq;
#pragma unroll
        for (int ai = 0; ai < 2; ++ai)
#pragma unroll
            for (int m = 0; m < 4; ++m) { const int row = row0 + ai * HALF + m * 16; const float w = row_w[row];
                float h[8];
#pragma unroll
                for (int n = 0; n < 2; ++n)
#pragma unroll
                    for (int i = 0; i < 4; ++i) { const float g = acc[ai][0][m][n][i], up = acc[ai][1][m][n][i]; h[n * 4 + i] = g / (1.f + __expf(-g)) * up * w; }
                u32x4 o; o.x = cvt_pk_bf16(h[0], h[1]); o.y = cvt_pk_bf16(h[2], h[3]); o.z = cvt_pk_bf16(h[4], h[5]); o.w = cvt_pk_bf16(h[6], h[7]);
                *(u32x4*)(H + (size_t)row * 256 + col0) = o; asm volatile("" ::: "memory"); }
    }
};
struct EpiScatterStore {
    static constexpr bool PERM = true, AFTER_DRAIN = false, HAS_INIT = false;
    bf16_t* Y; const int* row_tok;
    __device__ __forceinline__ void operator()(const f32x4 (&acc)[2][2][4][2], const Unit& u, int wr, int wc, int fr, int fq) const {
        const int col0 = (u.pn & 3) * BM + wc * 32 + 8 * fq;
#pragma unroll
        for (int ai = 0; ai < 2; ++ai)
#pragma unroll
            for (int m = 0; m < 4; ++m) { const int t2 = row_tok[u.pm * BM + ai * HALF + wr * 64 + m * 16 + fr];
                if (t2 >= 0) { const unsigned o = (unsigned)t2 * 1024u + (unsigned)col0;
#pragma unroll
                    for (int bj = 0; bj < 2; ++bj) { const f32x4 v0 = acc[ai][bj][m][0], v1 = acc[ai][bj][m][1];
                        u32x4 w; w.x = cvt_pk_bf16(v0[0], v0[1]); w.y = cvt_pk_bf16(v0[2], v0[3]); w.z = cvt_pk_bf16(v1[0], v1[1]); w.w = cvt_pk_bf16(v1[2], v1[3]);
                        *(u32x4*)(Y + (o + (unsigned)(bj * HALF))) = w; } }
                asm volatile("" ::: "memory"); }
    }
};
struct MoeOrder {
    int G, c, ntiles, nsub; const PG8_LAS int* tile_e; int L0, L1;
    __device__ __forceinline__ bool next(int i, Unit& u) const {
        const int L = L0 + i * G + c; if (c < 0 || L >= L1) return false;
        const int T = L / nsub, j = L - T * nsub; u.pm = T; u.pn = tile_e[T] * nsub + j; return true;
    }
    __device__ __forceinline__ void a_ready(const Unit&) const {}
    __device__ __forceinline__ void done(const Unit&) const {}
};
template <class Epi, class Sched, bool ALIGN_EPI = false, bool SP2 = false>
__device__ __forceinline__ void gemm_phase(PG8_LAS unsigned char* lds, const Gemm g, const Sched& S, const Epi& E, const int tid_in, const unsigned char* lds_generic) {
    const int tid = tid_in, wid = __builtin_amdgcn_readfirstlane(tid >> 6), lane = tid & 63, wr = wid >> 2, wc = wid & 3, fr = lane & 15, fq = lane >> 4;
    const int K = g.K, nt = K / BK;
    unsigned voffA[2], voffB[2];
#pragma unroll
    for (int i = 0; i < 2; ++i) { int R, C; stage_rc(tid * 16 + i * 8192, R, C); const int Rb = Epi::PERM ? ((R & ~31) + perm32(R & 31)) : R;
        voffA[i] = (unsigned)(R * K + C) * 2u; voffB[i] = (unsigned)(Rb * K + C) * 2u; }
    const size_t kstep = (size_t)(BK * 2);
    const size_t hstep = (size_t)HALF * K * 2;
    const size_t tstep = 2 * hstep;
    const unsigned ldsw = (unsigned)wid * 1024u;
    const int aoff = lds_byte(wr * 64 + fr, fq * 8), boff = lds_byte(wc * 32 + fr, fq * 8);
#define PG8_SA(b, h) (((b) * 2 + (h)) * HTB)
#define PG8_SB(b, h) ((4 + (b) * 2 + (h)) * HTB)
#define PG8_STAGE(bufoff, gbase, voff) do { _Pragma("unroll") for (int _i = 0; _i < 2; ++_i) \
        __builtin_amdgcn_global_load_lds((const unsigned*)((const char*)(gbase) + (voff)[_i]), (PG8_LAS unsigned*)(lds + (bufoff) + ldsw + _i * 8192), 16, 0, 0); } while (0)
#define PG8_LDA(dst, b, h) do { _Pragma("unroll") for (int m = 0; m < 4; ++m) _Pragma("unroll") for (int k = 0; k < 2; ++k) dst[m][k] = *(const PG8_LAS bf16x8*)(lds + PG8_SA(b, h) + aoff + m * 2048 + k * 1024); } while (0)
#define PG8_LDB(dst, b, h) do { _Pragma("unroll") for (int n = 0; n < 2; ++n) _Pragma("unroll") for (int k = 0; k < 2; ++k) dst[n][k] = *(const PG8_LAS bf16x8*)(lds + PG8_SB(b, h) + boff + n * 2048 + k * 1024); } while (0)
#define PG8_MMA(ai, bj, At, Bt) do { __builtin_amdgcn_s_setprio(1); _Pragma("unroll") for (int m = 0; m < 4; ++m) _Pragma("unroll") for (int n = 0; n < 2; ++n) _Pragma("unroll") for (int k = 0; k < 2; ++k) \
        acc[ai][bj][m][n] = __builtin_amdgcn_mfma_f32_16x16x32_bf16(Bt[n][k], At[m][k], acc[ai][bj][m][n], 0, 0, 0); __builtin_amdgcn_s_setprio(0); } while (0)
#define PG8_WAIT_V(n) asm volatile("s_waitcnt vmcnt(" #n ")" ::: "memory")
#define PG8_WAIT_L(n) asm volatile("s_waitcnt lgkmcnt(" #n ")" ::: "memory")
#define PG8_BAR __builtin_amdgcn_s_barrier()
#define PG8_SCHED __builtin_amdgcn_sched_barrier(0)
    Unit cur, nxt; int ui = 0;
    if (!S.next(0, cur)) return;
    f32x4 acc[2][2][4][2];
#pragma unroll
    for (int a = 0; a < 2; ++a)
#pragma unroll
        for (int b = 0; b < 2; ++b)
#pragma unroll
            for (int m = 0; m < 4; ++m)
#pragma unroll
                for (int n = 0; n < 2; ++n) acc[a][b][m][n] = (f32x4){0.f, 0.f, 0.f, 0.f};
    if constexpr (Epi::HAS_INIT) E.init(acc, cur, wr, wc, fr, fq);
    bf16x8 At[4][2], B0[2][2], B1[2][2];
    const char* cA = (const char*)g.A + (size_t)cur.pm * tstep; const char* cB = (const char*)g.Bt + (size_t)cur.pn * tstep;
    S.a_ready(cur);
    if constexpr (SP2) {
        PG8_STAGE(PG8_SB(0, 0), cB, voffB); PG8_STAGE(PG8_SB(0, 1), cB + hstep, voffB); PG8_STAGE(PG8_SA(0, 0), cA, voffA); PG8_STAGE(PG8_SA(0, 1), cA + hstep, voffA);
        if (wr == 1) PG8_BAR;
        PG8_WAIT_V(2); PG8_BAR;
        PG8_STAGE(PG8_SB(1, 0), cB + kstep, voffB); PG8_STAGE(PG8_SA(1, 0), cA + kstep, voffA); PG8_STAGE(PG8_SB(1, 1), cB + hstep + kstep, voffB);
        PG8_WAIT_V(6); PG8_BAR;
    } else {
        PG8_STAGE(PG8_SB(0, 0), cB, voffB); PG8_STAGE(PG8_SA(0, 0), cA, voffA); PG8_STAGE(PG8_SB(0, 1), cB + hstep, voffB); PG8_STAGE(PG8_SA(0, 1), cA + hstep, voffA);
        if (wr == 1) PG8_BAR;
        PG8_WAIT_V(4); PG8_BAR;
        PG8_STAGE(PG8_SB(1, 0), cB + kstep, voffB); PG8_STAGE(PG8_SA(1, 0), cA + kstep, voffA); PG8_STAGE(PG8_SB(1, 1), cB + hstep + kstep, voffB);
        PG8_WAIT_V(6); PG8_BAR;
    }
    for (;;) {
        const bool has_next = S.next(ui + 1, nxt);
        const char* nA = has_next ? (const char*)g.A + (size_t)nxt.pm * tstep : cA; const char* nB = has_next ? (const char*)g.Bt + (size_t)nxt.pn * tstep : cB;
        for (int t = 0; t < nt; t += 2) {
            const bool last = (t == nt - 2);
            const char* a1 = cA + (size_t)(t + 1) * kstep;
            const char* a2 = last ? nA : cA + (size_t)(t + 2) * kstep; const char* b2 = last ? nB : cB + (size_t)(t + 2) * kstep;
            const char* a3 = a2 + kstep; const char* b3 = b2 + kstep;
            if (last && has_next) S.a_ready(nxt);
            if constexpr (SP2) {
            PG8_LDB(B0, 0, 0); PG8_LDB(B1, 0, 1); PG8_SCHED; PG8_LDA(At, 0, 0); PG8_STAGE(PG8_SA(1, 1), a1 + hstep, voffA);
            PG8_WAIT_V(8); PG8_WAIT_L(0); PG8_BAR; PG8_MMA(0, 0, At, B0); PG8_MMA(0, 1, At, B1); PG8_BAR; PG8_SCHED;
            PG8_LDA(At, 0, 1); PG8_STAGE(PG8_SB(0, 0), b2, voffB); PG8_STAGE(PG8_SB(0, 1), b2 + hstep, voffB); PG8_STAGE(PG8_SA(0, 0), a2, voffA);
            PG8_WAIT_V(8); PG8_WAIT_L(0); PG8_BAR; PG8_MMA(1, 0, At, B0); PG8_MMA(1, 1, At, B1); PG8_BAR; PG8_SCHED;
            PG8_LDB(B0, 1, 0); PG8_LDB(B1, 1, 1); PG8_SCHED; PG8_LDA(At, 1, 0); PG8_STAGE(PG8_SA(0, 1), a2 + hstep, voffA);
            PG8_WAIT_V(8); PG8_WAIT_L(0); PG8_BAR; PG8_MMA(0, 0, At, B0); PG8_MMA(0, 1, At, B1); PG8_BAR; PG8_SCHED;
            PG8_LDA(At, 1, 1); PG8_STAGE(PG8_SB(1, 0), b3, voffB); PG8_STAGE(PG8_SB(1, 1), b3 + hstep, voffB); PG8_STAGE(PG8_SA(1, 0), a3, voffA);
            PG8_WAIT_V(8); PG8_WAIT_L(0); PG8_BAR; PG8_MMA(1, 0, At, B0); PG8_MMA(1, 1, At, B1); PG8_BAR; PG8_SCHED;
            } else {
            PG8_LDB(B0, 0, 0); PG8_SCHED; PG8_LDA(At, 0, 0); PG8_STAGE(PG8_SA(1, 1), a1 + hstep, voffA);
            PG8_WAIT_L(8); PG8_BAR; PG8_WAIT_L(0); PG8_MMA(0, 0, At, B0); PG8_BAR; PG8_SCHED;
            PG8_LDB(B1, 0, 1); PG8_STAGE(PG8_SB(0, 0), b2, voffB);
            PG8_BAR; PG8_WAIT_L(0); PG8_MMA(0, 1, At, B1); PG8_BAR;
            PG8_LDA(At, 0, 1); PG8_STAGE(PG8_SA(0, 0), a2, voffA);
            PG8_BAR; PG8_WAIT_L(0); PG8_MMA(1, 0, At, B0); PG8_BAR; PG8_SCHED;
            PG8_STAGE(PG8_SB(0, 1), b2 + hstep, voffB);
            PG8_WAIT_V(6); PG8_BAR; PG8_MMA(1, 1, At, B1); PG8_BAR;
            PG8_LDB(B0, 1, 0); PG8_SCHED; PG8_LDA(At, 1, 0); PG8_STAGE(PG8_SA(0, 1), a2 + hstep, voffA);
            PG8_WAIT_L(8); PG8_BAR; PG8_WAIT_L(0); PG8_MMA(0, 0, At, B0); PG8_BAR; PG8_SCHED;
            PG8_LDB(B1, 1, 1); PG8_STAGE(PG8_SB(1, 0), b3, voffB);
            PG8_BAR; PG8_WAIT_L(0); PG8_MMA(0, 1, At, B1); PG8_BAR;
            PG8_LDA(At, 1, 1); PG8_STAGE(PG8_SA(1, 0), a3, voffA);
            PG8_BAR; PG8_WAIT_L(0); PG8_MMA(1, 0, At, B0); PG8_BAR; PG8_SCHED;
            PG8_STAGE(PG8_SB(1, 1), b3 + hstep, voffB);
            PG8_WAIT_V(6); PG8_BAR; PG8_MMA(1, 1, At, B1); PG8_BAR;
            }
        }
        if constexpr (ALIGN_EPI) { if (wr == 0) PG8_BAR; }
        if constexpr (!Epi::AFTER_DRAIN) {
            const int l2 = phase_tid_fwd(lds_generic) & 63;
            E(acc, cur, wr, wc, l2 & 15, l2 >> 4); S.done(cur); }
        if (!has_next) break;
#pragma unroll
        for (int a = 0; a < 2; ++a)
#pragma unroll
            for (int b = 0; b < 2; ++b)
#pragma unroll
                for (int m = 0; m < 4; ++m)
#pragma unroll
                    for (int n = 0; n < 2; ++n) acc[a][b][m][n] = (f32x4){0.f, 0.f, 0.f, 0.f};
        if constexpr (Epi::HAS_INIT) E.init(acc, nxt, wr, wc, fr, fq);
        cur = nxt; cA = nA; cB = nB; ++ui;
        if constexpr (ALIGN_EPI) { if (wr == 1) PG8_BAR; }
    }
    PG8_WAIT_V(0);
    if constexpr (!ALIGN_EPI) { if (wr == 0) PG8_BAR; }
    PG8_BAR;
    if constexpr (Epi::AFTER_DRAIN) { E.fused(acc, cur, wr, wc, fr, fq, lds, wid, lane); S.done(cur); }
#undef PG8_SA
#undef PG8_SB
#undef PG8_STAGE
#undef PG8_LDA
#undef PG8_LDB
#undef PG8_MMA
#undef PG8_WAIT_V
#undef PG8_WAIT_L
#undef PG8_BAR
#undef PG8_SCHED
}
}


namespace fa {
#define FA_LAS __attribute__((address_space(3)))
typedef short bf16x8 __attribute__((ext_vector_type(8)));
typedef float f32x16 __attribute__((ext_vector_type(16)));
typedef float f32x2_t __attribute__((ext_vector_type(2)));
typedef __bf16 bf16x2_t __attribute__((ext_vector_type(2)));
typedef unsigned u32x4 __attribute__((ext_vector_type(4)));
__device__ __forceinline__ unsigned cvtpk(float lo, float hi) { f32x2_t v = {lo, hi}; bf16x2_t b = __builtin_convertvector(v, bf16x2_t); return __builtin_bit_cast(unsigned, b); }
__device__ __forceinline__ float max3f(float a, float b, float c) { float r; asm("v_max3_f32 %0, %1, %2, %3" : "=v"(r) : "v"(a), "v"(b), "v"(c)); return r; }
__device__ __forceinline__ float min2f(float a, float b) { float r; asm("v_min_f32 %0, %1, %2" : "=v"(r) : "v"(a), "v"(b)); return r; }
__device__ __forceinline__ float xhalf(float v, int lane) { return __int_as_float(__builtin_amdgcn_ds_bpermute((lane ^ 32) << 2, __float_as_int(v))); }
struct Tile { const bf16_t* kg; const bf16_t* vg; int key0; const bf16_t* kg2; };
template <int KS, int KIND, bool KB2, class TileFn>
__device__ __forceinline__ void attn_unit(FA_LAS unsigned char* lds, int tid, int ntiles, const TileFn& tile_of, const bf16_t* qrow, int qpos, float slope2,
                                          unsigned long long selbits, int kofs  , f32x16& o0_out, f32x16& o1_out, float& il_out, float& m_out, float& l_out) {
    constexpr int KBYTES = KB2 ? 8192 : 2 * KS * 1024;
    constexpr float THR = 8.f;
    const int lane = tid & 63, r32 = lane & 31, hi = lane >> 5;
    bf16x8 qf[KS];
#pragma unroll
    for (int ks = 0; ks < KS; ++ks) qf[ks] = *(const bf16x8*)(qrow + 16 * ks + 8 * hi);
    f32x16 o0, o1;
#pragma unroll
    for (int r = 0; r < 16; ++r) { o0[r] = 0.f; o1[r] = 0.f; }
    float mref = 0.f;
    f32x16 lacc;
#pragma unroll
    for (int r = 0; r < 16; ++r) lacc[r] = 0.f;
    const u32x4 ones_w = {0x3F803F80u, 0x3F803F80u, 0x3F803F80u, 0x3F803F80u}; const bf16x8 ones8 = __builtin_bit_cast(bf16x8, ones_w);
    static_assert(KBYTES == 8192, "every wave stages 1 KiB of K and 1 KiB of V per tile (the vmcnt arithmetic below counts 2 loads per wave and tile)");
    const int nv = KIND == 3 ? (qpos >= 31 ? ((qpos - 31) >> 4) + 1 : 0) : 0;
    FA_LAS unsigned char* wbase = lds + (tid >> 6) * 1024;
    auto stage = [&](const Tile& Tt, int slot) {
        const char* ksrc = (KB2 && tid >= 256) ? (const char*)Tt.kg2 + (tid - 256) * 16 : (const char*)Tt.kg + tid * 16;
        __builtin_amdgcn_global_load_lds((const unsigned*)ksrc, (FA_LAS unsigned*)(wbase + slot * 16384), 16, 0, 0);
        __builtin_amdgcn_global_load_lds((const unsigned*)((const char*)Tt.vg + tid * 16), (FA_LAS unsigned*)(wbase + slot * 16384 + 8192), 16, 0, 0);
    };
    asm volatile("s_waitcnt vmcnt(0)" ::: "memory");
    Tile T = tile_of(0), T1 = T;
    stage(T, 0);
    if (ntiles > 1) { T1 = tile_of(1); stage(T1, 1); asm volatile("s_waitcnt vmcnt(2)" ::: "memory"); } else asm volatile("s_waitcnt vmcnt(0)" ::: "memory");
    __builtin_amdgcn_s_barrier();
    int slot = 0;
    for (int i = 0; i < ntiles; ++i) {
        Tile T2 = T1;
        if (i + 2 < ntiles) { T2 = tile_of(i + 2); stage(T2, slot == 0 ? 2 : slot - 1); }
        unsigned lofs = slot * 16384 + r32 * 32 + hi * 16; asm volatile("" : "+v"(lofs));
        const FA_LAS unsigned char* Kl = lds + lofs + kofs; const FA_LAS unsigned char* Vl = lds + lofs + 8192;
        const int key0 = T.key0;
        bool act, full, bit = true; int lim; float base, slopek;
        if (KIND == 3) { lim = nv - 1 - key0 - 4 * hi; act = key0 < nv; full = key0 + 63 < nv;
                         slopek = slope2 * 16.f; base = slope2 * (float)(16 * (key0 + 4 * hi) + 31 - qpos); }
        else { lim = qpos - key0 - 4 * hi; act = key0 <= qpos; full = key0 + 63 <= qpos; slopek = slope2; base = slope2 * (float)(key0 + 4 * hi - qpos);
               if (KIND == 1) { bit = (selbits >> (key0 >> 6)) & 1ull; act = act && bit; if (!bit) lim = -100000; }
               if (KIND == 2) { act = act && (key0 + 63 > qpos - 512); full = full && (key0 > qpos - 512); } }
        if (__builtin_amdgcn_ballot_w64(act) != 0ull) {
            const bool allfull = __builtin_amdgcn_ballot_w64(full) == ~0ull;
            f32x16 s0, s1;
            const float bm = (KIND == 1 && !bit) ? -1e30f : base - mref;
#pragma unroll
            for (int r = 0; r < 16; ++r) { const int c0 = (r & 3) + 8 * (r >> 2); s0[r] = __builtin_fmaf(slopek, (float)c0, bm); s1[r] = __builtin_fmaf(slopek, (float)(c0 + 32), bm); }
#pragma unroll
            for (int ks = 0; ks < KS; ++ks) {
                const bf16x8 a0 = *(const FA_LAS bf16x8*)(Kl + ks * 1024);
                const bf16x8 a1 = *(const FA_LAS bf16x8*)(Kl + (KS + ks) * 1024);
                s0 = __builtin_amdgcn_mfma_f32_32x32x16_bf16(a0, qf[ks], s0, 0, 0, 0);
                s1 = __builtin_amdgcn_mfma_f32_32x32x16_bf16(a1, qf[ks], s1, 0, 0, 0);
            }
            if (!allfull) {
#pragma unroll
                for (int r = 0; r < 16; ++r) { const int c0 = (r & 3) + 8 * (r >> 2);
                    int p0 = min(lim - c0, 0), p1 = min(lim - c0 - 32, 0);
                    if (KIND == 2) { p0 += min(c0 - lim + 511, 0); p1 += min(c0 + 32 - lim + 511, 0); }
                    s0[r] = __builtin_fmaf((float)p0, 1e30f, s0[r]); s1[r] = __builtin_fmaf((float)p1, 1e30f, s1[r]); }
            }
            float mx = max3f(s0[0], s1[0], s0[1]);
            mx = max3f(mx, s1[1], s0[2]);
#pragma unroll
            for (int r = 2; r < 15; ++r) mx = max3f(mx, s1[r], s0[r + 1]);
            mx = max3f(mx, s1[15], s1[15]);
            mx = max3f(mx, xhalf(mx, lane), mx);
            if (__builtin_amdgcn_ballot_w64(mx > THR) != 0ull) {
                const float dl = __builtin_fmaxf(mx, 0.f), f = __builtin_amdgcn_exp2f(-dl);
                mref += dl;
#pragma unroll
                for (int r = 0; r < 16; ++r) { s0[r] -= dl; s1[r] -= dl; o0[r] *= f; o1[r] *= f; lacc[r] *= f; }
            }
#pragma unroll
            for (int r = 0; r < 16; ++r) { s0[r] = __builtin_amdgcn_exp2f(s0[r]); s1[r] = __builtin_amdgcn_exp2f(s1[r]); }
#pragma unroll
            for (int kb = 0; kb < 2; ++kb)
#pragma unroll
                for (int sp = 0; sp < 2; ++sp) {
                    u32x4 pw;
                    if (kb == 0) { pw.x = cvtpk(s0[8 * sp + 0], s0[8 * sp + 1]); pw.y = cvtpk(s0[8 * sp + 2], s0[8 * sp + 3]); pw.z = cvtpk(s0[8 * sp + 4], s0[8 * sp + 5]); pw.w = cvtpk(s0[8 * sp + 6], s0[8 * sp + 7]); }
                    else         { pw.x = cvtpk(s1[8 * sp + 0], s1[8 * sp + 1]); pw.y = cvtpk(s1[8 * sp + 2], s1[8 * sp + 3]); pw.z = cvtpk(s1[8 * sp + 4], s1[8 * sp + 5]); pw.w = cvtpk(s1[8 * sp + 6], s1[8 * sp + 7]); }
                    const bf16x8 pf = __builtin_bit_cast(bf16x8, pw);
                    const bf16x8 v0 = *(const FA_LAS bf16x8*)(Vl + ((kb * 2 + sp) * 2 + 0) * 1024);
                    const bf16x8 v1 = *(const FA_LAS bf16x8*)(Vl + ((kb * 2 + sp) * 2 + 1) * 1024);
                    o0 = __builtin_amdgcn_mfma_f32_32x32x16_bf16(v0, pf, o0, 0, 0, 0);
                    o1 = __builtin_amdgcn_mfma_f32_32x32x16_bf16(v1, pf, o1, 0, 0, 0);
                    lacc = __builtin_amdgcn_mfma_f32_32x32x16_bf16(ones8, pf, lacc, 0, 0, 0);
                }
        }
        if (i + 2 < ntiles) asm volatile("s_waitcnt vmcnt(2)" ::: "memory"); else asm volatile("s_waitcnt vmcnt(0)" ::: "memory");
        asm volatile("s_waitcnt lgkmcnt(0)" ::: "memory");
        __builtin_amdgcn_s_barrier();
        T = T1; T1 = T2; slot = slot == 2 ? 0 : slot + 1;
    }
    const float lt = lacc[0];
    const bool rowvalid = KIND == 3 ? nv > 0 : true;
    const float il = (rowvalid && lt > 0.f) ? 1.f / lt : 0.f;
    m_out = mref; l_out = lt; il_out = il; o0_out = o0; o1_out = o1;
}
__device__ __forceinline__ void store_o_f32(float* orow, const f32x16& o0, const f32x16& o1, float il, int hi) {
#pragma unroll
    for (int g = 0; g < 4; ++g) {
        const int d = 8 * g + 4 * hi;
        *(float4*)(orow + d) = make_float4(o0[4 * g] * il, o0[4 * g + 1] * il, o0[4 * g + 2] * il, o0[4 * g + 3] * il);
        *(float4*)(orow + 32 + d) = make_float4(o1[4 * g] * il, o1[4 * g + 1] * il, o1[4 * g + 2] * il, o1[4 * g + 3] * il);
    }
}
__device__ __forceinline__ void store_normed_bf16(bf16_t* mrow, const f32x16& v0, const f32x16& v1, const float* gain64, float scale, int lane, int hi) {
    float ss = 0.f;
#pragma unroll
    for (int r = 0; r < 16; ++r) ss += v0[r] * v0[r] + v1[r] * v1[r];
    ss += xhalf(ss, lane);
    const float rr = rsqrtf(ss * (1.f / 64) + 1e-6f) * scale;
#pragma unroll
    for (int g = 0; g < 4; ++g) {
        const int d = 8 * g + 4 * hi;
        const float4 g0 = *(const float4*)(gain64 + d), g1 = *(const float4*)(gain64 + 32 + d);
        uint2 w0, w1;
        w0.x = cvtpk(v0[4 * g] * rr * g0.x, v0[4 * g + 1] * rr * g0.y); w0.y = cvtpk(v0[4 * g + 2] * rr * g0.z, v0[4 * g + 3] * rr * g0.w);
        w1.x = cvtpk(v1[4 * g] * rr * g1.x, v1[4 * g + 1] * rr * g1.y); w1.y = cvtpk(v1[4 * g + 2] * rr * g1.z, v1[4 * g + 3] * rr * g1.w);
        *(uint2*)(mrow + d) = w0; *(uint2*)(mrow + 32 + d) = w1;
    }
}
}


namespace scan {
typedef short bf16x8 __attribute__((ext_vector_type(8)));
typedef float f32x16 __attribute__((ext_vector_type(16)));
__device__ __forceinline__ int spos(int s) { const int s16 = s & 15; return (s & ~15) + 8 * ((s16 >> 2) & 1) + (((s16 >> 3) << 2) | (s16 & 3)); }
__device__ __forceinline__ float xhalf(float v, int lane) { return __int_as_float(__builtin_amdgcn_ds_bpermute((lane ^ 32) << 2, __float_as_int(v))); }
constexpr size_t A8 = (size_t)MT * 256 * 2, SM = (size_t)1024 * 64 * 4;
template <int MIX> struct BufsT {
    char* r1; char* r2;
    static constexpr size_t R1OFF = MIX == 0 ? 0 : 6 * A8 + 5 * SM;
    __device__ __forceinline__ bf16_t* QA() const { return (bf16_t*)(r1 + R1OFF); }
    __device__ __forceinline__ bf16_t* KA() const { return (bf16_t*)(r1 + R1OFF + A8); }
    __device__ __forceinline__ bf16_t* KAT() const { return (bf16_t*)(r1 + R1OFF + 2 * A8); }
    __device__ __forceinline__ char* rest() const { return MIX == 0 ? r1 + 3 * A8 : r2; }
    __device__ __forceinline__ bf16_t* VT() const { return (bf16_t*)(rest()); }
    __device__ __forceinline__ bf16_t* Ub() const { return (bf16_t*)(rest() + A8); }
    __device__ __forceinline__ bf16_t* Sp() const { return (bf16_t*)(rest() + 2 * A8); }
    __device__ __forceinline__ float* Un() const { return (float*)(rest() + 3 * A8); }
    __device__ __forceinline__ float* np() const { return (float*)(rest() + 3 * A8 + SM); }
    __device__ __forceinline__ float* dL() const { return (float*)(rest() + 3 * A8 + 2 * SM); }
    __device__ __forceinline__ float* dmid() const { return (float*)(rest() + 3 * A8 + 3 * SM); }
    __device__ __forceinline__ float* dLm() const { return (float*)(rest() + 3 * A8 + 4 * SM); }
};

__host__ __device__ constexpr int spos_c(int s) { return (s & ~15) + 8 * (((s & 15) >> 2) & 1) + ((((s & 15) >> 3) << 2) | (s & 3)); }
template <int MIX>
__device__ __forceinline__ void prep_k(const bf16_t* P, const float* convw, const float* gbias, const float* lbp, int layer, const BufsT<MIX>& B, int idx) {
    const int k = idx & 63, ci = idx >> 6, h = ci & 3, chunk = ci >> 2, c = chunk & 63, lane = k;
    const size_t m0 = (size_t)chunk * 64;
    unsigned kapk[32];
    float bL, bmid;
    if (MIX == 1) {
        float lb = 0.f; if (layer == 1) lb = sigmoidf_(lbp[256 + h * 64 + k] - lbp[h * 64 + k]);
        const bf16_t* zc = P + m0 * LDP + PC_CF + h * 64 + k; const bf16_t* qc = P + m0 * LDP + PC_CQ + h * 64 + k;
        float bc[64], kr[64];
        {   bf16_t zr[64];
#pragma unroll
            for (int s = 0; s < 64; ++s) zr[s] = zc[(size_t)s * LDP];
            float bs = 0.f;
#pragma unroll
            for (int s = 0; s < 64; ++s) { const float f = lb + (1.f - lb) * sigmoidf_(bf2f(zr[s])); bs += __logf(f); bc[s] = bs; kr[s] = 1.f - f; } }
        bmid = bc[31]; bL = bc[63];
#pragma unroll
        for (int g = 0; g < 4; ++g) {
            bf16_t qr[16];
#pragma unroll
            for (int i = 0; i < 16; ++i) qr[i] = qc[(size_t)(16 * g + i) * LDP];
#pragma unroll
            for (int i = 0; i < 16; ++i) { const int s2 = 16 * g + i; const size_t m = m0 + s2;
                const float qa = siluf_(bf2f(qr[i])) * __expf(bc[s2] - bmid), ka = kr[s2] * __expf(bmid - bc[s2]);
                const unsigned kab = f2bf(ka);
                B.QA()[m * 256 + h * 64 + k] = f2bf(qa); B.KA()[m * 256 + h * 64 + k] = (bf16_t)kab;
                const int p = spos_c(s2); if (p & 1) kapk[p >> 1] |= kab << 16; else kapk[p >> 1] = kab; }
        }
    } else {
        const float bi = gbias[h], bfz = gbias[4 + h];
        const float fpre = bf2f(P[(m0 + lane) * LDP + PC_BF + h]) + bfz, ipre = bf2f(P[(m0 + lane) * LDP + PC_BI + h]) + bi;
        float gsum = -log1pf(__expf(-fpre));
#pragma unroll
        for (int o = 1; o < 64; o <<= 1) { const float y = __int_as_float(__builtin_amdgcn_ds_bpermute(((lane - o) & 63) << 2, __float_as_int(gsum))); if (lane >= o) gsum += y; }
        bmid = rdlane(gsum, 31); bL = rdlane(gsum, 63);
        const float ea = __expf(gsum - bmid), eb = __expf(bmid - gsum + ipre);
        const bf16_t* qc = P + m0 * LDP + PC_BQ + h * 64 + k; const bf16_t* kc = P + m0 * LDP + PC_BK + h * 64 + k;
        float wq[4], wk[4];
#pragma unroll
        for (int j = 0; j < 4; ++j) { wq[j] = convw[j * 512 + h * 64 + k]; wk[j] = convw[j * 512 + 256 + h * 64 + k]; }
        float q1 = 0.f, q2 = 0.f, q3 = 0.f, k1 = 0.f, k2 = 0.f, k3 = 0.f;
        if (c > 0) { q1 = bf2f(*(qc - (size_t)1 * LDP)); q2 = bf2f(*(qc - (size_t)2 * LDP)); q3 = bf2f(*(qc - (size_t)3 * LDP));
                     k1 = bf2f(*(kc - (size_t)1 * LDP)); k2 = bf2f(*(kc - (size_t)2 * LDP)); k3 = bf2f(*(kc - (size_t)3 * LDP)); }
#pragma unroll
        for (int g = 0; g < 4; ++g) {
            bf16_t qr[16], kr2[16];
#pragma unroll
            for (int i = 0; i < 16; ++i) { qr[i] = qc[(size_t)(16 * g + i) * LDP]; kr2[i] = kc[(size_t)(16 * g + i) * LDP]; }
#pragma unroll
            for (int i = 0; i < 16; ++i) { const int s2 = 16 * g + i; const size_t m = m0 + s2;
                const float q0 = bf2f(qr[i]), k0 = bf2f(kr2[i]);
                const float qv = wq[3] * q0 + wq[2] * q1 + wq[1] * q2 + wq[0] * q3, kv = wk[3] * k0 + wk[2] * k1 + wk[1] * k2 + wk[0] * k3;
                q3 = q2; q2 = q1; q1 = q0; k3 = k2; k2 = k1; k1 = k0;
                const float qa = siluf_(qv) * 0.125f * rdlane(ea, s2), ka = siluf_(kv) * rdlane(eb, s2);
                const unsigned kab = f2bf(ka);
                B.QA()[m * 256 + h * 64 + k] = f2bf(qa); B.KA()[m * 256 + h * 64 + k] = (bf16_t)kab;
                const int p = spos_c(s2); if (p & 1) kapk[p >> 1] |= kab << 16; else kapk[p >> 1] = kab; }
        }
    }
    uint4* kat = (uint4*)(B.KAT() + ((size_t)ci * 64 + k) * 64);
#pragma unroll
    for (int i = 0; i < 8; ++i) kat[i] = make_uint4(kapk[4 * i], kapk[4 * i + 1], kapk[4 * i + 2], kapk[4 * i + 3]);
    B.dL()[ci * 64 + k] = __expf(bL); B.dmid()[ci * 64 + k] = __expf(bmid); B.dLm()[ci * 64 + k] = __expf(bL - bmid);
}
__device__ __forceinline__ void prep_v(const bf16_t* P, int pcol, bf16_t* VT, int idx) {
    const int e = idx & 63, ci = idx >> 6, h = ci & 3; const size_t m0 = (size_t)(ci >> 2) * 64;
    const bf16_t* vc = P + m0 * LDP + pcol + h * 64 + e;
    bf16_t vr[64];
#pragma unroll
    for (int s = 0; s < 64; ++s) vr[s] = vc[(size_t)s * LDP];
    unsigned pk[32];
#pragma unroll
    for (int s = 0; s < 64; ++s) { const int p = spos_c(s); if (p & 1) pk[p >> 1] |= (unsigned)vr[s] << 16; else pk[p >> 1] = vr[s]; }
    uint4* vt = (uint4*)(VT + ((size_t)ci * 64 + e) * 64);
#pragma unroll
    for (int i = 0; i < 8; ++i) vt[i] = make_uint4(pk[4 * i], pk[4 * i + 1], pk[4 * i + 2], pk[4 * i + 3]);
}
template <int MIX>
__device__ __forceinline__ void stepA(const BufsT<MIX>& B, int ci, int lane) {
    const int r32 = lane & 31, hi = lane >> 5;
    const bf16_t* vt = B.VT() + (size_t)ci * 4096; const bf16_t* kat = B.KAT() + (size_t)ci * 4096;
    f32x16 acc[2][2];
#pragma unroll
    for (int a = 0; a < 2; ++a)
#pragma unroll
        for (int b = 0; b < 2; ++b)
#pragma unroll
            for (int r = 0; r < 16; ++r) acc[a][b][r] = 0.f;
    float nsum[2] = {0.f, 0.f};
#pragma unroll
    for (int g = 0; g < 4; ++g) {
        bf16x8 a[2], bb[2];
#pragma unroll
        for (int et = 0; et < 2; ++et) a[et] = *(const bf16x8*)(vt + (32 * et + r32) * 64 + 16 * g + 8 * hi);
#pragma unroll
        for (int kt = 0; kt < 2; ++kt) { bb[kt] = *(const bf16x8*)(kat + (32 * kt + r32) * 64 + 16 * g + 8 * hi);
            if (MIX == 0) {
#pragma unroll
                for (int j = 0; j < 8; ++j) nsum[kt] += bf2f((bf16_t)bb[kt][j]); } }
#pragma unroll
        for (int et = 0; et < 2; ++et)
#pragma unroll
            for (int kt = 0; kt < 2; ++kt) acc[et][kt] = __builtin_amdgcn_mfma_f32_32x32x16_bf16(a[et], bb[kt], acc[et][kt], 0, 0, 0);
    }
#pragma unroll
    for (int kt = 0; kt < 2; ++kt) {
        const float dl = B.dLm()[ci * 64 + 32 * kt + r32];
#pragma unroll
        for (int et = 0; et < 2; ++et)
#pragma unroll
            for (int r = 0; r < 16; ++r) { const int e = 32 * et + (r & 3) + 8 * (r >> 2) + 4 * hi; B.Ub()[((size_t)ci * 64 + e) * 64 + 32 * kt + r32] = f2bf(acc[et][kt][r] * dl); }
        if (MIX == 0) { const float ns = nsum[kt] + xhalf(nsum[kt], lane); if (hi == 0) B.Un()[ci * 64 + 32 * kt + r32] = ns * dl; }
    }
}
template <int MIX>
__device__ __forceinline__ void stepB(const BufsT<MIX>& B, int idx) {
    const int k = idx & 63, e = (idx >> 6) & 63, bh = idx >> 12, h = bh & 3, b = bh >> 2;
    const bool nrow = MIX == 0 && e == 0;
    float S = 0.f, Sn = 0.f;
#pragma unroll 1
    for (int c0 = 0; c0 < 64; c0 += 16) {
        float dm[16], dl[16], u[16], un[16];
#pragma unroll
        for (int i = 0; i < 16; ++i) { const int ci = (b * 64 + c0 + i) * 4 + h; dm[i] = B.dmid()[ci * 64 + k]; dl[i] = B.dL()[ci * 64 + k];
            u[i] = bf2f(B.Ub()[((size_t)ci * 64 + e) * 64 + k]); un[i] = 0.f;
            if (MIX == 0) { if (nrow) un[i] = B.Un()[ci * 64 + k]; } }
#pragma unroll
        for (int i = 0; i < 16; ++i) { const int ci = (b * 64 + c0 + i) * 4 + h;
            B.Sp()[((size_t)ci * 64 + e) * 64 + k] = f2bf(S * dm[i]);
            if (MIX == 0) { if (nrow) B.np()[ci * 64 + k] = Sn * dm[i]; Sn = dl[i] * Sn + un[i]; }
            S = dl[i] * S + u[i]; }
    }
}
template <int MIX>
__device__ __forceinline__ void stepC(const BufsT<MIX>& B, const bf16_t* P, int gatecol, const float* outg, bf16_t* mixed, int mixcol, int ci, int lane) {
    const int r32 = lane & 31, hi = lane >> 5, h = ci & 3; const size_t m0 = (size_t)(ci >> 2) * 64;
    const bf16_t* vt = B.VT() + (size_t)ci * 4096; const bf16_t* sp = B.Sp() + (size_t)ci * 4096;
#pragma unroll
    for (int tt = 0; tt < 2; ++tt) {
        bf16x8 qf[4], kf[2][4], vf[2][2][2], sf[4][2];
#pragma unroll
        for (int ks = 0; ks < 4; ++ks) qf[ks] = *(const bf16x8*)(B.QA() + (m0 + 32 * tt + r32) * 256 + h * 64 + 16 * ks + 8 * hi);
#pragma unroll
        for (int st = 0; st <= tt; ++st) {
#pragma unroll
            for (int ks = 0; ks < 4; ++ks) kf[st][ks] = *(const bf16x8*)(B.KA() + (m0 + 32 * st + r32) * 256 + h * 64 + 16 * ks + 8 * hi);
#pragma unroll
            for (int s2 = 0; s2 < 2; ++s2)
#pragma unroll
                for (int et = 0; et < 2; ++et) vf[st][s2][et] = *(const bf16x8*)(vt + (32 * et + r32) * 64 + 32 * st + 16 * s2 + 8 * hi); }
#pragma unroll
        for (int ks = 0; ks < 4; ++ks)
#pragma unroll
            for (int et = 0; et < 2; ++et) sf[ks][et] = *(const bf16x8*)(sp + (32 * et + r32) * 64 + 16 * ks + 8 * hi);
        f32x16 o[2];
#pragma unroll
        for (int r = 0; r < 16; ++r) { o[0][r] = 0.f; o[1][r] = 0.f; }
        float den = 0.f;
#pragma unroll
        for (int st = 0; st <= tt; ++st) {
            f32x16 pt;
#pragma unroll
            for (int r = 0; r < 16; ++r) pt[r] = 0.f;
#pragma unroll
            for (int ks = 0; ks < 4; ++ks) pt = __builtin_amdgcn_mfma_f32_32x32x16_bf16(kf[st][ks], qf[ks], pt, 0, 0, 0);
            if (st == tt) {
#pragma unroll
                for (int r = 0; r < 16; ++r) { const int sl = (r & 3) + 8 * (r >> 2) + 4 * hi; pt[r] = sl <= r32 ? pt[r] : 0.f; } }
            if (MIX == 0) {
#pragma unroll
                for (int r = 0; r < 16; ++r) den += pt[r]; }
#pragma unroll
            for (int s2 = 0; s2 < 2; ++s2) {
                fa::u32x4 pw; pw.x = fa::cvtpk(pt[8 * s2 + 0], pt[8 * s2 + 1]); pw.y = fa::cvtpk(pt[8 * s2 + 2], pt[8 * s2 + 3]); pw.z = fa::cvtpk(pt[8 * s2 + 4], pt[8 * s2 + 5]); pw.w = fa::cvtpk(pt[8 * s2 + 6], pt[8 * s2 + 7]);
                const bf16x8 pf = __builtin_bit_cast(bf16x8, pw);
#pragma unroll
                for (int et = 0; et < 2; ++et) o[et] = __builtin_amdgcn_mfma_f32_32x32x16_bf16(vf[st][s2][et], pf, o[et], 0, 0, 0);
            }
        }
#pragma unroll
        for (int ks = 0; ks < 4; ++ks)
#pragma unroll
            for (int et = 0; et < 2; ++et) o[et] = __builtin_amdgcn_mfma_f32_32x32x16_bf16(sf[ks][et], qf[ks], o[et], 0, 0, 0);
        if (MIX == 0) {
#pragma unroll
            for (int ks = 0; ks < 4; ++ks)
#pragma unroll
                for (int j = 0; j < 8; ++j) den += bf2f((bf16_t)qf[ks][j]) * B.np()[ci * 64 + 16 * ks + 8 * hi + j];
            den += xhalf(den, lane);
            const float sc = 1.f / __builtin_fmaxf(__builtin_fabsf(den), 1.f);
#pragma unroll
            for (int r = 0; r < 16; ++r) { o[0][r] *= sc; o[1][r] *= sc; }
        }
        float ss = 0.f;
#pragma unroll
        for (int r = 0; r < 16; ++r) ss += o[0][r] * o[0][r] + o[1][r] * o[1][r];
        ss += xhalf(ss, lane);
        const float rr = rsqrtf(ss * (1.f / 64) + EPS);
        const size_t m = m0 + 32 * tt + r32;
#pragma unroll
        for (int et = 0; et < 2; ++et)
#pragma unroll
            for (int g = 0; g < 4; ++g) {
                const int e = 32 * et + 8 * g + 4 * hi;
                const uint2 gt2 = *(const uint2*)(P + m * LDP + gatecol + h * 64 + e);
                const float4 og = *(const float4*)(outg + h * 64 + e);
                const float g0 = sigmoidf_(__uint_as_float(gt2.x << 16)), g1 = sigmoidf_(__uint_as_float(gt2.x & 0xffff0000u)),
                            g2 = sigmoidf_(__uint_as_float(gt2.y << 16)), g3 = sigmoidf_(__uint_as_float(gt2.y & 0xffff0000u));
                uint2 w; w.x = pk2bf(o[et][4 * g] * rr * og.x * g0, o[et][4 * g + 1] * rr * og.y * g1); w.y = pk2bf(o[et][4 * g + 2] * rr * og.z * g2, o[et][4 * g + 3] * rr * og.w * g3);
                *(uint2*)(mixed + m * DM + mixcol + h * 64 + e) = w;
            }
    }
}
}

template <int N> struct IntC { static constexpr int value = N; };
struct Params {
    const float* x_in; const float* norm_mix; const float* norm_ffn; const float* w_in; const float* w_out;
    const float* diff_q_gain; const float* diff_k_gain; const float* diff_lambda; const float* diff_sub_gain;
    const float* mlstm_conv; const float* mlstm_gate_bias; const float* mlstm_out_gain; const float* hgrn_lb; const float* hgrn_out_gain;
    const float* nsa_cmp_pos; const float* nsa_cmp_w1; const float* nsa_cmp_w2; const float* nsa_q_gain; const float* nsa_k_gain; const float* nsa_out_gain;
    const float* moe_w_group; const float* moe_b_group; const float* moe_w_expert; const float* moe_b_expert;
    const float* moe_w_gate; const float* moe_w_up; const float* moe_w_down;
    float* out; char* ws;
};


constexpr int LDS_TIDTAB = LDS_BYTES - 512;
__device__ __forceinline__ int hw_wave_slot() { return (int)(__builtin_amdgcn_s_getreg((5 << 11) | 4) & 63u); }
__device__ __forceinline__ int lane_id_fresh() { unsigned ones = ~0u; asm volatile("" : "+s"(ones)); return (int)__builtin_amdgcn_mbcnt_hi(ones, __builtin_amdgcn_mbcnt_lo(ones, 0u)); }
__device__ __forceinline__ int phase_tid(const unsigned char* lds_generic) {
    const __attribute__((address_space(3))) int* tab = (const __attribute__((address_space(3))) int*)((const __attribute__((address_space(3))) unsigned char*)lds_generic + LDS_TIDTAB);
    const int w = __builtin_amdgcn_readfirstlane(tab[hw_wave_slot()]);
    return w * 64 + lane_id_fresh();
}

__device__ __forceinline__ int phase_tid_fwd(const unsigned char* lds_generic) { return phase_tid(lds_generic); }

constexpr size_t al256(size_t x) { return (x + 255) & ~(size_t)255; }
constexpr size_t WS_P = 0;
constexpr size_t WS_TB = WS_P + al256((size_t)MT * LDP * 2);
constexpr size_t WS_MIXED = WS_TB + al256((size_t)MT * DM * 2);
constexpr size_t WS_DQ = WS_MIXED + al256((size_t)MT * DM * 2);
constexpr size_t WS_DK = WS_DQ + al256((size_t)MT * 256 * 4);
constexpr size_t WS_NQ = WS_DK + al256((size_t)MT * 256 * 4);
constexpr size_t WS_KSN = WS_NQ + al256((size_t)MT * 256 * 4);
constexpr size_t WS_KWN = WS_KSN + al256((size_t)MT * 64 * 4);
constexpr size_t WS_CMP = WS_KWN + al256((size_t)MT * 64 * 4);
constexpr size_t WS_OCMP = WS_CMP + al256((size_t)2 * NB * NCMP * 64 * 4);
constexpr size_t WS_IMP = WS_OCMP + al256((size_t)MT * 256 * 4);
constexpr size_t WS_SELMASK = WS_IMP + al256((size_t)MT * 64 * 4);
constexpr size_t WS_RE = WS_SELMASK + al256((size_t)MT * 8);
constexpr size_t WS_RW = WS_RE + al256((size_t)MT * 2 * 4);
constexpr size_t WS_RS = WS_RW + al256((size_t)MT * 2 * 4);
constexpr int MOE_ROWS_MAX = 2 * MT + 32 * 256;
constexpr size_t WS_ROWTOK = WS_RS + al256((size_t)MT * 2 * 4);
constexpr size_t WS_ROWW = WS_ROWTOK + al256((size_t)MOE_ROWS_MAX * 4);
constexpr size_t WS_CNT = WS_ROWW + al256((size_t)MOE_ROWS_MAX * 4);
constexpr size_t WS_CNTBLK = WS_CNT + 256;
constexpr size_t WS_BAR = WS_CNTBLK + 1024 * 32 * 4;
constexpr size_t WS_WIN_T = WS_BAR + 32768;
constexpr size_t WS_WOUT_T = WS_WIN_T + 2 * al256((size_t)LDP * DM * 2);
constexpr size_t WS_W1T = WS_WOUT_T + 2 * al256((size_t)DM * DM * 2);
constexpr size_t WS_DGATE = WS_W1T + 2 * al256((size_t)2 * 64 * 2048 * 2);
constexpr size_t WS_END = WS_DGATE + al256((size_t)MT * 12 * 2);
static_assert((size_t)32 * 512 * DM * 2 + (size_t)32 * DM * 256 * 2 + (size_t)MOE_ROWS_MAX * 256 * 2 <= WS_TB, "MoE weight copies + H overlay P");
static_assert(WS_MIXED + (size_t)MOE_ROWS_MAX * DM * 2 <= WS_SELMASK, "sorted activations overlay mixed..imp");
#define W_P ((bf16_t*)(pq->ws + WS_P))
#define W_TB ((bf16_t*)(pq->ws + WS_TB))
#define W_MIXED ((bf16_t*)(pq->ws + WS_MIXED))
#define W_DQ ((float*)(pq->ws + WS_DQ))
#define W_DK ((float*)(pq->ws + WS_DK))
#define W_QBF ((bf16_t*)(pq->ws + WS_DQ))
#define W_DKF ((bf16_t*)(pq->ws + WS_DK))
#define W_DVF ((bf16_t*)(pq->ws + WS_DK + (size_t)MT * 256 * 2))
#define W_DO ((float*)(pq->ws + WS_TB))
#define W_NQ ((float*)(pq->ws + WS_NQ))
#define W_NQB ((bf16_t*)(pq->ws + WS_NQ))
#define W_KSF ((bf16_t*)(pq->ws + WS_KSN))
#define W_VSF ((bf16_t*)(pq->ws + WS_KSN + (size_t)MT * 64 * 2))
#define W_KWF ((bf16_t*)(pq->ws + WS_KWN))
#define W_VWF ((bf16_t*)(pq->ws + WS_KWN + (size_t)MT * 64 * 2))
#define W_KCF ((bf16_t*)(pq->ws + WS_CMP))
#define W_VCF ((bf16_t*)(pq->ws + WS_CMP + 131072))
#define W_QUEUE ((unsigned*)(pq->ws + WS_BAR + 16384))
#define W_KSN ((float*)(pq->ws + WS_KSN))
#define W_KWN ((float*)(pq->ws + WS_KWN))
#define W_CMP ((float*)(pq->ws + WS_CMP))
#define W_OCMP ((float*)(pq->ws + WS_OCMP))
#define W_IMP ((float*)(pq->ws + WS_IMP))
#define W_OSEL W_DQ
#define W_OWIN W_DK
#define W_SELMASK ((unsigned long long*)(pq->ws + WS_SELMASK))
#define W_RE ((int*)(pq->ws + WS_RE))
#define W_RW ((float*)(pq->ws + WS_RW))
#define W_RS ((int*)(pq->ws + WS_RS))
#define W_ROWTOK ((int*)(pq->ws + WS_ROWTOK))
#define W_ROWW ((float*)(pq->ws + WS_ROWW))
#define W_CNT ((int*)(pq->ws + WS_CNT))
#define W_CNTBLK ((int*)(pq->ws + WS_CNTBLK))
#define W_WGU_T ((bf16_t*)(pq->ws + WS_P))
#define W_WD_T ((bf16_t*)(pq->ws + WS_P + (size_t)32 * 512 * DM * 2))
#define W_HS ((bf16_t*)(pq->ws + WS_P + (size_t)32 * 512 * DM * 2 + (size_t)32 * DM * 256 * 2))
#define W_ASORT ((bf16_t*)(pq->ws + WS_MIXED))
#define W_YMOE ((bf16_t*)(pq->ws + WS_MIXED))

#define SCAN_BUFS(Bm, Bh) scan::BufsT<0> Bm{pq->ws + WS_DQ, pq->ws + WS_TB}; scan::BufsT<1> Bh{pq->ws + WS_DQ, pq->ws + WS_TB};
static_assert(WS_DQ + (size_t)9 * MT * 256 * 2 + (size_t)5 * 1024 * 64 * 4 <= WS_SELMASK, "scan overlay 1");
static_assert((size_t)3 * MT * 256 * 2 + (size_t)5 * 1024 * 64 * 4 <= (size_t)MT * DM * 2, "scan overlay 2");
#define W_WIN_T_L(L) ((bf16_t*)(pq->ws + WS_WIN_T + (size_t)(L) * al256((size_t)LDP * DM * 2)))
#define W_WIN_T W_WIN_T_L(l)
#define W_WOUT_T_L(L) ((bf16_t*)(pq->ws + WS_WOUT_T + (size_t)(L) * al256((size_t)DM * DM * 2)))
#define W_WOUT_T W_WOUT_T_L(l)
#define W_DGATE ((bf16_t*)(pq->ws + WS_DGATE))
#define W_W1T_L(L) ((bf16_t*)(pq->ws + WS_W1T + (size_t)(L) * al256((size_t)2 * 64 * 2048 * 2)))
#define W_W1T W_W1T_L(l)

__device__ __forceinline__ float4 bf4_to_f4(uint2 u) { return make_float4(__uint_as_float(u.x << 16), __uint_as_float(u.x & 0xffff0000u), __uint_as_float(u.y << 16), __uint_as_float(u.y & 0xffff0000u)); }
__device__ __forceinline__ void norm_row(float* x, const float* xsrc, const bf16_t* ymoe, const float* gain, bf16_t* t, int row, int lane) {
    const float4* xr = (const float4*)(xsrc + (size_t)row * DM);
    float4 v[4]; float s = 0.f;
#pragma unroll
    for (int j = 0; j < 4; ++j) { v[j] = xr[lane + 64 * j];
        if (ymoe) { const float4 a = bf4_to_f4(((const uint2*)(ymoe + (size_t)row * 2 * DM))[lane + 64 * j]), b = bf4_to_f4(((const uint2*)(ymoe + ((size_t)row * 2 + 1) * DM))[lane + 64 * j]);
            v[j].x += a.x + b.x; v[j].y += a.y + b.y; v[j].z += a.z + b.z; v[j].w += a.w + b.w; ((float4*)(x + (size_t)row * DM))[lane + 64 * j] = v[j]; }
        s += v[j].x * v[j].x + v[j].y * v[j].y + v[j].z * v[j].z + v[j].w * v[j].w; }
    const float r = rsqrtf(wave_sum(s, lane) * (1.f / DM) + EPS);
#pragma unroll
    for (int j = 0; j < 4; ++j) {
        const float4 g = ((const float4*)gain)[lane + 64 * j];
        ushort4 o; o.x = f2bf(v[j].x * r * g.x); o.y = f2bf(v[j].y * r * g.y); o.z = f2bf(v[j].z * r * g.z); o.w = f2bf(v[j].w * r * g.w);
        ((ushort4*)(t + (size_t)row * DM))[lane + 64 * j] = o;
    }
}


typedef __attribute__((address_space(3))) float lds_f32;
typedef unsigned v4u_t __attribute__((ext_vector_type(4)));
template <bool MAP>
__device__ __forceinline__ void transpose_item(const float* W, int K, int Nsrc, int Nnew, bf16_t* WT, lds_f32* scr, int item, int lane) {
    const int nblk = Nnew / 32, kb = item / nblk, nb = item % nblk, k0 = 64 * kb, n0 = 32 * nb;
    const int n = n0 + (lane & 31); const int sc = MAP ? src_col(n) : n; const bool ok = MAP ? (n < IN_COLS) : true;
    float tv[32];
#pragma unroll
    for (int i = 0; i < 32; ++i) { const int kk = 2 * i + (lane >> 5); tv[i] = ok ? W[(size_t)(k0 + kk) * Nsrc + sc] : 0.f; }
#pragma unroll
    for (int i = 0; i < 32; ++i) { const int kk = 2 * i + (lane >> 5); scr[kk * 33 + (lane & 31)] = tv[i]; }
    asm volatile("s_waitcnt lgkmcnt(0)" ::: "memory");
    const int c = lane & 7;
#pragma unroll
    for (int j = 0; j < 4; ++j) { const int nn = (lane >> 3) + 8 * j; const lds_f32* sp = scr + (8 * c) * 33 + nn;
        v4u_t o; o.x = pk2bf(sp[0 * 33], sp[1 * 33]); o.y = pk2bf(sp[2 * 33], sp[3 * 33]); o.z = pk2bf(sp[4 * 33], sp[5 * 33]); o.w = pk2bf(sp[6 * 33], sp[7 * 33]);
        *(v4u_t*)(WT + (size_t)(n0 + nn) * K + k0 + 8 * c) = o; }
    asm volatile("s_waitcnt lgkmcnt(0)" ::: "memory");
}

constexpr float LOG2E = 1.4426950408889634f;
__device__ __forceinline__ void diff_prep_qk(const bf16_t* P, const float* qgain, const float* kgain, bf16_t* Qbf, bf16_t* Kf, int idx) {
    const int m = idx >> 3, g = idx & 7;
    {   const uint4* p = (const uint4*)(P + (size_t)m * LDP + PC_AQ + g * 32); float v[32]; float ss = 0.f;
#pragma unroll
        for (int i = 0; i < 4; ++i) { const uint4 u = p[i]; const unsigned w[4] = {u.x, u.y, u.z, u.w};
#pragma unroll
            for (int j = 0; j < 4; ++j) { v[i * 8 + 2 * j] = __uint_as_float(w[j] << 16); v[i * 8 + 2 * j + 1] = __uint_as_float(w[j] & 0xffff0000u); } }
#pragma unroll
        for (int d = 0; d < 32; ++d) ss += v[d] * v[d];
        const float r = rsqrtf(ss * (1.f / 32) + EPS) * (0.17677669529663687f * LOG2E);
        uint4* o = (uint4*)(Qbf + (size_t)m * 256 + g * 32);
#pragma unroll
        for (int i = 0; i < 4; ++i) { uint4 u; u.x = pk2bf(v[i * 8 + 0] * r * qgain[i * 8 + 0], v[i * 8 + 1] * r * qgain[i * 8 + 1]); u.y = pk2bf(v[i * 8 + 2] * r * qgain[i * 8 + 2], v[i * 8 + 3] * r * qgain[i * 8 + 3]);
            u.z = pk2bf(v[i * 8 + 4] * r * qgain[i * 8 + 4], v[i * 8 + 5] * r * qgain[i * 8 + 5]); u.w = pk2bf(v[i * 8 + 6] * r * qgain[i * 8 + 6], v[i * 8 + 7] * r * qgain[i * 8 + 7]); o[i] = u; } }
    {   const uint4* p = (const uint4*)(P + (size_t)m * LDP + PC_AK + g * 32); float v[32]; float ss = 0.f;
#pragma unroll
        for (int i = 0; i < 4; ++i) { const uint4 u = p[i]; const unsigned w[4] = {u.x, u.y, u.z, u.w};
#pragma unroll
            for (int j = 0; j < 4; ++j) { v[i * 8 + 2 * j] = __uint_as_float(w[j] << 16); v[i * 8 + 2 * j + 1] = __uint_as_float(w[j] & 0xffff0000u); } }
#pragma unroll
        for (int d = 0; d < 32; ++d) ss += v[d] * v[d];
        const float r = rsqrtf(ss * (1.f / 32) + EPS);
        const int b = m / SEQ, t = m % SEQ, tile = t >> 6, kb = (t >> 5) & 1, rr = t & 31;
#pragma unroll
        for (int i = 0; i < 4; ++i) { uint4 u; u.x = pk2bf(v[i * 8 + 0] * r * kgain[i * 8 + 0], v[i * 8 + 1] * r * kgain[i * 8 + 1]); u.y = pk2bf(v[i * 8 + 2] * r * kgain[i * 8 + 2], v[i * 8 + 3] * r * kgain[i * 8 + 3]);
            u.z = pk2bf(v[i * 8 + 4] * r * kgain[i * 8 + 4], v[i * 8 + 5] * r * kgain[i * 8 + 5]); u.w = pk2bf(v[i * 8 + 6] * r * kgain[i * 8 + 6], v[i * 8 + 7] * r * kgain[i * 8 + 7]);
            const int ks = i >> 1, hh = i & 1;
            *(uint4*)(Kf + ((((((size_t)(b * 8 + g) * 64 + tile) * 2 + kb) * 2 + ks) * 32 + rr) * 2 + hh) * 8) = u; } }
}
__device__ __forceinline__ void vfrag_item(const bf16_t* P, int pcol, int hstride, int nheads, bf16_t* Vf, int idx) {
    const int hh = idx & 1, d32 = (idx >> 1) & 31, dblk = (idx >> 6) & 1, sp = (idx >> 7) & 1, kb = (idx >> 8) & 1, tile = (idx >> 9) & 63;
    const int bh = idx >> 15, h = bh % nheads, b = bh / nheads;
    const int key0 = 64 * tile + 32 * kb + 16 * sp + 4 * hh, col = pcol + h * hstride + dblk * 32 + d32;
    unsigned short e[8];
#pragma unroll
    for (int j = 0; j < 8; ++j) e[j] = P[(size_t)(b * SEQ + key0 + 8 * (j >> 2) + (j & 3)) * LDP + col];
    uint4 u; u.x = e[0] | ((unsigned)e[1] << 16); u.y = e[2] | ((unsigned)e[3] << 16); u.z = e[4] | ((unsigned)e[5] << 16); u.w = e[6] | ((unsigned)e[7] << 16);
    *(uint4*)(Vf + (size_t)idx * 8) = u;
}

__device__ __forceinline__ int kcf_off(int n, int d);
__device__ __forceinline__ int vcf_off(int n, int d);
__device__ __forceinline__ void nsa_compress_unit(FA_LAS unsigned char* lds, int tid, const bf16_t* P, const float* pos, const bf16_t* W1T, const float* w2, const float* kgain0, float* cmp, int item) {
    const int lane = tid & 63, wave = tid >> 6, r32 = lane & 31, hi = lane >> 5, j = item >> 5, rt = item & 31;
    const int pc = j == 0 ? PC_KC : PC_VC;
    {   const int R = min(rt * 32 + r32, NB * NCMP - 1), b = R / NCMP, n = R % NCMP;
        fa::f32x16 acc0, acc1;
#pragma unroll
        for (int r = 0; r < 16; ++r) { acc0[r] = 0.f; acc1[r] = 0.f; }
        const bf16_t* arow = P + (size_t)(b * SEQ + 16 * n) * LDP + pc;
#pragma unroll 4
        for (int ksl = 0; ksl < 16; ++ksl) {
            const int kbase = (wave * 16 + ksl) * 16 + 8 * hi, l = kbase >> 6, d = kbase & 63;
            const uint4 raw = *(const uint4*)(arow + (size_t)l * LDP + d);
            const float4 p0 = *(const float4*)(pos + (j * 32 + l) * 64 + d), p1 = *(const float4*)(pos + (j * 32 + l) * 64 + d + 4);
            fa::u32x4 aw;
            aw.x = pk2bf(__uint_as_float(raw.x << 16) + p0.x, __uint_as_float(raw.x & 0xffff0000u) + p0.y); aw.y = pk2bf(__uint_as_float(raw.y << 16) + p0.z, __uint_as_float(raw.y & 0xffff0000u) + p0.w);
            aw.z = pk2bf(__uint_as_float(raw.z << 16) + p1.x, __uint_as_float(raw.z & 0xffff0000u) + p1.y); aw.w = pk2bf(__uint_as_float(raw.w << 16) + p1.z, __uint_as_float(raw.w & 0xffff0000u) + p1.w);
            const fa::bf16x8 af = __builtin_bit_cast(fa::bf16x8, aw);
            const fa::bf16x8 b0 = *(const fa::bf16x8*)(W1T + (size_t)(j * 64 + r32) * 2048 + kbase), b1 = *(const fa::bf16x8*)(W1T + (size_t)(j * 64 + 32 + r32) * 2048 + kbase);
            acc0 = __builtin_amdgcn_mfma_f32_32x32x16_bf16(af, b0, acc0, 0, 0, 0);
            acc1 = __builtin_amdgcn_mfma_f32_32x32x16_bf16(af, b1, acc1, 0, 0, 0);
        }
        FA_LAS float* part = (FA_LAS float*)lds;
#pragma unroll
        for (int r = 0; r < 16; ++r) { const int row = (r & 3) + 8 * (r >> 2) + 4 * hi; part[(wave * 32 + row) * 64 + r32] = acc0[r]; part[(wave * 32 + row) * 64 + 32 + r32] = acc1[r]; }
    }
    __syncthreads();
    const int row = tid >> 4, c4 = (tid & 15) * 4;
    FA_LAS float* hidl = (FA_LAS float*)(lds + 65536);
    {   const FA_LAS float* part = (const FA_LAS float*)lds;
#pragma unroll
        for (int i = 0; i < 4; ++i) { float x = 0.f;
#pragma unroll
            for (int w = 0; w < 8; ++w) x += part[(w * 32 + row) * 64 + c4 + i];
            const float u = 0.7978845608028654f * (x + 0.044715f * x * x * x), th = 1.f - 2.f / (1.f + __expf(2.f * u));
            hidl[row * 64 + c4 + i] = 0.5f * x * (1.f + th); }
    }
    __syncthreads();
    float y[4] = {0.f, 0.f, 0.f, 0.f};
#pragma unroll 1
    for (int k0 = 0; k0 < 64; k0 += 16) {
        float4 wv[16];
#pragma unroll
        for (int u = 0; u < 16; ++u) wv[u] = *(const float4*)(w2 + (j * 64 + k0 + u) * 64 + c4);
#pragma unroll
        for (int u = 0; u < 16; ++u) { const float hv = hidl[row * 64 + k0 + u]; y[0] += hv * wv[u].x; y[1] += hv * wv[u].y; y[2] += hv * wv[u].z; y[3] += hv * wv[u].w; } }
    if (j == 0) { float ss = y[0] * y[0] + y[1] * y[1] + y[2] * y[2] + y[3] * y[3];
#pragma unroll
        for (int o = 1; o < 16; o <<= 1) ss += __int_as_float(__builtin_amdgcn_ds_bpermute((lane ^ o) << 2, __float_as_int(ss)));
        const float r = rsqrtf(ss * (1.f / 64) + EPS);
#pragma unroll
        for (int i = 0; i < 4; ++i) y[i] = y[i] * r * kgain0[c4 + i]; }
    const int R = rt * 32 + row;
    if (R < NB * NCMP) { const int b = R / NCMP, n = R % NCMP;
        bf16_t* dst = (bf16_t*)cmp + (size_t)j * 65536 + (size_t)b * 4 * 4096;
#pragma unroll
        for (int i = 0; i < 4; ++i) { if (j == 0) dst[kcf_off(n, c4 + i)] = f2bf(y[i]); else dst[vcf_off(n, c4 + i)] = f2bf(y[i]);
            if (n == NCMP - 1) { if (j == 0) dst[kcf_off(NCMP, c4 + i)] = 0; else dst[vcf_off(NCMP, c4 + i)] = 0; } } }
    __syncthreads();
}
__device__ __forceinline__ void moe_route_row(const float* x, const float* gain, const FA_LAS float* wl  , const float* bg, const float* be, bf16_t* t, int* re, float* rw, int* rs, FA_LAS int* cnt  ,
                                              int row, int lane) {
    const float4* xr = (const float4*)(x + (size_t)row * DM);
    float4 v[4]; float s = 0.f;
#pragma unroll
    for (int j = 0; j < 4; ++j) { v[j] = xr[lane + 64 * j]; s += v[j].x * v[j].x + v[j].y * v[j].y + v[j].z * v[j].z + v[j].w * v[j].w; }
    const float r = rsqrtf(wave_sum(s, lane) * (1.f / DM) + EPS);
    float lg[36];
#pragma unroll
    for (int o = 0; o < 36; ++o) lg[o] = 0.f;
#pragma unroll
    for (int j = 0; j < 4; ++j) {
        const float4 g = ((const float4*)gain)[lane + 64 * j];
        float tn[4] = {v[j].x * r * g.x, v[j].y * r * g.y, v[j].z * r * g.z, v[j].w * r * g.w};
        ushort4 o4; o4.x = f2bf(tn[0]); o4.y = f2bf(tn[1]); o4.z = f2bf(tn[2]); o4.w = f2bf(tn[3]);
        ((ushort4*)(t + (size_t)row * DM))[lane + 64 * j] = o4;
#pragma unroll
        for (int i = 0; i < 4; ++i) {
            const int k = (lane + 64 * j) * 4 + i;
            typedef float f32x4v __attribute__((ext_vector_type(4)));
            const FA_LAS f32x4v* wr = (const FA_LAS f32x4v*)(wl + (((j * 4 + i) * 64 + lane) * 36)); (void)k;
            const f32x4v w4 = wr[0];
            lg[0] += tn[i] * w4.x; lg[1] += tn[i] * w4.y; lg[2] += tn[i] * w4.z; lg[3] += tn[i] * w4.w;
#pragma unroll
            for (int e4 = 0; e4 < 8; ++e4) { const f32x4v w = wr[1 + e4];
                lg[4 + e4 * 4 + 0] += tn[i] * w.x; lg[4 + e4 * 4 + 1] += tn[i] * w.y; lg[4 + e4 * 4 + 2] += tn[i] * w.z; lg[4 + e4 * 4 + 3] += tn[i] * w.w; }
            asm volatile("" ::: "memory");
        }
    }
#pragma unroll
    for (int o = 0; o < 36; ++o) lg[o] = wave_sum(lg[o], lane);
    float gl[4]; float gmx = NEG; int gs = 0;
#pragma unroll
    for (int g = 0; g < 4; ++g) { gl[g] = lg[g] + bg[g]; if (gl[g] > gmx) { gmx = gl[g]; gs = g; } }
    float gz = 0.f;
#pragma unroll
    for (int g = 0; g < 4; ++g) gz += __expf(gl[g] - gmx);
    const float gprob = 1.f / gz;
    float el[8];
#pragma unroll
    for (int e = 0; e < 8; ++e) {
        const float a0 = lg[4 + e] + be[e], a1 = lg[12 + e] + be[8 + e], a2 = lg[20 + e] + be[16 + e], a3 = lg[28 + e] + be[24 + e];
        el[e] = gs == 0 ? a0 : (gs == 1 ? a1 : (gs == 2 ? a2 : a3));
    }
    float m1 = NEG; int i1 = 0;
#pragma unroll
    for (int e = 0; e < 8; ++e) if (el[e] > m1) { m1 = el[e]; i1 = e; }
    float m2 = NEG; int i2 = 0;
#pragma unroll
    for (int e = 0; e < 8; ++e) if (e != i1 && el[e] > m2) { m2 = el[e]; i2 = e; }
    const float p2 = __expf(m2 - m1);
    const float w1 = gprob / (1.f + p2), w2 = gprob * p2 / (1.f + p2);
    if (lane == 0) { const int e1 = gs * 8 + i1, e2 = gs * 8 + i2;
        re[row * 2] = e1; re[row * 2 + 1] = e2; rw[row * 2] = w1; rw[row * 2 + 1] = w2;
        rs[row * 2] = __hip_atomic_fetch_add(cnt + e1, 1, __ATOMIC_RELAXED, __HIP_MEMORY_SCOPE_WORKGROUP); rs[row * 2 + 1] = __hip_atomic_fetch_add(cnt + e2, 1, __ATOMIC_RELAXED, __HIP_MEMORY_SCOPE_WORKGROUP); }
}


constexpr int RT_RS = 1032;
constexpr int RT_IMG_BYTES = 2 * 36 * RT_RS * 2;
static_assert(RT_IMG_BYTES + 128 + 1024 <= LDS_TIDTAB, "router weight image + counters + sum-of-squares exchange fit below the LDS control words");
__device__ __forceinline__ void moe_route_round(FA_LAS unsigned char* lds, int tid, const float* x, const float* gain, const float* bg, const float* be, bf16_t* tb, int* re, float* rw, int* rs,
                                                int tile, bool valid) {
    const int lane = tid & 63, wave = tid >> 6, r32 = lane & 31, hi = lane >> 5, tsel = wave >> 2, kq = wave & 3;
    const FA_LAS bf16_t* wimg = (const FA_LAS bf16_t*)lds;
    FA_LAS int* cnt = (FA_LAS int*)(lds + RT_IMG_BYTES);
    FA_LAS float* ssx = (FA_LAS float*)(lds + RT_IMG_BYTES + 128);
    const int row = tile * 32 + r32;
    const float* xr = x + (size_t)(valid ? row : 0) * DM + 256 * kq + 8 * hi;
    float ss = 0.f;
    {   float4 xa[16], xb[16];
#pragma unroll
        for (int ks = 0; ks < 16; ++ks) { xa[ks] = *(const float4*)(xr + 16 * ks); xb[ks] = *(const float4*)(xr + 16 * ks + 4); }
#pragma unroll
        for (int ks = 0; ks < 16; ++ks) { const float4 a = xa[ks], b = xb[ks]; ss += (a.x * a.x + a.y * a.y) + (a.z * a.z + a.w * a.w) + (b.x * b.x + b.y * b.y) + (b.z * b.z + b.w * b.w); } }
    ss += fa::xhalf(ss, lane);
    if (hi == 0) ssx[(tsel * 4 + kq) * 32 + r32] = ss;
    __syncthreads();
    const float rstd = rsqrtf(((ssx[(tsel * 4 + 0) * 32 + r32] + ssx[(tsel * 4 + 1) * 32 + r32]) + (ssx[(tsel * 4 + 2) * 32 + r32] + ssx[(tsel * 4 + 3) * 32 + r32])) * (1.f / DM) + EPS);
    fa::f32x16 acc0, acc1;
#pragma unroll
    for (int r = 0; r < 16; ++r) { acc0[r] = 0.f; acc1[r] = 0.f; }
    const FA_LAS bf16_t* whi0 = wimg + r32 * RT_RS + 256 * kq + 8 * hi; const FA_LAS bf16_t* whi1 = wimg + min(32 + r32, 35) * RT_RS + 256 * kq + 8 * hi;
    const FA_LAS bf16_t* wlo0 = whi0 + 36 * RT_RS; const FA_LAS bf16_t* wlo1 = whi1 + 36 * RT_RS;
    bf16_t* trow = tb + (size_t)row * DM + 256 * kq + 8 * hi;
    const float* gq = gain + 256 * kq + 8 * hi;
#pragma unroll 4
    for (int ks = 0; ks < 16; ++ks) {
        const float4 a = *(const float4*)(xr + 16 * ks), b = *(const float4*)(xr + 16 * ks + 4);
        const float4 ga = *(const float4*)(gq + 16 * ks), gb = *(const float4*)(gq + 16 * ks + 4);
        const float t[8] = {a.x * rstd * ga.x, a.y * rstd * ga.y, a.z * rstd * ga.z, a.w * rstd * ga.w, b.x * rstd * gb.x, b.y * rstd * gb.y, b.z * rstd * gb.z, b.w * rstd * gb.w};
        fa::u32x4 ph, pl;
        ph.x = fa::cvtpk(t[0], t[1]); ph.y = fa::cvtpk(t[2], t[3]); ph.z = fa::cvtpk(t[4], t[5]); ph.w = fa::cvtpk(t[6], t[7]);
        pl.x = fa::cvtpk(t[0] - __uint_as_float(ph.x << 16), t[1] - __uint_as_float(ph.x & 0xffff0000u)); pl.y = fa::cvtpk(t[2] - __uint_as_float(ph.y << 16), t[3] - __uint_as_float(ph.y & 0xffff0000u));
        pl.z = fa::cvtpk(t[4] - __uint_as_float(ph.z << 16), t[5] - __uint_as_float(ph.z & 0xffff0000u)); pl.w = fa::cvtpk(t[6] - __uint_as_float(ph.w << 16), t[7] - __uint_as_float(ph.w & 0xffff0000u));
        if (valid) *(fa::u32x4*)(trow + 16 * ks) = ph;
        const fa::bf16x8 bh = __builtin_bit_cast(fa::bf16x8, ph), bl = __builtin_bit_cast(fa::bf16x8, pl);
        const fa::bf16x8 ah0 = *(const FA_LAS fa::bf16x8*)(whi0 + 16 * ks), ah1 = *(const FA_LAS fa::bf16x8*)(whi1 + 16 * ks);
        const fa::bf16x8 al0 = *(const FA_LAS fa::bf16x8*)(wlo0 + 16 * ks), al1 = *(const FA_LAS fa::bf16x8*)(wlo1 + 16 * ks);
        acc0 = __builtin_amdgcn_mfma_f32_32x32x16_bf16(ah0, bh, acc0, 0, 0, 0); acc1 = __builtin_amdgcn_mfma_f32_32x32x16_bf16(ah1, bh, acc1, 0, 0, 0);
        acc0 = __builtin_amdgcn_mfma_f32_32x32x16_bf16(al0, bh, acc0, 0, 0, 0); acc1 = __builtin_amdgcn_mfma_f32_32x32x16_bf16(al1, bh, acc1, 0, 0, 0);
        acc0 = __builtin_amdgcn_mfma_f32_32x32x16_bf16(ah0, bl, acc0, 0, 0, 0); acc1 = __builtin_amdgcn_mfma_f32_32x32x16_bf16(ah1, bl, acc1, 0, 0, 0);
    }
    __syncthreads();
    FA_LAS float* xch = (FA_LAS float*)lds;
#pragma unroll
    for (int r = 0; r < 16; ++r) xch[((tsel * 4 + kq) * 20 + r) * 64 + lane] = acc0[r];
#pragma unroll
    for (int r = 0; r < 4; ++r) xch[((tsel * 4 + kq) * 20 + 16 + r) * 64 + lane] = acc1[r];
    __syncthreads();
    if (kq == 0 && valid) {
#pragma unroll
        for (int r = 0; r < 16; ++r) acc0[r] = (xch[((tsel * 4 + 0) * 20 + r) * 64 + lane] + xch[((tsel * 4 + 1) * 20 + r) * 64 + lane]) + (xch[((tsel * 4 + 2) * 20 + r) * 64 + lane] + xch[((tsel * 4 + 3) * 20 + r) * 64 + lane]);
#pragma unroll
        for (int r = 0; r < 4; ++r) acc1[r] = (xch[((tsel * 4 + 0) * 20 + 16 + r) * 64 + lane] + xch[((tsel * 4 + 1) * 20 + 16 + r) * 64 + lane]) + (xch[((tsel * 4 + 2) * 20 + 16 + r) * 64 + lane] + xch[((tsel * 4 + 3) * 20 + 16 + r) * 64 + lane]);
        float L[36];
#pragma unroll
        for (int r = 0; r < 16; ++r) { const float other = fa::xhalf(acc0[r], lane); const int o_mine = (r & 3) + 8 * (r >> 2);
            L[o_mine] = hi ? other : acc0[r]; L[o_mine + 4] = hi ? acc0[r] : other; }
#pragma unroll
        for (int r = 0; r < 4; ++r) { const float other = fa::xhalf(acc1[r], lane); L[32 + r] = hi ? other : acc1[r]; }
        float gl[4]; float gmx = NEG; int gs = 0;
#pragma unroll
        for (int g = 0; g < 4; ++g) { gl[g] = L[g] + bg[g]; if (gl[g] > gmx) { gmx = gl[g]; gs = g; } }
        float gz = 0.f;
#pragma unroll
        for (int g = 0; g < 4; ++g) gz += __expf(gl[g] - gmx);
        const float gprob = 1.f / gz;
        float el[8];
#pragma unroll
        for (int e = 0; e < 8; ++e) {
            const float a0 = L[4 + e] + be[e], a1 = L[12 + e] + be[8 + e], a2 = L[20 + e] + be[16 + e], a3 = L[28 + e] + be[24 + e];
            el[e] = gs == 0 ? a0 : (gs == 1 ? a1 : (gs == 2 ? a2 : a3));
        }
        float m1 = NEG; int i1 = 0;
#pragma unroll
        for (int e = 0; e < 8; ++e) if (el[e] > m1) { m1 = el[e]; i1 = e; }
        float m2 = NEG; int i2 = 0;
#pragma unroll
        for (int e = 0; e < 8; ++e) if (e != i1 && el[e] > m2) { m2 = el[e]; i2 = e; }
        const float p2 = __expf(m2 - m1);
        const float w1 = gprob / (1.f + p2), w2 = gprob * p2 / (1.f + p2);
        if (hi == 0) { const int e1 = gs * 8 + i1, e2 = gs * 8 + i2;
            re[row * 2] = e1; re[row * 2 + 1] = e2; rw[row * 2] = w1; rw[row * 2 + 1] = w2;
            rs[row * 2] = __hip_atomic_fetch_add(cnt + e1, 1, __ATOMIC_RELAXED, __HIP_MEMORY_SCOPE_WORKGROUP); rs[row * 2 + 1] = __hip_atomic_fetch_add(cnt + e2, 1, __ATOMIC_RELAXED, __HIP_MEMORY_SCOPE_WORKGROUP); }
    }
}


__device__ __forceinline__ void moe_tr_item(int it, const float* wgate, const float* wup, const float* wdown, bf16_t* WguT, bf16_t* WdT, lds_f32* scr, int lane) {
    if (it < 32 * 256) { const int e = it >> 8, r = it & 255, kb = r >> 4, nb = r & 15, j = nb >> 3, hf = (nb >> 2) & 1, cb = nb & 3;
        transpose_item<false>((hf ? wup : wgate) + (size_t)e * DM * 256 + j * 128 + cb * 32, DM, 256, 32, WguT + ((size_t)e * 512 + nb * 32) * DM, scr, kb, lane); }
    else { const int i2 = it - 32 * 256, e = i2 >> 7, r = i2 & 127;
        transpose_item<false>(wdown + (size_t)e * 256 * DM, 256, DM, DM, WdT + (size_t)e * DM * 256, scr, r, lane); }
}
#define MOE_TR_DRAIN() do { \
    FA_LAS int* qs_ = (FA_LAS int*)(lds + LDS_BYTES - 128); lds_f32* scr_ = (lds_f32*)lds + wave * (64 * 33); \
    const float* wg_ = pq->moe_w_gate + (size_t)l * 32 * DM * 256; const float* wu_ = pq->moe_w_up + (size_t)l * 32 * DM * 256; const float* wd_ = pq->moe_w_down + (size_t)l * 32 * 256 * DM; \
    for (;;) { if (tid == 0) *qs_ = (int)atomicAdd(W_QUEUE + (32 + l) * 16, 1u); __syncthreads(); const int bi_ = *qs_; __syncthreads(); \
        if (bi_ >= (32 * 256 + 32 * 128) / 8) break; moe_tr_item(bi_ * 8 + wave, wg_, wu_, wd_, W_WGU_T, W_WD_T, scr_, lane); } } while (0)

__device__ __forceinline__ void nsa_prep_q(const bf16_t* P, const float* qgain, bf16_t* Qn, int idx) {
    const int m = idx >> 2, h = idx & 3;
    const uint4* p = (const uint4*)(P + (size_t)m * LDP + PC_DQ + h * 64); float v[64]; float ss = 0.f;
#pragma unroll
    for (int i = 0; i < 8; ++i) { const uint4 u = p[i]; const unsigned w[4] = {u.x, u.y, u.z, u.w};
#pragma unroll
        for (int j = 0; j < 4; ++j) { v[i * 8 + 2 * j] = __uint_as_float(w[j] << 16); v[i * 8 + 2 * j + 1] = __uint_as_float(w[j] & 0xffff0000u); } }
#pragma unroll
    for (int d = 0; d < 64; ++d) ss += v[d] * v[d];
    const float r = rsqrtf(ss * (1.f / 64) + EPS) * (0.125f * LOG2E);
    uint4* o = (uint4*)(Qn + (size_t)m * 256 + h * 64);
#pragma unroll
    for (int i = 0; i < 8; ++i) { uint4 u; u.x = pk2bf(v[i * 8 + 0] * r * qgain[i * 8 + 0], v[i * 8 + 1] * r * qgain[i * 8 + 1]); u.y = pk2bf(v[i * 8 + 2] * r * qgain[i * 8 + 2], v[i * 8 + 3] * r * qgain[i * 8 + 3]);
        u.z = pk2bf(v[i * 8 + 4] * r * qgain[i * 8 + 4], v[i * 8 + 5] * r * qgain[i * 8 + 5]); u.w = pk2bf(v[i * 8 + 6] * r * qgain[i * 8 + 6], v[i * 8 + 7] * r * qgain[i * 8 + 7]); o[i] = u; }
}
__device__ __forceinline__ void nsa_prep_k(const bf16_t* P, int pcol, const float* kgain, bf16_t* Kf, int m) {
    const uint4* p = (const uint4*)(P + (size_t)m * LDP + pcol); float v[64]; float ss = 0.f;
#pragma unroll
    for (int i = 0; i < 8; ++i) { const uint4 u = p[i]; const unsigned w[4] = {u.x, u.y, u.z, u.w};
#pragma unroll
        for (int j = 0; j < 4; ++j) { v[i * 8 + 2 * j] = __uint_as_float(w[j] << 16); v[i * 8 + 2 * j + 1] = __uint_as_float(w[j] & 0xffff0000u); } }
#pragma unroll
    for (int d = 0; d < 64; ++d) ss += v[d] * v[d];
    const float r = rsqrtf(ss * (1.f / 64) + EPS);
    const int b = m / SEQ, t = m % SEQ, tile = t >> 6, kb = (t >> 5) & 1, rr = t & 31;
#pragma unroll
    for (int i = 0; i < 8; ++i) { uint4 u; u.x = pk2bf(v[i * 8 + 0] * r * kgain[i * 8 + 0], v[i * 8 + 1] * r * kgain[i * 8 + 1]); u.y = pk2bf(v[i * 8 + 2] * r * kgain[i * 8 + 2], v[i * 8 + 3] * r * kgain[i * 8 + 3]);
        u.z = pk2bf(v[i * 8 + 4] * r * kgain[i * 8 + 4], v[i * 8 + 5] * r * kgain[i * 8 + 5]); u.w = pk2bf(v[i * 8 + 6] * r * kgain[i * 8 + 6], v[i * 8 + 7] * r * kgain[i * 8 + 7]);
        const int ks = i >> 1, hh = i & 1;
        *(uint4*)(Kf + (((((size_t)(b * 64 + tile) * 2 + kb) * 4 + ks) * 32 + rr) * 2 + hh) * 8) = u; }
}
__device__ __forceinline__ int kcf_off(int n, int d) { return ((((((n >> 6) * 2 + ((n >> 5) & 1)) * 4 + (d >> 4)) * 32 + (n & 31)) * 2 + ((d >> 3) & 1)) * 8) + (d & 7); }
__device__ __forceinline__ int vcf_off(int n, int d) { const int s16 = n & 15; return (((((((n >> 6) * 2 + ((n >> 5) & 1)) * 2 + ((n >> 4) & 1)) * 2 + (d >> 5)) * 32 + (d & 31)) * 2 + ((s16 >> 2) & 1)) * 8) + (((s16 >> 3) << 2) | (s16 & 3)); }

__device__ __forceinline__ void nsa_cmp_unit(FA_LAS unsigned char* lds, int tid, const bf16_t* Qn, const bf16_t* Kcf, const bf16_t* Vcf, float* ocmp, unsigned long long* selmask, int b, int qb) {
    const int lane = tid & 63, wave = tid >> 6, r32 = lane & 31, hi = lane >> 5, head = wave >> 1, tl = 32 * (wave & 1) + r32, t = qb * 64 + tl;
    const size_t m = (size_t)b * SEQ + t;
    const float slope2 = exp2f(-(float)(2 * head + 2)) * LOG2E;
    const int ntiles = (4 * qb + 66) >> 6;
    const bf16_t* kb0 = Kcf + (size_t)b * 4 * 4096; const bf16_t* vb0 = Vcf + (size_t)b * 4 * 4096;
    auto tile_of = [=](int i) { fa::Tile T; T.kg = kb0 + (size_t)i * 4096; T.vg = vb0 + (size_t)i * 4096; T.key0 = i * 64; T.kg2 = nullptr; return T; };
    float mfin, lfin;
    {   fa::f32x16 a0, a1; float ilc; fa::attn_unit<4, 3, false>(lds, tid, ntiles, tile_of, Qn + m * 256 + head * 64, t, slope2, 0ull, 0, a0, a1, ilc, mfin, lfin);
        fa::store_o_f32(ocmp + (m * 4 + head) * 64, a0, a1, ilc, hi); }
    FA_LAS float* impH = (FA_LAS float*)lds;
    for (int i = tid; i < 4 * 64 * 64; i += NTHR) impH[i] = 0.f;
    __syncthreads();
    const int nv = t >= 31 ? ((t - 31) >> 4) + 1 : 0;
    const float il = (nv > 0 && lfin > 0.f) ? 1.f / lfin : 0.f;
    fa::bf16x8 qf[4];
#pragma unroll
    for (int ks = 0; ks < 4; ++ks) qf[ks] = *(const fa::bf16x8*)(Qn + m * 256 + head * 64 + 16 * ks + 8 * hi);
    float carry = 0.f;
    fa::bf16x8 kfr[2][4];
#pragma unroll
    for (int kb = 0; kb < 2; ++kb)
#pragma unroll
        for (int ks = 0; ks < 4; ++ks) kfr[kb][ks] = *(const fa::bf16x8*)(kb0 + (((kb * 4 + ks) * 32 + r32) * 2 + hi) * 8);
    for (int ti = 0; ti < ntiles; ++ti) {
        fa::bf16x8 kcur[2][4];
#pragma unroll
        for (int kb = 0; kb < 2; ++kb)
#pragma unroll
            for (int ks = 0; ks < 4; ++ks) kcur[kb][ks] = kfr[kb][ks];
        if (ti + 1 < ntiles) {
#pragma unroll
            for (int kb = 0; kb < 2; ++kb)
#pragma unroll
                for (int ks = 0; ks < 4; ++ks) kfr[kb][ks] = *(const fa::bf16x8*)(kb0 + (size_t)(ti + 1) * 4096 + (((kb * 4 + ks) * 32 + r32) * 2 + hi) * 8); }
#pragma unroll
        for (int kb = 0; kb < 2; ++kb) {
            fa::f32x16 sc;
#pragma unroll
            for (int r = 0; r < 16; ++r) sc[r] = 0.f;
#pragma unroll
            for (int ks = 0; ks < 4; ++ks) sc = __builtin_amdgcn_mfma_f32_32x32x16_bf16(kcur[kb][ks], qf[ks], sc, 0, 0, 0);
#pragma unroll
            for (int g = 0; g < 4; ++g) {
                const int n0 = 64 * ti + 32 * kb + 8 * g + 4 * hi;
                float p[4];
#pragma unroll
                for (int i = 0; i < 4; ++i) { const int n = n0 + i; const float val = sc[4 * g + i] + slope2 * (float)(16 * n + 31 - t);
                    p[i] = n < nv ? __builtin_amdgcn_exp2f(val - mfin) * il : 0.f; }
                const float a1 = (p[0] + p[1]) + (p[2] + 0.5f * p[3]), a2 = 0.5f * p[3];
                const float recv = fa::xhalf(a2, lane);
                const float val = a1 + (hi ? recv : carry);
                if (!hi) carry = recv;
                impH[(head * 64 + tl) * 64 + (n0 >> 2)] = val;
            }
        }
    }
    __syncthreads();
    FA_LAS long long* keys = (FA_LAS long long*)(lds + 65536) + wave * 512;
    long long mykey[8];
#pragma unroll
    for (int tt = 0; tt < 8; ++tt) {
        const int tok = 8 * wave + tt;
        float v = ((impH[(0 * 64 + tok) * 64 + lane] + impH[(1 * 64 + tok) * 64 + lane]) + impH[(2 * 64 + tok) * 64 + lane]) + impH[(3 * 64 + tok) * 64 + lane];
        v = lane <= qb ? v : -1.f;
        if (lane == 0 || lane == qb || lane == qb - 1) v = 2.f;
        mykey[tt] = (long long)(((unsigned long long)(long long)__float_as_int(v) << 6) | (unsigned long long)(63 - lane));
        keys[tt * 64 + lane] = mykey[tt];
    }
#pragma unroll
    for (int tt = 0; tt < 8; ++tt) {
        const int tok = 8 * wave + tt;
        int rank = 0;
#pragma unroll 8
        for (int i = 0; i < 64; i += 2) { const fa::u32x4 kk = *(const FA_LAS fa::u32x4*)(keys + tt * 64 + i);
            const long long k0 = (long long)(((unsigned long long)kk.y << 32) | kk.x), k1 = (long long)(((unsigned long long)kk.w << 32) | kk.z);
            rank += (k0 > mykey[tt] ? 1 : 0) + (k1 > mykey[tt] ? 1 : 0); }
        const unsigned long long msk = __builtin_amdgcn_ballot_w64(rank < 16);
        if (lane == 0) selmask[(size_t)b * SEQ + qb * 64 + tok] = msk;
    }
    __syncthreads();
}
__device__ __forceinline__ void nsa_selwin_unit(FA_LAS unsigned char* lds, int tid, const bf16_t* Qn, const bf16_t* Ksf, const bf16_t* Vsf, const bf16_t* Kwf, const bf16_t* Vwf,
                                                const unsigned long long* selmask, const float* ocmp, const bf16_t* P, const float* outg, bf16_t* mixed, int b, int qb) {
    const int lane = tid & 63, wave = tid >> 6, hi = lane >> 5, head = wave >> 1, tl = 32 * (wave & 1) + (lane & 31), t = qb * 64 + tl;
    const size_t m = (size_t)b * SEQ + t;
    const float slope2 = exp2f(-(float)(2 * head + 2)) * LOG2E;
    float mo, lo, ilx;
    fa::f32x16 acc0, acc1;
    {
        const bf16_t* kb0 = Ksf + (size_t)b * 64 * 4096; const bf16_t* vb0 = Vsf + (size_t)b * 64 * 4096;
        const unsigned long long sel = selmask[m];
        unsigned lo32 = (unsigned)sel, hi32 = (unsigned)(sel >> 32);
#pragma unroll
        for (int o = 1; o < 64; o <<= 1) { lo32 |= (unsigned)__builtin_amdgcn_ds_bpermute((lane ^ o) << 2, (int)lo32); hi32 |= (unsigned)__builtin_amdgcn_ds_bpermute((lane ^ o) << 2, (int)hi32); }
        FA_LAS unsigned* uni = (FA_LAS unsigned*)(lds + 49152);
        FA_LAS unsigned char* tlist = lds + 49152 + 16;
        if (wave < 2 && lane == 0) { uni[wave * 2] = lo32; uni[wave * 2 + 1] = hi32; }
        __syncthreads();
        const unsigned long long U = ((unsigned long long)(uni[1] | uni[3]) << 32) | (unsigned long long)(uni[0] | uni[2]);
        if (tid < 64 && ((U >> tid) & 1ull)) tlist[__builtin_popcountll(U & ((1ull << tid) - 1ull))] = (unsigned char)tid;
        __syncthreads();
        const int ntiles = __builtin_popcountll(U);
        auto tile_of = [=](int i) { const int j = tlist[i]; fa::Tile T; T.kg = kb0 + (size_t)j * 4096; T.vg = vb0 + (size_t)j * 4096; T.key0 = j * 64; T.kg2 = nullptr; return T; };
        fa::attn_unit<4, 1, false>(lds, tid, ntiles, tile_of, Qn + m * 256 + head * 64, t, slope2, sel, 0, acc0, acc1, ilx, mo, lo);
        const float g1 = sigmoidf_(bf2f(P[m * 12 + head * 3 + 1])) * ilx;
#pragma unroll
        for (int r = 0; r < 16; ++r) { acc0[r] *= g1; acc1[r] *= g1; }
    }
    {
        const bf16_t* kb0 = Kwf + (size_t)b * 64 * 4096; const bf16_t* vb0 = Vwf + (size_t)b * 64 * 4096;
        const int first = qb >= 8 ? qb - 8 : 0;
        auto tile_of = [=](int i) { const int j = first + i; fa::Tile T; T.kg = kb0 + (size_t)j * 4096; T.vg = vb0 + (size_t)j * 4096; T.key0 = j * 64; T.kg2 = nullptr; return T; };
        fa::f32x16 w0, w1;
        fa::attn_unit<4, 2, false>(lds, tid, qb - first + 1, tile_of, Qn + m * 256 + head * 64, t, slope2, 0ull, 0, w0, w1, ilx, mo, lo);
        const float g2 = sigmoidf_(bf2f(P[m * 12 + head * 3 + 2])) * ilx;
#pragma unroll
        for (int r = 0; r < 16; ++r) { acc0[r] += g2 * w0[r]; acc1[r] += g2 * w1[r]; }
    }
    {
        const float g0 = sigmoidf_(bf2f(P[m * 12 + head * 3 + 0]));
        const float* oc = ocmp + (m * 4 + head) * 64;
#pragma unroll
        for (int g = 0; g < 4; ++g) { const int d = 8 * g + 4 * hi; const float4 c0 = *(const float4*)(oc + d), c1 = *(const float4*)(oc + 32 + d);
            acc0[4 * g] += g0 * c0.x; acc0[4 * g + 1] += g0 * c0.y; acc0[4 * g + 2] += g0 * c0.z; acc0[4 * g + 3] += g0 * c0.w;
            acc1[4 * g] += g0 * c1.x; acc1[4 * g + 1] += g0 * c1.y; acc1[4 * g + 2] += g0 * c1.z; acc1[4 * g + 3] += g0 * c1.w; }
    }
    fa::store_normed_bf16(mixed + m * DM + 768 + head * 64, acc0, acc1, outg + head * 64, 1.f, lane, hi);
}
__device__ __forceinline__ void diff_unit(FA_LAS unsigned char* lds, int tid, const bf16_t* Qbf, const bf16_t* Kf, const bf16_t* Vf, const float* lamv, const float* subg, float lam_init,
                                          bf16_t* mixed, int b, int h, int qh) {
    const int lane = tid & 63, wave = tid >> 6, hi = lane >> 5, c = wave >> 2;
    const bf16_t* vbase = Vf + (size_t)(b * 4 + h) * 64 * 4096;
    const bf16_t* kbase0 = Kf + (size_t)((b * 4 + h) * 2 + 0) * 64 * 2048; const bf16_t* kbase1 = Kf + (size_t)((b * 4 + h) * 2 + 1) * 64 * 2048;
    const int back = h == 0 ? 4 : (h == 1 ? 15 : 60), first = 2 * qh - back > 0 ? 2 * qh - back : 0;
    const float slope2 = exp2f(-(float)(2 * h + 1)) * LOG2E;
    const int t = qh * 128 + (wave & 3) * 32 + (lane & 31); const size_t m = (size_t)b * SEQ + t;
    fa::f32x16 a0, a1; float ila, mo, lo;
    auto tile_of = [=](int i) { const int j = first + i; fa::Tile T; T.kg = kbase0 + (size_t)j * 2048; T.kg2 = kbase1 + (size_t)j * 2048; T.vg = vbase + (size_t)j * 4096; T.key0 = j * 64; return T; };
    fa::attn_unit<2, 0, true>(lds, tid, 2 * (qh + 1) - first, tile_of, Qbf + m * 256 + h * 64 + c * 32, t, slope2, 0ull, c * 4096, a0, a1, ila, mo, lo);
    FA_LAS float* xch = (FA_LAS float*)lds;
    if (c == 1) {
#pragma unroll
        for (int r = 0; r < 16; ++r) { xch[((wave & 3) * 32 + r) * 64 + lane] = a0[r] * ila; xch[((wave & 3) * 32 + 16 + r) * 64 + lane] = a1[r] * ila; }
    }
    __syncthreads();
    if (c == 0) {
        float d01 = 0.f, d23 = 0.f;
        {   float4 lv[32];
#pragma unroll
            for (int i = 0; i < 32; ++i) lv[i] = ((const float4*)lamv)[i];
#pragma unroll
            for (int i = 0; i < 8; ++i) { d01 += lv[i].x * lv[8 + i].x + lv[i].y * lv[8 + i].y + lv[i].z * lv[8 + i].z + lv[i].w * lv[8 + i].w;
                d23 += lv[16 + i].x * lv[24 + i].x + lv[16 + i].y * lv[24 + i].y + lv[16 + i].z * lv[24 + i].z + lv[16 + i].w * lv[24 + i].w; } }
        const float lam = __expf(d01) - __expf(d23) + lam_init;
#pragma unroll
        for (int r = 0; r < 16; ++r) { a0[r] = a0[r] * ila - lam * xch[(wave * 32 + r) * 64 + lane]; a1[r] = a1[r] * ila - lam * xch[(wave * 32 + 16 + r) * 64 + lane]; }
        fa::store_normed_bf16(mixed + m * DM + h * 64, a0, a1, subg + h * 64, 1.f - lam_init, lane, hi);
    }
    __syncthreads();
}

__device__ __forceinline__ void moe_table(const int* cnt, __attribute__((address_space(3))) int* tab, int tid) {
    if (tid < 64) {
        const int lane = tid; const int c = lane < 32 ? cnt[lane] : 0; const int pc = (c + 255) >> 8;
        int x = pc;
#pragma unroll
        for (int o = 1; o < 32; o <<= 1) { const int y = __builtin_amdgcn_ds_bpermute(((lane - o) & 63) << 2, x); if (lane >= o) x += y; }
        const int ex = x - pc;
        if (lane < 32) { tab[lane] = ex * 256; tab[32 + lane] = c; for (int t = 0; t < pc; ++t) tab[128 + ex + t] = lane; }
        if (lane == 31) tab[64] = x;
    }
    __syncthreads();
}

#define XB_TMO      128
#define XB_XCNT(j)  (256  + 64 * (j))
#define XB_XSUB(j)  (1280 + 64 * (j))
#define XB_XGEN(j)  (2304 + 64 * (j))
#define XB_TOP      3328
#define XB_TOPGEN   3392
#define XCD_BAR_WORDS 3456
#define XB_SPIN_CAP (1u << 18)

__device__ __forceinline__ unsigned xb_ld(unsigned* p)              { return __hip_atomic_load(p, __ATOMIC_RELAXED, __HIP_MEMORY_SCOPE_AGENT); }
__device__ __forceinline__ unsigned xb_add(unsigned* p, unsigned v) { return __hip_atomic_fetch_add(p, v, __ATOMIC_RELAXED, __HIP_MEMORY_SCOPE_AGENT); }
__device__ __forceinline__ unsigned xb_xcc_id() { return (unsigned)__builtin_amdgcn_s_getreg((3 << 11) | 20) & 0xFu; }
#define XB_SPIN(cond, bar) do { unsigned _sp = 0; while (cond) { __builtin_amdgcn_s_sleep(1); \
    if ((++_sp & 255u) == 0u) { if (xb_ld(&(bar)[XB_TMO])) break; if (_sp > XB_SPIN_CAP) { atomicAdd(&(bar)[XB_TMO], 1u); break; } } } } while (0)

struct XcdBarrier {
    unsigned* bar; unsigned x;
    volatile __attribute__((address_space(3))) unsigned* st;
};

__device__ __forceinline__ XcdBarrier xcd_barrier_post(unsigned* bar, volatile __attribute__((address_space(3))) unsigned* st) {
    XcdBarrier b; b.bar = bar; b.x = xb_xcc_id(); b.st = st;
    if (threadIdx.x == 0) (void)xb_add(&bar[XB_XCNT(b.x)], 1u);
    return b;
}
__device__ __forceinline__ void xcd_barrier_complete(unsigned* bar, unsigned x, unsigned& nloc, unsigned& nx) {
    const unsigned G = gridDim.x * gridDim.y * gridDim.z;
    unsigned sum, cnt, mine, sp = 0u;
    for (;;) {
        sum = 0u; cnt = 0u; mine = 0u;
#pragma unroll
        for (unsigned j = 0; j < 16; ++j) { const unsigned c = xb_ld(&bar[XB_XCNT(j)]); sum += c; cnt += (c > 0u) ? 1u : 0u; mine = (j == x) ? c : mine; }
        if (sum == G) break;
        __builtin_amdgcn_s_sleep(1);
        if ((++sp & 255u) == 0u) { if (xb_ld(&bar[XB_TMO])) break; if (sp > XB_SPIN_CAP) { atomicAdd(&bar[XB_TMO], 1u); break; } }
    }
    nloc = mine > 0u ? mine : 1u; nx = cnt > 0u ? cnt : 1u;
}

__device__ __forceinline__ void xcd_barrier(const XcdBarrier& b, const int tid) {
    asm volatile("s_waitcnt vmcnt(0)" ::: "memory");
    __syncthreads();
    if (tid == 0) {
        unsigned* bar = b.bar;
        __builtin_amdgcn_s_waitcnt(0);
        unsigned nloc = b.st[0], nx = b.st[1];
        if (nloc == 0u) { xcd_barrier_complete(bar, b.x, nloc, nx); b.st[0] = nloc; b.st[1] = nx; }
        const unsigned old = xb_add(&bar[XB_XSUB(b.x)], 1u);
        const unsigned gen = old / nloc;
        if (old + 1u == (gen + 1u) * nloc) {
            __builtin_amdgcn_fence(__ATOMIC_RELEASE, "agent");
            asm volatile("s_waitcnt vmcnt(0)" ::: "memory");
            const unsigned og = xb_add(&bar[XB_TOP], 1u);
            const unsigned tg = og / nx;
            if (og + 1u == (tg + 1u) * nx) xb_add(&bar[XB_TOPGEN], 1u);
            else XB_SPIN(xb_ld(&bar[XB_TOPGEN]) == tg, bar);
            __builtin_amdgcn_fence(__ATOMIC_ACQUIRE, "agent");
            xb_add(&bar[XB_XGEN(b.x)], 1u);
            asm volatile("s_waitcnt vmcnt(0)" ::: "memory");
        } else {
            XB_SPIN(xb_ld(&bar[XB_XGEN(b.x)]) == gen, bar);
            __builtin_amdgcn_fence(__ATOMIC_ACQUIRE, "agent");
            asm volatile("s_waitcnt vmcnt(0)" ::: "memory");
        }
    }
    __syncthreads();
}


__global__ void __launch_bounds__(NTHR) mega_fwd(Params p_unused) {
    extern __shared__ __attribute__((aligned(16))) unsigned char lds[];
    cg::grid_group grid = cg::this_grid(); grid.sync();
    volatile __attribute__((address_space(3))) unsigned* bar_st = (volatile __attribute__((address_space(3))) unsigned*)(lds + LDS_BYTES - 64);
    if (threadIdx.x < 2) bar_st[threadIdx.x] = 0u;
    if ((threadIdx.x & 63) == 0) ((__attribute__((address_space(3))) int*)((__attribute__((address_space(3))) unsigned char*)lds + LDS_TIDTAB))[hw_wave_slot()] = threadIdx.x >> 6;
    __syncthreads();
#ifndef USE_XCD_BARRIER
#define USE_XCD_BARRIER 1
#endif
#ifndef PROBE_LO
#define PROBE_LO (-1)
#define PROBE_HI 0
#endif
#define PROBE_MULT 8
#define PROBE_STAMPS ((unsigned long long*)(((const __attribute__((address_space(4))) Params*)__builtin_amdgcn_kernarg_segment_ptr())->ws + WS_BAR + 24576))
#define GRID_BARRIER() do { const int tb_ = phase_tid(lds); xcd_barrier(xbar, tb_); if (PROBE_LO >= 0) { if (blockIdx.x == 0 && tb_ == 0) PROBE_STAMPS[layer * 16 + (__COUNTER__ - BAR_BASE)] = __builtin_amdgcn_s_memrealtime(); } } while (0)
    constexpr int BAR_BASE = __COUNTER__;
    XcdBarrier xbar; (void)xbar;
    {   typedef const __attribute__((address_space(4))) Params* cparams0_t; const cparams0_t p0 = (cparams0_t)__builtin_amdgcn_kernarg_segment_ptr();
        xbar = xcd_barrier_post((unsigned*)(p0->ws + WS_BAR), bar_st); }
    if (PROBE_LO >= 0) { if (blockIdx.x == 0 && threadIdx.x == 0) PROBE_STAMPS[0] = __builtin_amdgcn_s_memrealtime(); }
    typedef const __attribute__((address_space(4))) Params* cparams_t;
    const cparams_t pp = (cparams_t)__builtin_amdgcn_kernarg_segment_ptr();
#define PHASE_VARS \
    const int tid = phase_tid(lds); \
    int bid = blockIdx.x; asm volatile("" : "+s"(bid)); int G = gridDim.x; asm volatile("" : "+s"(G)); int l = layer; asm volatile("" : "+s"(l)); \
    cparams_t pq = pp; asm volatile("" : "+s"(pq)); \
    const float* xcur = l == 0 ? pq->x_in : pq->out; (void)xcur; \
    const int lane = tid & 63, wave = tid >> 6, half = tid >> 8, tid256 = tid & 255; \
    const int gw = bid * NWAVE + wave, NGW = G * NWAVE; \
    const int gt = bid * NTHR + tid, NGT = G * NTHR; \
    float* ldsf = (float*)lds + half * 4096; \
    (void)lane; (void)tid256; (void)gw; (void)NGW; (void)gt; (void)NGT; (void)ldsf;

    auto layer_body = [&](auto LC) __attribute__((always_inline)) {
        constexpr int layer = decltype(LC)::value;
        {   PHASE_VARS
        if (l == 0) {
            lds_f32* scr = (lds_f32*)lds + wave * (64 * 33);
            constexpr int N1 = (DM / 64) * (LDP / 32), N2 = (DM / 64) * (DM / 32), N3 = 128, NL = N1 + N2 + N3;
            for (int it = gw; it < 2 * NL; it += NGW) { const int L = it / NL, r = it - L * NL;
                if (r < N1) transpose_item<true>(pq->w_in + (size_t)L * DM * IN_COLS, DM, IN_COLS, LDP, W_WIN_T_L(L), scr, r, lane);
                else if (r < N1 + N2) transpose_item<false>(pq->w_out + (size_t)L * DM * DM, DM, DM, DM, W_WOUT_T_L(L), scr, r - N1, lane);
                else { const int r3 = r - N1 - N2; transpose_item<false>(pq->nsa_cmp_w1 + ((size_t)L * 2 + (r3 >> 6)) * 2048 * 64, 2048, 64, 64, W_W1T_L(L) + (size_t)(r3 >> 6) * 64 * 2048, scr, r3 & 63, lane); } }
        }
        for (int row = gw; row < MT; row += NGW) norm_row(pq->out, xcur, l == 0 ? nullptr : W_YMOE, pq->norm_mix + l * DM, W_TB, row, lane);
        }
        GRID_BARRIER();
        {   PHASE_VARS
        {   pg8::Gemm g{W_TB, W_WIN_T, MT, LDP, DM}; pg8::StaticOrder S; S.init(MT, LDP, G, bid);
            pg8::EpiBf16<0> E{W_P, LDP, nullptr, 0, 0, 1.f};
            pg8::gemm_phase<pg8::EpiBf16<0>, pg8::StaticOrder, true, true>((PG8_LAS unsigned char*)lds, g, S, E, tid, lds); }
        }
        GRID_BARRIER();
        {   PHASE_VARS
        SCAN_BUFS(Bm, Bh)
        const int half_t = (G >> 1) * NTHR;
        for (int i = gt; i < 4 * 65536; i += NGT) { const int w = i >> 16, j = i & 65535;
            if (w == 0) scan::prep_k<0>(W_P, pq->mlstm_conv + l * 4 * 512, pq->mlstm_gate_bias + l * 8, nullptr, l, Bm, j);
            else if (w == 1) scan::prep_k<1>(W_P, nullptr, nullptr, pq->hgrn_lb, l, Bh, j);
            else if (half_t != 65536) { if (w == 2) scan::prep_v(W_P, PC_BV, Bm.VT(), j); else scan::prep_v(W_P, PC_CI, Bh.VT(), j); } }
        if (half_t == 65536 && gt >= half_t) {
            for (int i = gt - half_t; i < 2 * 65536; i += half_t) { const int j = i & 65535;
                if (i < 65536) scan::prep_v(W_P, PC_BV, Bm.VT(), j); else scan::prep_v(W_P, PC_CI, Bh.VT(), j); } }
        }
        GRID_BARRIER();
        {   PHASE_VARS
        SCAN_BUFS(Bm, Bh)
        for (int it = gw; it < 2048; it += NGW) { if (it < 1024) scan::stepA<0>(Bm, it, lane); else scan::stepA<1>(Bh, it - 1024, lane); }
        }
        GRID_BARRIER();
        {   PHASE_VARS
        SCAN_BUFS(Bm, Bh)
        for (int i = gt; i < 2 * 65536; i += NGT) { if (i < 65536) scan::stepB<0>(Bm, i); else scan::stepB<1>(Bh, i - 65536); }
        }
        GRID_BARRIER();
        {   PHASE_VARS
        SCAN_BUFS(Bm, Bh)
        for (int it = gw; it < 2048; it += NGW) {
            if (it < 1024) scan::stepC<0>(Bm, W_P, PC_BO, pq->mlstm_out_gain + l * 256, W_MIXED, 256, it, lane);
            else scan::stepC<1>(Bh, W_P, PC_CG, pq->hgrn_out_gain + l * 256, W_MIXED, 512, it - 1024, lane); }
        }
        GRID_BARRIER();
        {   PHASE_VARS
        for (int i = gt; i < MT * 8; i += NGT) diff_prep_qk(W_P, pq->diff_q_gain + l * 32, pq->diff_k_gain + l * 32, W_QBF, W_DKF, i);
        const int nskip = G >= 128 ? 64 : 0, gt_v = (bid - nskip) * NTHR + tid, NGT_v = (G - nskip) * NTHR;
        if (bid >= nskip) for (int i = gt_v; i < NB * 4 * 64 * 512; i += NGT_v) vfrag_item(W_P, PC_AV, 64, 4, W_DVF, i);
        const int gt_q = ((bid + G - (G >> 1)) % G) * NTHR + tid, gt_k = ((bid + G - (G >> 2)) % G) * NTHR + tid;
        for (int i = gt_q; i < MT * 4; i += NGT) nsa_prep_q(W_P, pq->nsa_q_gain + l * 64, W_NQB, i);
        for (int i = gt_k; i < 2 * MT; i += NGT) { if (i < MT) nsa_prep_k(W_P, PC_KS, pq->nsa_k_gain + (l * 3 + 1) * 64, W_KSF, i); else nsa_prep_k(W_P, PC_KW, pq->nsa_k_gain + (l * 3 + 2) * 64, W_KWF, i - MT); }
        if (bid >= nskip) for (int i = gt_v; i < 2 * NB * 64 * 512; i += NGT_v) { if (i < NB * 64 * 512) vfrag_item(W_P, PC_VS, 0, 1, W_VSF, i); else vfrag_item(W_P, PC_VW, 0, 1, W_VWF, i - NB * 64 * 512); }
        for (int i = gt_q; i < MT * 12; i += NGT) W_DGATE[i] = W_P[(size_t)(i / 12) * LDP + PC_DG + (i % 12)];
        for (int it = bid; it < 64; it += G)
            nsa_compress_unit((FA_LAS unsigned char*)lds, tid, W_P, pq->nsa_cmp_pos + l * 2 * 32 * 64, W_W1T, pq->nsa_cmp_w2 + l * 2 * 64 * 64, pq->nsa_k_gain + (l * 3 + 0) * 64, W_CMP, it);
        }
        GRID_BARRIER();
        {   PHASE_VARS
        {
            FA_LAS int* qslot = (FA_LAS int*)(lds + LDS_BYTES - 128);
            for (int kq = 0; kq < 8; ++kq) {
                const int q = (bid + kq) & 7;
                for (;;) {
                    if (tid == 0) *qslot = (int)atomicAdd(W_QUEUE + ((l * 2 + 0) * 8 + q) * 16, 1u);
                    __syncthreads();
                    const int it = *qslot;
                    __syncthreads();
                    if (it >= 96) break;
                    const bool is_cmp = it >= 20 && it < 52;
                    if (!is_cmp) {
                        bool lo; int qh;
                        if (it < 20) { lo = false; qh = 31 - it; } else if (it < 56) { lo = false; qh = 11 - (it - 52); } else if (it < 80) { lo = true; qh = 31 - (it - 56); }
                        else if (it < 88) { lo = false; qh = 7 - (it - 80); } else { lo = true; qh = 7 - (it - 88); }
                        const int b = q >> 1, hp = q & 1, h = lo ? hp : 3 - hp;
                        diff_unit((FA_LAS unsigned char*)lds, tid, W_QBF, W_DKF, W_DVF, pq->diff_lambda + l * 128, pq->diff_sub_gain + l * 256, 0.8f - 0.6f * __expf(-0.3f * (float)l), W_MIXED, b, h, qh);
                    } else { const int u = q * 32 + (it - 20); nsa_cmp_unit((FA_LAS unsigned char*)lds, tid, W_NQB, W_KCF, W_VCF, W_OCMP, W_SELMASK, u >> 6, 63 - (u & 63)); }
                }
            }
            __syncthreads();
            MOE_TR_DRAIN();
        }
        }
        GRID_BARRIER();
        {   PHASE_VARS
        {
            FA_LAS int* qslot = (FA_LAS int*)(lds + LDS_BYTES - 128);
            for (int kq = 0; kq < 8; ++kq) {
                const int q = (bid + kq) & 7;
                for (;;) {
                    if (tid == 0) *qslot = (int)atomicAdd(W_QUEUE + ((l * 2 + 1) * 8 + q) * 16, 1u);
                    __syncthreads();
                    const int it = *qslot;
                    __syncthreads();
                    if (it >= 32) break;
                    const int b = q >> 1, qb = 2 * (31 - it) + (q & 1);
                    nsa_selwin_unit((FA_LAS unsigned char*)lds, tid, W_NQB, W_KSF, W_VSF, W_KWF, W_VWF, W_SELMASK, W_OCMP, W_DGATE, pq->nsa_out_gain + l * 256, W_MIXED, b, qb);
                }
            }
            __syncthreads();
            MOE_TR_DRAIN();
        }
        }
        GRID_BARRIER();
        {   PHASE_VARS
        {   pg8::Gemm g{W_MIXED, W_WOUT_T, MT, DM, DM}; pg8::StaticOrder S; S.init(MT, DM, G, bid);
            pg8::EpiResF32 E{xcur, pq->out, DM};
            pg8::gemm_phase<pg8::EpiResF32, pg8::StaticOrder, true, true>((PG8_LAS unsigned char*)lds, g, S, E, tid, lds); }
        }
        GRID_BARRIER();
        {   PHASE_VARS
        MOE_TR_DRAIN();
        __syncthreads();
        {   FA_LAS bf16_t* wimg = (FA_LAS bf16_t*)lds; const float* wg = pq->moe_w_group + l * DM * 4; const float* we = pq->moe_w_expert + l * DM * 32;
            FA_LAS int* lcnt = (FA_LAS int*)(lds + RT_IMG_BYTES);
            if (tid < 32) lcnt[tid] = 0;
            for (int t0 = bid; t0 < MT / 32; t0 += 2 * G) {
                __syncthreads();
#pragma unroll 1
                for (int i0 = tid; i0 < DM * 36; i0 += 12 * NTHR) {
                    float wv[12];
#pragma unroll
                    for (int u = 0; u < 12; ++u) { const int i = i0 + u * NTHR, k = i / 36, o = i - k * 36; wv[u] = o < 4 ? wg[k * 4 + o] : we[k * 32 + o - 4]; }
#pragma unroll
                    for (int u = 0; u < 12; ++u) { const int i = i0 + u * NTHR, k = i / 36, o = i - k * 36; const bf16_t h16 = f2bf(wv[u]); wimg[o * RT_RS + k] = h16; wimg[(36 + o) * RT_RS + k] = f2bf(wv[u] - bf2f(h16)); }
                }
                __syncthreads();
                const int tile = t0 + (wave >> 2) * G;
                moe_route_round((FA_LAS unsigned char*)lds, tid, pq->out, pq->norm_ffn + l * DM, pq->moe_b_group + l * 4, pq->moe_b_expert + l * 32, W_TB, W_RE, W_RW, W_RS, tile, tile < MT / 32);
            }
            __syncthreads();
            if (tid < 32) W_CNTBLK[bid * 32 + tid] = lcnt[tid];
        }
        }
        GRID_BARRIER();
        {   PHASE_VARS
        __attribute__((address_space(3))) int* tab = (__attribute__((address_space(3))) int*)(lds + 131072);
        {
            __attribute__((address_space(3))) int* part = tab + 512;
            const int e = tid & 31, pg = tid >> 5; int tot = 0, bs = 0;
            for (int b2 = pg; b2 < G; b2 += 16) { const int c = W_CNTBLK[b2 * 32 + e]; tot += c; bs += b2 < bid ? c : 0; }
            part[pg * 32 + e] = tot; part[512 + pg * 32 + e] = bs;
            __syncthreads();
            if (tid < 32) { int t2 = 0, b3 = 0;
#pragma unroll
                for (int i = 0; i < 16; ++i) { t2 += part[i * 32 + tid]; b3 += part[512 + i * 32 + tid]; }
                tab[96 + tid] = b3; part[tid] = t2; if (bid == 0) W_CNT[tid] = t2; }
            __syncthreads();
            if (tid < 64) { const int c = tid < 32 ? part[tid] : 0; const int pc = (c + 255) >> 8; int x = pc;
#pragma unroll
                for (int o = 1; o < 32; o <<= 1) { const int y = __builtin_amdgcn_ds_bpermute(((tid - o) & 63) << 2, x); if (tid >= o) x += y; }
                const int ex = x - pc;
                if (tid < 32) { tab[tid] = ex * 256; tab[32 + tid] = c; } }
            __syncthreads();
        }
        for (int rr = tid >> 6; rr < 32 * ((MT / 32 - bid + G - 1) / G); rr += NWAVE) { const int row = (bid + (rr >> 5) * G) * 32 + (rr & 31);
            const uint4* src = (const uint4*)(W_TB + (size_t)row * DM);
            const uint4 v0 = src[lane], v1 = src[lane + 64];
#pragma unroll
            for (int i = 0; i < 2; ++i) { const int e = W_RE[row * 2 + i], r = tab[e] + tab[96 + e] + W_RS[row * 2 + i];
                uint4* dst = (uint4*)(W_ASORT + (size_t)r * DM); dst[lane] = v0; dst[lane + 64] = v1;
                if (lane == 0) { W_ROWTOK[r] = row * 2 + i; W_ROWW[r] = W_RW[row * 2 + i]; } }
        }
        if (bid == 0) for (int e = wave; e < 32; e += NWAVE) { const int r0 = tab[e] + tab[32 + e], r1 = tab[e] + ((tab[32 + e] + 255) & ~255);
            for (int r = r0 + lane; r < r1; r += 64) { W_ROWTOK[r] = -1; W_ROWW[r] = 0.f; } }
        }
        GRID_BARRIER();
        {   PHASE_VARS
        __attribute__((address_space(3))) int* tab = (__attribute__((address_space(3))) int*)(lds + 131072);
        moe_table(W_CNT, tab, tid);
        const int nT = tab[64]; const bool split3 = G >= 256 && 2 * nT > G;
        {   pg8::Gemm g{W_ASORT, W_WGU_T, MOE_ROWS_MAX, 32 * 512, DM}; const int cx = (G & 7) ? bid : (bid & 7) * (G >> 3) + (bid >> 3);
            pg8::MoeOrder S{G, cx, nT, 2, tab + 128, 0, split3 ? G : 2 * nT};
            pg8::EpiSwiglu E{W_HS, W_ROWW};
            pg8::gemm_phase<pg8::EpiSwiglu, pg8::MoeOrder, true, true>((PG8_LAS unsigned char*)lds, g, S, E, tid, lds); }
        }
        GRID_BARRIER();
        {   PHASE_VARS
        __attribute__((address_space(3))) int* tab = (__attribute__((address_space(3))) int*)(lds + 131072);
        moe_table(W_CNT, tab, tid);
        const int nT = tab[64]; const bool split3 = G >= 256 && 2 * nT > G; const int n_extra = split3 ? 2 * nT - G : 0, tdone = split3 ? G / 2 : nT;
        const int xq = bid & 7, xr = bid >> 3, neq = n_extra >> 3, ner = n_extra & 7, ne_x = neq + (xq < ner ? 1 : 0), ne_pre = xq * neq + (xq < ner ? xq : ner);
        const bool sw = (G & 7) == 0, is_extra = sw ? xr < ne_x : bid < n_extra;
        const int cu_ = sw ? ne_pre + xr : bid, cd_ = sw ? xq * (G >> 3) - ne_pre + xr - ne_x : bid - n_extra;
        if (is_extra) {
            pg8::Gemm g{W_ASORT, W_WGU_T, MOE_ROWS_MAX, 32 * 512, DM}; pg8::MoeOrder S{G, cu_, nT, 2, tab + 128, G, 2 * nT};
            pg8::EpiSwiglu E{W_HS, W_ROWW};
            pg8::gemm_phase<pg8::EpiSwiglu, pg8::MoeOrder, true, true>((PG8_LAS unsigned char*)lds, g, S, E, tid, lds);
        } else {
            pg8::Gemm g{W_HS, W_WD_T, MOE_ROWS_MAX, 32 * DM, 256}; pg8::MoeOrder S{G - n_extra, cd_, nT, 4, tab + 128, 0, 4 * tdone};
            pg8::EpiScatterStore E{W_YMOE, W_ROWTOK};
            pg8::gemm_phase<pg8::EpiScatterStore, pg8::MoeOrder, true, true>((PG8_LAS unsigned char*)lds, g, S, E, tid, lds);
        }
        }
        GRID_BARRIER();
        {   PHASE_VARS
        __attribute__((address_space(3))) int* tab = (__attribute__((address_space(3))) int*)(lds + 131072);
        moe_table(W_CNT, tab, tid);
        const int nT = tab[64]; const bool split3 = G >= 256 && 2 * nT > G; const int tdone = split3 ? G / 2 : nT;
        {   pg8::Gemm g{W_HS, W_WD_T, MOE_ROWS_MAX, 32 * DM, 256}; const int nrem = 4 * (nT - tdone), chk = (nrem + 7) >> 3;
            const int cx = (G & 7) ? bid : nrem <= G ? ((bid >> 3) < chk ? (bid & 7) * chk + (bid >> 3) : -1) : (bid & 7) * (G >> 3) + (bid >> 3);
            pg8::MoeOrder S{G, cx, nT, 4, tab + 128, 4 * tdone, 4 * nT};
            pg8::EpiScatterStore E{W_YMOE, W_ROWTOK};
            pg8::gemm_phase<pg8::EpiScatterStore, pg8::MoeOrder, true, true>((PG8_LAS unsigned char*)lds, g, S, E, tid, lds); }
        }
        GRID_BARRIER();
    };
    layer_body(IntC<0>{});
    layer_body(IntC<1>{});
    {   const int layer = DEPTH; PHASE_VARS
        for (int i = gt; i < MT * DM / 4; i += NGT) { const int row = i >> 8, c4 = i & 255;
            float4 v = ((const float4*)pq->out)[i];
            const float4 a = bf4_to_f4(((const uint2*)(W_YMOE + (size_t)row * 2 * DM))[c4]), b = bf4_to_f4(((const uint2*)(W_YMOE + ((size_t)row * 2 + 1) * DM))[c4]);
            v.x += a.x + b.x; v.y += a.y + b.y; v.z += a.z + b.z; v.w += a.w + b.w; ((float4*)pq->out)[i] = v; }
    }
    if (PROBE_LO >= 0) {
        const int tb_ = phase_tid(lds); xcd_barrier(xbar, tb_);
        if (tb_ == 0) { const unsigned long long d = (__hip_atomic_load(PROBE_STAMPS + PROBE_HI, __ATOMIC_RELAXED, __HIP_MEMORY_SCOPE_AGENT) - __hip_atomic_load(PROBE_STAMPS + PROBE_LO, __ATOMIC_RELAXED, __HIP_MEMORY_SCOPE_AGENT))
                + (__hip_atomic_load(PROBE_STAMPS + 16 + PROBE_HI, __ATOMIC_RELAXED, __HIP_MEMORY_SCOPE_AGENT) - __hip_atomic_load(PROBE_STAMPS + 16 + PROBE_LO, __ATOMIC_RELAXED, __HIP_MEMORY_SCOPE_AGENT));
            const unsigned long long t0 = __builtin_amdgcn_s_memrealtime(); while (__builtin_amdgcn_s_memrealtime() - t0 < PROBE_MULT * d) __builtin_amdgcn_s_sleep(32); }
        __syncthreads();
    }
}
}

extern "C" void kernel_launch(void* const* d_in, const int* in_sizes, int n_in, void* d_out, int out_size, void* d_ws, size_t ws_size, hipStream_t stream) {
    Params p{};
    p.x_in = (const float*)d_in[0]; p.norm_mix = (const float*)d_in[1]; p.norm_ffn = (const float*)d_in[2]; p.w_in = (const float*)d_in[3]; p.w_out = (const float*)d_in[4];
    p.diff_q_gain = (const float*)d_in[5]; p.diff_k_gain = (const float*)d_in[6]; p.diff_lambda = (const float*)d_in[7]; p.diff_sub_gain = (const float*)d_in[8];
    p.mlstm_conv = (const float*)d_in[9]; p.mlstm_gate_bias = (const float*)d_in[10]; p.mlstm_out_gain = (const float*)d_in[11]; p.hgrn_lb = (const float*)d_in[12];
    p.hgrn_out_gain = (const float*)d_in[13]; p.nsa_cmp_pos = (const float*)d_in[14]; p.nsa_cmp_w1 = (const float*)d_in[15]; p.nsa_cmp_w2 = (const float*)d_in[16];
    p.nsa_q_gain = (const float*)d_in[17]; p.nsa_k_gain = (const float*)d_in[18]; p.nsa_out_gain = (const float*)d_in[19];
    p.moe_w_group = (const float*)d_in[20]; p.moe_b_group = (const float*)d_in[21]; p.moe_w_expert = (const float*)d_in[22]; p.moe_b_expert = (const float*)d_in[23];
    p.moe_w_gate = (const float*)d_in[24]; p.moe_w_up = (const float*)d_in[25]; p.moe_w_down = (const float*)d_in[26];
    p.out = (float*)d_out;

    p.ws = (char*)d_ws;
    if (WS_END > ws_size) { fprintf(stderr, "kernel_launch: workspace too small: need %zu, have %zu\n", (size_t)WS_END, ws_size); return; }

    static int grid_blocks = 0;
    if (!grid_blocks) {
        int dev = 0, cus = 0, per_cu = 0;
        hipGetDevice(&dev);
        hipDeviceGetAttribute(&cus, hipDeviceAttributeMultiprocessorCount, dev);
        hipFuncSetAttribute((const void*)mega_fwd, hipFuncAttributeMaxDynamicSharedMemorySize, LDS_BYTES);
        hipOccupancyMaxActiveBlocksPerMultiprocessor(&per_cu, (const void*)mega_fwd, NTHR, LDS_BYTES);
        if (per_cu < 1) per_cu = 1;
        if (per_cu > 1) per_cu = 1;
        grid_blocks = cus * per_cu;
    }
    hipMemsetAsync((char*)d_ws + WS_BAR, 0, 32768, stream);
    void* args[] = {&p};
    hipError_t e = hipLaunchCooperativeKernel((const void*)mega_fwd, dim3(grid_blocks), dim3(NTHR), args, LDS_BYTES, stream);
    if (e != hipSuccess) fprintf(stderr, "cooperative launch failed: %s (grid %d)\n", hipGetErrorString(e), grid_blocks);
}
```

```cpp
#include <hip/hip_runtime.h>
#include <hip/hip_cooperative_groups.h>
#include <stdint.h>
#include <cstdio>
namespace cg = cooperative_groups;

namespace {
constexpr int DM = 1024, NB = 4, SEQ = 4096, DEPTH = 2, MT = NB * SEQ;
constexpr int IN_COLS = 3476, LDP = 3584;
constexpr float EPS = 1e-6f, NEG = -1e30f;
constexpr int PC_AQ = 0, PC_AK = 256, PC_AV = 512, PC_BQ = 768, PC_BK = 1024, PC_BV = 1280, PC_BO = 1536, PC_CQ = 1792, PC_CF = 2048,
              PC_CI = 2304, PC_CG = 2560, PC_DQ = 2816, PC_KC = 3072, PC_VC = 3136, PC_KS = 3200, PC_VS = 3264, PC_KW = 3328, PC_VW = 3392,
              PC_BI = 3456, PC_BF = 3460, PC_DG = 3464;
constexpr int NCMP = 255;
constexpr int NTHR = 512, NWAVE = 8;
constexpr int LDS_BYTES = 151552;

typedef unsigned short bf16_t;
__device__ __forceinline__ float bf2f(bf16_t v) { return __uint_as_float(((unsigned)v) << 16); }
__device__ __forceinline__ bf16_t f2bf(float f) { unsigned u = __float_as_uint(f); return (bf16_t)((u + 0x7fffu + ((u >> 16) & 1u)) >> 16); }
__device__ __forceinline__ unsigned pk2bf(float lo, float hi) { return (unsigned)f2bf(lo) | ((unsigned)f2bf(hi) << 16); }
__device__ __forceinline__ int src_col(int c) { return c < 1536 ? c : (c < 3456 ? c + 8 : (c < 3460 ? c - 3456 + 1536 : (c < 3464 ? c - 3460 + 1540 : c))); }
__device__ __forceinline__ float sigmoidf_(float x) { return 1.f / (1.f + __expf(-x)); }
__device__ __forceinline__ float siluf_(float x) { return x / (1.f + __expf(-x)); }
__device__ __forceinline__ float wave_sum(float v, int lane) {
#pragma unroll
    for (int o = 1; o < 64; o <<= 1) v += __int_as_float(__builtin_amdgcn_ds_bpermute((lane ^ o) << 2, __float_as_int(v)));
    return v;
}
__device__ __forceinline__ float rdlane(float v, int k) { return __int_as_float(__builtin_amdgcn_readlane(__float_as_int(v), k)); }

__device__ __forceinline__ int phase_tid_fwd(const unsigned char* lds_generic);
namespace pg8 {
#define PG8_LAS __attribute__((address_space(3)))
typedef unsigned short bf16_t;
typedef short bf16x8 __attribute__((ext_vector_type(8)));
typedef float f32x4 __attribute__((ext_vector_type(4)));
typedef unsigned u32x4 __attribute__((ext_vector_type(4)));
constexpr int BM = 256, BK = 64, HALF = 128, HTB = HALF * BK * 2  , STAGE_BYTES = 8 * HTB, NXCD = 8, WGM = 8;

__host__ __device__ __forceinline__ int lds_byte(int r, int c) { const int st = (r >> 4) * 2 + (c >> 5), rr = r & 15, cc = c & 31, ob = rr * 64 + cc * 2; return st * 1024 + (ob ^ (((ob >> 9) & 1) << 5)); }
__host__ __device__ __forceinline__ void stage_rc(int b, int& R, int& C) { const int st = b / 1024, sb = b % 1024, swz = sb ^ (((sb >> 9) & 1) << 5); R = (st >> 1) * 16 + swz / 64; C = (st & 1) * 32 + (swz % 64) / 2; }
__host__ __device__ __forceinline__ int perm32(int rho) { const int n = rho >> 4, i = rho & 15; return 8 * (i >> 2) + 4 * n + (i & 3); }

struct Unit { int pm, pn; };
struct Gemm { const bf16_t* A; const bf16_t* Bt; int M, N, K; };

struct StaticOrder {
    int nM, nN, nwg, G, c;
    __host__ __device__ void init(int M, int N, int G_, int c_) { nM = M / BM; nN = N / BM; nwg = nM * nN; G = G_; c = c_; }
    __host__ __device__ bool next(int i, Unit& u) const {
        const long L = (long)i * G + c; if (L >= nwg) return false;
        int wgid = (int)L; { const int q = nwg / NXCD, r = nwg % NXCD, xcd = wgid % NXCD, off = wgid / NXCD; wgid = (xcd < r ? xcd * (q + 1) : r * (q + 1) + (xcd - r) * q) + off; }
        const int nig = WGM * nN, gid = wgid / nig, fm = gid * WGM, gsz = (nM - fm) < WGM ? (nM - fm) : WGM;
        u.pm = fm + ((wgid % nig) % gsz); u.pn = (wgid % nig) / gsz; return true;
    }
    __device__ __forceinline__ void a_ready(const Unit&) const {}
    __device__ __forceinline__ void done(const Unit&) const {}
};

__device__ __forceinline__ unsigned cvt_pk_bf16(float lo, float hi) { unsigned r; asm volatile("v_cvt_pk_bf16_f32 %0, %1, %2" : "=v"(r) : "v"(lo), "v"(hi)); return r; }
template <int ACT  > struct EpiBf16 {
    static constexpr bool PERM = true, AFTER_DRAIN = false, HAS_INIT = false; static_assert(ACT == 0, "EpiBf16: only ACT 0 here");
    bf16_t* O; int ldc; const float* bias; int split_cols; size_t split_stride; float scale0;
    __device__ __forceinline__ void operator()(const f32x4 (&acc)[2][2][4][2], const Unit& u, int wr, int wc, int fr, int fq) const {
        const int row0 = u.pm * BM + wr * 64 + fr; int colt = u.pn * BM; bf16_t* base = O;
        float sc = 1.f; if (split_cols) { const int t = colt / split_cols; base += (size_t)t * split_stride; colt -= t * split_cols; if (t == 0) sc = scale0; }
        const int col0 = colt + wc * 32 + 8 * fq, bcol0 = u.pn * BM + wc * 32 + 8 * fq;
        f32x4 bv[2][2];
#pragma unroll
        for (int bj = 0; bj < 2; ++bj)
#pragma unroll
            for (int n = 0; n < 2; ++n) bv[bj][n] = bias ? *(const f32x4*)(bias + bcol0 + bj * HALF + 4 * n) : (f32x4){0.f, 0.f, 0.f, 0.f};
#pragma unroll
        for (int ai = 0; ai < 2; ++ai)
#pragma unroll
            for (int m = 0; m < 4; ++m) { bf16_t* rowp = base + (size_t)(row0 + ai * HALF + m * 16) * ldc + col0;
#pragma unroll
                for (int bj = 0; bj < 2; ++bj) { f32x4 v0 = acc[ai][bj][m][0] + bv[bj][0], v1 = acc[ai][bj][m][1] + bv[bj][1];
                    v0 = v0 * sc; v1 = v1 * sc; u32x4 w; w.x = cvt_pk_bf16(v0[0], v0[1]); w.y = cvt_pk_bf16(v0[2], v0[3]); w.z = cvt_pk_bf16(v1[0], v1[1]); w.w = cvt_pk_bf16(v1[2], v1[3]);
                    *(u32x4*)(rowp + bj * HALF) = w; } }
    }
};


struct EpiResF32 {
    static constexpr bool PERM = false, AFTER_DRAIN = false, HAS_INIT = true;
    const float* base; float* out; int ldc;
    __device__ __forceinline__ void init(f32x4 (&acc)[2][2][4][2], const Unit& u, int wr, int wc, int fr, int fq) const {
        const int col0 = u.pn * BM + wc * 32 + 4 * fq;
#pragma unroll
        for (int ai = 0; ai < 2; ++ai)
#pragma unroll
            for (int m = 0; m < 4; ++m) { const size_t off = (size_t)(u.pm * BM + ai * HALF + wr * 64 + m * 16 + fr) * ldc + col0;
#pragma unroll
                for (int bj = 0; bj < 2; ++bj)
#pragma unroll
                    for (int n = 0; n < 2; ++n) acc[ai][bj][m][n] = *(const f32x4*)(base + off + bj * HALF + n * 16); }
    }
    __device__ __forceinline__ void operator()(const f32x4 (&acc)[2][2][4][2], const Unit& u, int wr, int wc, int fr, int fq) const {
        const int col0 = u.pn * BM + wc * 32 + 4 * fq;
#pragma unroll
        for (int ai = 0; ai < 2; ++ai)
#pragma unroll
            for (int m = 0; m < 4; ++m) { const size_t off = (size_t)(u.pm * BM + ai * HALF + wr * 64 + m * 16 + fr) * ldc + col0;
#pragma unroll
                for (int bj = 0; bj < 2; ++bj)
#pragma unroll
                    for (int n = 0; n < 2; ++n) *(f32x4*)(out + off + bj * HALF + n * 16) = acc[ai][bj][m][n]; }
    }
};

template <bool BASE_BF> struct EpiResB {
    static constexpr bool PERM = true, AFTER_DRAIN = false, HAS_INIT = true;
    const void* base; bf16_t* out; int ldc;
    __device__ __forceinline__ void init(f32x4 (&acc)[2][2][4][2], const Unit& u, int wr, int wc, int fr, int fq) const {
        const int col0 = u.pn * BM + wc * 32 + 8 * fq;
#pragma unroll
        for (int ai = 0; ai < 2; ++ai)
#pragma unroll
            for (int m = 0; m < 4; ++m) { const size_t off = (size_t)(u.pm * BM + ai * HALF + wr * 64 + m * 16 + fr) * ldc + col0;
#pragma unroll
                for (int bj = 0; bj < 2; ++bj) {
                    if constexpr (BASE_BF) { const u32x4 w = *(const u32x4*)((const bf16_t*)base + off + bj * HALF);
                        acc[ai][bj][m][0] = (f32x4){__uint_as_float(w.x << 16), __uint_as_float(w.x & 0xffff0000u), __uint_as_float(w.y << 16), __uint_as_float(w.y & 0xffff0000u)};
                        acc[ai][bj][m][1] = (f32x4){__uint_as_float(w.z << 16), __uint_as_float(w.z & 0xffff0000u), __uint_as_float(w.w << 16), __uint_as_float(w.w & 0xffff0000u)}; }
                    else { acc[ai][bj][m][0] = *(const f32x4*)((const float*)base + off + bj * HALF); acc[ai][bj][m][1] = *(const f32x4*)((const float*)base + off + bj * HALF + 4); } } }
    }
    __device__ __forceinline__ void operator()(const f32x4 (&acc)[2][2][4][2], const Unit& u, int wr, int wc, int fr, int fq) const {
        const int col0 = u.pn * BM + wc * 32 + 8 * fq;
#pragma unroll
        for (int ai = 0; ai < 2; ++ai)
#pragma unroll
            for (int m = 0; m < 4; ++m) { bf16_t* rowp = out + (size_t)(u.pm * BM + ai * HALF + wr * 64 + m * 16 + fr) * ldc + col0;
#pragma unroll
                for (int bj = 0; bj < 2; ++bj) { const f32x4 v0 = acc[ai][bj][m][0], v1 = acc[ai][bj][m][1];
                    u32x4 w; w.x = cvt_pk_bf16(v0[0], v0[1]); w.y = cvt_pk_bf16(v0[2], v0[3]); w.z = cvt_pk_bf16(v1[0], v1[1]); w.w = cvt_pk_bf16(v1[2], v1[3]);
                    *(u32x4*)(rowp + bj * HALF) = w; } }
    }
};

struct EpiSwiglu {
    static constexpr bool PERM = true, AFTER_DRAIN = false, HAS_INIT = false;
    bf16_t* H; const float* row_w;
    __device__ __forceinline__ void operator()(const f32x4 (&acc)[2][2][4][2], const Unit& u, int wr, int wc, int fr, int fq) const {
        const int row0 = u.pm * BM + wr * 64 + fr, col0 = (u.pn & 1) * HALF + wc * 32 + 8 * fq;
#pragma unroll
        for (int ai = 0; ai < 2; ++ai)
#pragma unroll
            for (int m = 0; m < 4; ++m) { const int row = row0 + ai * HALF + m * 16; const float w = row_w[row];
                float h[8];
#pragma unroll
                for (int n = 0; n < 2; ++n)
#pragma unroll
                    for (int i = 0; i < 4; ++i) { const float g = acc[ai][0][m][n][i], up = acc[ai][1][m][n][i]; h[n * 4 + i] = g / (1.f + __expf(-g)) * up * w; }
                u32x4 o; o.x = cvt_pk_bf16(h[0], h[1]); o.y = cvt_pk_bf16(h[2], h[3]); o.z = cvt_pk_bf16(h[4], h[5]); o.w = cvt_pk_bf16(h[6], h[7]);
                *(u32x4*)(H + (size_t)row * 256 + col0) = o; asm volatile("" ::: "memory"); }
    }
};
struct EpiScatterStore {
    static constexpr bool PERM = true, AFTER_DRAIN = false, HAS_INIT = false;
    bf16_t* Y; const int* row_tok;
    __device__ __forceinline__ void operator()(const f32x4 (&acc)[2][2][4][2], const Unit& u, int wr, int wc, int fr, int fq) const {
        const int col0 = (u.pn & 3) * BM + wc * 32 + 8 * fq;
#pragma unroll
        for (int ai = 0; ai < 2; ++ai)
#pragma unroll
            for (int m = 0; m < 4; ++m) { const int t2 = row_tok[u.pm * BM + ai * HALF + wr * 64 + m * 16 + fr];
                if (t2 >= 0) { const unsigned o = (unsigned)t2 * 1024u + (unsigned)col0;
#pragma unroll
                    for (int bj = 0; bj < 2; ++bj) { const f32x4 v0 = acc[ai][bj][m][0], v1 = acc[ai][bj][m][1];
                        u32x4 w; w.x = cvt_pk_bf16(v0[0], v0[1]); w.y = cvt_pk_bf16(v0[2], v0[3]); w.z = cvt_pk_bf16(v1[0], v1[1]); w.w = cvt_pk_bf16(v1[2], v1[3]);
                        *(u32x4*)(Y + (o + (unsigned)(bj * HALF))) = w; } }
                asm volatile("" ::: "memory"); }
    }
};
struct MoeOrder {
    int G, c, ntiles, nsub; const PG8_LAS int* tile_e; int L0, L1;
    __device__ __forceinline__ bool next(int i, Unit& u) const {
        const int L = L0 + i * G + c; if (c < 0 || L >= L1) return false;
        const int T = L / nsub, j = L - T * nsub; u.pm = T; u.pn = tile_e[T] * nsub + j; return true;
    }
    __device__ __forceinline__ void a_ready(const Unit&) const {}
    __device__ __forceinline__ void done(const Unit&) const {}
};
template <class Epi, class Sched, bool ALIGN_EPI = false, bool SP2 = false>
__device__ __forceinline__ void gemm_phase(PG8_LAS unsigned char* lds, const Gemm g, const Sched& S, const Epi& E, const int tid_in, const unsigned char* lds_generic) {
    const int tid = tid_in, wid = __builtin_amdgcn_readfirstlane(tid >> 6), lane = tid & 63, wr = wid >> 2, wc = wid & 3, fr = lane & 15, fq = lane >> 4;
    const int K = g.K, nt = K / BK;
    unsigned voffA[2], voffB[2];
#pragma unroll
    for (int i = 0; i < 2; ++i) { int R, C; stage_rc(tid * 16 + i * 8192, R, C); const int Rb = Epi::PERM ? ((R & ~31) + perm32(R & 31)) : R;
        voffA[i] = (unsigned)(R * K + C) * 2u; voffB[i] = (unsigned)(Rb * K + C) * 2u; }
    const size_t kstep = (size_t)(BK * 2);
    const size_t hstep = (size_t)HALF * K * 2;
    const size_t tstep = 2 * hstep;
    const unsigned ldsw = (unsigned)wid * 1024u;
    const int aoff = lds_byte(wr * 64 + fr, fq * 8), boff = lds_byte(wc * 32 + fr, fq * 8);
#define PG8_SA(b, h) (((b) * 2 + (h)) * HTB)
#define PG8_SB(b, h) ((4 + (b) * 2 + (h)) * HTB)
#define PG8_STAGE(bufoff, gbase, voff) do { _Pragma("unroll") for (int _i = 0; _i < 2; ++_i) \
        __builtin_amdgcn_global_load_lds((const unsigned*)((const char*)(gbase) + (voff)[_i]), (PG8_LAS unsigned*)(lds + (bufoff) + ldsw + _i * 8192), 16, 0, 0); } while (0)
#define PG8_LDA(dst, b, h) do { _Pragma("unroll") for (int m = 0; m < 4; ++m) _Pragma("unroll") for (int k = 0; k < 2; ++k) dst[m][k] = *(const PG8_LAS bf16x8*)(lds + PG8_SA(b, h) + aoff + m * 2048 + k * 1024); } while (0)
#define PG8_LDB(dst, b, h) do { _Pragma("unroll") for (int n = 0; n < 2; ++n) _Pragma("unroll") for (int k = 0; k < 2; ++k) dst[n][k] = *(const PG8_LAS bf16x8*)(lds + PG8_SB(b, h) + boff + n * 2048 + k * 1024); } while (0)
#define PG8_MMA(ai, bj, At, Bt) do { __builtin_amdgcn_s_setprio(1); _Pragma("unroll") for (int m = 0; m < 4; ++m) _Pragma("unroll") for (int n = 0; n < 2; ++n) _Pragma("unroll") for (int k = 0; k < 2; ++k) \
        acc[ai][bj][m][n] = __builtin_amdgcn_mfma_f32_16x16x32_bf16(Bt[n][k], At[m][k], acc[ai][bj][m][n], 0, 0, 0); __builtin_amdgcn_s_setprio(0); } while (0)
#define PG8_WAIT_V(n) asm volatile("s_waitcnt vmcnt(" #n ")" ::: "memory")
#define PG8_WAIT_L(n) asm volatile("s_waitcnt lgkmcnt(" #n ")" ::: "memory")
#define PG8_BAR __builtin_amdgcn_s_barrier()
#define PG8_SCHED __builtin_amdgcn_sched_barrier(0)
    Unit cur, nxt; int ui = 0;
    if (!S.next(0, cur)) return;
    f32x4 acc[2][2][4][2];
#pragma unroll
    for (int a = 0; a < 2; ++a)
#pragma unroll
        for (int b = 0; b < 2; ++b)
#pragma unroll
            for (int m = 0; m < 4; ++m)
#pragma unroll
                for (int n = 0; n < 2; ++n) acc[a][b][m][n] = (f32x4){0.f, 0.f, 0.f, 0.f};
    if constexpr (Epi::HAS_INIT) E.init(acc, cur, wr, wc, fr, fq);
    bf16x8 At[4][2], B0[2][2], B1[2][2];
    const char* cA = (const char*)g.A + (size_t)cur.pm * tstep; const char* cB = (const char*)g.Bt + (size_t)cur.pn * tstep;
    S.a_ready(cur);
    if constexpr (SP2) {
        PG8_STAGE(PG8_SB(0, 0), cB, voffB); PG8_STAGE(PG8_SB(0, 1), cB + hstep, voffB); PG8_STAGE(PG8_SA(0, 0), cA, voffA); PG8_STAGE(PG8_SA(0, 1), cA + hstep, voffA);
        if (wr == 1) PG8_BAR;
        PG8_WAIT_V(2); PG8_BAR;
        PG8_STAGE(PG8_SB(1, 0), cB + kstep, voffB); PG8_STAGE(PG8_SA(1, 0), cA + kstep, voffA); PG8_STAGE(PG8_SB(1, 1), cB + hstep + kstep, voffB);
        PG8_WAIT_V(6); PG8_BAR;
    } else {
        PG8_STAGE(PG8_SB(0, 0), cB, voffB); PG8_STAGE(PG8_SA(0, 0), cA, voffA); PG8_STAGE(PG8_SB(0, 1), cB + hstep, voffB); PG8_STAGE(PG8_SA(0, 1), cA + hstep, voffA);
        if (wr == 1) PG8_BAR;
        PG8_WAIT_V(4); PG8_BAR;
        PG8_STAGE(PG8_SB(1, 0), cB + kstep, voffB); PG8_STAGE(PG8_SA(1, 0), cA + kstep, voffA); PG8_STAGE(PG8_SB(1, 1), cB + hstep + kstep, voffB);
        PG8_WAIT_V(6); PG8_BAR;
    }
    for (;;) {
        const bool has_next = S.next(ui + 1, nxt);
        const char* nA = has_next ? (const char*)g.A + (size_t)nxt.pm * tstep : cA; const char* nB = has_next ? (const char*)g.Bt + (size_t)nxt.pn * tstep : cB;
        for (int t = 0; t < nt; t += 2) {
            const bool last = (t == nt - 2);
            const char* a1 = cA + (size_t)(t + 1) * kstep;
            const char* a2 = last ? nA : cA + (size_t)(t + 2) * kstep; const char* b2 = last ? nB : cB + (size_t)(t + 2) * kstep;
            const char* a3 = a2 + kstep; const char* b3 = b2 + kstep;
            if (last && has_next) S.a_ready(nxt);
            if constexpr (SP2) {
            PG8_LDB(B0, 0, 0); PG8_LDB(B1, 0, 1); PG8_SCHED; PG8_LDA(At, 0, 0); PG8_STAGE(PG8_SA(1, 1), a1 + hstep, voffA);
            PG8_WAIT_V(8); PG8_WAIT_L(0); PG8_BAR; PG8_MMA(0, 0, At, B0); PG8_MMA(0, 1, At, B1); PG8_BAR; PG8_SCHED;
            PG8_LDA(At, 0, 1); PG8_STAGE(PG8_SB(0, 0), b2, voffB); PG8_STAGE(PG8_SB(0, 1), b2 + hstep, voffB); PG8_STAGE(PG8_SA(0, 0), a2, voffA);
            PG8_WAIT_V(8); PG8_WAIT_L(0); PG8_BAR; PG8_MMA(1, 0, At, B0); PG8_MMA(1, 1, At, B1); PG8_BAR; PG8_SCHED;
            PG8_LDB(B0, 1, 0); PG8_LDB(B1, 1, 1); PG8_SCHED; PG8_LDA(At, 1, 0); PG8_STAGE(PG8_SA(0, 1), a2 + hstep, voffA);
            PG8_WAIT_V(8); PG8_WAIT_L(0); PG8_BAR; PG8_MMA(0, 0, At, B0); PG8_MMA(0, 1, At, B1); PG8_BAR; PG8_SCHED;
            PG8_LDA(At, 1, 1); PG8_STAGE(PG8_SB(1, 0), b3, voffB); PG8_STAGE(PG8_SB(1, 1), b3 + hstep, voffB); PG8_STAGE(PG8_SA(1, 0), a3, voffA);
            PG8_WAIT_V(8); PG8_WAIT_L(0); PG8_BAR; PG8_MMA(1, 0, At, B0); PG8_MMA(1, 1, At, B1); PG8_BAR; PG8_SCHED;
            } else {
            PG8_LDB(B0, 0, 0); PG8_SCHED; PG8_LDA(At, 0, 0); PG8_STAGE(PG8_SA(1, 1), a1 + hstep, voffA);
            PG8_WAIT_L(8); PG8_BAR; PG8_WAIT_L(0); PG8_MMA(0, 0, At, B0); PG8_BAR; PG8_SCHED;
            PG8_LDB(B1, 0, 1); PG8_STAGE(PG8_SB(0, 0), b2, voffB);
            PG8_BAR; PG8_WAIT_L(0); PG8_MMA(0, 1, At, B1); PG8_BAR;
            PG8_LDA(At, 0, 1); PG8_STAGE(PG8_SA(0, 0), a2, voffA);
            PG8_BAR; PG8_WAIT_L(0); PG8_MMA(1, 0, At, B0); PG8_BAR; PG8_SCHED;
            PG8_STAGE(PG8_SB(0, 1), b2 + hstep, voffB);
            PG8_WAIT_V(6); PG8_BAR; PG8_MMA(1, 1, At, B1); PG8_BAR;
            PG8_LDB(B0, 1, 0); PG8_SCHED; PG8_LDA(At, 1, 0); PG8_STAGE(PG8_SA(0, 1), a2 + hstep, voffA);
            PG8_WAIT_L(8); PG8_BAR; PG8_WAIT_L(0); PG8_MMA(0, 0, At, B0); PG8_BAR; PG8_SCHED;
            PG8_LDB(B1, 1, 1); PG8_STAGE(PG8_SB(1, 0), b3, voffB);
            PG8_BAR; PG8_WAIT_L(0); PG8_MMA(0, 1, At, B1); PG8_BAR;
            PG8_LDA(At, 1, 1); PG8_STAGE(PG8_SA(1, 0), a3, voffA);
            PG8_BAR; PG8_WAIT_L(0); PG8_MMA(1, 0, At, B0); PG8_BAR; PG8_SCHED;
            PG8_STAGE(PG8_SB(1, 1), b3 + hstep, voffB);
            PG8_WAIT_V(6); PG8_BAR; PG8_MMA(1, 1, At, B1); PG8_BAR;
            }
        }
        if constexpr (ALIGN_EPI) { if (wr == 0) PG8_BAR; }
        if constexpr (!Epi::AFTER_DRAIN) {
            const int l2 = phase_tid_fwd(lds_generic) & 63;
            E(acc, cur, wr, wc, l2 & 15, l2 >> 4); S.done(cur); }
        if (!has_next) break;
#pragma unroll
        for (int a = 0; a < 2; ++a)
#pragma unroll
            for (int b = 0; b < 2; ++b)
#pragma unroll
                for (int m = 0; m < 4; ++m)
#pragma unroll
                    for (int n = 0; n < 2; ++n) acc[a][b][m][n] = (f32x4){0.f, 0.f, 0.f, 0.f};
        if constexpr (Epi::HAS_INIT) E.init(acc, nxt, wr, wc, fr, fq);
        cur = nxt; cA = nA; cB = nB; ++ui;
        if constexpr (ALIGN_EPI) { if (wr == 1) PG8_BAR; }
    }
    PG8_WAIT_V(0);
    if constexpr (!ALIGN_EPI) { if (wr == 0) PG8_BAR; }
    PG8_BAR;
    if constexpr (Epi::AFTER_DRAIN) { E.fused(acc, cur, wr, wc, fr, fq, lds, wid, lane); S.done(cur); }
#undef PG8_SA
#undef PG8_SB
#undef PG8_STAGE
#undef PG8_LDA
#undef PG8_LDB
#undef PG8_MMA
#undef PG8_WAIT_V
#undef PG8_WAIT_L
#undef PG8_BAR
#undef PG8_SCHED
}
}


namespace fa {
#define FA_LAS __attribute__((address_space(3)))
typedef short bf16x8 __attribute__((ext_vector_type(8)));
typedef float f32x16 __attribute__((ext_vector_type(16)));
typedef float f32x2_t __attribute__((ext_vector_type(2)));
typedef __bf16 bf16x2_t __attribute__((ext_vector_type(2)));
typedef unsigned u32x4 __attribute__((ext_vector_type(4)));
__device__ __forceinline__ unsigned cvtpk(float lo, float hi) { f32x2_t v = {lo, hi}; bf16x2_t b = __builtin_convertvector(v, bf16x2_t); return __builtin_bit_cast(unsigned, b); }
__device__ __forceinline__ float max3f(float a, float b, float c) { float r; asm("v_max3_f32 %0, %1, %2, %3" : "=v"(r) : "v"(a), "v"(b), "v"(c)); return r; }
__device__ __forceinline__ float min2f(float a, float b) { float r; asm("v_min_f32 %0, %1, %2" : "=v"(r) : "v"(a), "v"(b)); return r; }
__device__ __forceinline__ float xhalf(float v, int lane) { return __int_as_float(__builtin_amdgcn_ds_bpermute((lane ^ 32) << 2, __float_as_int(v))); }
struct Tile { const bf16_t* kg; const bf16_t* vg; int key0; const bf16_t* kg2; };
template <int KS, int KIND, bool KB2, class TileFn>
__device__ __forceinline__ void attn_unit(FA_LAS unsigned char* lds, int tid, int ntiles, const TileFn& tile_of, const bf16_t* qrow, int qpos, float slope2,
                                          unsigned long long selbits, int kofs  , f32x16& o0_out, f32x16& o1_out, float& il_out, float& m_out, float& l_out) {
    constexpr int KBYTES = KB2 ? 8192 : 2 * KS * 1024;
    constexpr float THR = 8.f;
    const int lane = tid & 63, r32 = lane & 31, hi = lane >> 5;
    bf16x8 qf[KS];
#pragma unroll
    for (int ks = 0; ks < KS; ++ks) qf[ks] = *(const bf16x8*)(qrow + 16 * ks + 8 * hi);
    f32x16 o0, o1;
#pragma unroll
    for (int r = 0; r < 16; ++r) { o0[r] = 0.f; o1[r] = 0.f; }
    float mref = 0.f;
    f32x16 lacc;
#pragma unroll
    for (int r = 0; r < 16; ++r) lacc[r] = 0.f;
    const u32x4 ones_w = {0x3F803F80u, 0x3F803F80u, 0x3F803F80u, 0x3F803F80u}; const bf16x8 ones8 = __builtin_bit_cast(bf16x8, ones_w);
    static_assert(KBYTES == 8192, "every wave stages 1 KiB of K and 1 KiB of V per tile (the vmcnt arithmetic below counts 2 loads per wave and tile)");
    const int nv = KIND == 3 ? (qpos >= 31 ? ((qpos - 31) >> 4) + 1 : 0) : 0;
    FA_LAS unsigned char* wbase = lds + (tid >> 6) * 1024;
    auto stage = [&](const Tile& Tt, int slot) {
        const char* ksrc = (KB2 && tid >= 256) ? (const char*)Tt.kg2 + (tid - 256) * 16 : (const char*)Tt.kg + tid * 16;
        __builtin_amdgcn_global_load_lds((const unsigned*)ksrc, (FA_LAS unsigned*)(wbase + slot * 16384), 16, 0, 0);
        __builtin_amdgcn_global_load_lds((const unsigned*)((const char*)Tt.vg + tid * 16), (FA_LAS unsigned*)(wbase + slot * 16384 + 8192), 16, 0, 0);
    };
    asm volatile("s_waitcnt vmcnt(0)" ::: "memory");
    Tile T = tile_of(0), T1 = T;
    stage(T, 0);
    if (ntiles > 1) { T1 = tile_of(1); stage(T1, 1); asm volatile("s_waitcnt vmcnt(2)" ::: "memory"); } else asm volatile("s_waitcnt vmcnt(0)" ::: "memory");
    __builtin_amdgcn_s_barrier();
    int slot = 0;
    for (int i = 0; i < ntiles; ++i) {
        Tile T2 = T1;
        if (i + 2 < ntiles) { T2 = tile_of(i + 2); stage(T2, slot == 0 ? 2 : slot - 1); }
        unsigned lofs = slot * 16384 + r32 * 32 + hi * 16; asm volatile("" : "+v"(lofs));
        const FA_LAS unsigned char* Kl = lds + lofs + kofs; const FA_LAS unsigned char* Vl = lds + lofs + 8192;
        const int key0 = T.key0;
        bool act, full, bit = true; int lim; float base, slopek;
        if (KIND == 3) { lim = nv - 1 - key0 - 4 * hi; act = key0 < nv; full = key0 + 63 < nv;
                         slopek = slope2 * 16.f; base = slope2 * (float)(16 * (key0 + 4 * hi) + 31 - qpos); }
        else { lim = qpos - key0 - 4 * hi; act = key0 <= qpos; full = key0 + 63 <= qpos; slopek = slope2; base = slope2 * (float)(key0 + 4 * hi - qpos);
               if (KIND == 1) { bit = (selbits >> (key0 >> 6)) & 1ull; act = act && bit; if (!bit) lim = -100000; }
               if (KIND == 2) { act = act && (key0 + 63 > qpos - 512); full = full && (key0 > qpos - 512); } }
        if (__builtin_amdgcn_ballot_w64(act) != 0ull) {
            const bool allfull = __builtin_amdgcn_ballot_w64(full) == ~0ull;
            f32x16 s0, s1;
            const float bm = (KIND == 1 && !bit) ? -1e30f : base - mref;
#pragma unroll
            for (int r = 0; r < 16; ++r) { const int c0 = (r & 3) + 8 * (r >> 2); s0[r] = __builtin_fmaf(slopek, (float)c0, bm); s1[r] = __builtin_fmaf(slopek, (float)(c0 + 32), bm); }
#pragma unroll
            for (int ks = 0; ks < KS; ++ks) {
                const bf16x8 a0 = *(const FA_LAS bf16x8*)(Kl + ks * 1024);
                const bf16x8 a1 = *(const FA_LAS bf16x8*)(Kl + (KS + ks) * 1024);
                s0 = __builtin_amdgcn_mfma_f32_32x32x16_bf16(a0, qf[ks], s0, 0, 0, 0);
                s1 = __builtin_amdgcn_mfma_f32_32x32x16_bf16(a1, qf[ks], s1, 0, 0, 0);
            }
            if (!allfull) {
#pragma unroll
                for (int r = 0; r < 16; ++r) { const int c0 = (r & 3) + 8 * (r >> 2);
                    int p0 = min(lim - c0, 0), p1 = min(lim - c0 - 32, 0);
                    if (KIND == 2) { p0 += min(c0 - lim + 511, 0); p1 += min(c0 + 32 - lim + 511, 0); }
                    s0[r] = __builtin_fmaf((float)p0, 1e30f, s0[r]); s1[r] = __builtin_fmaf((float)p1, 1e30f, s1[r]); }
            }
            float mx = max3f(s0[0], s1[0], s0[1]);
            mx = max3f(mx, s1[1], s0[2]);
#pragma unroll
            for (int r = 2; r < 15; ++r) mx = max3f(mx, s1[r], s0[r + 1]);
            mx = max3f(mx, s1[15], s1[15]);
            mx = max3f(mx, xhalf(mx, lane), mx);
            if (__builtin_amdgcn_ballot_w64(mx > THR) != 0ull) {
                const float dl = __builtin_fmaxf(mx, 0.f), f = __builtin_amdgcn_exp2f(-dl);
                mref += dl;
#pragma unroll
                for (int r = 0; r < 16; ++r) { s0[r] -= dl; s1[r] -= dl; o0[r] *= f; o1[r] *= f; lacc[r] *= f; }
            }
#pragma unroll
            for (int r = 0; r < 16; ++r) { s0[r] = __builtin_amdgcn_exp2f(s0[r]); s1[r] = __builtin_amdgcn_exp2f(s1[r]); }
#pragma unroll
            for (int kb = 0; kb < 2; ++kb)
#pragma unroll
                for (int sp = 0; sp < 2; ++sp) {
                    u32x4 pw;
                    if (kb == 0) { pw.x = cvtpk(s0[8 * sp + 0], s0[8 * sp + 1]); pw.y = cvtpk(s0[8 * sp + 2], s0[8 * sp + 3]); pw.z = cvtpk(s0[8 * sp + 4], s0[8 * sp + 5]); pw.w = cvtpk(s0[8 * sp + 6], s0[8 * sp + 7]); }
                    else         { pw.x = cvtpk(s1[8 * sp + 0], s1[8 * sp + 1]); pw.y = cvtpk(s1[8 * sp + 2], s1[8 * sp + 3]); pw.z = cvtpk(s1[8 * sp + 4], s1[8 * sp + 5]); pw.w = cvtpk(s1[8 * sp + 6], s1[8 * sp + 7]); }
                    const bf16x8 pf = __builtin_bit_cast(bf16x8, pw);
                    const bf16x8 v0 = *(const FA_LAS bf16x8*)(Vl + ((kb * 2 + sp) * 2 + 0) * 1024);
                    const bf16x8 v1 = *(const FA_LAS bf16x8*)(Vl + ((kb * 2 + sp) * 2 + 1) * 1024);
                    o0 = __builtin_amdgcn_mfma_f32_32x32x16_bf16(v0, pf, o0, 0, 0, 0);
                    o1 = __builtin_amdgcn_mfma_f32_32x32x16_bf16(v1, pf, o1, 0, 0, 0);
                    lacc = __builtin_amdgcn_mfma_f32_32x32x16_bf16(ones8, pf, lacc, 0, 0, 0);
                }
        }
        if (i + 2 < ntiles) asm volatile("s_waitcnt vmcnt(2)" ::: "memory"); else asm volatile("s_waitcnt vmcnt(0)" ::: "memory");
        asm volatile("s_waitcnt lgkmcnt(0)" ::: "memory");
        __builtin_amdgcn_s_barrier();
        T = T1; T1 = T2; slot = slot == 2 ? 0 : slot + 1;
    }
    const float lt = lacc[0];
    const bool rowvalid = KIND == 3 ? nv > 0 : true;
    const float il = (rowvalid && lt > 0.f) ? 1.f / lt : 0.f;
    m_out = mref; l_out = lt; il_out = il; o0_out = o0; o1_out = o1;
}
__device__ __forceinline__ void store_o_f32(float* orow, const f32x16& o0, const f32x16& o1, float il, int hi) {
#pragma unroll
    for (int g = 0; g < 4; ++g) {
        const int d = 8 * g + 4 * hi;
        *(float4*)(orow + d) = make_float4(o0[4 * g] * il, o0[4 * g + 1] * il, o0[4 * g + 2] * il, o0[4 * g + 3] * il);
        *(float4*)(orow + 32 + d) = make_float4(o1[4 * g] * il, o1[4 * g + 1] * il, o1[4 * g + 2] * il, o1[4 * g + 3] * il);
    }
}
__device__ __forceinline__ void store_normed_bf16(bf16_t* mrow, const f32x16& v0, const f32x16& v1, const float* gain64, float scale, int lane, int hi) {
    float ss = 0.f;
#pragma unroll
    for (int r = 0; r < 16; ++r) ss += v0[r] * v0[r] + v1[r] * v1[r];
    ss += xhalf(ss, lane);
    const float rr = rsqrtf(ss * (1.f / 64) + 1e-6f) * scale;
#pragma unroll
    for (int g = 0; g < 4; ++g) {
        const int d = 8 * g + 4 * hi;
        const float4 g0 = *(const float4*)(gain64 + d), g1 = *(const float4*)(gain64 + 32 + d);
        uint2 w0, w1;
        w0.x = cvtpk(v0[4 * g] * rr * g0.x, v0[4 * g + 1] * rr * g0.y); w0.y = cvtpk(v0[4 * g + 2] * rr * g0.z, v0[4 * g + 3] * rr * g0.w);
        w1.x = cvtpk(v1[4 * g] * rr * g1.x, v1[4 * g + 1] * rr * g1.y); w1.y = cvtpk(v1[4 * g + 2] * rr * g1.z, v1[4 * g + 3] * rr * g1.w);
        *(uint2*)(mrow + d) = w0; *(uint2*)(mrow + 32 + d) = w1;
    }
}
}


namespace scan {
typedef short bf16x8 __attribute__((ext_vector_type(8)));
typedef float f32x16 __attribute__((ext_vector_type(16)));
__device__ __forceinline__ int spos(int s) { const int s16 = s & 15; return (s & ~15) + 8 * ((s16 >> 2) & 1) + (((s16 >> 3) << 2) | (s16 & 3)); }
__device__ __forceinline__ float xhalf(float v, int lane) { return __int_as_float(__builtin_amdgcn_ds_bpermute((lane ^ 32) << 2, __float_as_int(v))); }
constexpr size_t A8 = (size_t)MT * 256 * 2, SM = (size_t)1024 * 64 * 4;
template <int MIX> struct BufsT {
    char* r1; char* r2;
    static constexpr size_t R1OFF = MIX == 0 ? 0 : 6 * A8 + 5 * SM;
    __device__ __forceinline__ bf16_t* QA() const { return (bf16_t*)(r1 + R1OFF); }
    __device__ __forceinline__ bf16_t* KA() const { return (bf16_t*)(r1 + R1OFF + A8); }
    __device__ __forceinline__ bf16_t* KAT() const { return (bf16_t*)(r1 + R1OFF + 2 * A8); }
    __device__ __forceinline__ char* rest() const { return MIX == 0 ? r1 + 3 * A8 : r2; }
    __device__ __forceinline__ bf16_t* VT() const { return (bf16_t*)(rest()); }
    __device__ __forceinline__ bf16_t* Ub() const { return (bf16_t*)(rest() + A8); }
    __device__ __forceinline__ bf16_t* Sp() const { return (bf16_t*)(rest() + 2 * A8); }
    __device__ __forceinline__ float* Un() const { return (float*)(rest() + 3 * A8); }
    __device__ __forceinline__ float* np() const { return (float*)(rest() + 3 * A8 + SM); }
    __device__ __forceinline__ float* dL() const { return (float*)(rest() + 3 * A8 + 2 * SM); }
    __device__ __forceinline__ float* dmid() const { return (float*)(rest() + 3 * A8 + 3 * SM); }
    __device__ __forceinline__ float* dLm() const { return (float*)(rest() + 3 * A8 + 4 * SM); }
};

__host__ __device__ constexpr int spos_c(int s) { return (s & ~15) + 8 * (((s & 15) >> 2) & 1) + ((((s & 15) >> 3) << 2) | (s & 3)); }
template <int MIX>
__device__ __forceinline__ void prep_k(const bf16_t* P, const float* convw, const float* gbias, const float* lbp, int layer, const BufsT<MIX>& B, int idx) {
    const int k = idx & 63, ci = idx >> 6, h = ci & 3, chunk = ci >> 2, c = chunk & 63, lane = k;
    const size_t m0 = (size_t)chunk * 64;
    unsigned kapk[32];
    float bL, bmid;
    if (MIX == 1) {
        float lb = 0.f; if (layer == 1) lb = sigmoidf_(lbp[256 + h * 64 + k] - lbp[h * 64 + k]);
        const bf16_t* zc = P + m0 * LDP + PC_CF + h * 64 + k; const bf16_t* qc = P + m0 * LDP + PC_CQ + h * 64 + k;
        float bc[64], kr[64];
        {   bf16_t zr[64];
#pragma unroll
            for (int s = 0; s < 64; ++s) zr[s] = zc[(size_t)s * LDP];
            float bs = 0.f;
#pragma unroll
            for (int s = 0; s < 64; ++s) { const float f = lb + (1.f - lb) * sigmoidf_(bf2f(zr[s])); bs += __logf(f); bc[s] = bs; kr[s] = 1.f - f; } }
        bmid = bc[31]; bL = bc[63];
#pragma unroll
        for (int g = 0; g < 4; ++g) {
            bf16_t qr[16];
#pragma unroll
            for (int i = 0; i < 16; ++i) qr[i] = qc[(size_t)(16 * g + i) * LDP];
#pragma unroll
            for (int i = 0; i < 16; ++i) { const int s2 = 16 * g + i; const size_t m = m0 + s2;
                const float qa = siluf_(bf2f(qr[i])) * __expf(bc[s2] - bmid), ka = kr[s2] * __expf(bmid - bc[s2]);
                const unsigned kab = f2bf(ka);
                B.QA()[m * 256 + h * 64 + k] = f2bf(qa); B.KA()[m * 256 + h * 64 + k] = (bf16_t)kab;
                const int p = spos_c(s2); if (p & 1) kapk[p >> 1] |= kab << 16; else kapk[p >> 1] = kab; }
        }
    } else {
        const float bi = gbias[h], bfz = gbias[4 + h];
        const float fpre = bf2f(P[(m0 + lane) * LDP + PC_BF + h]) + bfz, ipre = bf2f(P[(m0 + lane) * LDP + PC_BI + h]) + bi;
        float gsum = -log1pf(__expf(-fpre));
#pragma unroll
        for (int o = 1; o < 64; o <<= 1) { const float y = __int_as_float(__builtin_amdgcn_ds_bpermute(((lane - o) & 63) << 2, __float_as_int(gsum))); if (lane >= o) gsum += y; }
        bmid = rdlane(gsum, 31); bL = rdlane(gsum, 63);
        const float ea = __expf(gsum - bmid), eb = __expf(bmid - gsum + ipre);
        const bf16_t* qc = P + m0 * LDP + PC_BQ + h * 64 + k; const bf16_t* kc = P + m0 * LDP + PC_BK + h * 64 + k;
        float wq[4], wk[4];
#pragma unroll
        for (int j = 0; j < 4; ++j) { wq[j] = convw[j * 512 + h * 64 + k]; wk[j] = convw[j * 512 + 256 + h * 64 + k]; }
        float q1 = 0.f, q2 = 0.f, q3 = 0.f, k1 = 0.f, k2 = 0.f, k3 = 0.f;
        if (c > 0) { q1 = bf2f(*(qc - (size_t)1 * LDP)); q2 = bf2f(*(qc - (size_t)2 * LDP)); q3 = bf2f(*(qc - (size_t)3 * LDP));
                     k1 = bf2f(*(kc - (size_t)1 * LDP)); k2 = bf2f(*(kc - (size_t)2 * LDP)); k3 = bf2f(*(kc - (size_t)3 * LDP)); }
#pragma unroll
        for (int g = 0; g < 4; ++g) {
            bf16_t qr[16], kr2[16];
#pragma unroll
            for (int i = 0; i < 16; ++i) { qr[i] = qc[(size_t)(16 * g + i) * LDP]; kr2[i] = kc[(size_t)(16 * g + i) * LDP]; }
#pragma unroll
            for (int i = 0; i < 16; ++i) { const int s2 = 16 * g + i; const size_t m = m0 + s2;
                const float q0 = bf2f(qr[i]), k0 = bf2f(kr2[i]);
                const float qv = wq[3] * q0 + wq[2] * q1 + wq[1] * q2 + wq[0] * q3, kv = wk[3] * k0 + wk[2] * k1 + wk[1] * k2 + wk[0] * k3;
                q3 = q2; q2 = q1; q1 = q0; k3 = k2; k2 = k1; k1 = k0;
                const float qa = siluf_(qv) * 0.125f * rdlane(ea, s2), ka = siluf_(kv) * rdlane(eb, s2);
                const unsigned kab = f2bf(ka);
                B.QA()[m * 256 + h * 64 + k] = f2bf(qa); B.KA()[m * 256 + h * 64 + k] = (bf16_t)kab;
                const int p = spos_c(s2); if (p & 1) kapk[p >> 1] |= kab << 16; else kapk[p >> 1] = kab; }
        }
    }
    uint4* kat = (uint4*)(B.KAT() + ((size_t)ci * 64 + k) * 64);
#pragma unroll
    for (int i = 0; i < 8; ++i) kat[i] = make_uint4(kapk[4 * i], kapk[4 * i + 1], kapk[4 * i + 2], kapk[4 * i + 3]);
    B.dL()[ci * 64 + k] = __expf(bL); B.dmid()[ci * 64 + k] = __expf(bmid); B.dLm()[ci * 64 + k] = __expf(bL - bmid);
}
__device__ __forceinline__ void prep_v(const bf16_t* P, int pcol, bf16_t* VT, int idx) {
    const int e = idx & 63, ci = idx >> 6, h = ci & 3; const size_t m0 = (size_t)(ci >> 2) * 64;
    const bf16_t* vc = P + m0 * LDP + pcol + h * 64 + e;
    bf16_t vr[64];
#pragma unroll
    for (int s = 0; s < 64; ++s) vr[s] = vc[(size_t)s * LDP];
    unsigned pk[32];
#pragma unroll
    for (int s = 0; s < 64; ++s) { const int p = spos_c(s); if (p & 1) pk[p >> 1] |= (unsigned)vr[s] << 16; else pk[p >> 1] = vr[s]; }
    uint4* vt = (uint4*)(VT + ((size_t)ci * 64 + e) * 64);
#pragma unroll
    for (int i = 0; i < 8; ++i) vt[i] = make_uint4(pk[4 * i], pk[4 * i + 1], pk[4 * i + 2], pk[4 * i + 3]);
}
template <int MIX>
__device__ __forceinline__ void stepA(const BufsT<MIX>& B, int ci, int lane) {
    const int r32 = lane & 31, hi = lane >> 5;
    const bf16_t* vt = B.VT() + (size_t)ci * 4096; const bf16_t* kat = B.KAT() + (size_t)ci * 4096;
    f32x16 acc[2][2];
#pragma unroll
    for (int a = 0; a < 2; ++a)
#pragma unroll
        for (int b = 0; b < 2; ++b)
#pragma unroll
            for (int r = 0; r < 16; ++r) acc[a][b][r] = 0.f;
    float nsum[2] = {0.f, 0.f};
#pragma unroll
    for (int g = 0; g < 4; ++g) {
        bf16x8 a[2], bb[2];
#pragma unroll
        for (int et = 0; et < 2; ++et) a[et] = *(const bf16x8*)(vt + (32 * et + r32) * 64 + 16 * g + 8 * hi);
#pragma unroll
        for (int kt = 0; kt < 2; ++kt) { bb[kt] = *(const bf16x8*)(kat + (32 * kt + r32) * 64 + 16 * g + 8 * hi);
            if (MIX == 0) {
#pragma unroll
                for (int j = 0; j < 8; ++j) nsum[kt] += bf2f((bf16_t)bb[kt][j]); } }
#pragma unroll
        for (int et = 0; et < 2; ++et)
#pragma unroll
            for (int kt = 0; kt < 2; ++kt) acc[et][kt] = __builtin_amdgcn_mfma_f32_32x32x16_bf16(a[et], bb[kt], acc[et][kt], 0, 0, 0);
    }
#pragma unroll
    for (int kt = 0; kt < 2; ++kt) {
        const float dl = B.dLm()[ci * 64 + 32 * kt + r32];
#pragma unroll
        for (int et = 0; et < 2; ++et)
#pragma unroll
            for (int r = 0; r < 16; ++r) { const int e = 32 * et + (r & 3) + 8 * (r >> 2) + 4 * hi; B.Ub()[((size_t)ci * 64 + e) * 64 + 32 * kt + r32] = f2bf(acc[et][kt][r] * dl); }
        if (MIX == 0) { const float ns = nsum[kt] + xhalf(nsum[kt], lane); if (hi == 0) B.Un()[ci * 64 + 32 * kt + r32] = ns * dl; }
    }
}
template <int MIX>
__device__ __forceinline__ void stepB(const BufsT<MIX>& B, int idx) {
    const int k = idx & 63, e = (idx >> 6) & 63, bh = idx >> 12, h = bh & 3, b = bh >> 2;
    const bool nrow = MIX == 0 && e == 0;
    float S = 0.f, Sn = 0.f;
#pragma unroll 1
    for (int c0 = 0; c0 < 64; c0 += 16) {
        float dm[16], dl[16], u[16], un[16];
#pragma unroll
        for (int i = 0; i < 16; ++i) { const int ci = (b * 64 + c0 + i) * 4 + h; dm[i] = B.dmid()[ci * 64 + k]; dl[i] = B.dL()[ci * 64 + k];
            u[i] = bf2f(B.Ub()[((size_t)ci * 64 + e) * 64 + k]); un[i] = 0.f;
            if (MIX == 0) { if (nrow) un[i] = B.Un()[ci * 64 + k]; } }
#pragma unroll
        for (int i = 0; i < 16; ++i) { const int ci = (b * 64 + c0 + i) * 4 + h;
            B.Sp()[((size_t)ci * 64 + e) * 64 + k] = f2bf(S * dm[i]);
            if (MIX == 0) { if (nrow) B.np()[ci * 64 + k] = Sn * dm[i]; Sn = dl[i] * Sn + un[i]; }
            S = dl[i] * S + u[i]; }
    }
}
template <int MIX>
__device__ __forceinline__ void stepC(const BufsT<MIX>& B, const bf16_t* P, int gatecol, const float* outg, bf16_t* mixed, int mixcol, int ci, int lane) {
    const int r32 = lane & 31, hi = lane >> 5, h = ci & 3; const size_t m0 = (size_t)(ci >> 2) * 64;
    const bf16_t* vt = B.VT() + (size_t)ci * 4096; const bf16_t* sp = B.Sp() + (size_t)ci * 4096;
#pragma unroll
    for (int tt = 0; tt < 2; ++tt) {
        bf16x8 qf[4], kf[2][4], vf[2][2][2], sf[4][2];
#pragma unroll
        for (int ks = 0; ks < 4; ++ks) qf[ks] = *(const bf16x8*)(B.QA() + (m0 + 32 * tt + r32) * 256 + h * 64 + 16 * ks + 8 * hi);
#pragma unroll
        for (int st = 0; st <= tt; ++st) {
#pragma unroll
            for (int ks = 0; ks < 4; ++ks) kf[st][ks] = *(const bf16x8*)(B.KA() + (m0 + 32 * st + r32) * 256 + h * 64 + 16 * ks + 8 * hi);
#pragma unroll
            for (int s2 = 0; s2 < 2; ++s2)
#pragma unroll
                for (int et = 0; et < 2; ++et) vf[st][s2][et] = *(const bf16x8*)(vt + (32 * et + r32) * 64 + 32 * st + 16 * s2 + 8 * hi); }
#pragma unroll
        for (int ks = 0; ks < 4; ++ks)
#pragma unroll
            for (int et = 0; et < 2; ++et) sf[ks][et] = *(const bf16x8*)(sp + (32 * et + r32) * 64 + 16 * ks + 8 * hi);
        f32x16 o[2];
#pragma unroll
        for (int r = 0; r < 16; ++r) { o[0][r] = 0.f; o[1][r] = 0.f; }
        float den = 0.f;
#pragma unroll
        for (int st = 0; st <= tt; ++st) {
            f32x16 pt;
#pragma unroll
            for (int r = 0; r < 16; ++r) pt[r] = 0.f;
#pragma unroll
            for (int ks = 0; ks < 4; ++ks) pt = __builtin_amdgcn_mfma_f32_32x32x16_bf16(kf[st][ks], qf[ks], pt, 0, 0, 0);
            if (st == tt) {
#pragma unroll
                for (int r = 0; r < 16; ++r) { const int sl = (r & 3) + 8 * (r >> 2) + 4 * hi; pt[r] = sl <= r32 ? pt[r] : 0.f; } }
            if (MIX == 0) {
#pragma unroll
                for (int r = 0; r < 16; ++r) den += pt[r]; }
#pragma unroll
            for (int s2 = 0; s2 < 2; ++s2) {
                fa::u32x4 pw; pw.x = fa::cvtpk(pt[8 * s2 + 0], pt[8 * s2 + 1]); pw.y = fa::cvtpk(pt[8 * s2 + 2], pt[8 * s2 + 3]); pw.z = fa::cvtpk(pt[8 * s2 + 4], pt[8 * s2 + 5]); pw.w = fa::cvtpk(pt[8 * s2 + 6], pt[8 * s2 + 7]);
                const bf16x8 pf = __builtin_bit_cast(bf16x8, pw);
#pragma unroll
                for (int et = 0; et < 2; ++et) o[et] = __builtin_amdgcn_mfma_f32_32x32x16_bf16(vf[st][s2][et], pf, o[et], 0, 0, 0);
            }
        }
#pragma unroll
        for (int ks = 0; ks < 4; ++ks)
#pragma unroll
            for (int et = 0; et < 2; ++et) o[et] = __builtin_amdgcn_mfma_f32_32x32x16_bf16(sf[ks][et], qf[ks], o[et], 0, 0, 0);
        if (MIX == 0) {
#pragma unroll
            for (int ks = 0; ks < 4; ++ks)
#pragma unroll
                for (int j = 0; j < 8; ++j) den += bf2f((bf16_t)qf[ks][j]) * B.np()[ci * 64 + 16 * ks + 8 * hi + j];
            den += xhalf(den, lane);
            const float sc = 1.f / __builtin_fmaxf(__builtin_fabsf(den), 1.f);
#pragma unroll
            for (int r = 0; r < 16; ++r) { o[0][r] *= sc; o[1][r] *= sc; }
        }
        float ss = 0.f;
#pragma unroll
        for (int r = 0; r < 16; ++r) ss += o[0][r] * o[0][r] + o[1][r] * o[1][r];
        ss += xhalf(ss, lane);
        const float rr = rsqrtf(ss * (1.f / 64) + EPS);
        const size_t m = m0 + 32 * tt + r32;
#pragma unroll
        for (int et = 0; et < 2; ++et)
#pragma unroll
            for (int g = 0; g < 4; ++g) {
                const int e = 32 * et + 8 * g + 4 * hi;
                const uint2 gt2 = *(const uint2*)(P + m * LDP + gatecol + h * 64 + e);
                const float4 og = *(const float4*)(outg + h * 64 + e);
                const float g0 = sigmoidf_(__uint_as_float(gt2.x << 16)), g1 = sigmoidf_(__uint_as_float(gt2.x & 0xffff0000u)),
                            g2 = sigmoidf_(__uint_as_float(gt2.y << 16)), g3 = sigmoidf_(__uint_as_float(gt2.y & 0xffff0000u));
                uint2 w; w.x = pk2bf(o[et][4 * g] * rr * og.x * g0, o[et][4 * g + 1] * rr * og.y * g1); w.y = pk2bf(o[et][4 * g + 2] * rr * og.z * g2, o[et][4 * g + 3] * rr * og.w * g3);
                *(uint2*)(mixed + m * DM + mixcol + h * 64 + e) = w;
            }
    }
}
}

template <int N> struct IntC { static constexpr int value = N; };
struct Params {
    const float* x_in; const float* norm_mix; const float* norm_ffn; const float* w_in; const float* w_out;
    const float* diff_q_gain; const float* diff_k_gain; const float* diff_lambda; const float* diff_sub_gain;
    const float* mlstm_conv; const float* mlstm_gate_bias; const float* mlstm_out_gain; const float* hgrn_lb; const float* hgrn_out_gain;
    const float* nsa_cmp_pos; const float* nsa_cmp_w1; const float* nsa_cmp_w2; const float* nsa_q_gain; const float* nsa_k_gain; const float* nsa_out_gain;
    const float* moe_w_group; const float* moe_b_group; const float* moe_w_expert; const float* moe_b_expert;
    const float* moe_w_gate; const float* moe_w_up; const float* moe_w_down;
    float* out; char* ws;
};


constexpr int LDS_TIDTAB = LDS_BYTES - 512;
__device__ __forceinline__ int hw_wave_slot() { return (int)(__builtin_amdgcn_s_getreg((5 << 11) | 4) & 63u); }
__device__ __forceinline__ int lane_id_fresh() { unsigned ones = ~0u; asm volatile("" : "+s"(ones)); return (int)__builtin_amdgcn_mbcnt_hi(ones, __builtin_amdgcn_mbcnt_lo(ones, 0u)); }
__device__ __forceinline__ int phase_tid(const unsigned char* lds_generic) {
    const __attribute__((address_space(3))) int* tab = (const __attribute__((address_space(3))) int*)((const __attribute__((address_space(3))) unsigned char*)lds_generic + LDS_TIDTAB);
    const int w = __builtin_amdgcn_readfirstlane(tab[hw_wave_slot()]);
    return w * 64 + lane_id_fresh();
}

__device__ __forceinline__ int phase_tid_fwd(const unsigned char* lds_generic) { return phase_tid(lds_generic); }

constexpr size_t al256(size_t x) { return (x + 255) & ~(size_t)255; }
constexpr size_t WS_P = 0;
constexpr size_t WS_TB = WS_P + al256((size_t)MT * LDP * 2);
constexpr size_t WS_MIXED = WS_TB + al256((size_t)MT * DM * 2);
constexpr size_t WS_DQ = WS_MIXED + al256((size_t)MT * DM * 2);
constexpr size_t WS_DK = WS_DQ + al256((size_t)MT * 256 * 4);
constexpr size_t WS_NQ = WS_DK + al256((size_t)MT * 256 * 4);
constexpr size_t WS_KSN = WS_NQ + al256((size_t)MT * 256 * 4);
constexpr size_t WS_KWN = WS_KSN + al256((size_t)MT * 64 * 4);
constexpr size_t WS_CMP = WS_KWN + al256((size_t)MT * 64 * 4);
constexpr size_t WS_OCMP = WS_CMP + al256((size_t)2 * NB * NCMP * 64 * 4);
constexpr size_t WS_IMP = WS_OCMP + al256((size_t)MT * 256 * 4);
constexpr size_t WS_SELMASK = WS_IMP + al256((size_t)MT * 64 * 4);
constexpr size_t WS_RE = WS_SELMASK + al256((size_t)MT * 8);
constexpr size_t WS_RW = WS_RE + al256((size_t)MT * 2 * 4);
constexpr size_t WS_RS = WS_RW + al256((size_t)MT * 2 * 4);
constexpr int MOE_ROWS_MAX = 2 * MT + 32 * 256;
constexpr size_t WS_ROWTOK = WS_RS + al256((size_t)MT * 2 * 4);
constexpr size_t WS_ROWW = WS_ROWTOK + al256((size_t)MOE_ROWS_MAX * 4);
constexpr size_t WS_CNT = WS_ROWW + al256((size_t)MOE_ROWS_MAX * 4);
constexpr size_t WS_CNTBLK = WS_CNT + 256;
constexpr size_t WS_BAR = WS_CNTBLK + 1024 * 32 * 4;
constexpr size_t WS_WIN_T = WS_BAR + 32768;
constexpr size_t WS_WOUT_T = WS_WIN_T + 2 * al256((size_t)LDP * DM * 2);
constexpr size_t WS_W1T = WS_WOUT_T + 2 * al256((size_t)DM * DM * 2);
constexpr size_t WS_DGATE = WS_W1T + 2 * al256((size_t)2 * 64 * 2048 * 2);
constexpr size_t WS_END = WS_DGATE + al256((size_t)MT * 12 * 2);
static_assert((size_t)32 * 512 * DM * 2 + (size_t)32 * DM * 256 * 2 + (size_t)MOE_ROWS_MAX * 256 * 2 <= WS_TB, "MoE weight copies + H overlay P");
constexpr size_t WS_RES = al256((size_t)32 * 512 * DM * 2 + (size_t)32 * DM * 256 * 2 + (size_t)MOE_ROWS_MAX * 256 * 2);
static_assert(WS_RES + (size_t)MT * DM * 2 <= WS_TB, "bf16 residual copy fits in the P tail");
static_assert(WS_MIXED + (size_t)MOE_ROWS_MAX * DM * 2 <= WS_SELMASK, "sorted activations overlay mixed..imp");
#define W_P ((bf16_t*)(pq->ws + WS_P))
#define W_TB ((bf16_t*)(pq->ws + WS_TB))
#define W_RES ((bf16_t*)(pq->ws + WS_RES))
#define W_MIXED ((bf16_t*)(pq->ws + WS_MIXED))
#define W_DQ ((float*)(pq->ws + WS_DQ))
#define W_DK ((float*)(pq->ws + WS_DK))
#define W_QBF ((bf16_t*)(pq->ws + WS_DQ))
#define W_DKF ((bf16_t*)(pq->ws + WS_DK))
#define W_DVF ((bf16_t*)(pq->ws + WS_DK + (size_t)MT * 256 * 2))
#define W_DO ((float*)(pq->ws + WS_TB))
#define W_NQ ((float*)(pq->ws + WS_NQ))
#define W_NQB ((bf16_t*)(pq->ws + WS_NQ))
#define W_KSF ((bf16_t*)(pq->ws + WS_KSN))
#define W_VSF ((bf16_t*)(pq->ws + WS_KSN + (size_t)MT * 64 * 2))
#define W_KWF ((bf16_t*)(pq->ws + WS_KWN))
#define W_VWF ((bf16_t*)(pq->ws + WS_KWN + (size_t)MT * 64 * 2))
#define W_KCF ((bf16_t*)(pq->ws + WS_CMP))
#define W_VCF ((bf16_t*)(pq->ws + WS_CMP + 131072))
#define W_QUEUE ((unsigned*)(pq->ws + WS_BAR + 16384))
#define W_KSN ((float*)(pq->ws + WS_KSN))
#define W_KWN ((float*)(pq->ws + WS_KWN))
#define W_CMP ((float*)(pq->ws + WS_CMP))
#define W_OCMP ((float*)(pq->ws + WS_OCMP))
#define W_IMP ((float*)(pq->ws + WS_IMP))
#define W_OSEL W_DQ
#define W_OWIN W_DK
#define W_SELMASK ((unsigned long long*)(pq->ws + WS_SELMASK))
#define W_RE ((int*)(pq->ws + WS_RE))
#define W_RW ((float*)(pq->ws + WS_RW))
#define W_RS ((int*)(pq->ws + WS_RS))
#define W_ROWTOK ((int*)(pq->ws + WS_ROWTOK))
#define W_ROWW ((float*)(pq->ws + WS_ROWW))
#define W_CNT ((int*)(pq->ws + WS_CNT))
#define W_CNTBLK ((int*)(pq->ws + WS_CNTBLK))
#define W_WGU_T ((bf16_t*)(pq->ws + WS_P))
#define W_WD_T ((bf16_t*)(pq->ws + WS_P + (size_t)32 * 512 * DM * 2))
#define W_HS ((bf16_t*)(pq->ws + WS_P + (size_t)32 * 512 * DM * 2 + (size_t)32 * DM * 256 * 2))
#define W_ASORT ((bf16_t*)(pq->ws + WS_MIXED))
#define W_YMOE ((bf16_t*)(pq->ws + WS_MIXED))

#define SCAN_BUFS(Bm, Bh) scan::BufsT<0> Bm{pq->ws + WS_DQ, pq->ws + WS_TB}; scan::BufsT<1> Bh{pq->ws + WS_DQ, pq->ws + WS_TB};
static_assert(WS_DQ + (size_t)9 * MT * 256 * 2 + (size_t)5 * 1024 * 64 * 4 <= WS_SELMASK, "scan overlay 1");
static_assert((size_t)3 * MT * 256 * 2 + (size_t)5 * 1024 * 64 * 4 <= (size_t)MT * DM * 2, "scan overlay 2");
#define W_WIN_T_L(L) ((bf16_t*)(pq->ws + WS_WIN_T + (size_t)(L) * al256((size_t)LDP * DM * 2)))
#define W_WIN_T W_WIN_T_L(l)
#define W_WOUT_T_L(L) ((bf16_t*)(pq->ws + WS_WOUT_T + (size_t)(L) * al256((size_t)DM * DM * 2)))
#define W_WOUT_T W_WOUT_T_L(l)
#define W_DGATE ((bf16_t*)(pq->ws + WS_DGATE))
#define W_W1T_L(L) ((bf16_t*)(pq->ws + WS_W1T + (size_t)(L) * al256((size_t)2 * 64 * 2048 * 2)))
#define W_W1T W_W1T_L(l)

__device__ __forceinline__ float4 bf4_to_f4(uint2 u) { return make_float4(__uint_as_float(u.x << 16), __uint_as_float(u.x & 0xffff0000u), __uint_as_float(u.y << 16), __uint_as_float(u.y & 0xffff0000u)); }
#ifndef NORM_NR
#define NORM_NR 4
#endif
template <int NR>
__device__ __forceinline__ void norm_rows(float* x, const float* xsrc, const bf16_t* ymoe, const float* gain, bf16_t* t, int row, int rstride, int lane) {
    float4 v[NR][4]; float s[NR];
#pragma unroll
    for (int k = 0; k < NR; ++k) { const float4* xr = (const float4*)(xsrc + (size_t)(row + k * rstride) * DM);
#pragma unroll
        for (int j = 0; j < 4; ++j) v[k][j] = xr[lane + 64 * j]; }
    if (ymoe) {
        uint2 ya[NR][4], yb[NR][4];
#pragma unroll
        for (int k = 0; k < NR; ++k) { const uint2* y0 = (const uint2*)(ymoe + (size_t)(row + k * rstride) * 2 * DM);
#pragma unroll
            for (int j = 0; j < 4; ++j) { ya[k][j] = y0[lane + 64 * j]; yb[k][j] = y0[256 + lane + 64 * j]; } }
#pragma unroll
        for (int k = 0; k < NR; ++k)
#pragma unroll
            for (int j = 0; j < 4; ++j) { const float4 a = bf4_to_f4(ya[k][j]), b = bf4_to_f4(yb[k][j]);
                v[k][j].x += a.x + b.x; v[k][j].y += a.y + b.y; v[k][j].z += a.z + b.z; v[k][j].w += a.w + b.w; ((float4*)(x + (size_t)(row + k * rstride) * DM))[lane + 64 * j] = v[k][j]; }
    }
#pragma unroll
    for (int k = 0; k < NR; ++k) { s[k] = 0.f;
#pragma unroll
        for (int j = 0; j < 4; ++j) s[k] += v[k][j].x * v[k][j].x + v[k][j].y * v[k][j].y + v[k][j].z * v[k][j].z + v[k][j].w * v[k][j].w; }
#pragma unroll
    for (int o = 1; o < 64; o <<= 1) {
#pragma unroll
        for (int k = 0; k < NR; ++k) s[k] += __int_as_float(__builtin_amdgcn_ds_bpermute((lane ^ o) << 2, __float_as_int(s[k]))); }
#pragma unroll
    for (int j = 0; j < 4; ++j) {
        const float4 g = ((const float4*)gain)[lane + 64 * j];
#pragma unroll
        for (int k = 0; k < NR; ++k) { const float r = rsqrtf(s[k] * (1.f / DM) + EPS);
            ushort4 o; o.x = f2bf(v[k][j].x * r * g.x); o.y = f2bf(v[k][j].y * r * g.y); o.z = f2bf(v[k][j].z * r * g.z); o.w = f2bf(v[k][j].w * r * g.w);
            ((ushort4*)(t + (size_t)(row + k * rstride) * DM))[lane + 64 * j] = o; }
    }
}


template <int NR>
__device__ __forceinline__ void norm_rows_bf(bf16_t* xout, const bf16_t* xsrc, const bf16_t* ymoe, const float* gain, bf16_t* t, int row, int rstride, int lane) {
    float4 v[NR][4]; float s[NR];
    {   uint2 xr[NR][4], ya[NR][4], yb[NR][4];
#pragma unroll
        for (int k = 0; k < NR; ++k) { const uint2* x0 = (const uint2*)(xsrc + (size_t)(row + k * rstride) * DM); const uint2* y0 = (const uint2*)(ymoe + (size_t)(row + k * rstride) * 2 * DM);
#pragma unroll
            for (int j = 0; j < 4; ++j) { xr[k][j] = x0[lane + 64 * j]; ya[k][j] = y0[lane + 64 * j]; yb[k][j] = y0[256 + lane + 64 * j]; } }
#pragma unroll
        for (int k = 0; k < NR; ++k)
#pragma unroll
            for (int j = 0; j < 4; ++j) { const float4 x4 = bf4_to_f4(xr[k][j]), a = bf4_to_f4(ya[k][j]), b = bf4_to_f4(yb[k][j]);
                v[k][j].x = x4.x + (a.x + b.x); v[k][j].y = x4.y + (a.y + b.y); v[k][j].z = x4.z + (a.z + b.z); v[k][j].w = x4.w + (a.w + b.w);
                uint2 o; o.x = pk2bf(v[k][j].x, v[k][j].y); o.y = pk2bf(v[k][j].z, v[k][j].w); ((uint2*)(xout + (size_t)(row + k * rstride) * DM))[lane + 64 * j] = o; }
    }
#pragma unroll
    for (int k = 0; k < NR; ++k) { s[k] = 0.f;
#pragma unroll
        for (int j = 0; j < 4; ++j) s[k] += v[k][j].x * v[k][j].x + v[k][j].y * v[k][j].y + v[k][j].z * v[k][j].z + v[k][j].w * v[k][j].w; }
#pragma unroll
    for (int o = 1; o < 64; o <<= 1) {
#pragma unroll
        for (int k = 0; k < NR; ++k) s[k] += __int_as_float(__builtin_amdgcn_ds_bpermute((lane ^ o) << 2, __float_as_int(s[k]))); }
#pragma unroll
    for (int j = 0; j < 4; ++j) {
        const float4 g = ((const float4*)gain)[lane + 64 * j];
#pragma unroll
        for (int k = 0; k < NR; ++k) { const float r = rsqrtf(s[k] * (1.f / DM) + EPS);
            ushort4 o; o.x = f2bf(v[k][j].x * r * g.x); o.y = f2bf(v[k][j].y * r * g.y); o.z = f2bf(v[k][j].z * r * g.z); o.w = f2bf(v[k][j].w * r * g.w);
            ((ushort4*)(t + (size_t)(row + k * rstride) * DM))[lane + 64 * j] = o; }
    }
}


typedef __attribute__((address_space(3))) float lds_f32;
typedef unsigned v4u_t __attribute__((ext_vector_type(4)));
template <bool MAP>
__device__ __forceinline__ void transpose_item(const float* W, int K, int Nsrc, int Nnew, bf16_t* WT, lds_f32* scr, int item, int lane) {
    const int nblk = Nnew / 32, kb = item / nblk, nb = item % nblk, k0 = 64 * kb, n0 = 32 * nb;
    const int n = n0 + (lane & 31); const int sc = MAP ? src_col(n) : n; const bool ok = MAP ? (n < IN_COLS) : true;
    float tv[32];
#pragma unroll
    for (int i = 0; i < 32; ++i) { const int kk = 2 * i + (lane >> 5); tv[i] = ok ? W[(size_t)(k0 + kk) * Nsrc + sc] : 0.f; }
#pragma unroll
    for (int i = 0; i < 32; ++i) { const int kk = 2 * i + (lane >> 5); scr[kk * 33 + (lane & 31)] = tv[i]; }
    asm volatile("s_waitcnt lgkmcnt(0)" ::: "memory");
    const int c = lane & 7;
#pragma unroll
    for (int j = 0; j < 4; ++j) { const int nn = (lane >> 3) + 8 * j; const lds_f32* sp = scr + (8 * c) * 33 + nn;
        v4u_t o; o.x = pk2bf(sp[0 * 33], sp[1 * 33]); o.y = pk2bf(sp[2 * 33], sp[3 * 33]); o.z = pk2bf(sp[4 * 33], sp[5 * 33]); o.w = pk2bf(sp[6 * 33], sp[7 * 33]);
        *(v4u_t*)(WT + (size_t)(n0 + nn) * K + k0 + 8 * c) = o; }
    asm volatile("s_waitcnt lgkmcnt(0)" ::: "memory");
}

constexpr float LOG2E = 1.4426950408889634f;
__device__ __forceinline__ void diff_prep_qk(const bf16_t* P, const float* qgain, const float* kgain, bf16_t* Qbf, bf16_t* Kf, int idx) {
    const int m = idx >> 3, g = idx & 7;
    {   const uint4* p = (const uint4*)(P + (size_t)m * LDP + PC_AQ + g * 32); float v[32]; float ss = 0.f;
#pragma unroll
        for (int i = 0; i < 4; ++i) { const uint4 u = p[i]; const unsigned w[4] = {u.x, u.y, u.z, u.w};
#pragma unroll
            for (int j = 0; j < 4; ++j) { v[i * 8 + 2 * j] = __uint_as_float(w[j] << 16); v[i * 8 + 2 * j + 1] = __uint_as_float(w[j] & 0xffff0000u); } }
#pragma unroll
        for (int d = 0; d < 32; ++d) ss += v[d] * v[d];
        const float r = rsqrtf(ss * (1.f / 32) + EPS) * (0.17677669529663687f * LOG2E);
        uint4* o = (uint4*)(Qbf + (size_t)m * 256 + g * 32);
#pragma unroll
        for (int i = 0; i < 4; ++i) { uint4 u; u.x = pk2bf(v[i * 8 + 0] * r * qgain[i * 8 + 0], v[i * 8 + 1] * r * qgain[i * 8 + 1]); u.y = pk2bf(v[i * 8 + 2] * r * qgain[i * 8 + 2], v[i * 8 + 3] * r * qgain[i * 8 + 3]);
            u.z = pk2bf(v[i * 8 + 4] * r * qgain[i * 8 + 4], v[i * 8 + 5] * r * qgain[i * 8 + 5]); u.w = pk2bf(v[i * 8 + 6] * r * qgain[i * 8 + 6], v[i * 8 + 7] * r * qgain[i * 8 + 7]); o[i] = u; } }
    {   const uint4* p = (const uint4*)(P + (size_t)m * LDP + PC_AK + g * 32); float v[32]; float ss = 0.f;
#pragma unroll
        for (int i = 0; i < 4; ++i) { const uint4 u = p[i]; const unsigned w[4] = {u.x, u.y, u.z, u.w};
#pragma unroll
            for (int j = 0; j < 4; ++j) { v[i * 8 + 2 * j] = __uint_as_float(w[j] << 16); v[i * 8 + 2 * j + 1] = __uint_as_float(w[j] & 0xffff0000u); } }
#pragma unroll
        for (int d = 0; d < 32; ++d) ss += v[d] * v[d];
        const float r = rsqrtf(ss * (1.f / 32) + EPS);
        const int b = m / SEQ, t = m % SEQ, tile = t >> 6, kb = (t >> 5) & 1, rr = t & 31;
#pragma unroll
        for (int i = 0; i < 4; ++i) { uint4 u; u.x = pk2bf(v[i * 8 + 0] * r * kgain[i * 8 + 0], v[i * 8 + 1] * r * kgain[i * 8 + 1]); u.y = pk2bf(v[i * 8 + 2] * r * kgain[i * 8 + 2], v[i * 8 + 3] * r * kgain[i * 8 + 3]);
            u.z = pk2bf(v[i * 8 + 4] * r * kgain[i * 8 + 4], v[i * 8 + 5] * r * kgain[i * 8 + 5]); u.w = pk2bf(v[i * 8 + 6] * r * kgain[i * 8 + 6], v[i * 8 + 7] * r * kgain[i * 8 + 7]);
            const int ks = i >> 1, hh = i & 1;
            *(uint4*)(Kf + ((((((size_t)(b * 8 + g) * 64 + tile) * 2 + kb) * 2 + ks) * 32 + rr) * 2 + hh) * 8) = u; } }
}
__device__ __forceinline__ void vfrag_item(const bf16_t* P, int pcol, int hstride, int nheads, bf16_t* Vf, int idx) {
    const int hh = idx & 1, d32 = (idx >> 1) & 31, dblk = (idx >> 6) & 1, sp = (idx >> 7) & 1, kb = (idx >> 8) & 1, tile = (idx >> 9) & 63;
    const int bh = idx >> 15, h = bh % nheads, b = bh / nheads;
    const int key0 = 64 * tile + 32 * kb + 16 * sp + 4 * hh, col = pcol + h * hstride + dblk * 32 + d32;
    unsigned short e[8];
#pragma unroll
    for (int j = 0; j < 8; ++j) e[j] = P[(size_t)(b * SEQ + key0 + 8 * (j >> 2) + (j & 3)) * LDP + col];
    uint4 u; u.x = e[0] | ((unsigned)e[1] << 16); u.y = e[2] | ((unsigned)e[3] << 16); u.z = e[4] | ((unsigned)e[5] << 16); u.w = e[6] | ((unsigned)e[7] << 16);
    *(uint4*)(Vf + (size_t)idx * 8) = u;
}

__device__ __forceinline__ int kcf_off(int n, int d);
__device__ __forceinline__ int vcf_off(int n, int d);
__device__ __forceinline__ void nsa_compress_unit(FA_LAS unsigned char* lds, int tid, const bf16_t* P, const float* pos, const bf16_t* W1T, const float* w2, const float* kgain0, float* cmp, int item) {
    const int lane = tid & 63, wave = tid >> 6, r32 = lane & 31, hi = lane >> 5, j = item >> 5, rt = item & 31;
    const int pc = j == 0 ? PC_KC : PC_VC;
    {   const int R = min(rt * 32 + r32, NB * NCMP - 1), b = R / NCMP, n = R % NCMP;
        fa::f32x16 acc0, acc1;
#pragma unroll
        for (int r = 0; r < 16; ++r) { acc0[r] = 0.f; acc1[r] = 0.f; }
        const bf16_t* arow = P + (size_t)(b * SEQ + 16 * n) * LDP + pc;
#pragma unroll 4
        for (int ksl = 0; ksl < 16; ++ksl) {
            const int kbase = (wave * 16 + ksl) * 16 + 8 * hi, l = kbase >> 6, d = kbase & 63;
            const uint4 raw = *(const uint4*)(arow + (size_t)l * LDP + d);
            const float4 p0 = *(const float4*)(pos + (j * 32 + l) * 64 + d), p1 = *(const float4*)(pos + (j * 32 + l) * 64 + d + 4);
            fa::u32x4 aw;
            aw.x = pk2bf(__uint_as_float(raw.x << 16) + p0.x, __uint_as_float(raw.x & 0xffff0000u) + p0.y); aw.y = pk2bf(__uint_as_float(raw.y << 16) + p0.z, __uint_as_float(raw.y & 0xffff0000u) + p0.w);
            aw.z = pk2bf(__uint_as_float(raw.z << 16) + p1.x, __uint_as_float(raw.z & 0xffff0000u) + p1.y); aw.w = pk2bf(__uint_as_float(raw.w << 16) + p1.z, __uint_as_float(raw.w & 0xffff0000u) + p1.w);
            const fa::bf16x8 af = __builtin_bit_cast(fa::bf16x8, aw);
            const fa::bf16x8 b0 = *(const fa::bf16x8*)(W1T + (size_t)(j * 64 + r32) * 2048 + kbase), b1 = *(const fa::bf16x8*)(W1T + (size_t)(j * 64 + 32 + r32) * 2048 + kbase);
            acc0 = __builtin_amdgcn_mfma_f32_32x32x16_bf16(af, b0, acc0, 0, 0, 0);
            acc1 = __builtin_amdgcn_mfma_f32_32x32x16_bf16(af, b1, acc1, 0, 0, 0);
        }
        FA_LAS float* part = (FA_LAS float*)lds;
#pragma unroll
        for (int r = 0; r < 16; ++r) { const int row = (r & 3) + 8 * (r >> 2) + 4 * hi; part[(wave * 32 + row) * 64 + r32] = acc0[r]; part[(wave * 32 + row) * 64 + 32 + r32] = acc1[r]; }
    }
    __syncthreads();
    const int row = tid >> 4, c4 = (tid & 15) * 4;
    FA_LAS float* hidl = (FA_LAS float*)(lds + 65536);
    {   const FA_LAS float* part = (const FA_LAS float*)lds;
#pragma unroll
        for (int i = 0; i < 4; ++i) { float x = 0.f;
#pragma unroll
            for (int w = 0; w < 8; ++w) x += part[(w * 32 + row) * 64 + c4 + i];
            const float u = 0.7978845608028654f * (x + 0.044715f * x * x * x), th = 1.f - 2.f / (1.f + __expf(2.f * u));
            hidl[row * 64 + c4 + i] = 0.5f * x * (1.f + th); }
    }
    __syncthreads();
    float y[4] = {0.f, 0.f, 0.f, 0.f};
#pragma unroll 1
    for (int k0 = 0; k0 < 64; k0 += 16) {
        float4 wv[16];
#pragma unroll
        for (int u = 0; u < 16; ++u) wv[u] = *(const float4*)(w2 + (j * 64 + k0 + u) * 64 + c4);
#pragma unroll
        for (int u = 0; u < 16; ++u) { const float hv = hidl[row * 64 + k0 + u]; y[0] += hv * wv[u].x; y[1] += hv * wv[u].y; y[2] += hv * wv[u].z; y[3] += hv * wv[u].w; } }
    if (j == 0) { float ss = y[0] * y[0] + y[1] * y[1] + y[2] * y[2] + y[3] * y[3];
#pragma unroll
        for (int o = 1; o < 16; o <<= 1) ss += __int_as_float(__builtin_amdgcn_ds_bpermute((lane ^ o) << 2, __float_as_int(ss)));
        const float r = rsqrtf(ss * (1.f / 64) + EPS);
#pragma unroll
        for (int i = 0; i < 4; ++i) y[i] = y[i] * r * kgain0[c4 + i]; }
    const int R = rt * 32 + row;
    if (R < NB * NCMP) { const int b = R / NCMP, n = R % NCMP;
        bf16_t* dst = (bf16_t*)cmp + (size_t)j * 65536 + (size_t)b * 4 * 4096;
#pragma unroll
        for (int i = 0; i < 4; ++i) { if (j == 0) dst[kcf_off(n, c4 + i)] = f2bf(y[i]); else dst[vcf_off(n, c4 + i)] = f2bf(y[i]);
            if (n == NCMP - 1) { if (j == 0) dst[kcf_off(NCMP, c4 + i)] = 0; else dst[vcf_off(NCMP, c4 + i)] = 0; } } }
    __syncthreads();
}
__device__ __forceinline__ void moe_route_row(const float* x, const float* gain, const FA_LAS float* wl  , const float* bg, const float* be, bf16_t* t, int* re, float* rw, int* rs, FA_LAS int* cnt  ,
                                              int row, int lane) {
    const float4* xr = (const float4*)(x + (size_t)row * DM);
    float4 v[4]; float s = 0.f;
#pragma unroll
    for (int j = 0; j < 4; ++j) { v[j] = xr[lane + 64 * j]; s += v[j].x * v[j].x + v[j].y * v[j].y + v[j].z * v[j].z + v[j].w * v[j].w; }
    const float r = rsqrtf(wave_sum(s, lane) * (1.f / DM) + EPS);
    float lg[36];
#pragma unroll
    for (int o = 0; o < 36; ++o) lg[o] = 0.f;
#pragma unroll
    for (int j = 0; j < 4; ++j) {
        const float4 g = ((const float4*)gain)[lane + 64 * j];
        float tn[4] = {v[j].x * r * g.x, v[j].y * r * g.y, v[j].z * r * g.z, v[j].w * r * g.w};
        ushort4 o4; o4.x = f2bf(tn[0]); o4.y = f2bf(tn[1]); o4.z = f2bf(tn[2]); o4.w = f2bf(tn[3]);
        ((ushort4*)(t + (size_t)row * DM))[lane + 64 * j] = o4;
#pragma unroll
        for (int i = 0; i < 4; ++i) {
            const int k = (lane + 64 * j) * 4 + i;
            typedef float f32x4v __attribute__((ext_vector_type(4)));
            const FA_LAS f32x4v* wr = (const FA_LAS f32x4v*)(wl + (((j * 4 + i) * 64 + lane) * 36)); (void)k;
            const f32x4v w4 = wr[0];
            lg[0] += tn[i] * w4.x; lg[1] += tn[i] * w4.y; lg[2] += tn[i] * w4.z; lg[3] += tn[i] * w4.w;
#pragma unroll
            for (int e4 = 0; e4 < 8; ++e4) { const f32x4v w = wr[1 + e4];
                lg[4 + e4 * 4 + 0] += tn[i] * w.x; lg[4 + e4 * 4 + 1] += tn[i] * w.y; lg[4 + e4 * 4 + 2] += tn[i] * w.z; lg[4 + e4 * 4 + 3] += tn[i] * w.w; }
            asm volatile("" ::: "memory");
        }
    }
#pragma unroll
    for (int o = 0; o < 36; ++o) lg[o] = wave_sum(lg[o], lane);
    float gl[4]; float gmx = NEG; int gs = 0;
#pragma unroll
    for (int g = 0; g < 4; ++g) { gl[g] = lg[g] + bg[g]; if (gl[g] > gmx) { gmx = gl[g]; gs = g; } }
    float gz = 0.f;
#pragma unroll
    for (int g = 0; g < 4; ++g) gz += __expf(gl[g] - gmx);
    const float gprob = 1.f / gz;
    float el[8];
#pragma unroll
    for (int e = 0; e < 8; ++e) {
        const float a0 = lg[4 + e] + be[e], a1 = lg[12 + e] + be[8 + e], a2 = lg[20 + e] + be[16 + e], a3 = lg[28 + e] + be[24 + e];
        el[e] = gs == 0 ? a0 : (gs == 1 ? a1 : (gs == 2 ? a2 : a3));
    }
    float m1 = NEG; int i1 = 0;
#pragma unroll
    for (int e = 0; e < 8; ++e) if (el[e] > m1) { m1 = el[e]; i1 = e; }
    float m2 = NEG; int i2 = 0;
#pragma unroll
    for (int e = 0; e < 8; ++e) if (e != i1 && el[e] > m2) { m2 = el[e]; i2 = e; }
    const float p2 = __expf(m2 - m1);
    const float w1 = gprob / (1.f + p2), w2 = gprob * p2 / (1.f + p2);
    if (lane == 0) { const int e1 = gs * 8 + i1, e2 = gs * 8 + i2;
        re[row * 2] = e1; re[row * 2 + 1] = e2; rw[row * 2] = w1; rw[row * 2 + 1] = w2;
        rs[row * 2] = __hip_atomic_fetch_add(cnt + e1, 1, __ATOMIC_RELAXED, __HIP_MEMORY_SCOPE_WORKGROUP); rs[row * 2 + 1] = __hip_atomic_fetch_add(cnt + e2, 1, __ATOMIC_RELAXED, __HIP_MEMORY_SCOPE_WORKGROUP); }
}


constexpr int RT_RS = 1032;
constexpr int RT_IMG_BYTES = 2 * 36 * RT_RS * 2;
static_assert(RT_IMG_BYTES + 128 + 1024 <= LDS_TIDTAB, "router weight image + counters + sum-of-squares exchange fit below the LDS control words");
__device__ __forceinline__ void moe_route_round(FA_LAS unsigned char* lds, int tid, const bf16_t* x, const float* gain, const float* bg, const float* be, bf16_t* tb, int* re, float* rw, int* rs,
                                                int tile, bool valid) {
    const int lane = tid & 63, wave = tid >> 6, r32 = lane & 31, hi = lane >> 5, tsel = wave >> 2, kq = wave & 3;
    const FA_LAS bf16_t* wimg = (const FA_LAS bf16_t*)lds;
    FA_LAS int* cnt = (FA_LAS int*)(lds + RT_IMG_BYTES);
    FA_LAS float* ssx = (FA_LAS float*)(lds + RT_IMG_BYTES + 128);
    const int row = tile * 32 + r32;
    const bf16_t* xr = x + (size_t)(valid ? row : 0) * DM + 256 * kq + 8 * hi;
    float ss = 0.f;
    {   uint4 xa[16];
#pragma unroll
        for (int ks = 0; ks < 16; ++ks) xa[ks] = *(const uint4*)(xr + 16 * ks);
#pragma unroll
        for (int ks = 0; ks < 16; ++ks) { const float4 a = bf4_to_f4(make_uint2(xa[ks].x, xa[ks].y)), b = bf4_to_f4(make_uint2(xa[ks].z, xa[ks].w)); ss += (a.x * a.x + a.y * a.y) + (a.z * a.z + a.w * a.w) + (b.x * b.x + b.y * b.y) + (b.z * b.z + b.w * b.w); } }
    ss += fa::xhalf(ss, lane);
    if (hi == 0) ssx[(tsel * 4 + kq) * 32 + r32] = ss;
    __syncthreads();
    const float rstd = rsqrtf(((ssx[(tsel * 4 + 0) * 32 + r32] + ssx[(tsel * 4 + 1) * 32 + r32]) + (ssx[(tsel * 4 + 2) * 32 + r32] + ssx[(tsel * 4 + 3) * 32 + r32])) * (1.f / DM) + EPS);
    fa::f32x16 acc0, acc1;
#pragma unroll
    for (int r = 0; r < 16; ++r) { acc0[r] = 0.f; acc1[r] = 0.f; }
    const FA_LAS bf16_t* whi0 = wimg + r32 * RT_RS + 256 * kq + 8 * hi; const FA_LAS bf16_t* whi1 = wimg + min(32 + r32, 35) * RT_RS + 256 * kq + 8 * hi;
    const FA_LAS bf16_t* wlo0 = whi0 + 36 * RT_RS; const FA_LAS bf16_t* wlo1 = whi1 + 36 * RT_RS;
    bf16_t* trow = tb + (size_t)row * DM + 256 * kq + 8 * hi;
    const float* gq = gain + 256 * kq + 8 * hi;
#pragma unroll 4
    for (int ks = 0; ks < 16; ++ks) {
        const uint4 xv = *(const uint4*)(xr + 16 * ks); const float4 a = bf4_to_f4(make_uint2(xv.x, xv.y)), b = bf4_to_f4(make_uint2(xv.z, xv.w));
        const float4 ga = *(const float4*)(gq + 16 * ks), gb = *(const float4*)(gq + 16 * ks + 4);
        const float t[8] = {a.x * rstd * ga.x, a.y * rstd * ga.y, a.z * rstd * ga.z, a.w * rstd * ga.w, b.x * rstd * gb.x, b.y * rstd * gb.y, b.z * rstd * gb.z, b.w * rstd * gb.w};
        fa::u32x4 ph, pl;
        ph.x = fa::cvtpk(t[0], t[1]); ph.y = fa::cvtpk(t[2], t[3]); ph.z = fa::cvtpk(t[4], t[5]); ph.w = fa::cvtpk(t[6], t[7]);
        pl.x = fa::cvtpk(t[0] - __uint_as_float(ph.x << 16), t[1] - __uint_as_float(ph.x & 0xffff0000u)); pl.y = fa::cvtpk(t[2] - __uint_as_float(ph.y << 16), t[3] - __uint_as_float(ph.y & 0xffff0000u));
        pl.z = fa::cvtpk(t[4] - __uint_as_float(ph.z << 16), t[5] - __uint_as_float(ph.z & 0xffff0000u)); pl.w = fa::cvtpk(t[6] - __uint_as_float(ph.w << 16), t[7] - __uint_as_float(ph.w & 0xffff0000u));
        if (valid) *(fa::u32x4*)(trow + 16 * ks) = ph;
        const fa::bf16x8 bh = __builtin_bit_cast(fa::bf16x8, ph), bl = __builtin_bit_cast(fa::bf16x8, pl);
        const fa::bf16x8 ah0 = *(const FA_LAS fa::bf16x8*)(whi0 + 16 * ks), ah1 = *(const FA_LAS fa::bf16x8*)(whi1 + 16 * ks);
        const fa::bf16x8 al0 = *(const FA_LAS fa::bf16x8*)(wlo0 + 16 * ks), al1 = *(const FA_LAS fa::bf16x8*)(wlo1 + 16 * ks);
        acc0 = __builtin_amdgcn_mfma_f32_32x32x16_bf16(ah0, bh, acc0, 0, 0, 0); acc1 = __builtin_amdgcn_mfma_f32_32x32x16_bf16(ah1, bh, acc1, 0, 0, 0);
        acc0 = __builtin_amdgcn_mfma_f32_32x32x16_bf16(al0, bh, acc0, 0, 0, 0); acc1 = __builtin_amdgcn_mfma_f32_32x32x16_bf16(al1, bh, acc1, 0, 0, 0);
        acc0 = __builtin_amdgcn_mfma_f32_32x32x16_bf16(ah0, bl, acc0, 0, 0, 0); acc1 = __builtin_amdgcn_mfma_f32_32x32x16_bf16(ah1, bl, acc1, 0, 0, 0);
    }
    __syncthreads();
    FA_LAS float* xch = (FA_LAS float*)lds;
#pragma unroll
    for (int r = 0; r < 16; ++r) xch[((tsel * 4 + kq) * 20 + r) * 64 + lane] = acc0[r];
#pragma unroll
    for (int r = 0; r < 4; ++r) xch[((tsel * 4 + kq) * 20 + 16 + r) * 64 + lane] = acc1[r];
    __syncthreads();
    if (kq == 0 && valid) {
#pragma unroll
        for (int r = 0; r < 16; ++r) acc0[r] = (xch[((tsel * 4 + 0) * 20 + r) * 64 + lane] + xch[((tsel * 4 + 1) * 20 + r) * 64 + lane]) + (xch[((tsel * 4 + 2) * 20 + r) * 64 + lane] + xch[((tsel * 4 + 3) * 20 + r) * 64 + lane]);
#pragma unroll
        for (int r = 0; r < 4; ++r) acc1[r] = (xch[((tsel * 4 + 0) * 20 + 16 + r) * 64 + lane] + xch[((tsel * 4 + 1) * 20 + 16 + r) * 64 + lane]) + (xch[((tsel * 4 + 2) * 20 + 16 + r) * 64 + lane] + xch[((tsel * 4 + 3) * 20 + 16 + r) * 64 + lane]);
        float L[36];
#pragma unroll
        for (int r = 0; r < 16; ++r) { const float other = fa::xhalf(acc0[r], lane); const int o_mine = (r & 3) + 8 * (r >> 2);
            L[o_mine] = hi ? other : acc0[r]; L[o_mine + 4] = hi ? acc0[r] : other; }
#pragma unroll
        for (int r = 0; r < 4; ++r) { const float other = fa::xhalf(acc1[r], lane); L[32 + r] = hi ? other : acc1[r]; }
        float gl[4]; float gmx = NEG; int gs = 0;
#pragma unroll
        for (int g = 0; g < 4; ++g) { gl[g] = L[g] + bg[g]; if (gl[g] > gmx) { gmx = gl[g]; gs = g; } }
        float gz = 0.f;
#pragma unroll
        for (int g = 0; g < 4; ++g) gz += __expf(gl[g] - gmx);
        const float gprob = 1.f / gz;
        float el[8];
#pragma unroll
        for (int e = 0; e < 8; ++e) {
            const float a0 = L[4 + e] + be[e], a1 = L[12 + e] + be[8 + e], a2 = L[20 + e] + be[16 + e], a3 = L[28 + e] + be[24 + e];
            el[e] = gs == 0 ? a0 : (gs == 1 ? a1 : (gs == 2 ? a2 : a3));
        }
        float m1 = NEG; int i1 = 0;
#pragma unroll
        for (int e = 0; e < 8; ++e) if (el[e] > m1) { m1 = el[e]; i1 = e; }
        float m2 = NEG; int i2 = 0;
#pragma unroll
        for (int e = 0; e < 8; ++e) if (e != i1 && el[e] > m2) { m2 = el[e]; i2 = e; }
        const float p2 = __expf(m2 - m1);
        const float w1 = gprob / (1.f + p2), w2 = gprob * p2 / (1.f + p2);
        if (hi == 0) { const int e1 = gs * 8 + i1, e2 = gs * 8 + i2;
            re[row * 2] = e1; re[row * 2 + 1] = e2; rw[row * 2] = w1; rw[row * 2 + 1] = w2;
            rs[row * 2] = __hip_atomic_fetch_add(cnt + e1, 1, __ATOMIC_RELAXED, __HIP_MEMORY_SCOPE_WORKGROUP); rs[row * 2 + 1] = __hip_atomic_fetch_add(cnt + e2, 1, __ATOMIC_RELAXED, __HIP_MEMORY_SCOPE_WORKGROUP); }
    }
}


__device__ __forceinline__ void moe_tr_item(int it, const float* wgate, const float* wup, const float* wdown, bf16_t* WguT, bf16_t* WdT, lds_f32* scr, int lane) {
    if (it < 32 * 256) { const int e = it >> 8, r = it & 255, kb = r >> 4, nb = r & 15, j = nb >> 3, hf = (nb >> 2) & 1, cb = nb & 3;
        transpose_item<false>((hf ? wup : wgate) + (size_t)e * DM * 256 + j * 128 + cb * 32, DM, 256, 32, WguT + ((size_t)e * 512 + nb * 32) * DM, scr, kb, lane); }
    else { const int i2 = it - 32 * 256, e = i2 >> 7, r = i2 & 127;
        transpose_item<false>(wdown + (size_t)e * 256 * DM, 256, DM, DM, WdT + (size_t)e * DM * 256, scr, r, lane); }
}
#define MOE_TR_DRAIN() do { \
    FA_LAS int* qs_ = (FA_LAS int*)(lds + LDS_BYTES - 128); lds_f32* scr_ = (lds_f32*)lds + wave * (64 * 33); \
    const float* wg_ = pq->moe_w_gate + (size_t)l * 32 * DM * 256; const float* wu_ = pq->moe_w_up + (size_t)l * 32 * DM * 256; const float* wd_ = pq->moe_w_down + (size_t)l * 32 * 256 * DM; \
    for (;;) { if (tid == 0) *qs_ = (int)atomicAdd(W_QUEUE + (32 + l) * 16, 1u); __syncthreads(); const int bi_ = *qs_; __syncthreads(); \
        if (bi_ >= (32 * 256 + 32 * 128) / 8) break; moe_tr_item(bi_ * 8 + wave, wg_, wu_, wd_, W_WGU_T, W_WD_T, scr_, lane); } } while (0)

__device__ __forceinline__ void nsa_prep_q(const bf16_t* P, const float* qgain, bf16_t* Qn, int idx) {
    const int m = idx >> 2, h = idx & 3;
    const uint4* p = (const uint4*)(P + (size_t)m * LDP + PC_DQ + h * 64); float v[64]; float ss = 0.f;
#pragma unroll
    for (int i = 0; i < 8; ++i) { const uint4 u = p[i]; const unsigned w[4] = {u.x, u.y, u.z, u.w};
#pragma unroll
        for (int j = 0; j < 4; ++j) { v[i * 8 + 2 * j] = __uint_as_float(w[j] << 16); v[i * 8 + 2 * j + 1] = __uint_as_float(w[j] & 0xffff0000u); } }
#pragma unroll
    for (int d = 0; d < 64; ++d) ss += v[d] * v[d];
    const float r = rsqrtf(ss * (1.f / 64) + EPS) * (0.125f * LOG2E);
    uint4* o = (uint4*)(Qn + (size_t)m * 256 + h * 64);
#pragma unroll
    for (int i = 0; i < 8; ++i) { uint4 u; u.x = pk2bf(v[i * 8 + 0] * r * qgain[i * 8 + 0], v[i * 8 + 1] * r * qgain[i * 8 + 1]); u.y = pk2bf(v[i * 8 + 2] * r * qgain[i * 8 + 2], v[i * 8 + 3] * r * qgain[i * 8 + 3]);
        u.z = pk2bf(v[i * 8 + 4] * r * qgain[i * 8 + 4], v[i * 8 + 5] * r * qgain[i * 8 + 5]); u.w = pk2bf(v[i * 8 + 6] * r * qgain[i * 8 + 6], v[i * 8 + 7] * r * qgain[i * 8 + 7]); o[i] = u; }
}
__device__ __forceinline__ void nsa_prep_k(const bf16_t* P, int pcol, const float* kgain, bf16_t* Kf, int m) {
    const uint4* p = (const uint4*)(P + (size_t)m * LDP + pcol); float v[64]; float ss = 0.f;
#pragma unroll
    for (int i = 0; i < 8; ++i) { const uint4 u = p[i]; const unsigned w[4] = {u.x, u.y, u.z, u.w};
#pragma unroll
        for (int j = 0; j < 4; ++j) { v[i * 8 + 2 * j] = __uint_as_float(w[j] << 16); v[i * 8 + 2 * j + 1] = __uint_as_float(w[j] & 0xffff0000u); } }
#pragma unroll
    for (int d = 0; d < 64; ++d) ss += v[d] * v[d];
    const float r = rsqrtf(ss * (1.f / 64) + EPS);
    const int b = m / SEQ, t = m % SEQ, tile = t >> 6, kb = (t >> 5) & 1, rr = t & 31;
#pragma unroll
    for (int i = 0; i < 8; ++i) { uint4 u; u.x = pk2bf(v[i * 8 + 0] * r * kgain[i * 8 + 0], v[i * 8 + 1] * r * kgain[i * 8 + 1]); u.y = pk2bf(v[i * 8 + 2] * r * kgain[i * 8 + 2], v[i * 8 + 3] * r * kgain[i * 8 + 3]);
        u.z = pk2bf(v[i * 8 + 4] * r * kgain[i * 8 + 4], v[i * 8 + 5] * r * kgain[i * 8 + 5]); u.w = pk2bf(v[i * 8 + 6] * r * kgain[i * 8 + 6], v[i * 8 + 7] * r * kgain[i * 8 + 7]);
        const int ks = i >> 1, hh = i & 1;
        *(uint4*)(Kf + (((((size_t)(b * 64 + tile) * 2 + kb) * 4 + ks) * 32 + rr) * 2 + hh) * 8) = u; }
}
__device__ __forceinline__ int kcf_off(int n, int d) { return ((((((n >> 6) * 2 + ((n >> 5) & 1)) * 4 + (d >> 4)) * 32 + (n & 31)) * 2 + ((d >> 3) & 1)) * 8) + (d & 7); }
__device__ __forceinline__ int vcf_off(int n, int d) { const int s16 = n & 15; return (((((((n >> 6) * 2 + ((n >> 5) & 1)) * 2 + ((n >> 4) & 1)) * 2 + (d >> 5)) * 32 + (d & 31)) * 2 + ((s16 >> 2) & 1)) * 8) + (((s16 >> 3) << 2) | (s16 & 3)); }

__device__ __forceinline__ void nsa_cmp_unit(FA_LAS unsigned char* lds, int tid, const bf16_t* Qn, const bf16_t* Kcf, const bf16_t* Vcf, float* ocmp, unsigned long long* selmask, int b, int qb) {
    const int lane = tid & 63, wave = tid >> 6, r32 = lane & 31, hi = lane >> 5, head = wave >> 1, tl = 32 * (wave & 1) + r32, t = qb * 64 + tl;
    const size_t m = (size_t)b * SEQ + t;
    const float slope2 = exp2f(-(float)(2 * head + 2)) * LOG2E;
    const int ntiles = (4 * qb + 66) >> 6;
    const bf16_t* kb0 = Kcf + (size_t)b * 4 * 4096; const bf16_t* vb0 = Vcf + (size_t)b * 4 * 4096;
    auto tile_of = [=](int i) { fa::Tile T; T.kg = kb0 + (size_t)i * 4096; T.vg = vb0 + (size_t)i * 4096; T.key0 = i * 64; T.kg2 = nullptr; return T; };
    float mfin, lfin;
    {   fa::f32x16 a0, a1; float ilc; fa::attn_unit<4, 3, false>(lds, tid, ntiles, tile_of, Qn + m * 256 + head * 64, t, slope2, 0ull, 0, a0, a1, ilc, mfin, lfin);
        fa::store_o_f32(ocmp + (m * 4 + head) * 64, a0, a1, ilc, hi); }
    FA_LAS float* impH = (FA_LAS float*)lds;
    for (int i = tid; i < 4 * 64 * 64; i += NTHR) impH[i] = 0.f;
    __syncthreads();
    const int nv = t >= 31 ? ((t - 31) >> 4) + 1 : 0;
    const float il = (nv > 0 && lfin > 0.f) ? 1.f / lfin : 0.f;
    fa::bf16x8 qf[4];
#pragma unroll
    for (int ks = 0; ks < 4; ++ks) qf[ks] = *(const fa::bf16x8*)(Qn + m * 256 + head * 64 + 16 * ks + 8 * hi);
    float carry = 0.f;
    fa::bf16x8 kfr[2][4];
#pragma unroll
    for (int kb = 0; kb < 2; ++kb)
#pragma unroll
        for (int ks = 0; ks < 4; ++ks) kfr[kb][ks] = *(const fa::bf16x8*)(kb0 + (((kb * 4 + ks) * 32 + r32) * 2 + hi) * 8);
    for (int ti = 0; ti < ntiles; ++ti) {
        fa::bf16x8 kcur[2][4];
#pragma unroll
        for (int kb = 0; kb < 2; ++kb)
#pragma unroll
            for (int ks = 0; ks < 4; ++ks) kcur[kb][ks] = kfr[kb][ks];
        if (ti + 1 < ntiles) {
#pragma unroll
            for (int kb = 0; kb < 2; ++kb)
#pragma unroll
                for (int ks = 0; ks < 4; ++ks) kfr[kb][ks] = *(const fa::bf16x8*)(kb0 + (size_t)(ti + 1) * 4096 + (((kb * 4 + ks) * 32 + r32) * 2 + hi) * 8); }
#pragma unroll
        for (int kb = 0; kb < 2; ++kb) {
            fa::f32x16 sc;
#pragma unroll
            for (int r = 0; r < 16; ++r) sc[r] = 0.f;
#pragma unroll
            for (int ks = 0; ks < 4; ++ks) sc = __builtin_amdgcn_mfma_f32_32x32x16_bf16(kcur[kb][ks], qf[ks], sc, 0, 0, 0);
#pragma unroll
            for (int g = 0; g < 4; ++g) {
                const int n0 = 64 * ti + 32 * kb + 8 * g + 4 * hi;
                float p[4];
#pragma unroll
                for (int i = 0; i < 4; ++i) { const int n = n0 + i; const float val = sc[4 * g + i] + slope2 * (float)(16 * n + 31 - t);
                    p[i] = n < nv ? __builtin_amdgcn_exp2f(val - mfin) * il : 0.f; }
                const float a1 = (p[0] + p[1]) + (p[2] + 0.5f * p[3]), a2 = 0.5f * p[3];
                const float recv = fa::xhalf(a2, lane);
                const float val = a1 + (hi ? recv : carry);
                if (!hi) carry = recv;
                impH[(head * 64 + tl) * 64 + (n0 >> 2)] = val;
            }
        }
    }
    __syncthreads();
    FA_LAS long long* keys = (FA_LAS long long*)(lds + 65536) + wave * 512;
    long long mykey[8];
#pragma unroll
    for (int tt = 0; tt < 8; ++tt) {
        const int tok = 8 * wave + tt;
        float v = ((impH[(0 * 64 + tok) * 64 + lane] + impH[(1 * 64 + tok) * 64 + lane]) + impH[(2 * 64 + tok) * 64 + lane]) + impH[(3 * 64 + tok) * 64 + lane];
        v = lane <= qb ? v : -1.f;
        if (lane == 0 || lane == qb || lane == qb - 1) v = 2.f;
        mykey[tt] = (long long)(((unsigned long long)(long long)__float_as_int(v) << 6) | (unsigned long long)(63 - lane));
        keys[tt * 64 + lane] = mykey[tt];
    }
#pragma unroll
    for (int tt = 0; tt < 8; ++tt) {
        const int tok = 8 * wave + tt;
        int rank = 0;
#pragma unroll 8
        for (int i = 0; i < 64; i += 2) { const fa::u32x4 kk = *(const FA_LAS fa::u32x4*)(keys + tt * 64 + i);
            const long long k0 = (long long)(((unsigned long long)kk.y << 32) | kk.x), k1 = (long long)(((unsigned long long)kk.w << 32) | kk.z);
            rank += (k0 > mykey[tt] ? 1 : 0) + (k1 > mykey[tt] ? 1 : 0); }
        const unsigned long long msk = __builtin_amdgcn_ballot_w64(rank < 16);
        if (lane == 0) selmask[(size_t)b * SEQ + qb * 64 + tok] = msk;
    }
    __syncthreads();
}
__device__ __forceinline__ void nsa_selwin_unit(FA_LAS unsigned char* lds, int tid, const bf16_t* Qn, const bf16_t* Ksf, const bf16_t* Vsf, const bf16_t* Kwf, const bf16_t* Vwf,
                                                const unsigned long long* selmask, const float* ocmp, const bf16_t* P, const float* outg, bf16_t* mixed, int b, int qb) {
    const int lane = tid & 63, wave = tid >> 6, hi = lane >> 5, head = wave >> 1, tl = 32 * (wave & 1) + (lane & 31), t = qb * 64 + tl;
    const size_t m = (size_t)b * SEQ + t;
    const float slope2 = exp2f(-(float)(2 * head + 2)) * LOG2E;
    float mo, lo, ilx;
    fa::f32x16 acc0, acc1;
    {
        const bf16_t* kb0 = Ksf + (size_t)b * 64 * 4096; const bf16_t* vb0 = Vsf + (size_t)b * 64 * 4096;
        const unsigned long long sel = selmask[m];
        unsigned lo32 = (unsigned)sel, hi32 = (unsigned)(sel >> 32);
#pragma unroll
        for (int o = 1; o < 64; o <<= 1) { lo32 |= (unsigned)__builtin_amdgcn_ds_bpermute((lane ^ o) << 2, (int)lo32); hi32 |= (unsigned)__builtin_amdgcn_ds_bpermute((lane ^ o) << 2, (int)hi32); }
        FA_LAS unsigned* uni = (FA_LAS unsigned*)(lds + 49152);
        FA_LAS unsigned char* tlist = lds + 49152 + 16;
        if (wave < 2 && lane == 0) { uni[wave * 2] = lo32; uni[wave * 2 + 1] = hi32; }
        __syncthreads();
        const unsigned long long U = ((unsigned long long)(uni[1] | uni[3]) << 32) | (unsigned long long)(uni[0] | uni[2]);
        if (tid < 64 && ((U >> tid) & 1ull)) tlist[__builtin_popcountll(U & ((1ull << tid) - 1ull))] = (unsigned char)tid;
        __syncthreads();
        const int ntiles = __builtin_popcountll(U);
        auto tile_of = [=](int i) { const int j = tlist[i]; fa::Tile T; T.kg = kb0 + (size_t)j * 4096; T.vg = vb0 + (size_t)j * 4096; T.key0 = j * 64; T.kg2 = nullptr; return T; };
        fa::attn_unit<4, 1, false>(lds, tid, ntiles, tile_of, Qn + m * 256 + head * 64, t, slope2, sel, 0, acc0, acc1, ilx, mo, lo);
        const float g1 = sigmoidf_(bf2f(P[m * 12 + head * 3 + 1])) * ilx;
#pragma unroll
        for (int r = 0; r < 16; ++r) { acc0[r] *= g1; acc1[r] *= g1; }
    }
    {
        const bf16_t* kb0 = Kwf + (size_t)b * 64 * 4096; const bf16_t* vb0 = Vwf + (size_t)b * 64 * 4096;
        const int first = qb >= 8 ? qb - 8 : 0;
        auto tile_of = [=](int i) { const int j = first + i; fa::Tile T; T.kg = kb0 + (size_t)j * 4096; T.vg = vb0 + (size_t)j * 4096; T.key0 = j * 64; T.kg2 = nullptr; return T; };
        fa::f32x16 w0, w1;
        fa::attn_unit<4, 2, false>(lds, tid, qb - first + 1, tile_of, Qn + m * 256 + head * 64, t, slope2, 0ull, 0, w0, w1, ilx, mo, lo);
        const float g2 = sigmoidf_(bf2f(P[m * 12 + head * 3 + 2])) * ilx;
#pragma unroll
        for (int r = 0; r < 16; ++r) { acc0[r] += g2 * w0[r]; acc1[r] += g2 * w1[r]; }
    }
    {
        const float g0 = sigmoidf_(bf2f(P[m * 12 + head * 3 + 0]));
        const float* oc = ocmp + (m * 4 + head) * 64;
#pragma unroll
        for (int g = 0; g < 4; ++g) { const int d = 8 * g + 4 * hi; const float4 c0 = *(const float4*)(oc + d), c1 = *(const float4*)(oc + 32 + d);
            acc0[4 * g] += g0 * c0.x; acc0[4 * g + 1] += g0 * c0.y; acc0[4 * g + 2] += g0 * c0.z; acc0[4 * g + 3] += g0 * c0.w;
            acc1[4 * g] += g0 * c1.x; acc1[4 * g + 1] += g0 * c1.y; acc1[4 * g + 2] += g0 * c1.z; acc1[4 * g + 3] += g0 * c1.w; }
    }
    fa::store_normed_bf16(mixed + m * DM + 768 + head * 64, acc0, acc1, outg + head * 64, 1.f, lane, hi);
}
__device__ __forceinline__ void diff_unit(FA_LAS unsigned char* lds, int tid, const bf16_t* Qbf, const bf16_t* Kf, const bf16_t* Vf, const float* lamv, const float* subg, float lam_init,
                                          bf16_t* mixed, int b, int h, int qh) {
    const int lane = tid & 63, wave = tid >> 6, hi = lane >> 5, c = wave >> 2;
    const bf16_t* vbase = Vf + (size_t)(b * 4 + h) * 64 * 4096;
    const bf16_t* kbase0 = Kf + (size_t)((b * 4 + h) * 2 + 0) * 64 * 2048; const bf16_t* kbase1 = Kf + (size_t)((b * 4 + h) * 2 + 1) * 64 * 2048;
    const int back = h == 0 ? 4 : (h == 1 ? 15 : 60), first = 2 * qh - back > 0 ? 2 * qh - back : 0;
    const float slope2 = exp2f(-(float)(2 * h + 1)) * LOG2E;
    const int t = qh * 128 + (wave & 3) * 32 + (lane & 31); const size_t m = (size_t)b * SEQ + t;
    fa::f32x16 a0, a1; float ila, mo, lo;
    auto tile_of = [=](int i) { const int j = first + i; fa::Tile T; T.kg = kbase0 + (size_t)j * 2048; T.kg2 = kbase1 + (size_t)j * 2048; T.vg = vbase + (size_t)j * 4096; T.key0 = j * 64; return T; };
    fa::attn_unit<2, 0, true>(lds, tid, 2 * (qh + 1) - first, tile_of, Qbf + m * 256 + h * 64 + c * 32, t, slope2, 0ull, c * 4096, a0, a1, ila, mo, lo);
    FA_LAS float* xch = (FA_LAS float*)lds;
    if (c == 1) {
#pragma unroll
        for (int r = 0; r < 16; ++r) { xch[((wave & 3) * 32 + r) * 64 + lane] = a0[r] * ila; xch[((wave & 3) * 32 + 16 + r) * 64 + lane] = a1[r] * ila; }
    }
    __syncthreads();
    if (c == 0) {
        float d01 = 0.f, d23 = 0.f;
        {   float4 lv[32];
#pragma unroll
            for (int i = 0; i < 32; ++i) lv[i] = ((const float4*)lamv)[i];
#pragma unroll
            for (int i = 0; i < 8; ++i) { d01 += lv[i].x * lv[8 + i].x + lv[i].y * lv[8 + i].y + lv[i].z * lv[8 + i].z + lv[i].w * lv[8 + i].w;
                d23 += lv[16 + i].x * lv[24 + i].x + lv[16 + i].y * lv[24 + i].y + lv[16 + i].z * lv[24 + i].z + lv[16 + i].w * lv[24 + i].w; } }
        const float lam = __expf(d01) - __expf(d23) + lam_init;
#pragma unroll
        for (int r = 0; r < 16; ++r) { a0[r] = a0[r] * ila - lam * xch[(wave * 32 + r) * 64 + lane]; a1[r] = a1[r] * ila - lam * xch[(wave * 32 + 16 + r) * 64 + lane]; }
        fa::store_normed_bf16(mixed + m * DM + h * 64, a0, a1, subg + h * 64, 1.f - lam_init, lane, hi);
    }
    __syncthreads();
}

__device__ __forceinline__ void moe_table(const int* cnt, __attribute__((address_space(3))) int* tab, int tid) {
    if (tid < 64) {
        const int lane = tid; const int c = lane < 32 ? cnt[lane] : 0; const int pc = (c + 255) >> 8;
        int x = pc;
#pragma unroll
        for (int o = 1; o < 32; o <<= 1) { const int y = __builtin_amdgcn_ds_bpermute(((lane - o) & 63) << 2, x); if (lane >= o) x += y; }
        const int ex = x - pc;
        if (lane < 32) { tab[lane] = ex * 256; tab[32 + lane] = c; for (int t = 0; t < pc; ++t) tab[128 + ex + t] = lane; }
        if (lane == 31) tab[64] = x;
    }
    __syncthreads();
}

#define XB_TMO      128
#define XB_XCNT(j)  (256  + 64 * (j))
#define XB_XSUB(j)  (1280 + 64 * (j))
#define XB_XGEN(j)  (2304 + 64 * (j))
#define XB_TOP      3328
#define XB_TOPGEN   3392
#define XCD_BAR_WORDS 3456
#define XB_SPIN_CAP (1u << 18)

__device__ __forceinline__ unsigned xb_ld(unsigned* p)              { return __hip_atomic_load(p, __ATOMIC_RELAXED, __HIP_MEMORY_SCOPE_AGENT); }
__device__ __forceinline__ unsigned xb_add(unsigned* p, unsigned v) { return __hip_atomic_fetch_add(p, v, __ATOMIC_RELAXED, __HIP_MEMORY_SCOPE_AGENT); }
__device__ __forceinline__ unsigned xb_xcc_id() { return (unsigned)__builtin_amdgcn_s_getreg((3 << 11) | 20) & 0xFu; }
#define XB_SPIN(cond, bar) do { unsigned _sp = 0; while (cond) { __builtin_amdgcn_s_sleep(1); \
    if ((++_sp & 255u) == 0u) { if (xb_ld(&(bar)[XB_TMO])) break; if (_sp > XB_SPIN_CAP) { atomicAdd(&(bar)[XB_TMO], 1u); break; } } } } while (0)

struct XcdBarrier {
    unsigned* bar; unsigned x;
    volatile __attribute__((address_space(3))) unsigned* st;
};

__device__ __forceinline__ XcdBarrier xcd_barrier_post(unsigned* bar, volatile __attribute__((address_space(3))) unsigned* st) {
    XcdBarrier b; b.bar = bar; b.x = xb_xcc_id(); b.st = st;
    if (threadIdx.x == 0) (void)xb_add(&bar[XB_XCNT(b.x)], 1u);
    return b;
}
__device__ __forceinline__ void xcd_barrier_complete(unsigned* bar, unsigned x, unsigned& nloc, unsigned& nx) {
    const unsigned G = gridDim.x * gridDim.y * gridDim.z;
    unsigned sum, cnt, mine, sp = 0u;
    for (;;) {
        sum = 0u; cnt = 0u; mine = 0u;
#pragma unroll
        for (unsigned j = 0; j < 16; ++j) { const unsigned c = xb_ld(&bar[XB_XCNT(j)]); sum += c; cnt += (c > 0u) ? 1u : 0u; mine = (j == x) ? c : mine; }
        if (sum == G) break;
        __builtin_amdgcn_s_sleep(1);
        if ((++sp & 255u) == 0u) { if (xb_ld(&bar[XB_TMO])) break; if (sp > XB_SPIN_CAP) { atomicAdd(&bar[XB_TMO], 1u); break; } }
    }
    nloc = mine > 0u ? mine : 1u; nx = cnt > 0u ? cnt : 1u;
}

__device__ __forceinline__ void xcd_barrier(const XcdBarrier& b, const int tid) {
    asm volatile("s_waitcnt vmcnt(0)" ::: "memory");
    __syncthreads();
    if (tid == 0) {
        unsigned* bar = b.bar;
        __builtin_amdgcn_s_waitcnt(0);
        unsigned nloc = b.st[0], nx = b.st[1];
        if (nloc == 0u) { xcd_barrier_complete(bar, b.x, nloc, nx); b.st[0] = nloc; b.st[1] = nx; }
        const unsigned old = xb_add(&bar[XB_XSUB(b.x)], 1u);
        const unsigned gen = old / nloc;
        if (old + 1u == (gen + 1u) * nloc) {
            __builtin_amdgcn_fence(__ATOMIC_RELEASE, "agent");
            asm volatile("s_waitcnt vmcnt(0)" ::: "memory");
            const unsigned og = xb_add(&bar[XB_TOP], 1u);
            const unsigned tg = og / nx;
            if (og + 1u == (tg + 1u) * nx) xb_add(&bar[XB_TOPGEN], 1u);
            else XB_SPIN(xb_ld(&bar[XB_TOPGEN]) == tg, bar);
            __builtin_amdgcn_fence(__ATOMIC_ACQUIRE, "agent");
            xb_add(&bar[XB_XGEN(b.x)], 1u);
            asm volatile("s_waitcnt vmcnt(0)" ::: "memory");
        } else {
            XB_SPIN(xb_ld(&bar[XB_XGEN(b.x)]) == gen, bar);
            __builtin_amdgcn_fence(__ATOMIC_ACQUIRE, "agent");
            asm volatile("s_waitcnt vmcnt(0)" ::: "memory");
        }
    }
    __syncthreads();
}


__global__ void __launch_bounds__(NTHR) mega_fwd(Params p_unused) {
    extern __shared__ __attribute__((aligned(16))) unsigned char lds[];
    cg::grid_group grid = cg::this_grid(); grid.sync();
    volatile __attribute__((address_space(3))) unsigned* bar_st = (volatile __attribute__((address_space(3))) unsigned*)(lds + LDS_BYTES - 64);
    if (threadIdx.x < 2) bar_st[threadIdx.x] = 0u;
    if ((threadIdx.x & 63) == 0) ((__attribute__((address_space(3))) int*)((__attribute__((address_space(3))) unsigned char*)lds + LDS_TIDTAB))[hw_wave_slot()] = threadIdx.x >> 6;
    __syncthreads();
#ifndef USE_XCD_BARRIER
#define USE_XCD_BARRIER 1
#endif
#ifndef PROBE_LO
#define PROBE_LO (-1)
#define PROBE_HI 0
#endif
#define PROBE_MULT 8
#define PROBE_STAMPS ((unsigned long long*)(((const __attribute__((address_space(4))) Params*)__builtin_amdgcn_kernarg_segment_ptr())->ws + WS_BAR + 24576))
#define GRID_BARRIER() do { const int tb_ = phase_tid(lds); xcd_barrier(xbar, tb_); if (PROBE_LO >= 0) { if (blockIdx.x == 0 && tb_ == 0) PROBE_STAMPS[layer * 16 + (__COUNTER__ - BAR_BASE)] = __builtin_amdgcn_s_memrealtime(); } } while (0)
    constexpr int BAR_BASE = __COUNTER__;
    XcdBarrier xbar; (void)xbar;
    {   typedef const __attribute__((address_space(4))) Params* cparams0_t; const cparams0_t p0 = (cparams0_t)__builtin_amdgcn_kernarg_segment_ptr();
        xbar = xcd_barrier_post((unsigned*)(p0->ws + WS_BAR), bar_st); }
    if (PROBE_LO >= 0) { if (blockIdx.x == 0 && threadIdx.x == 0) PROBE_STAMPS[0] = __builtin_amdgcn_s_memrealtime(); }
    typedef const __attribute__((address_space(4))) Params* cparams_t;
    const cparams_t pp = (cparams_t)__builtin_amdgcn_kernarg_segment_ptr();
#define PHASE_VARS \
    const int tid = phase_tid(lds); \
    int bid = blockIdx.x; asm volatile("" : "+s"(bid)); int G = gridDim.x; asm volatile("" : "+s"(G)); int l = layer; asm volatile("" : "+s"(l)); \
    cparams_t pq = pp; asm volatile("" : "+s"(pq)); \
    const float* xcur = l == 0 ? pq->x_in : pq->out; (void)xcur; \
    const int lane = tid & 63, wave = tid >> 6, half = tid >> 8, tid256 = tid & 255; \
    const int gw = bid * NWAVE + wave, NGW = G * NWAVE; \
    const int gt = bid * NTHR + tid, NGT = G * NTHR; \
    float* ldsf = (float*)lds + half * 4096; \
    (void)lane; (void)tid256; (void)gw; (void)NGW; (void)gt; (void)NGT; (void)ldsf;

    auto layer_body = [&](auto LC) __attribute__((always_inline)) {
        constexpr int layer = decltype(LC)::value;
        {   PHASE_VARS
        if (l == 0) {
            lds_f32* scr = (lds_f32*)lds + wave * (64 * 33);
            constexpr int N1 = (DM / 64) * (LDP / 32), N2 = (DM / 64) * (DM / 32), N3 = 128, NL = N1 + N2 + N3;
            for (int it = gw; it < 2 * NL; it += NGW) { const int L = it / NL, r = it - L * NL;
                if (r < N1) transpose_item<true>(pq->w_in + (size_t)L * DM * IN_COLS, DM, IN_COLS, LDP, W_WIN_T_L(L), scr, r, lane);
                else if (r < N1 + N2) transpose_item<false>(pq->w_out + (size_t)L * DM * DM, DM, DM, DM, W_WOUT_T_L(L), scr, r - N1, lane);
                else { const int r3 = r - N1 - N2; transpose_item<false>(pq->nsa_cmp_w1 + ((size_t)L * 2 + (r3 >> 6)) * 2048 * 64, 2048, 64, 64, W_W1T_L(L) + (size_t)(r3 >> 6) * 64 * 2048, scr, r3 & 63, lane); } }
        }
        {   int row = gw;
            if constexpr (layer == 0) {
                for (; row + (NORM_NR - 1) * NGW < MT; row += NORM_NR * NGW) norm_rows<NORM_NR>(nullptr, pq->x_in, nullptr, pq->norm_mix + l * DM, W_TB, row, NGW, lane);
                for (; row < MT; row += NGW) norm_rows<1>(nullptr, pq->x_in, nullptr, pq->norm_mix + l * DM, W_TB, row, NGW, lane);
            } else {
                for (; row + NGW < MT; row += 2 * NGW) norm_rows_bf<2>((bf16_t*)pq->out, W_RES, W_YMOE, pq->norm_mix + l * DM, W_TB, row, NGW, lane);
                for (; row < MT; row += NGW) norm_rows_bf<1>((bf16_t*)pq->out, W_RES, W_YMOE, pq->norm_mix + l * DM, W_TB, row, NGW, lane); } }
        }
        GRID_BARRIER();
        {   PHASE_VARS
        {   pg8::Gemm g{W_TB, W_WIN_T, MT, LDP, DM}; pg8::StaticOrder S; S.init(MT, LDP, G, bid);
            pg8::EpiBf16<0> E{W_P, LDP, nullptr, 0, 0, 1.f};
            pg8::gemm_phase<pg8::EpiBf16<0>, pg8::StaticOrder, true, true>((PG8_LAS unsigned char*)lds, g, S, E, tid, lds); }
        }
        GRID_BARRIER();
        {   PHASE_VARS
        SCAN_BUFS(Bm, Bh)
        const int half_t = (G >> 1) * NTHR;
        for (int i = gt; i < 4 * 65536; i += NGT) { const int w = i >> 16, j = i & 65535;
            if (w == 0) scan::prep_k<0>(W_P, pq->mlstm_conv + l * 4 * 512, pq->mlstm_gate_bias + l * 8, nullptr, l, Bm, j);
            else if (w == 1) scan::prep_k<1>(W_P, nullptr, nullptr, pq->hgrn_lb, l, Bh, j);
            else if (half_t != 65536) { if (w == 2) scan::prep_v(W_P, PC_BV, Bm.VT(), j); else scan::prep_v(W_P, PC_CI, Bh.VT(), j); } }
        if (half_t == 65536 && gt >= half_t) {
            for (int i = gt - half_t; i < 2 * 65536; i += half_t) { const int j = i & 65535;
                if (i < 65536) scan::prep_v(W_P, PC_BV, Bm.VT(), j); else scan::prep_v(W_P, PC_CI, Bh.VT(), j); } }
        }
        GRID_BARRIER();
        {   PHASE_VARS
        SCAN_BUFS(Bm, Bh)
        for (int it = gw; it < 2048; it += NGW) { if (it < 1024) scan::stepA<0>(Bm, it, lane); else scan::stepA<1>(Bh, it - 1024, lane); }
        }
        GRID_BARRIER();
        {   PHASE_VARS
        SCAN_BUFS(Bm, Bh)
        for (int i = gt; i < 2 * 65536; i += NGT) { if (i < 65536) scan::stepB<0>(Bm, i); else scan::stepB<1>(Bh, i - 65536); }
        }
        GRID_BARRIER();
        {   PHASE_VARS
        SCAN_BUFS(Bm, Bh)
        for (int it = gw; it < 2048; it += NGW) {
            if (it < 1024) scan::stepC<0>(Bm, W_P, PC_BO, pq->mlstm_out_gain + l * 256, W_MIXED, 256, it, lane);
            else scan::stepC<1>(Bh, W_P, PC_CG, pq->hgrn_out_gain + l * 256, W_MIXED, 512, it - 1024, lane); }
        }
        GRID_BARRIER();
        {   PHASE_VARS
        for (int i = gt; i < MT * 8; i += NGT) diff_prep_qk(W_P, pq->diff_q_gain + l * 32, pq->diff_k_gain + l * 32, W_QBF, W_DKF, i);
        const int nskip = G >= 128 ? 64 : 0, gt_v = (bid - nskip) * NTHR + tid, NGT_v = (G - nskip) * NTHR;
        if (bid >= nskip) for (int i = gt_v; i < NB * 4 * 64 * 512; i += NGT_v) vfrag_item(W_P, PC_AV, 64, 4, W_DVF, i);
        const int gt_q = ((bid + G - (G >> 1)) % G) * NTHR + tid, gt_k = ((bid + G - (G >> 2)) % G) * NTHR + tid;
        for (int i = gt_q; i < MT * 4; i += NGT) nsa_prep_q(W_P, pq->nsa_q_gain + l * 64, W_NQB, i);
        for (int i = gt_k; i < 2 * MT; i += NGT) { if (i < MT) nsa_prep_k(W_P, PC_KS, pq->nsa_k_gain + (l * 3 + 1) * 64, W_KSF, i); else nsa_prep_k(W_P, PC_KW, pq->nsa_k_gain + (l * 3 + 2) * 64, W_KWF, i - MT); }
        if (bid >= nskip) for (int i = gt_v; i < 2 * NB * 64 * 512; i += NGT_v) { if (i < NB * 64 * 512) vfrag_item(W_P, PC_VS, 0, 1, W_VSF, i); else vfrag_item(W_P, PC_VW, 0, 1, W_VWF, i - NB * 64 * 512); }
        for (int i = gt_q; i < MT * 12; i += NGT) W_DGATE[i] = W_P[(size_t)(i / 12) * LDP + PC_DG + (i % 12)];
        for (int it = bid; it < 64; it += G)
            nsa_compress_unit((FA_LAS unsigned char*)lds, tid, W_P, pq->nsa_cmp_pos + l * 2 * 32 * 64, W_W1T, pq->nsa_cmp_w2 + l * 2 * 64 * 64, pq->nsa_k_gain + (l * 3 + 0) * 64, W_CMP, it);
        }
        GRID_BARRIER();
        {   PHASE_VARS
        {
            FA_LAS int* qslot = (FA_LAS int*)(lds + LDS_BYTES - 128);
            for (int kq = 0; kq < 8; ++kq) {
                const int q = (bid + kq) & 7;
                for (;;) {
                    if (tid == 0) *qslot = (int)atomicAdd(W_QUEUE + ((l * 2 + 0) * 8 + q) * 16, 1u);
                    __syncthreads();
                    const int it = *qslot;
                    __syncthreads();
                    if (it >= 96) break;
                    const bool is_cmp = it >= 20 && it < 52;
                    if (!is_cmp) {
                        bool lo; int qh;
                        if (it < 20) { lo = false; qh = 31 - it; } else if (it < 56) { lo = false; qh = 11 - (it - 52); } else if (it < 80) { lo = true; qh = 31 - (it - 56); }
                        else if (it < 88) { lo = false; qh = 7 - (it - 80); } else { lo = true; qh = 7 - (it - 88); }
                        const int b = q >> 1, hp = q & 1, h = lo ? hp : 3 - hp;
                        diff_unit((FA_LAS unsigned char*)lds, tid, W_QBF, W_DKF, W_DVF, pq->diff_lambda + l * 128, pq->diff_sub_gain + l * 256, 0.8f - 0.6f * __expf(-0.3f * (float)l), W_MIXED, b, h, qh);
                    } else { const int u = q * 32 + (it - 20); nsa_cmp_unit((FA_LAS unsigned char*)lds, tid, W_NQB, W_KCF, W_VCF, W_OCMP, W_SELMASK, u >> 6, 63 - (u & 63)); }
                }
            }
            __syncthreads();
            MOE_TR_DRAIN();
        }
        }
        GRID_BARRIER();
        {   PHASE_VARS
        {
            FA_LAS int* qslot = (FA_LAS int*)(lds + LDS_BYTES - 128);
            for (int kq = 0; kq < 8; ++kq) {
                const int q = (bid + kq) & 7;
                for (;;) {
                    if (tid == 0) *qslot = (int)atomicAdd(W_QUEUE + ((l * 2 + 1) * 8 + q) * 16, 1u);
                    __syncthreads();
                    const int it = *qslot;
                    __syncthreads();
                    if (it >= 32) break;
                    const int b = q >> 1, qb = 2 * (31 - it) + (q & 1);
                    nsa_selwin_unit((FA_LAS unsigned char*)lds, tid, W_NQB, W_KSF, W_VSF, W_KWF, W_VWF, W_SELMASK, W_OCMP, W_DGATE, pq->nsa_out_gain + l * 256, W_MIXED, b, qb);
                }
            }
            __syncthreads();
            MOE_TR_DRAIN();
        }
        }
        GRID_BARRIER();
        {   PHASE_VARS
        {   pg8::Gemm g{W_MIXED, W_WOUT_T, MT, DM, DM}; pg8::StaticOrder S; S.init(MT, DM, G, bid);
            if constexpr (layer == 0) { pg8::EpiResB<false> E{pq->x_in, W_RES, DM};
                pg8::gemm_phase<pg8::EpiResB<false>, pg8::StaticOrder, true, true>((PG8_LAS unsigned char*)lds, g, S, E, tid, lds); }
            else { pg8::EpiResB<true> E{pq->out, W_RES, DM};
                pg8::gemm_phase<pg8::EpiResB<true>, pg8::StaticOrder, true, true>((PG8_LAS unsigned char*)lds, g, S, E, tid, lds); } }
        }
        GRID_BARRIER();
        {   PHASE_VARS
        MOE_TR_DRAIN();
        __syncthreads();
        {   FA_LAS bf16_t* wimg = (FA_LAS bf16_t*)lds; const float* wg = pq->moe_w_group + l * DM * 4; const float* we = pq->moe_w_expert + l * DM * 32;
            FA_LAS int* lcnt = (FA_LAS int*)(lds + RT_IMG_BYTES);
            if (tid < 32) lcnt[tid] = 0;
            for (int t0 = bid; t0 < MT / 32; t0 += 2 * G) {
                __syncthreads();
#pragma unroll 1
                for (int i0 = tid; i0 < DM * 36; i0 += 12 * NTHR) {
                    float wv[12];
#pragma unroll
                    for (int u = 0; u < 12; ++u) { const int i = i0 + u * NTHR, k = i / 36, o = i - k * 36; wv[u] = o < 4 ? wg[k * 4 + o] : we[k * 32 + o - 4]; }
#pragma unroll
                    for (int u = 0; u < 12; ++u) { const int i = i0 + u * NTHR, k = i / 36, o = i - k * 36; const bf16_t h16 = f2bf(wv[u]); wimg[o * RT_RS + k] = h16; wimg[(36 + o) * RT_RS + k] = f2bf(wv[u] - bf2f(h16)); }
                }
                __syncthreads();
                const int tile = t0 + (wave >> 2) * G;
                moe_route_round((FA_LAS unsigned char*)lds, tid, W_RES, pq->norm_ffn + l * DM, pq->moe_b_group + l * 4, pq->moe_b_expert + l * 32, W_TB, W_RE, W_RW, W_RS, tile, tile < MT / 32);
            }
            __syncthreads();
            if (tid < 32) W_CNTBLK[bid * 32 + tid] = lcnt[tid];
        }
        }
        GRID_BARRIER();
        {   PHASE_VARS
        __attribute__((address_space(3))) int* tab = (__attribute__((address_space(3))) int*)(lds + 131072);
        {
            __attribute__((address_space(3))) int* part = tab + 512;
            const int e = tid & 31, pg = tid >> 5; int tot = 0, bs = 0;
            for (int b2 = pg; b2 < G; b2 += 16) { const int c = W_CNTBLK[b2 * 32 + e]; tot += c; bs += b2 < bid ? c : 0; }
            part[pg * 32 + e] = tot; part[512 + pg * 32 + e] = bs;
            __syncthreads();
            if (tid < 32) { int t2 = 0, b3 = 0;
#pragma unroll
                for (int i = 0; i < 16; ++i) { t2 += part[i * 32 + tid]; b3 += part[512 + i * 32 + tid]; }
                tab[96 + tid] = b3; part[tid] = t2; if (bid == 0) W_CNT[tid] = t2; }
            __syncthreads();
            if (tid < 64) { const int c = tid < 32 ? part[tid] : 0; const int pc = (c + 255) >> 8; int x = pc;
#pragma unroll
                for (int o = 1; o < 32; o <<= 1) { const int y = __builtin_amdgcn_ds_bpermute(((tid - o) & 63) << 2, x); if (tid >= o) x += y; }
                const int ex = x - pc;
                if (tid < 32) { tab[tid] = ex * 256; tab[32 + tid] = c; } }
            __syncthreads();
        }
        {   const int nrr = 32 * ((MT / 32 - bid + G - 1) / G);
#define G8B_LOAD(u) const int rr##u = rbase + u * NWAVE, row##u = (bid + (rr##u >> 5) * G) * 32 + (rr##u & 31); const uint4* src##u = (const uint4*)(W_TB + (size_t)row##u * DM); \
            const uint4 va##u = src##u[lane], vb##u = src##u[lane + 64]; const int2 ee##u = ((const int2*)W_RE)[row##u], ss##u = ((const int2*)W_RS)[row##u]; const float2 ww##u = ((const float2*)W_RW)[row##u];
#define G8B_STORE1(u, i, E, S, Wt) { const int e = E, r = tab[e] + tab[96 + e] + S; uint4* dst = (uint4*)(W_ASORT + (size_t)r * DM); dst[lane] = va##u; dst[lane + 64] = vb##u; \
            if (lane == 0) { W_ROWTOK[r] = row##u * 2 + i; W_ROWW[r] = Wt; } }
#define G8B_STORE(u) G8B_STORE1(u, 0, ee##u.x, ss##u.x, ww##u.x) G8B_STORE1(u, 1, ee##u.y, ss##u.y, ww##u.y)
            for (int rbase = tid >> 6; rbase < nrr; rbase += 4 * NWAVE) {
                G8B_LOAD(0) G8B_LOAD(1) G8B_LOAD(2) G8B_LOAD(3)
                G8B_STORE(0) G8B_STORE(1) G8B_STORE(2) G8B_STORE(3)
            }
        }
        if (bid == 0) for (int e = wave; e < 32; e += NWAVE) { const int r0 = tab[e] + tab[32 + e], r1 = tab[e] + ((tab[32 + e] + 255) & ~255);
            for (int r = r0 + lane; r < r1; r += 64) { W_ROWTOK[r] = -1; W_ROWW[r] = 0.f; } }
        }
        GRID_BARRIER();
        {   PHASE_VARS
        __attribute__((address_space(3))) int* tab = (__attribute__((address_space(3))) int*)(lds + 131072);
        moe_table(W_CNT, tab, tid);
        const int nT = tab[64]; const bool split3 = G >= 256 && 2 * nT > G;
        {   pg8::Gemm g{W_ASORT, W_WGU_T, MOE_ROWS_MAX, 32 * 512, DM}; const int cx = (G & 7) ? bid : (bid & 7) * (G >> 3) + (bid >> 3);
            pg8::MoeOrder S{G, cx, nT, 2, tab + 128, 0, split3 ? G : 2 * nT};
            pg8::EpiSwiglu E{W_HS, W_ROWW};
            pg8::gemm_phase<pg8::EpiSwiglu, pg8::MoeOrder, true, true>((PG8_LAS unsigned char*)lds, g, S, E, tid, lds); }
        }
        GRID_BARRIER();
        {   PHASE_VARS
        __attribute__((address_space(3))) int* tab = (__attribute__((address_space(3))) int*)(lds + 131072);
        moe_table(W_CNT, tab, tid);
        const int nT = tab[64]; const bool split3 = G >= 256 && 2 * nT > G; const int n_extra = split3 ? 2 * nT - G : 0, tdone = split3 ? G / 2 : nT;
        const int xq = bid & 7, xr = bid >> 3, neq = n_extra >> 3, ner = n_extra & 7, ne_x = neq + (xq < ner ? 1 : 0), ne_pre = xq * neq + (xq < ner ? xq : ner);
        const bool sw = (G & 7) == 0, is_extra = sw ? xr < ne_x : bid < n_extra;
        const int cu_ = sw ? ne_pre + xr : bid, cd_ = sw ? xq * (G >> 3) - ne_pre + xr - ne_x : bid - n_extra;
        if (is_extra) {
            pg8::Gemm g{W_ASORT, W_WGU_T, MOE_ROWS_MAX, 32 * 512, DM}; pg8::MoeOrder S{G, cu_, nT, 2, tab + 128, G, 2 * nT};
            pg8::EpiSwiglu E{W_HS, W_ROWW};
            pg8::gemm_phase<pg8::EpiSwiglu, pg8::MoeOrder, true, true>((PG8_LAS unsigned char*)lds, g, S, E, tid, lds);
        } else {
            pg8::Gemm g{W_HS, W_WD_T, MOE_ROWS_MAX, 32 * DM, 256}; pg8::MoeOrder S{G - n_extra, cd_, nT, 4, tab + 128, 0, 4 * tdone};
            pg8::EpiScatterStore E{W_YMOE, W_ROWTOK};
            pg8::gemm_phase<pg8::EpiScatterStore, pg8::MoeOrder, true, true>((PG8_LAS unsigned char*)lds, g, S, E, tid, lds);
        }
        }
        GRID_BARRIER();
        {   PHASE_VARS
        __attribute__((address_space(3))) int* tab = (__attribute__((address_space(3))) int*)(lds + 131072);
        moe_table(W_CNT, tab, tid);
        const int nT = tab[64]; const bool split3 = G >= 256 && 2 * nT > G; const int tdone = split3 ? G / 2 : nT;
        {   pg8::Gemm g{W_HS, W_WD_T, MOE_ROWS_MAX, 32 * DM, 256}; const int nrem = 4 * (nT - tdone), chk = (nrem + 7) >> 3;
            const int cx = (G & 7) ? bid : nrem <= G ? ((bid >> 3) < chk ? (bid & 7) * chk + (bid >> 3) : -1) : (bid & 7) * (G >> 3) + (bid >> 3);
            pg8::MoeOrder S{G, cx, nT, 4, tab + 128, 4 * tdone, 4 * nT};
            pg8::EpiScatterStore E{W_YMOE, W_ROWTOK};
            pg8::gemm_phase<pg8::EpiScatterStore, pg8::MoeOrder, true, true>((PG8_LAS unsigned char*)lds, g, S, E, tid, lds); }
        }
        GRID_BARRIER();
    };
    layer_body(IntC<0>{});
    layer_body(IntC<1>{});
    {   const int layer = DEPTH; PHASE_VARS
        for (int i0 = gt; i0 < MT * DM / 4; i0 += 4 * NGT) {
            float4 v[4]; uint2 ya[4], yb[4];
#pragma unroll
            for (int u = 0; u < 4; ++u) { const int i = i0 + u * NGT; if (i < MT * DM / 4) { const int row = i >> 8, c4 = i & 255;
                v[u] = bf4_to_f4(((const uint2*)W_RES)[i]); ya[u] = ((const uint2*)(W_YMOE + (size_t)row * 2 * DM))[c4]; yb[u] = ((const uint2*)(W_YMOE + ((size_t)row * 2 + 1) * DM))[c4]; } }
#pragma unroll
            for (int u = 0; u < 4; ++u) { const int i = i0 + u * NGT; if (i < MT * DM / 4) { const float4 a = bf4_to_f4(ya[u]), b = bf4_to_f4(yb[u]);
                v[u].x += a.x + b.x; v[u].y += a.y + b.y; v[u].z += a.z + b.z; v[u].w += a.w + b.w; ((float4*)pq->out)[i] = v[u]; } }
        }
    }
    if (PROBE_LO >= 0) {
        const int tb_ = phase_tid(lds); xcd_barrier(xbar, tb_);
        if (tb_ == 0) { const unsigned long long d = (__hip_atomic_load(PROBE_STAMPS + PROBE_HI, __ATOMIC_RELAXED, __HIP_MEMORY_SCOPE_AGENT) - __hip_atomic_load(PROBE_STAMPS + PROBE_LO, __ATOMIC_RELAXED, __HIP_MEMORY_SCOPE_AGENT))
                + (__hip_atomic_load(PROBE_STAMPS + 16 + PROBE_HI, __ATOMIC_RELAXED, __HIP_MEMORY_SCOPE_AGENT) - __hip_atomic_load(PROBE_STAMPS + 16 + PROBE_LO, __ATOMIC_RELAXED, __HIP_MEMORY_SCOPE_AGENT));
            const unsigned long long t0 = __builtin_amdgcn_s_memrealtime(); while (__builtin_amdgcn_s_memrealtime() - t0 < PROBE_MULT * d) __builtin_amdgcn_s_sleep(32); }
        __syncthreads();
    }
}
}

extern "C" void kernel_launch(void* const* d_in, const int* in_sizes, int n_in, void* d_out, int out_size, void* d_ws, size_t ws_size, hipStream_t stream) {
    Params p{};
    p.x_in = (const float*)d_in[0]; p.norm_mix = (const float*)d_in[1]; p.norm_ffn = (const float*)d_in[2]; p.w_in = (const float*)d_in[3]; p.w_out = (const float*)d_in[4];
    p.diff_q_gain = (const float*)d_in[5]; p.diff_k_gain = (const float*)d_in[6]; p.diff_lambda = (const float*)d_in[7]; p.diff_sub_gain = (const float*)d_in[8];
    p.mlstm_conv = (const float*)d_in[9]; p.mlstm_gate_bias = (const float*)d_in[10]; p.mlstm_out_gain = (const float*)d_in[11]; p.hgrn_lb = (const float*)d_in[12];
    p.hgrn_out_gain = (const float*)d_in[13]; p.nsa_cmp_pos = (const float*)d_in[14]; p.nsa_cmp_w1 = (const float*)d_in[15]; p.nsa_cmp_w2 = (const float*)d_in[16];
    p.nsa_q_gain = (const float*)d_in[17]; p.nsa_k_gain = (const float*)d_in[18]; p.nsa_out_gain = (const float*)d_in[19];
    p.moe_w_group = (const float*)d_in[20]; p.moe_b_group = (const float*)d_in[21]; p.moe_w_expert = (const float*)d_in[22]; p.moe_b_expert = (const float*)d_in[23];
    p.moe_w_gate = (const float*)d_in[24]; p.moe_w_up = (const float*)d_in[25]; p.moe_w_down = (const float*)d_in[26];
    p.out = (float*)d_out;

    p.ws = (char*)d_ws;
    if (WS_END > ws_size) { fprintf(stderr, "kernel_launch: workspace too small: need %zu, have %zu\n", (size_t)WS_END, ws_size); return; }

    static int grid_blocks = 0;
    if (!grid_blocks) {
        int dev = 0, cus = 0, per_cu = 0;
        hipGetDevice(&dev);
        hipDeviceGetAttribute(&cus, hipDeviceAttributeMultiprocessorCount, dev);
        hipFuncSetAttribute((const void*)mega_fwd, hipFuncAttributeMaxDynamicSharedMemorySize, LDS_BYTES);
        hipOccupancyMaxActiveBlocksPerMultiprocessor(&per_cu, (const void*)mega_fwd, NTHR, LDS_BYTES);
        if (per_cu < 1) per_cu = 1;
        if (per_cu > 1) per_cu = 1;
        grid_blocks = cus * per_cu;
    }
    hipMemsetAsync((char*)d_ws + WS_BAR, 0, 32768, stream);
    void* args[] = {&p};
    hipError_t e = hipLaunchCooperativeKernel((const void*)mega_fwd, dim3(grid_blocks), dim3(NTHR), args, LDS_BYTES, stream);
    if (e != hipSuccess) fprintf(stderr, "cooperative launch failed: %s (grid %d)\n", hipGetErrorString(e), grid_blocks);
}
```

```cpp
#include <hip/hip_runtime.h>
#include <hip/hip_cooperative_groups.h>
#include <stdint.h>
#include <cstdio>
namespace cg = cooperative_groups;

namespace {
constexpr int DM = 1024, NB = 4, SEQ = 4096, DEPTH = 2, MT = NB * SEQ;
constexpr int IN_COLS = 3476, LDP = 3584;
constexpr float EPS = 1e-6f, NEG = -1e30f;
constexpr int PC_AQ = 0, PC_AK = 256, PC_AV = 512, PC_BQ = 768, PC_BK = 1024, PC_BV = 1280, PC_BO = 1536, PC_CQ = 1792, PC_CF = 2048,
              PC_CI = 2304, PC_CG = 2560, PC_DQ = 2816, PC_KC = 3072, PC_VC = 3136, PC_KS = 3200, PC_VS = 3264, PC_KW = 3328, PC_VW = 3392,
              PC_BI = 3456, PC_BF = 3460, PC_DG = 3464;
constexpr int NCMP = 255;
constexpr int NTHR = 512, NWAVE = 8;
constexpr int LDS_BYTES = 151552;

typedef unsigned short bf16_t;
__device__ __forceinline__ float bf2f(bf16_t v) { return __uint_as_float(((unsigned)v) << 16); }
typedef float f32x2_g __attribute__((ext_vector_type(2)));
typedef __bf16 bf16x2_g __attribute__((ext_vector_type(2)));
__device__ __forceinline__ unsigned pk2bf(float lo, float hi) { f32x2_g v = {lo, hi}; bf16x2_g b = __builtin_convertvector(v, bf16x2_g); return __builtin_bit_cast(unsigned, b); }
__device__ __forceinline__ bf16_t f2bf(float f) { return (bf16_t)(pk2bf(f, 0.f) & 0xffffu); }
__device__ __forceinline__ int src_col(int c) { return c < 1536 ? c : (c < 3456 ? c + 8 : (c < 3460 ? c - 3456 + 1536 : (c < 3464 ? c - 3460 + 1540 : c))); }
__device__ __forceinline__ float sigmoidf_(float x) { return __builtin_amdgcn_rcpf(1.f + __expf(-x)); }
__device__ __forceinline__ float siluf_(float x) { return x * __builtin_amdgcn_rcpf(1.f + __expf(-x)); }
__device__ __forceinline__ float wave_sum(float v, int lane) {
#pragma unroll
    for (int o = 1; o < 64; o <<= 1) v += __int_as_float(__builtin_amdgcn_ds_bpermute((lane ^ o) << 2, __float_as_int(v)));
    return v;
}
__device__ __forceinline__ float rdlane(float v, int k) { return __int_as_float(__builtin_amdgcn_readlane(__float_as_int(v), k)); }

__device__ __forceinline__ int phase_tid_fwd(const unsigned char* lds_generic);
namespace pg8 {
#define PG8_LAS __attribute__((address_space(3)))
typedef unsigned short bf16_t;
typedef short bf16x8 __attribute__((ext_vector_type(8)));
typedef float f32x4 __attribute__((ext_vector_type(4)));
typedef unsigned u32x4 __attribute__((ext_vector_type(4)));
constexpr int BM = 256, BK = 64, HALF = 128, HTB = HALF * BK * 2  , STAGE_BYTES = 8 * HTB, NXCD = 8, WGM = 8;

__host__ __device__ __forceinline__ int lds_byte(int r, int c) { const int st = (r >> 4) * 2 + (c >> 5), rr = r & 15, cc = c & 31, ob = rr * 64 + cc * 2; return st * 1024 + (ob ^ (((ob >> 9) & 1) << 5)); }
__host__ __device__ __forceinline__ void stage_rc(int b, int& R, int& C) { const int st = b / 1024, sb = b % 1024, swz = sb ^ (((sb >> 9) & 1) << 5); R = (st >> 1) * 16 + swz / 64; C = (st & 1) * 32 + (swz % 64) / 2; }
__host__ __device__ __forceinline__ int perm32(int rho) { const int n = rho >> 4, i = rho & 15; return 8 * (i >> 2) + 4 * n + (i & 3); }

struct Unit { int pm, pn; };
struct Gemm { const bf16_t* A; const bf16_t* Bt; int M, N, K; const int* arow = nullptr; };

struct StaticOrder {
    int nM, nN, nwg, G, c;
    __host__ __device__ void init(int M, int N, int G_, int c_) { nM = M / BM; nN = N / BM; nwg = nM * nN; G = G_; c = c_; }
    __host__ __device__ bool next(int i, Unit& u) const {
        const long L = (long)i * G + c; if (L >= nwg) return false;
        int wgid = (int)L; { const int q = nwg / NXCD, r = nwg % NXCD, xcd = wgid % NXCD, off = wgid / NXCD; wgid = (xcd < r ? xcd * (q + 1) : r * (q + 1) + (xcd - r) * q) + off; }
        const int nig = WGM * nN, gid = wgid / nig, fm = gid * WGM, gsz = (nM - fm) < WGM ? (nM - fm) : WGM;
        u.pm = fm + ((wgid % nig) % gsz); u.pn = (wgid % nig) / gsz; return true;
    }
    __device__ __forceinline__ void a_ready(const Unit&) const {}
    __device__ __forceinline__ void done(const Unit&) const {}
};

__device__ __forceinline__ unsigned cvt_pk_bf16(float lo, float hi) { unsigned r; asm volatile("v_cvt_pk_bf16_f32 %0, %1, %2" : "=v"(r) : "v"(lo), "v"(hi)); return r; }
template <int ACT  > struct EpiBf16 {
    static constexpr bool PERM = true, AFTER_DRAIN = false, HAS_INIT = false; static_assert(ACT == 0, "EpiBf16: only ACT 0 here");
    bf16_t* O; int ldc; const float* bias; int split_cols; size_t split_stride; float scale0; const float* rowscale;
    __device__ __forceinline__ void operator()(const f32x4 (&acc)[2][2][4][2], const Unit& u, int wr, int wc, int fr, int fq) const {
        const int row0 = u.pm * BM + wr * 64 + fr; int colt = u.pn * BM; bf16_t* base = O;
        float sc = 1.f; if (split_cols) { const int t = colt / split_cols; base += (size_t)t * split_stride; colt -= t * split_cols; if (t == 0) sc = scale0; }
        const int col0 = colt + wc * 32 + 8 * fq, bcol0 = u.pn * BM + wc * 32 + 8 * fq;
        f32x4 bv[2][2];
#pragma unroll
        for (int bj = 0; bj < 2; ++bj)
#pragma unroll
            for (int n = 0; n < 2; ++n) bv[bj][n] = bias ? *(const f32x4*)(bias + bcol0 + bj * HALF + 4 * n) : (f32x4){0.f, 0.f, 0.f, 0.f};
#pragma unroll
        for (int ai = 0; ai < 2; ++ai)
#pragma unroll
            for (int m = 0; m < 4; ++m) { bf16_t* rowp = base + (size_t)(row0 + ai * HALF + m * 16) * ldc + col0; const float scr_ = rowscale ? sc * rowscale[row0 + ai * HALF + m * 16] : sc;
#pragma unroll
                for (int bj = 0; bj < 2; ++bj) { f32x4 v0 = acc[ai][bj][m][0] + bv[bj][0], v1 = acc[ai][bj][m][1] + bv[bj][1];
                    v0 = v0 * scr_; v1 = v1 * scr_; u32x4 w; w.x = cvt_pk_bf16(v0[0], v0[1]); w.y = cvt_pk_bf16(v0[2], v0[3]); w.z = cvt_pk_bf16(v1[0], v1[1]); w.w = cvt_pk_bf16(v1[2], v1[3]);
                    *(u32x4*)(rowp + bj * HALF) = w; } }
    }
};


struct EpiResF32 {
    static constexpr bool PERM = false, AFTER_DRAIN = false, HAS_INIT = true;
    const float* base; float* out; int ldc;
    __device__ __forceinline__ void init(f32x4 (&acc)[2][2][4][2], const Unit& u, int wr, int wc, int fr, int fq) const {
        const int col0 = u.pn * BM + wc * 32 + 4 * fq;
#pragma unroll
        for (int ai = 0; ai < 2; ++ai)
#pragma unroll
            for (int m = 0; m < 4; ++m) { const size_t off = (size_t)(u.pm * BM + ai * HALF + wr * 64 + m * 16 + fr) * ldc + col0;
#pragma unroll
                for (int bj = 0; bj < 2; ++bj)
#pragma unroll
                    for (int n = 0; n < 2; ++n) acc[ai][bj][m][n] = *(const f32x4*)(base + off + bj * HALF + n * 16); }
    }
    __device__ __forceinline__ void operator()(const f32x4 (&acc)[2][2][4][2], const Unit& u, int wr, int wc, int fr, int fq) const {
        const int col0 = u.pn * BM + wc * 32 + 4 * fq;
#pragma unroll
        for (int ai = 0; ai < 2; ++ai)
#pragma unroll
            for (int m = 0; m < 4; ++m) { const size_t off = (size_t)(u.pm * BM + ai * HALF + wr * 64 + m * 16 + fr) * ldc + col0;
#pragma unroll
                for (int bj = 0; bj < 2; ++bj)
#pragma unroll
                    for (int n = 0; n < 2; ++n) *(f32x4*)(out + off + bj * HALF + n * 16) = acc[ai][bj][m][n]; }
    }
};

template <bool BASE_BF> struct EpiResB {
    static constexpr bool PERM = true, AFTER_DRAIN = false, HAS_INIT = true;
    const void* base; bf16_t* out; int ldc;
    __device__ __forceinline__ void init(f32x4 (&acc)[2][2][4][2], const Unit& u, int wr, int wc, int fr, int fq) const {
        const int col0 = u.pn * BM + wc * 32 + 8 * fq;
#pragma unroll
        for (int ai = 0; ai < 2; ++ai)
#pragma unroll
            for (int m = 0; m < 4; ++m) { const size_t off = (size_t)(u.pm * BM + ai * HALF + wr * 64 + m * 16 + fr) * ldc + col0;
#pragma unroll
                for (int bj = 0; bj < 2; ++bj) {
                    if constexpr (BASE_BF) { const u32x4 w = *(const u32x4*)((const bf16_t*)base + off + bj * HALF);
                        acc[ai][bj][m][0] = (f32x4){__uint_as_float(w.x << 16), __uint_as_float(w.x & 0xffff0000u), __uint_as_float(w.y << 16), __uint_as_float(w.y & 0xffff0000u)};
                        acc[ai][bj][m][1] = (f32x4){__uint_as_float(w.z << 16), __uint_as_float(w.z & 0xffff0000u), __uint_as_float(w.w << 16), __uint_as_float(w.w & 0xffff0000u)}; }
                    else { acc[ai][bj][m][0] = *(const f32x4*)((const float*)base + off + bj * HALF); acc[ai][bj][m][1] = *(const f32x4*)((const float*)base + off + bj * HALF + 4); } } }
    }
    __device__ __forceinline__ void operator()(const f32x4 (&acc)[2][2][4][2], const Unit& u, int wr, int wc, int fr, int fq) const {
        const int col0 = u.pn * BM + wc * 32 + 8 * fq;
#pragma unroll
        for (int ai = 0; ai < 2; ++ai)
#pragma unroll
            for (int m = 0; m < 4; ++m) { bf16_t* rowp = out + (size_t)(u.pm * BM + ai * HALF + wr * 64 + m * 16 + fr) * ldc + col0;
#pragma unroll
                for (int bj = 0; bj < 2; ++bj) { const f32x4 v0 = acc[ai][bj][m][0], v1 = acc[ai][bj][m][1];
                    u32x4 w; w.x = cvt_pk_bf16(v0[0], v0[1]); w.y = cvt_pk_bf16(v0[2], v0[3]); w.z = cvt_pk_bf16(v1[0], v1[1]); w.w = cvt_pk_bf16(v1[2], v1[3]);
                    *(u32x4*)(rowp + bj * HALF) = w; } }
    }
};

struct EpiSwiglu {
    static constexpr bool PERM = true, AFTER_DRAIN = false, HAS_INIT = false;
    bf16_t* H; const float* row_w; const float* row_s;
    __device__ __forceinline__ void operator()(const f32x4 (&acc)[2][2][4][2], const Unit& u, int wr, int wc, int fr, int fq) const {
        const int row0 = u.pm * BM + wr * 64 + fr, col0 = (u.pn & 1) * HALF + wc * 32 + 8 * fq;
#pragma unroll
        for (int ai = 0; ai < 2; ++ai)
#pragma unroll
            for (int m = 0; m < 4; ++m) { const int row = row0 + ai * HALF + m * 16; const float w = row_w[row], sn = row_s[row];
                float h[8];
#pragma unroll
                for (int n = 0; n < 2; ++n)
#pragma unroll
                    for (int i = 0; i < 4; ++i) { const float g = acc[ai][0][m][n][i] * sn, up = acc[ai][1][m][n][i] * sn; h[n * 4 + i] = g * __builtin_amdgcn_rcpf(1.f + __expf(-g)) * up * w; }
                u32x4 o; o.x = cvt_pk_bf16(h[0], h[1]); o.y = cvt_pk_bf16(h[2], h[3]); o.z = cvt_pk_bf16(h[4], h[5]); o.w = cvt_pk_bf16(h[6], h[7]);
                *(u32x4*)(H + (size_t)row * 256 + col0) = o; asm volatile("" ::: "memory"); }
    }
};
struct EpiScatterStore {
    static constexpr bool PERM = true, AFTER_DRAIN = false, HAS_INIT = false;
    bf16_t* Y; const int* row_tok;
    __device__ __forceinline__ void operator()(const f32x4 (&acc)[2][2][4][2], const Unit& u, int wr, int wc, int fr, int fq) const {
        const int col0 = (u.pn & 3) * BM + wc * 32 + 8 * fq;
#pragma unroll
        for (int ai = 0; ai < 2; ++ai)
#pragma unroll
            for (int m = 0; m < 4; ++m) { const int t2 = row_tok[u.pm * BM + ai * HALF + wr * 64 + m * 16 + fr];
                if (t2 >= 0) { const unsigned o = (unsigned)t2 * 1024u + (unsigned)col0;
#pragma unroll
                    for (int bj = 0; bj < 2; ++bj) { const f32x4 v0 = acc[ai][bj][m][0], v1 = acc[ai][bj][m][1];
                        u32x4 w; w.x = cvt_pk_bf16(v0[0], v0[1]); w.y = cvt_pk_bf16(v0[2], v0[3]); w.z = cvt_pk_bf16(v1[0], v1[1]); w.w = cvt_pk_bf16(v1[2], v1[3]);
                        __builtin_nontemporal_store(w, (u32x4*)(Y + (o + (unsigned)(bj * HALF)))); } }
                asm volatile("" ::: "memory"); }
    }
};
struct MoeOrder {
    int G, c, ntiles, nsub; const PG8_LAS int* tile_e; int L0, L1;
    __device__ __forceinline__ bool next(int i, Unit& u) const {
        const int L = L0 + i * G + c; if (c < 0 || L >= L1) return false;
        const int T = L / nsub, j = L - T * nsub; u.pm = T; u.pn = tile_e[T] * nsub + j; return true;
    }
    __device__ __forceinline__ void a_ready(const Unit&) const {}
    __device__ __forceinline__ void done(const Unit&) const {}
};
template <class Epi, class Sched, bool ALIGN_EPI = false, bool SP2 = false, bool GA = false>
__device__ __forceinline__ void gemm_phase(PG8_LAS unsigned char* lds, const Gemm g, const Sched& S, const Epi& E, const int tid_in, const unsigned char* lds_generic) {
    const int tid = tid_in, wid = __builtin_amdgcn_readfirstlane(tid >> 6), lane = tid & 63, wr = wid >> 2, wc = wid & 3, fr = lane & 15, fq = lane >> 4;
    const int K = g.K, nt = K / BK;
    unsigned voffA[2], voffB[2];
#pragma unroll
    for (int i = 0; i < 2; ++i) { int R, C; stage_rc(tid * 16 + i * 8192, R, C); const int Rb = Epi::PERM ? ((R & ~31) + perm32(R & 31)) : R;
        voffA[i] = (unsigned)(R * K + C) * 2u; voffB[i] = (unsigned)(Rb * K + C) * 2u; }
    const size_t kstep = (size_t)(BK * 2);
    const size_t hstep = (size_t)HALF * K * 2;
    const size_t tstep = 2 * hstep;
    const unsigned ldsw = (unsigned)wid * 1024u;
    const int aoff = lds_byte(wr * 64 + fr, fq * 8), boff = lds_byte(wc * 32 + fr, fq * 8);
#define PG8_SA(b, h) (((b) * 2 + (h)) * HTB)
#define PG8_SB(b, h) ((4 + (b) * 2 + (h)) * HTB)
#define PG8_STAGE(bufoff, gbase, voff) do { _Pragma("unroll") for (int _i = 0; _i < 2; ++_i) \
        __builtin_amdgcn_global_load_lds((const unsigned*)((const char*)(gbase) + (voff)[_i]), (PG8_LAS unsigned*)(lds + (bufoff) + ldsw + _i * 8192), 16, 0, 0); } while (0)
#define PG8_LDA(dst, b, h) do { _Pragma("unroll") for (int m = 0; m < 4; ++m) _Pragma("unroll") for (int k = 0; k < 2; ++k) dst[m][k] = *(const PG8_LAS bf16x8*)(lds + PG8_SA(b, h) + aoff + m * 2048 + k * 1024); } while (0)
#define PG8_LDB(dst, b, h) do { _Pragma("unroll") for (int n = 0; n < 2; ++n) _Pragma("unroll") for (int k = 0; k < 2; ++k) dst[n][k] = *(const PG8_LAS bf16x8*)(lds + PG8_SB(b, h) + boff + n * 2048 + k * 1024); } while (0)
#define PG8_MMA(ai, bj, At, Bt) do { __builtin_amdgcn_s_setprio(1); _Pragma("unroll") for (int m = 0; m < 4; ++m) _Pragma("unroll") for (int n = 0; n < 2; ++n) _Pragma("unroll") for (int k = 0; k < 2; ++k) \
        acc[ai][bj][m][n] = __builtin_amdgcn_mfma_f32_16x16x32_bf16(Bt[n][k], At[m][k], acc[ai][bj][m][n], 0, 0, 0); __builtin_amdgcn_s_setprio(0); } while (0)
#define PG8_WAIT_V(n) asm volatile("s_waitcnt vmcnt(" #n ")" ::: "memory")
#define PG8_WAIT_L(n) asm volatile("s_waitcnt lgkmcnt(" #n ")" ::: "memory")
#define PG8_BAR __builtin_amdgcn_s_barrier()
#define PG8_SCHED __builtin_amdgcn_sched_barrier(0)
    Unit cur, nxt; int ui = 0;
    if (!S.next(0, cur)) return;
    static_assert(SP2 || !GA, "gather mode is written for the SP2 loop only");
    unsigned voffG[2][2];
    if constexpr (GA) {
#pragma unroll
        for (int h = 0; h < 2; ++h)
#pragma unroll
            for (int i = 0; i < 2; ++i) { int R, C; stage_rc(tid * 16 + i * 8192, R, C); int t2 = g.arow[cur.pm * BM + h * HALF + R]; t2 = t2 < 0 ? 0 : t2 >> 1;
                voffG[h][i] = (unsigned)(t2 * K + C) * 2u; }
    }
#define PG8_STAGE_A(b, h, ptr) do { if constexpr (GA) { PG8_STAGE(PG8_SA(b, h), ptr, voffG[h]); } else { PG8_STAGE(PG8_SA(b, h), (ptr) + (h) * hstep, voffA); } } while (0)
    f32x4 acc[2][2][4][2];
#pragma unroll
    for (int a = 0; a < 2; ++a)
#pragma unroll
        for (int b = 0; b < 2; ++b)
#pragma unroll
            for (int m = 0; m < 4; ++m)
#pragma unroll
                for (int n = 0; n < 2; ++n) acc[a][b][m][n] = (f32x4){0.f, 0.f, 0.f, 0.f};
    if constexpr (Epi::HAS_INIT) E.init(acc, cur, wr, wc, fr, fq);
    bf16x8 At[4][2], B0[2][2], B1[2][2];
    const char* cA = GA ? (const char*)g.A : (const char*)g.A + (size_t)cur.pm * tstep; const char* cB = (const char*)g.Bt + (size_t)cur.pn * tstep;
    S.a_ready(cur);
    if constexpr (SP2) {
        PG8_STAGE(PG8_SB(0, 0), cB, voffB); PG8_STAGE(PG8_SB(0, 1), cB + hstep, voffB); PG8_STAGE_A(0, 0, cA); PG8_STAGE_A(0, 1, cA);
        if (wr == 1) PG8_BAR;
        PG8_WAIT_V(2); PG8_BAR;
        PG8_STAGE(PG8_SB(1, 0), cB + kstep, voffB); PG8_STAGE_A(1, 0, cA + kstep); PG8_STAGE(PG8_SB(1, 1), cB + hstep + kstep, voffB);
        PG8_WAIT_V(6); PG8_BAR;
    } else {
        PG8_STAGE(PG8_SB(0, 0), cB, voffB); PG8_STAGE(PG8_SA(0, 0), cA, voffA); PG8_STAGE(PG8_SB(0, 1), cB + hstep, voffB); PG8_STAGE(PG8_SA(0, 1), cA + hstep, voffA);
        if (wr == 1) PG8_BAR;
        PG8_WAIT_V(4); PG8_BAR;
        PG8_STAGE(PG8_SB(1, 0), cB + kstep, voffB); PG8_STAGE(PG8_SA(1, 0), cA + kstep, voffA); PG8_STAGE(PG8_SB(1, 1), cB + hstep + kstep, voffB);
        PG8_WAIT_V(6); PG8_BAR;
    }
    for (;;) {
        const bool has_next = GA ? false : S.next(ui + 1, nxt);
        const char* nA = has_next ? (const char*)g.A + (size_t)nxt.pm * tstep : cA; const char* nB = has_next ? (const char*)g.Bt + (size_t)nxt.pn * tstep : cB;
        for (int t = 0; t < nt; t += 2) {
            const bool last = (t == nt - 2);
            const char* a1 = cA + (size_t)(t + 1) * kstep;
            const char* a2 = last ? nA : cA + (size_t)(t + 2) * kstep; const char* b2 = last ? nB : cB + (size_t)(t + 2) * kstep;
            const char* a3 = a2 + kstep; const char* b3 = b2 + kstep;
            if (last && has_next) S.a_ready(nxt);
            if constexpr (SP2) {
            PG8_LDB(B0, 0, 0); PG8_LDB(B1, 0, 1); PG8_SCHED; PG8_LDA(At, 0, 0); PG8_STAGE_A(1, 1, a1);
            PG8_WAIT_V(8); PG8_WAIT_L(0); PG8_BAR; PG8_MMA(0, 0, At, B0); PG8_MMA(0, 1, At, B1); PG8_BAR; PG8_SCHED;
            PG8_LDA(At, 0, 1); PG8_STAGE(PG8_SB(0, 0), b2, voffB); PG8_STAGE(PG8_SB(0, 1), b2 + hstep, voffB); PG8_STAGE_A(0, 0, a2);
            PG8_WAIT_V(8); PG8_WAIT_L(0); PG8_BAR; PG8_MMA(1, 0, At, B0); PG8_MMA(1, 1, At, B1); PG8_BAR; PG8_SCHED;
            PG8_LDB(B0, 1, 0); PG8_LDB(B1, 1, 1); PG8_SCHED; PG8_LDA(At, 1, 0); PG8_STAGE_A(0, 1, a2);
            PG8_WAIT_V(8); PG8_WAIT_L(0); PG8_BAR; PG8_MMA(0, 0, At, B0); PG8_MMA(0, 1, At, B1); PG8_BAR; PG8_SCHED;
            PG8_LDA(At, 1, 1); PG8_STAGE(PG8_SB(1, 0), b3, voffB); PG8_STAGE(PG8_SB(1, 1), b3 + hstep, voffB); PG8_STAGE_A(1, 0, a3);
            PG8_WAIT_V(8); PG8_WAIT_L(0); PG8_BAR; PG8_MMA(1, 0, At, B0); PG8_MMA(1, 1, At, B1); PG8_BAR; PG8_SCHED;
            } else {
            PG8_LDB(B0, 0, 0); PG8_SCHED; PG8_LDA(At, 0, 0); PG8_STAGE(PG8_SA(1, 1), a1 + hstep, voffA);
            PG8_WAIT_L(8); PG8_BAR; PG8_WAIT_L(0); PG8_MMA(0, 0, At, B0); PG8_BAR; PG8_SCHED;
            PG8_LDB(B1, 0, 1); PG8_STAGE(PG8_SB(0, 0), b2, voffB);
            PG8_BAR; PG8_WAIT_L(0); PG8_MMA(0, 1, At, B1); PG8_BAR;
            PG8_LDA(At, 0, 1); PG8_STAGE(PG8_SA(0, 0), a2, voffA);
            PG8_BAR; PG8_WAIT_L(0); PG8_MMA(1, 0, At, B0); PG8_BAR; PG8_SCHED;
            PG8_STAGE(PG8_SB(0, 1), b2 + hstep, voffB);
            PG8_WAIT_V(6); PG8_BAR; PG8_MMA(1, 1, At, B1); PG8_BAR;
            PG8_LDB(B0, 1, 0); PG8_SCHED; PG8_LDA(At, 1, 0); PG8_STAGE(PG8_SA(0, 1), a2 + hstep, voffA);
            PG8_WAIT_L(8); PG8_BAR; PG8_WAIT_L(0); PG8_MMA(0, 0, At, B0); PG8_BAR; PG8_SCHED;
            PG8_LDB(B1, 1, 1); PG8_STAGE(PG8_SB(1, 0), b3, voffB);
            PG8_BAR; PG8_WAIT_L(0); PG8_MMA(0, 1, At, B1); PG8_BAR;
            PG8_LDA(At, 1, 1); PG8_STAGE(PG8_SA(1, 0), a3, voffA);
            PG8_BAR; PG8_WAIT_L(0); PG8_MMA(1, 0, At, B0); PG8_BAR; PG8_SCHED;
            PG8_STAGE(PG8_SB(1, 1), b3 + hstep, voffB);
            PG8_WAIT_V(6); PG8_BAR; PG8_MMA(1, 1, At, B1); PG8_BAR;
            }
        }
        if constexpr (ALIGN_EPI) { if (wr == 0) PG8_BAR; }
        if constexpr (!Epi::AFTER_DRAIN) {
            const int l2 = phase_tid_fwd(lds_generic) & 63;
            E(acc, cur, wr, wc, l2 & 15, l2 >> 4); S.done(cur); }
        if (!has_next) break;
#pragma unroll
        for (int a = 0; a < 2; ++a)
#pragma unroll
            for (int b = 0; b < 2; ++b)
#pragma unroll
                for (int m = 0; m < 4; ++m)
#pragma unroll
                    for (int n = 0; n < 2; ++n) acc[a][b][m][n] = (f32x4){0.f, 0.f, 0.f, 0.f};
        if constexpr (Epi::HAS_INIT) E.init(acc, nxt, wr, wc, fr, fq);
        cur = nxt; cA = nA; cB = nB; ++ui;
        if constexpr (ALIGN_EPI) { if (wr == 1) PG8_BAR; }
    }
    PG8_WAIT_V(0);
    if constexpr (!ALIGN_EPI) { if (wr == 0) PG8_BAR; }
    PG8_BAR;
    if constexpr (Epi::AFTER_DRAIN) { E.fused(acc, cur, wr, wc, fr, fq, lds, wid, lane); S.done(cur); }
#undef PG8_SA
#undef PG8_SB
#undef PG8_STAGE
#undef PG8_STAGE_A
#undef PG8_LDA
#undef PG8_LDB
#undef PG8_MMA
#undef PG8_WAIT_V
#undef PG8_WAIT_L
#undef PG8_BAR
#undef PG8_SCHED
}
}


namespace fa {
#define FA_LAS __attribute__((address_space(3)))
typedef short bf16x8 __attribute__((ext_vector_type(8)));
typedef float f32x16 __attribute__((ext_vector_type(16)));
typedef float f32x2_t __attribute__((ext_vector_type(2)));
typedef __bf16 bf16x2_t __attribute__((ext_vector_type(2)));
typedef unsigned u32x4 __attribute__((ext_vector_type(4)));
__device__ __forceinline__ unsigned cvtpk(float lo, float hi) { f32x2_t v = {lo, hi}; bf16x2_t b = __builtin_convertvector(v, bf16x2_t); return __builtin_bit_cast(unsigned, b); }
__device__ __forceinline__ float max3f(float a, float b, float c) { float r; asm("v_max3_f32 %0, %1, %2, %3" : "=v"(r) : "v"(a), "v"(b), "v"(c)); return r; }
__device__ __forceinline__ float min2f(float a, float b) { float r; asm("v_min_f32 %0, %1, %2" : "=v"(r) : "v"(a), "v"(b)); return r; }
__device__ __forceinline__ float xhalf(float v, int lane) { return __int_as_float(__builtin_amdgcn_ds_bpermute((lane ^ 32) << 2, __float_as_int(v))); }
struct Tile { const bf16_t* kg; const bf16_t* vg; int key0; const bf16_t* kg2; };
template <int KS, int KIND, bool KB2, class TileFn>
__device__ __forceinline__ void attn_unit(FA_LAS unsigned char* lds, int tid, int ntiles, const TileFn& tile_of, const bf16_t* qrow, int qpos, float slope2,
                                          unsigned long long selbits, int kofs  , f32x16& o0_out, f32x16& o1_out, float& il_out, float& m_out, float& l_out) {
    constexpr int KBYTES = KB2 ? 8192 : 2 * KS * 1024;
    constexpr float THR = 8.f;
    const int lane = tid & 63, r32 = lane & 31, hi = lane >> 5;
    bf16x8 qf[KS];
#pragma unroll
    for (int ks = 0; ks < KS; ++ks) qf[ks] = *(const bf16x8*)(qrow + 16 * ks + 8 * hi);
    f32x16 o0, o1;
#pragma unroll
    for (int r = 0; r < 16; ++r) { o0[r] = 0.f; o1[r] = 0.f; }
    float mref = 0.f;
    f32x16 lacc;
#pragma unroll
    for (int r = 0; r < 16; ++r) lacc[r] = 0.f;
    const u32x4 ones_w = {0x3F803F80u, 0x3F803F80u, 0x3F803F80u, 0x3F803F80u}; const bf16x8 ones8 = __builtin_bit_cast(bf16x8, ones_w);
    static_assert(KBYTES == 8192, "every wave stages 1 KiB of K and 1 KiB of V per tile (the vmcnt arithmetic below counts 2 loads per wave and tile)");
    const int nv = KIND == 3 ? (qpos >= 31 ? ((qpos - 31) >> 4) + 1 : 0) : 0;
    FA_LAS unsigned char* wbase = lds + (tid >> 6) * 1024;
    auto stage = [&](const Tile& Tt, int slot) {
        const char* ksrc = (KB2 && tid >= 256) ? (const char*)Tt.kg2 + (tid - 256) * 16 : (const char*)Tt.kg + tid * 16;
        __builtin_amdgcn_global_load_lds((const unsigned*)ksrc, (FA_LAS unsigned*)(wbase + slot * 16384), 16, 0, 0);
        __builtin_amdgcn_global_load_lds((const unsigned*)((const char*)Tt.vg + tid * 16), (FA_LAS unsigned*)(wbase + slot * 16384 + 8192), 16, 0, 0);
    };
    asm volatile("s_waitcnt vmcnt(0)" ::: "memory");
    Tile T = tile_of(0), T1 = T;
    stage(T, 0);
    if (ntiles > 1) { T1 = tile_of(1); stage(T1, 1); asm volatile("s_waitcnt vmcnt(2)" ::: "memory"); } else asm volatile("s_waitcnt vmcnt(0)" ::: "memory");
    __builtin_amdgcn_s_barrier();
    int slot = 0;
    for (int i = 0; i < ntiles; ++i) {
        Tile T2 = T1;
        if (i + 2 < ntiles) { T2 = tile_of(i + 2); stage(T2, slot == 0 ? 2 : slot - 1); }
        unsigned lofs = slot * 16384 + r32 * 32 + hi * 16; asm volatile("" : "+v"(lofs));
        const FA_LAS unsigned char* Kl = lds + lofs + kofs; const FA_LAS unsigned char* Vl = lds + lofs + 8192;
        const int key0 = T.key0;
        bool act, full, bit = true; int lim; float base, slopek;
        if (KIND == 3) { lim = nv - 1 - key0 - 4 * hi; act = key0 < nv; full = key0 + 63 < nv;
                         slopek = slope2 * 16.f; base = slope2 * (float)(16 * (key0 + 4 * hi) + 31 - qpos); }
        else { lim = qpos - key0 - 4 * hi; act = key0 <= qpos; full = key0 + 63 <= qpos; slopek = slope2; base = slope2 * (float)(key0 + 4 * hi - qpos);
               if (KIND == 1) { bit = (selbits >> (key0 >> 6)) & 1ull; act = act && bit; if (!bit) lim = -100000; }
               if (KIND == 2) { act = act && (key0 + 63 > qpos - 512); full = full && (key0 > qpos - 512); } }
        if (__builtin_amdgcn_ballot_w64(act) != 0ull) {
            const bool allfull = __builtin_amdgcn_ballot_w64(full) == ~0ull;
            f32x16 s0, s1;
            const float bm = (KIND == 1 && !bit) ? -1e30f : base - mref;
#pragma unroll
            for (int r = 0; r < 16; ++r) { const int c0 = (r & 3) + 8 * (r >> 2); s0[r] = __builtin_fmaf(slopek, (float)c0, bm); s1[r] = __builtin_fmaf(slopek, (float)(c0 + 32), bm); }
#pragma unroll
            for (int ks = 0; ks < KS; ++ks) {
                const bf16x8 a0 = *(const FA_LAS bf16x8*)(Kl + ks * 1024);
                const bf16x8 a1 = *(const FA_LAS bf16x8*)(Kl + (KS + ks) * 1024);
                s0 = __builtin_amdgcn_mfma_f32_32x32x16_bf16(a0, qf[ks], s0, 0, 0, 0);
                s1 = __builtin_amdgcn_mfma_f32_32x32x16_bf16(a1, qf[ks], s1, 0, 0, 0);
            }
            if (!allfull) {
#pragma unroll
                for (int r = 0; r < 16; ++r) { const int c0 = (r & 3) + 8 * (r >> 2);
                    int p0 = min(lim - c0, 0), p1 = min(lim - c0 - 32, 0);
                    if (KIND == 2) { p0 += min(c0 - lim + 511, 0); p1 += min(c0 + 32 - lim + 511, 0); }
                    s0[r] = __builtin_fmaf((float)p0, 1e30f, s0[r]); s1[r] = __builtin_fmaf((float)p1, 1e30f, s1[r]); }
            }
            float mx = max3f(s0[0], s1[0], s0[1]);
            mx = max3f(mx, s1[1], s0[2]);
#pragma unroll
            for (int r = 2; r < 15; ++r) mx = max3f(mx, s1[r], s0[r + 1]);
            mx = max3f(mx, s1[15], s1[15]);
            mx = max3f(mx, xhalf(mx, lane), mx);
            if (__builtin_amdgcn_ballot_w64(mx > THR) != 0ull) {
                const float dl = __builtin_fmaxf(mx, 0.f), f = __builtin_amdgcn_exp2f(-dl);
                mref += dl;
#pragma unroll
                for (int r = 0; r < 16; ++r) { s0[r] -= dl; s1[r] -= dl; o0[r] *= f; o1[r] *= f; lacc[r] *= f; }
            }
#pragma unroll
            for (int r = 0; r < 16; ++r) { s0[r] = __builtin_amdgcn_exp2f(s0[r]); s1[r] = __builtin_amdgcn_exp2f(s1[r]); }
#pragma unroll
            for (int kb = 0; kb < 2; ++kb)
#pragma unroll
                for (int sp = 0; sp < 2; ++sp) {
                    u32x4 pw;
                    if (kb == 0) { pw.x = cvtpk(s0[8 * sp + 0], s0[8 * sp + 1]); pw.y = cvtpk(s0[8 * sp + 2], s0[8 * sp + 3]); pw.z = cvtpk(s0[8 * sp + 4], s0[8 * sp + 5]); pw.w = cvtpk(s0[8 * sp + 6], s0[8 * sp + 7]); }
                    else         { pw.x = cvtpk(s1[8 * sp + 0], s1[8 * sp + 1]); pw.y = cvtpk(s1[8 * sp + 2], s1[8 * sp + 3]); pw.z = cvtpk(s1[8 * sp + 4], s1[8 * sp + 5]); pw.w = cvtpk(s1[8 * sp + 6], s1[8 * sp + 7]); }
                    const bf16x8 pf = __builtin_bit_cast(bf16x8, pw);
                    const bf16x8 v0 = *(const FA_LAS bf16x8*)(Vl + ((kb * 2 + sp) * 2 + 0) * 1024);
                    const bf16x8 v1 = *(const FA_LAS bf16x8*)(Vl + ((kb * 2 + sp) * 2 + 1) * 1024);
                    o0 = __builtin_amdgcn_mfma_f32_32x32x16_bf16(v0, pf, o0, 0, 0, 0);
                    o1 = __builtin_amdgcn_mfma_f32_32x32x16_bf16(v1, pf, o1, 0, 0, 0);
                    lacc = __builtin_amdgcn_mfma_f32_32x32x16_bf16(ones8, pf, lacc, 0, 0, 0);
                }
        }
        if (i + 2 < ntiles) asm volatile("s_waitcnt vmcnt(2)" ::: "memory"); else asm volatile("s_waitcnt vmcnt(0)" ::: "memory");
        asm volatile("s_waitcnt lgkmcnt(0)" ::: "memory");
        __builtin_amdgcn_s_barrier();
        T = T1; T1 = T2; slot = slot == 2 ? 0 : slot + 1;
    }
    const float lt = lacc[0];
    const bool rowvalid = KIND == 3 ? nv > 0 : true;
    const float il = (rowvalid && lt > 0.f) ? 1.f / lt : 0.f;
    m_out = mref; l_out = lt; il_out = il; o0_out = o0; o1_out = o1;
}
__device__ __forceinline__ void store_o_f32(float* orow, const f32x16& o0, const f32x16& o1, float il, int hi) {
#pragma unroll
    for (int g = 0; g < 4; ++g) {
        const int d = 8 * g + 4 * hi;
        *(float4*)(orow + d) = make_float4(o0[4 * g] * il, o0[4 * g + 1] * il, o0[4 * g + 2] * il, o0[4 * g + 3] * il);
        *(float4*)(orow + 32 + d) = make_float4(o1[4 * g] * il, o1[4 * g + 1] * il, o1[4 * g + 2] * il, o1[4 * g + 3] * il);
    }
}
__device__ __forceinline__ void store_normed_bf16(bf16_t* mrow, const f32x16& v0, const f32x16& v1, const float* gain64, float scale, int lane, int hi) {
    float ss = 0.f;
#pragma unroll
    for (int r = 0; r < 16; ++r) ss += v0[r] * v0[r] + v1[r] * v1[r];
    ss += xhalf(ss, lane);
    const float rr = rsqrtf(ss * (1.f / 64) + 1e-6f) * scale;
#pragma unroll
    for (int g = 0; g < 4; ++g) {
        const int d = 8 * g + 4 * hi;
        const float4 g0 = *(const float4*)(gain64 + d), g1 = *(const float4*)(gain64 + 32 + d);
        uint2 w0, w1;
        w0.x = cvtpk(v0[4 * g] * rr * g0.x, v0[4 * g + 1] * rr * g0.y); w0.y = cvtpk(v0[4 * g + 2] * rr * g0.z, v0[4 * g + 3] * rr * g0.w);
        w1.x = cvtpk(v1[4 * g] * rr * g1.x, v1[4 * g + 1] * rr * g1.y); w1.y = cvtpk(v1[4 * g + 2] * rr * g1.z, v1[4 * g + 3] * rr * g1.w);
        *(uint2*)(mrow + d) = w0; *(uint2*)(mrow + 32 + d) = w1;
    }
}
}


namespace scan {
typedef short bf16x8 __attribute__((ext_vector_type(8)));
typedef float f32x16 __attribute__((ext_vector_type(16)));
__device__ __forceinline__ int spos(int s) { const int s16 = s & 15; return (s & ~15) + 8 * ((s16 >> 2) & 1) + (((s16 >> 3) << 2) | (s16 & 3)); }
__device__ __forceinline__ float xhalf(float v, int lane) { return __int_as_float(__builtin_amdgcn_ds_bpermute((lane ^ 32) << 2, __float_as_int(v))); }
constexpr size_t A8 = (size_t)MT * 256 * 2, SM = (size_t)1024 * 64 * 4;
template <int MIX> struct BufsT {
    char* r1; char* r2;
    static constexpr size_t R1OFF = MIX == 0 ? 0 : 6 * A8 + 5 * SM;
    __device__ __forceinline__ bf16_t* QA() const { return (bf16_t*)(r1 + R1OFF); }
    __device__ __forceinline__ bf16_t* KA() const { return (bf16_t*)(r1 + R1OFF + A8); }
    __device__ __forceinline__ bf16_t* KAT() const { return (bf16_t*)(r1 + R1OFF + 2 * A8); }
    __device__ __forceinline__ char* rest() const { return MIX == 0 ? r1 + 3 * A8 : r2; }
    __device__ __forceinline__ bf16_t* VT() const { return (bf16_t*)(rest()); }
    __device__ __forceinline__ bf16_t* Ub() const { return (bf16_t*)(rest() + A8); }
    __device__ __forceinline__ bf16_t* Sp() const { return (bf16_t*)(rest() + 2 * A8); }
    __device__ __forceinline__ float* Un() const { return (float*)(rest() + 3 * A8); }
    __device__ __forceinline__ float* np() const { return (float*)(rest() + 3 * A8 + SM); }
    __device__ __forceinline__ float* dL() const { return (float*)(rest() + 3 * A8 + 2 * SM); }
    __device__ __forceinline__ float* dmid() const { return (float*)(rest() + 3 * A8 + 3 * SM); }
    __device__ __forceinline__ float* dLm() const { return (float*)(rest() + 3 * A8 + 4 * SM); }
};

__host__ __device__ constexpr int spos_c(int s) { return (s & ~15) + 8 * (((s & 15) >> 2) & 1) + ((((s & 15) >> 3) << 2) | (s & 3)); }
template <int MIX>
__device__ __forceinline__ void prep_k(const bf16_t* P, const float* convw, const float* gbias, const float* lbp, int layer, const BufsT<MIX>& B, int idx) {
    const int k = idx & 63, ci = idx >> 6, h = ci & 3, chunk = ci >> 2, c = chunk & 63, lane = k;
    const size_t m0 = (size_t)chunk * 64;
    unsigned kapk[32];
    float bL, bmid;
    if (MIX == 1) {
        float lb = 0.f; if (layer == 1) lb = sigmoidf_(lbp[256 + h * 64 + k] - lbp[h * 64 + k]);
        const bf16_t* zc = P + m0 * LDP + PC_CF + h * 64 + k; const bf16_t* qc = P + m0 * LDP + PC_CQ + h * 64 + k;
        float bc[64], kr[64];
        {   bf16_t zr[64];
#pragma unroll
            for (int s = 0; s < 64; ++s) zr[s] = zc[(size_t)s * LDP];
            float bs = 0.f;
#pragma unroll
            for (int s = 0; s < 64; ++s) { const float f = lb + (1.f - lb) * sigmoidf_(bf2f(zr[s])); bs += __logf(f); bc[s] = bs; kr[s] = 1.f - f; } }
        bmid = bc[31]; bL = bc[63];
#pragma unroll
        for (int g = 0; g < 4; ++g) {
            bf16_t qr[16];
#pragma unroll
            for (int i = 0; i < 16; ++i) qr[i] = qc[(size_t)(16 * g + i) * LDP];
#pragma unroll
            for (int i = 0; i < 16; ++i) { const int s2 = 16 * g + i; const size_t m = m0 + s2;
                const float qa = siluf_(bf2f(qr[i])) * __expf(bc[s2] - bmid), ka = kr[s2] * __expf(bmid - bc[s2]);
                const unsigned kab = f2bf(ka);
                B.QA()[m * 256 + h * 64 + k] = f2bf(qa); B.KA()[m * 256 + h * 64 + k] = (bf16_t)kab;
                const int p = spos_c(s2); if (p & 1) kapk[p >> 1] |= kab << 16; else kapk[p >> 1] = kab; }
        }
    } else {
        const float bi = gbias[h], bfz = gbias[4 + h];
        const float fpre = bf2f(P[(m0 + lane) * LDP + PC_BF + h]) + bfz, ipre = bf2f(P[(m0 + lane) * LDP + PC_BI + h]) + bi;
        float gsum = -log1pf(__expf(-fpre));
#pragma unroll
        for (int o = 1; o < 64; o <<= 1) { const float y = __int_as_float(__builtin_amdgcn_ds_bpermute(((lane - o) & 63) << 2, __float_as_int(gsum))); if (lane >= o) gsum += y; }
        bmid = rdlane(gsum, 31); bL = rdlane(gsum, 63);
        const float ea = __expf(gsum - bmid), eb = __expf(bmid - gsum + ipre);
        const bf16_t* qc = P + m0 * LDP + PC_BQ + h * 64 + k; const bf16_t* kc = P + m0 * LDP + PC_BK + h * 64 + k;
        float wq[4], wk[4];
#pragma unroll
        for (int j = 0; j < 4; ++j) { wq[j] = convw[j * 512 + h * 64 + k]; wk[j] = convw[j * 512 + 256 + h * 64 + k]; }
        float q1 = 0.f, q2 = 0.f, q3 = 0.f, k1 = 0.f, k2 = 0.f, k3 = 0.f;
        if (c > 0) { q1 = bf2f(*(qc - (size_t)1 * LDP)); q2 = bf2f(*(qc - (size_t)2 * LDP)); q3 = bf2f(*(qc - (size_t)3 * LDP));
                     k1 = bf2f(*(kc - (size_t)1 * LDP)); k2 = bf2f(*(kc - (size_t)2 * LDP)); k3 = bf2f(*(kc - (size_t)3 * LDP)); }
#pragma unroll
        for (int g = 0; g < 4; ++g) {
            bf16_t qr[16], kr2[16];
#pragma unroll
            for (int i = 0; i < 16; ++i) { qr[i] = qc[(size_t)(16 * g + i) * LDP]; kr2[i] = kc[(size_t)(16 * g + i) * LDP]; }
#pragma unroll
            for (int i = 0; i < 16; ++i) { const int s2 = 16 * g + i; const size_t m = m0 + s2;
                const float q0 = bf2f(qr[i]), k0 = bf2f(kr2[i]);
                const float qv = wq[3] * q0 + wq[2] * q1 + wq[1] * q2 + wq[0] * q3, kv = wk[3] * k0 + wk[2] * k1 + wk[1] * k2 + wk[0] * k3;
                q3 = q2; q2 = q1; q1 = q0; k3 = k2; k2 = k1; k1 = k0;
                const float qa = siluf_(qv) * 0.125f * rdlane(ea, s2), ka = siluf_(kv) * rdlane(eb, s2);
                const unsigned kab = f2bf(ka);
                B.QA()[m * 256 + h * 64 + k] = f2bf(qa); B.KA()[m * 256 + h * 64 + k] = (bf16_t)kab;
                const int p = spos_c(s2); if (p & 1) kapk[p >> 1] |= kab << 16; else kapk[p >> 1] = kab; }
        }
    }
    uint4* kat = (uint4*)(B.KAT() + ((size_t)ci * 64 + k) * 64);
#pragma unroll
    for (int i = 0; i < 8; ++i) kat[i] = make_uint4(kapk[4 * i], kapk[4 * i + 1], kapk[4 * i + 2], kapk[4 * i + 3]);
    B.dL()[ci * 64 + k] = __expf(bL); B.dmid()[ci * 64 + k] = __expf(bmid); B.dLm()[ci * 64 + k] = __expf(bL - bmid);
}
__device__ __forceinline__ void prep_v(const bf16_t* P, int pcol, bf16_t* VT, int idx) {
    const int e = idx & 63, ci = idx >> 6, h = ci & 3; const size_t m0 = (size_t)(ci >> 2) * 64;
    const bf16_t* vc = P + m0 * LDP + pcol + h * 64 + e;
    bf16_t vr[64];
#pragma unroll
    for (int s = 0; s < 64; ++s) vr[s] = vc[(size_t)s * LDP];
    unsigned pk[32];
#pragma unroll
    for (int s = 0; s < 64; ++s) { const int p = spos_c(s); if (p & 1) pk[p >> 1] |= (unsigned)vr[s] << 16; else pk[p >> 1] = vr[s]; }
    uint4* vt = (uint4*)(VT + ((size_t)ci * 64 + e) * 64);
#pragma unroll
    for (int i = 0; i < 8; ++i) vt[i] = make_uint4(pk[4 * i], pk[4 * i + 1], pk[4 * i + 2], pk[4 * i + 3]);
}
template <int MIX>
__device__ __forceinline__ void stepA(const BufsT<MIX>& B, int ci, int lane) {
    const int r32 = lane & 31, hi = lane >> 5;
    const bf16_t* vt = B.VT() + (size_t)ci * 4096; const bf16_t* kat = B.KAT() + (size_t)ci * 4096;
    f32x16 acc[2][2];
#pragma unroll
    for (int a = 0; a < 2; ++a)
#pragma unroll
        for (int b = 0; b < 2; ++b)
#pragma unroll
            for (int r = 0; r < 16; ++r) acc[a][b][r] = 0.f;
    float nsum[2] = {0.f, 0.f};
#pragma unroll
    for (int g = 0; g < 4; ++g) {
        bf16x8 a[2], bb[2];
#pragma unroll
        for (int et = 0; et < 2; ++et) a[et] = *(const bf16x8*)(vt + (32 * et + r32) * 64 + 16 * g + 8 * hi);
#pragma unroll
        for (int kt = 0; kt < 2; ++kt) { bb[kt] = *(const bf16x8*)(kat + (32 * kt + r32) * 64 + 16 * g + 8 * hi);
            if (MIX == 0) {
#pragma unroll
                for (int j = 0; j < 8; ++j) nsum[kt] += bf2f((bf16_t)bb[kt][j]); } }
#pragma unroll
        for (int et = 0; et < 2; ++et)
#pragma unroll
            for (int kt = 0; kt < 2; ++kt) acc[et][kt] = __builtin_amdgcn_mfma_f32_32x32x16_bf16(a[et], bb[kt], acc[et][kt], 0, 0, 0);
    }
#pragma unroll
    for (int kt = 0; kt < 2; ++kt) {
        const float dl = B.dLm()[ci * 64 + 32 * kt + r32];
#pragma unroll
        for (int et = 0; et < 2; ++et)
#pragma unroll
            for (int r = 0; r < 16; ++r) { const int e = 32 * et + (r & 3) + 8 * (r >> 2) + 4 * hi; B.Ub()[((size_t)ci * 64 + e) * 64 + 32 * kt + r32] = f2bf(acc[et][kt][r] * dl); }
        if (MIX == 0) { const float ns = nsum[kt] + xhalf(nsum[kt], lane); if (hi == 0) B.Un()[ci * 64 + 32 * kt + r32] = ns * dl; }
    }
}
template <int MIX>
__device__ __forceinline__ void stepB(const BufsT<MIX>& B, int idx) {
    const int k = idx & 63, e = (idx >> 6) & 63, bh = idx >> 12, h = bh & 3, b = bh >> 2;
    const bool nrow = MIX == 0 && e == 0;
    float S = 0.f, Sn = 0.f;
#pragma unroll 1
    for (int c0 = 0; c0 < 64; c0 += 16) {
        float dm[16], dl[16], u[16], un[16];
#pragma unroll
        for (int i = 0; i < 16; ++i) { const int ci = (b * 64 + c0 + i) * 4 + h; dm[i] = B.dmid()[ci * 64 + k]; dl[i] = B.dL()[ci * 64 + k];
            u[i] = bf2f(B.Ub()[((size_t)ci * 64 + e) * 64 + k]); un[i] = 0.f;
            if (MIX == 0) { if (nrow) un[i] = B.Un()[ci * 64 + k]; } }
#pragma unroll
        for (int i = 0; i < 16; ++i) { const int ci = (b * 64 + c0 + i) * 4 + h;
            B.Sp()[((size_t)ci * 64 + e) * 64 + k] = f2bf(S * dm[i]);
            if (MIX == 0) { if (nrow) B.np()[ci * 64 + k] = Sn * dm[i]; Sn = dl[i] * Sn + un[i]; }
            S = dl[i] * S + u[i]; }
    }
}
template <int MIX>
__device__ __forceinline__ void stepC(const BufsT<MIX>& B, const bf16_t* P, int gatecol, const float* outg, bf16_t* mixed, int mixcol, int ci, int lane) {
    const int r32 = lane & 31, hi = lane >> 5, h = ci & 3; const size_t m0 = (size_t)(ci >> 2) * 64;
    const bf16_t* vt = B.VT() + (size_t)ci * 4096; const bf16_t* sp = B.Sp() + (size_t)ci * 4096;
#pragma unroll
    for (int tt = 0; tt < 2; ++tt) {
        bf16x8 qf[4], kf[2][4], vf[2][2][2], sf[4][2];
#pragma unroll
        for (int ks = 0; ks < 4; ++ks) qf[ks] = *(const bf16x8*)(B.QA() + (m0 + 32 * tt + r32) * 256 + h * 64 + 16 * ks + 8 * hi);
#pragma unroll
        for (int st = 0; st <= tt; ++st) {
#pragma unroll
            for (int ks = 0; ks < 4; ++ks) kf[st][ks] = *(const bf16x8*)(B.KA() + (m0 + 32 * st + r32) * 256 + h * 64 + 16 * ks + 8 * hi);
#pragma unroll
            for (int s2 = 0; s2 < 2; ++s2)
#pragma unroll
                for (int et = 0; et < 2; ++et) vf[st][s2][et] = *(const bf16x8*)(vt + (32 * et + r32) * 64 + 32 * st + 16 * s2 + 8 * hi); }
#pragma unroll
        for (int ks = 0; ks < 4; ++ks)
#pragma unroll
            for (int et = 0; et < 2; ++et) sf[ks][et] = *(const bf16x8*)(sp + (32 * et + r32) * 64 + 16 * ks + 8 * hi);
        f32x16 o[2];
#pragma unroll
        for (int r = 0; r < 16; ++r) { o[0][r] = 0.f; o[1][r] = 0.f; }
        float den = 0.f;
#pragma unroll
        for (int st = 0; st <= tt; ++st) {
            f32x16 pt;
#pragma unroll
            for (int r = 0; r < 16; ++r) pt[r] = 0.f;
#pragma unroll
            for (int ks = 0; ks < 4; ++ks) pt = __builtin_amdgcn_mfma_f32_32x32x16_bf16(kf[st][ks], qf[ks], pt, 0, 0, 0);
            if (st == tt) {
#pragma unroll
                for (int r = 0; r < 16; ++r) { const int sl = (r & 3) + 8 * (r >> 2) + 4 * hi; pt[r] = sl <= r32 ? pt[r] : 0.f; } }
            if (MIX == 0) {
#pragma unroll
                for (int r = 0; r < 16; ++r) den += pt[r]; }
#pragma unroll
            for (int s2 = 0; s2 < 2; ++s2) {
                fa::u32x4 pw; pw.x = fa::cvtpk(pt[8 * s2 + 0], pt[8 * s2 + 1]); pw.y = fa::cvtpk(pt[8 * s2 + 2], pt[8 * s2 + 3]); pw.z = fa::cvtpk(pt[8 * s2 + 4], pt[8 * s2 + 5]); pw.w = fa::cvtpk(pt[8 * s2 + 6], pt[8 * s2 + 7]);
                const bf16x8 pf = __builtin_bit_cast(bf16x8, pw);
#pragma unroll
                for (int et = 0; et < 2; ++et) o[et] = __builtin_amdgcn_mfma_f32_32x32x16_bf16(vf[st][s2][et], pf, o[et], 0, 0, 0);
            }
        }
#pragma unroll
        for (int ks = 0; ks < 4; ++ks)
#pragma unroll
            for (int et = 0; et < 2; ++et) o[et] = __builtin_amdgcn_mfma_f32_32x32x16_bf16(sf[ks][et], qf[ks], o[et], 0, 0, 0);
        if (MIX == 0) {
#pragma unroll
            for (int ks = 0; ks < 4; ++ks)
#pragma unroll
                for (int j = 0; j < 8; ++j) den += bf2f((bf16_t)qf[ks][j]) * B.np()[ci * 64 + 16 * ks + 8 * hi + j];
            den += xhalf(den, lane);
            const float sc = 1.f / __builtin_fmaxf(__builtin_fabsf(den), 1.f);
#pragma unroll
            for (int r = 0; r < 16; ++r) { o[0][r] *= sc; o[1][r] *= sc; }
        }
        float ss = 0.f;
#pragma unroll
        for (int r = 0; r < 16; ++r) ss += o[0][r] * o[0][r] + o[1][r] * o[1][r];
        ss += xhalf(ss, lane);
        const float rr = rsqrtf(ss * (1.f / 64) + EPS);
        const size_t m = m0 + 32 * tt + r32;
#pragma unroll
        for (int et = 0; et < 2; ++et)
#pragma unroll
            for (int g = 0; g < 4; ++g) {
                const int e = 32 * et + 8 * g + 4 * hi;
                const uint2 gt2 = *(const uint2*)(P + m * LDP + gatecol + h * 64 + e);
                const float4 og = *(const float4*)(outg + h * 64 + e);
                const float g0 = sigmoidf_(__uint_as_float(gt2.x << 16)), g1 = sigmoidf_(__uint_as_float(gt2.x & 0xffff0000u)),
                            g2 = sigmoidf_(__uint_as_float(gt2.y << 16)), g3 = sigmoidf_(__uint_as_float(gt2.y & 0xffff0000u));
                uint2 w; w.x = pk2bf(o[et][4 * g] * rr * og.x * g0, o[et][4 * g + 1] * rr * og.y * g1); w.y = pk2bf(o[et][4 * g + 2] * rr * og.z * g2, o[et][4 * g + 3] * rr * og.w * g3);
                *(uint2*)(mixed + m * DM + mixcol + h * 64 + e) = w;
            }
    }
}
}

template <int N> struct IntC { static constexpr int value = N; };
struct Params {
    const float* x_in; const float* norm_mix; const float* norm_ffn; const float* w_in; const float* w_out;
    const float* diff_q_gain; const float* diff_k_gain; const float* diff_lambda; const float* diff_sub_gain;
    const float* mlstm_conv; const float* mlstm_gate_bias; const float* mlstm_out_gain; const float* hgrn_lb; const float* hgrn_out_gain;
    const float* nsa_cmp_pos; const float* nsa_cmp_w1; const float* nsa_cmp_w2; const float* nsa_q_gain; const float* nsa_k_gain; const float* nsa_out_gain;
    const float* moe_w_group; const float* moe_b_group; const float* moe_w_expert; const float* moe_b_expert;
    const float* moe_w_gate; const float* moe_w_up; const float* moe_w_down;
    float* out; char* ws;
};


constexpr int LDS_TIDTAB = LDS_BYTES - 512;
__device__ __forceinline__ int hw_wave_slot() { return (int)(__builtin_amdgcn_s_getreg((5 << 11) | 4) & 63u); }
__device__ __forceinline__ int lane_id_fresh() { unsigned ones = ~0u; asm volatile("" : "+s"(ones)); return (int)__builtin_amdgcn_mbcnt_hi(ones, __builtin_amdgcn_mbcnt_lo(ones, 0u)); }
__device__ __forceinline__ int phase_tid(const unsigned char* lds_generic) {
    const __attribute__((address_space(3))) int* tab = (const __attribute__((address_space(3))) int*)((const __attribute__((address_space(3))) unsigned char*)lds_generic + LDS_TIDTAB);
    const int w = __builtin_amdgcn_readfirstlane(tab[hw_wave_slot()]);
    return w * 64 + lane_id_fresh();
}

__device__ __forceinline__ int phase_tid_fwd(const unsigned char* lds_generic) { return phase_tid(lds_generic); }

constexpr size_t al256(size_t x) { return (x + 255) & ~(size_t)255; }
constexpr size_t WS_P = 0;
constexpr size_t WS_TB = WS_P + al256((size_t)MT * LDP * 2);
constexpr size_t WS_MIXED = WS_TB + al256((size_t)MT * DM * 2);
constexpr size_t WS_DQ = WS_MIXED + al256((size_t)MT * DM * 2);
constexpr size_t WS_DK = WS_DQ + al256((size_t)MT * 256 * 4);
constexpr size_t WS_NQ = WS_DK + al256((size_t)MT * 256 * 4);
constexpr size_t WS_KSN = WS_NQ + al256((size_t)MT * 256 * 4);
constexpr size_t WS_KWN = WS_KSN + al256((size_t)MT * 64 * 4);
constexpr size_t WS_CMP = WS_KWN + al256((size_t)MT * 64 * 4);
constexpr size_t WS_OCMP = WS_CMP + al256((size_t)2 * NB * NCMP * 64 * 4);
constexpr size_t WS_IMP = WS_OCMP + al256((size_t)MT * 256 * 4);
constexpr size_t WS_SELMASK = WS_IMP + al256((size_t)MT * 64 * 4);
constexpr size_t WS_RE = WS_SELMASK + al256((size_t)MT * 8);
constexpr size_t WS_RW = WS_RE + al256((size_t)MT * 2 * 4);
constexpr size_t WS_RS = WS_RW + al256((size_t)MT * 2 * 4);
constexpr int MOE_ROWS_MAX = 2 * MT + 32 * 256;
constexpr size_t WS_ROWTOK = WS_RS + al256((size_t)MT * 2 * 4);
constexpr size_t WS_ROWW = WS_ROWTOK + al256((size_t)MOE_ROWS_MAX * 4);
constexpr size_t WS_CNT = WS_ROWW + al256((size_t)MOE_ROWS_MAX * 4);
constexpr size_t WS_CNTBLK = WS_CNT + 256;
constexpr size_t WS_BAR = WS_CNTBLK + 1024 * 32 * 4;
constexpr size_t WS_WIN_T = WS_BAR + 32768;
constexpr size_t WS_WOUT_T = WS_WIN_T + 2 * al256((size_t)LDP * DM * 2);
constexpr size_t WS_W1T = WS_WOUT_T + 2 * al256((size_t)DM * DM * 2);
constexpr size_t WS_DGATE = WS_W1T + 2 * al256((size_t)2 * 64 * 2048 * 2);
constexpr size_t WS_RIMG = WS_DGATE + al256((size_t)MT * 12 * 2);
constexpr size_t RIMG_BYTES = 148608;
constexpr size_t WS_END = WS_RIMG + 2 * al256(RIMG_BYTES);
static_assert((size_t)32 * 512 * DM * 2 + (size_t)32 * DM * 256 * 2 + (size_t)MOE_ROWS_MAX * 256 * 2 <= WS_TB, "MoE weight copies + H overlay P");
constexpr size_t WS_RES = al256((size_t)32 * 512 * DM * 2 + (size_t)32 * DM * 256 * 2 + (size_t)MOE_ROWS_MAX * 256 * 2);
static_assert(WS_RES + (size_t)MT * DM * 2 <= WS_TB, "bf16 residual copy fits in the P tail");
static_assert(WS_MIXED + (size_t)MOE_ROWS_MAX * DM * 2 <= WS_SELMASK, "sorted activations overlay mixed..imp");
#define W_P ((bf16_t*)(pq->ws + WS_P))
#define W_TB ((bf16_t*)(pq->ws + WS_TB))
#define W_RES ((bf16_t*)(pq->ws + WS_RES))
#define W_RSTD ((float*)(pq->ws + WS_TB))
#define W_ROWS ((float*)(pq->ws + WS_TB + (size_t)1048576))
#define W_MIXED ((bf16_t*)(pq->ws + WS_MIXED))
#define W_DQ ((float*)(pq->ws + WS_DQ))
#define W_DK ((float*)(pq->ws + WS_DK))
#define W_QBF ((bf16_t*)(pq->ws + WS_DQ))
#define W_DKF ((bf16_t*)(pq->ws + WS_DK))
#define W_DVF ((bf16_t*)(pq->ws + WS_DK + (size_t)MT * 256 * 2))
#define W_DO ((float*)(pq->ws + WS_TB))
#define W_NQ ((float*)(pq->ws + WS_NQ))
#define W_NQB ((bf16_t*)(pq->ws + WS_NQ))
#define W_KSF ((bf16_t*)(pq->ws + WS_KSN))
#define W_VSF ((bf16_t*)(pq->ws + WS_KSN + (size_t)MT * 64 * 2))
#define W_KWF ((bf16_t*)(pq->ws + WS_KWN))
#define W_VWF ((bf16_t*)(pq->ws + WS_KWN + (size_t)MT * 64 * 2))
#define W_KCF ((bf16_t*)(pq->ws + WS_CMP))
#define W_VCF ((bf16_t*)(pq->ws + WS_CMP + 131072))
#define W_QUEUE ((unsigned*)(pq->ws + WS_BAR + 16384))
#define W_KSN ((float*)(pq->ws + WS_KSN))
#define W_KWN ((float*)(pq->ws + WS_KWN))
#define W_CMP ((float*)(pq->ws + WS_CMP))
#define W_OCMP ((float*)(pq->ws + WS_OCMP))
#define W_IMP ((float*)(pq->ws + WS_IMP))
#define W_OSEL W_DQ
#define W_OWIN W_DK
#define W_SELMASK ((unsigned long long*)(pq->ws + WS_SELMASK))
#define W_RE ((int*)(pq->ws + WS_RE))
#define W_RW ((float*)(pq->ws + WS_RW))
#define W_RS ((int*)(pq->ws + WS_RS))
#define W_ROWTOK ((int*)(pq->ws + WS_ROWTOK))
#define W_ROWW ((float*)(pq->ws + WS_ROWW))
#define W_CNT ((int*)(pq->ws + WS_CNT))
#define W_CNTBLK ((int*)(pq->ws + WS_CNTBLK))
#define W_WGU_T ((bf16_t*)(pq->ws + WS_P))
#define W_WD_T ((bf16_t*)(pq->ws + WS_P + (size_t)32 * 512 * DM * 2))
#define W_HS ((bf16_t*)(pq->ws + WS_P + (size_t)32 * 512 * DM * 2 + (size_t)32 * DM * 256 * 2))
#define W_ASORT ((bf16_t*)(pq->ws + WS_MIXED))
#define W_YMOE ((bf16_t*)(pq->ws + WS_MIXED))

#define SCAN_BUFS(Bm, Bh) scan::BufsT<0> Bm{pq->ws + WS_DQ, pq->ws + WS_TB}; scan::BufsT<1> Bh{pq->ws + WS_DQ, pq->ws + WS_TB};
static_assert(WS_DQ + (size_t)9 * MT * 256 * 2 + (size_t)5 * 1024 * 64 * 4 <= WS_SELMASK, "scan overlay 1");
static_assert((size_t)3 * MT * 256 * 2 + (size_t)5 * 1024 * 64 * 4 <= (size_t)MT * DM * 2, "scan overlay 2");
#define W_WIN_T_L(L) ((bf16_t*)(pq->ws + WS_WIN_T + (size_t)(L) * al256((size_t)LDP * DM * 2)))
#define W_WIN_T W_WIN_T_L(l)
#define W_WOUT_T_L(L) ((bf16_t*)(pq->ws + WS_WOUT_T + (size_t)(L) * al256((size_t)DM * DM * 2)))
#define W_WOUT_T W_WOUT_T_L(l)
#define W_DGATE ((bf16_t*)(pq->ws + WS_DGATE))
#define W_RIMG_L(L) ((bf16_t*)(pq->ws + WS_RIMG + (size_t)(L) * al256(RIMG_BYTES)))
#define W_W1T_L(L) ((bf16_t*)(pq->ws + WS_W1T + (size_t)(L) * al256((size_t)2 * 64 * 2048 * 2)))
#define W_W1T W_W1T_L(l)

__device__ __forceinline__ float4 bf4_to_f4(uint2 u) { return make_float4(__uint_as_float(u.x << 16), __uint_as_float(u.x & 0xffff0000u), __uint_as_float(u.y << 16), __uint_as_float(u.y & 0xffff0000u)); }
typedef float f32x4_nt __attribute__((ext_vector_type(4)));
typedef unsigned u32x2_nt __attribute__((ext_vector_type(2)));
__device__ __forceinline__ float4 ldnt_f4(const float4* p) { const f32x4_nt v = __builtin_nontemporal_load((const f32x4_nt*)p); return make_float4(v.x, v.y, v.z, v.w); }
__device__ __forceinline__ uint2 ldnt_u2(const uint2* p) { const u32x2_nt v = __builtin_nontemporal_load((const u32x2_nt*)p); return make_uint2(v.x, v.y); }
__device__ __forceinline__ void stnt_f4(float4* p, float4 v) { const f32x4_nt w = {v.x, v.y, v.z, v.w}; __builtin_nontemporal_store(w, (f32x4_nt*)p); }
#ifndef NORM_NR
#define NORM_NR 4
#endif
template <int NR>
__device__ __forceinline__ void norm_rows_x(bf16_t* xb, const float* xsrc, float* rstd_out, int row, int rstride, int lane) {
    float4 v[NR][4]; float s[NR];
#pragma unroll
    for (int k = 0; k < NR; ++k) { const float4* xr = (const float4*)(xsrc + (size_t)(row + k * rstride) * DM);
#pragma unroll
        for (int j = 0; j < 4; ++j) v[k][j] = ldnt_f4(xr + lane + 64 * j); }
#pragma unroll
    for (int k = 0; k < NR; ++k) { s[k] = 0.f;
#pragma unroll
        for (int j = 0; j < 4; ++j) { uint2 o; o.x = pk2bf(v[k][j].x, v[k][j].y); o.y = pk2bf(v[k][j].z, v[k][j].w); ((uint2*)(xb + (size_t)(row + k * rstride) * DM))[lane + 64 * j] = o;
            s[k] += v[k][j].x * v[k][j].x + v[k][j].y * v[k][j].y + v[k][j].z * v[k][j].z + v[k][j].w * v[k][j].w; } }
#pragma unroll
    for (int o = 1; o < 64; o <<= 1) {
#pragma unroll
        for (int k = 0; k < NR; ++k) s[k] += __int_as_float(__builtin_amdgcn_ds_bpermute((lane ^ o) << 2, __float_as_int(s[k]))); }
    if (lane == 0) {
#pragma unroll
        for (int k = 0; k < NR; ++k) rstd_out[row + k * rstride] = rsqrtf(s[k] * (1.f / DM) + EPS); }
}
template <int NR>
__device__ __forceinline__ void norm_rows_bf(bf16_t* xout, const bf16_t* xsrc, const bf16_t* ymoe, float* rstd_out, int row, int rstride, int lane) {
    float s[NR];
    {   uint2 xr[NR][4], ya[NR][4], yb[NR][4];
#pragma unroll
        for (int k = 0; k < NR; ++k) { const uint2* x0 = (const uint2*)(xsrc + (size_t)(row + k * rstride) * DM); const uint2* y0 = (const uint2*)(ymoe + (size_t)(row + k * rstride) * 2 * DM);
#pragma unroll
            for (int j = 0; j < 4; ++j) { xr[k][j] = ldnt_u2(x0 + lane + 64 * j); ya[k][j] = ldnt_u2(y0 + lane + 64 * j); yb[k][j] = ldnt_u2(y0 + 256 + lane + 64 * j); } }
#pragma unroll
        for (int k = 0; k < NR; ++k) { s[k] = 0.f;
#pragma unroll
            for (int j = 0; j < 4; ++j) { const float4 x4 = bf4_to_f4(xr[k][j]), a = bf4_to_f4(ya[k][j]), b = bf4_to_f4(yb[k][j]);
                const float vx = x4.x + (a.x + b.x), vy = x4.y + (a.y + b.y), vz = x4.z + (a.z + b.z), vw = x4.w + (a.w + b.w);
                uint2 o; o.x = pk2bf(vx, vy); o.y = pk2bf(vz, vw); ((uint2*)(xout + (size_t)(row + k * rstride) * DM))[lane + 64 * j] = o;
                s[k] += vx * vx + vy * vy + vz * vz + vw * vw; } }
    }
#pragma unroll
    for (int o = 1; o < 64; o <<= 1) {
#pragma unroll
        for (int k = 0; k < NR; ++k) s[k] += __int_as_float(__builtin_amdgcn_ds_bpermute((lane ^ o) << 2, __float_as_int(s[k]))); }
    if (lane == 0) {
#pragma unroll
        for (int k = 0; k < NR; ++k) rstd_out[row + k * rstride] = rsqrtf(s[k] * (1.f / DM) + EPS); }
}


typedef __attribute__((address_space(3))) float lds_f32;
typedef unsigned v4u_t __attribute__((ext_vector_type(4)));
template <bool MAP, bool KSC = false>
__device__ __forceinline__ void transpose_item(const float* W, int K, int Nsrc, int Nnew, bf16_t* WT, lds_f32* scr, int item, int lane, const float* kscale = nullptr) {
    const int nblk = Nnew / 32, kb = item / nblk, nb = item % nblk, k0 = 64 * kb, n0 = 32 * nb;
    const int n = n0 + (lane & 31); const int sc = MAP ? src_col(n) : n; const bool ok = MAP ? (n < IN_COLS) : true;
    float tv[32];
#pragma unroll
    for (int i = 0; i < 32; ++i) { const int kk = 2 * i + (lane >> 5); tv[i] = ok ? __builtin_nontemporal_load(W + (size_t)(k0 + kk) * Nsrc + sc) : 0.f; }
    if constexpr (KSC) {
        float kv[32];
#pragma unroll
        for (int i = 0; i < 32; ++i) kv[i] = kscale[k0 + 2 * i + (lane >> 5)];
#pragma unroll
        for (int i = 0; i < 32; ++i) tv[i] *= kv[i];
    }
#pragma unroll
    for (int i = 0; i < 32; ++i) { const int kk = 2 * i + (lane >> 5); scr[kk * 33 + (lane & 31)] = tv[i]; }
    asm volatile("s_waitcnt lgkmcnt(0)" ::: "memory");
    const int c = lane & 7;
#pragma unroll
    for (int j = 0; j < 4; ++j) { const int nn = (lane >> 3) + 8 * j; const lds_f32* sp = scr + (8 * c) * 33 + nn;
        v4u_t o; o.x = pk2bf(sp[0 * 33], sp[1 * 33]); o.y = pk2bf(sp[2 * 33], sp[3 * 33]); o.z = pk2bf(sp[4 * 33], sp[5 * 33]); o.w = pk2bf(sp[6 * 33], sp[7 * 33]);
        *(v4u_t*)(WT + (size_t)(n0 + nn) * K + k0 + 8 * c) = o; }
    asm volatile("s_waitcnt lgkmcnt(0)" ::: "memory");
}

constexpr float LOG2E = 1.4426950408889634f;
__device__ __forceinline__ void diff_prep_qk(const bf16_t* P, const float* qgain, const float* kgain, bf16_t* Qbf, bf16_t* Kf, int idx) {
    const int m = idx >> 3, g = idx & 7;
    {   const uint4* p = (const uint4*)(P + (size_t)m * LDP + PC_AQ + g * 32); float v[32]; float ss = 0.f;
#pragma unroll
        for (int i = 0; i < 4; ++i) { const uint4 u = p[i]; const unsigned w[4] = {u.x, u.y, u.z, u.w};
#pragma unroll
            for (int j = 0; j < 4; ++j) { v[i * 8 + 2 * j] = __uint_as_float(w[j] << 16); v[i * 8 + 2 * j + 1] = __uint_as_float(w[j] & 0xffff0000u); } }
#pragma unroll
        for (int d = 0; d < 32; ++d) ss += v[d] * v[d];
        const float r = rsqrtf(ss * (1.f / 32) + EPS) * (0.17677669529663687f * LOG2E);
        uint4* o = (uint4*)(Qbf + (size_t)m * 256 + g * 32);
#pragma unroll
        for (int i = 0; i < 4; ++i) { uint4 u; u.x = pk2bf(v[i * 8 + 0] * r * qgain[i * 8 + 0], v[i * 8 + 1] * r * qgain[i * 8 + 1]); u.y = pk2bf(v[i * 8 + 2] * r * qgain[i * 8 + 2], v[i * 8 + 3] * r * qgain[i * 8 + 3]);
            u.z = pk2bf(v[i * 8 + 4] * r * qgain[i * 8 + 4], v[i * 8 + 5] * r * qgain[i * 8 + 5]); u.w = pk2bf(v[i * 8 + 6] * r * qgain[i * 8 + 6], v[i * 8 + 7] * r * qgain[i * 8 + 7]); o[i] = u; } }
    {   const uint4* p = (const uint4*)(P + (size_t)m * LDP + PC_AK + g * 32); float v[32]; float ss = 0.f;
#pragma unroll
        for (int i = 0; i < 4; ++i) { const uint4 u = p[i]; const unsigned w[4] = {u.x, u.y, u.z, u.w};
#pragma unroll
            for (int j = 0; j < 4; ++j) { v[i * 8 + 2 * j] = __uint_as_float(w[j] << 16); v[i * 8 + 2 * j + 1] = __uint_as_float(w[j] & 0xffff0000u); } }
#pragma unroll
        for (int d = 0; d < 32; ++d) ss += v[d] * v[d];
        const float r = rsqrtf(ss * (1.f / 32) + EPS);
        const int b = m / SEQ, t = m % SEQ, tile = t >> 6, kb = (t >> 5) & 1, rr = t & 31;
#pragma unroll
        for (int i = 0; i < 4; ++i) { uint4 u; u.x = pk2bf(v[i * 8 + 0] * r * kgain[i * 8 + 0], v[i * 8 + 1] * r * kgain[i * 8 + 1]); u.y = pk2bf(v[i * 8 + 2] * r * kgain[i * 8 + 2], v[i * 8 + 3] * r * kgain[i * 8 + 3]);
            u.z = pk2bf(v[i * 8 + 4] * r * kgain[i * 8 + 4], v[i * 8 + 5] * r * kgain[i * 8 + 5]); u.w = pk2bf(v[i * 8 + 6] * r * kgain[i * 8 + 6], v[i * 8 + 7] * r * kgain[i * 8 + 7]);
            const int ks = i >> 1, hh = i & 1;
            *(uint4*)(Kf + ((((((size_t)(b * 8 + g) * 64 + tile) * 2 + kb) * 2 + ks) * 32 + rr) * 2 + hh) * 8) = u; } }
}
__device__ __forceinline__ void vfrag_item(const bf16_t* P, int pcol, int hstride, int nheads, bf16_t* Vf, int idx) {
    const int hh = idx & 1, d32 = (idx >> 1) & 31, dblk = (idx >> 6) & 1, sp = (idx >> 7) & 1, kb = (idx >> 8) & 1, tile = (idx >> 9) & 63;
    const int bh = idx >> 15, h = bh % nheads, b = bh / nheads;
    const int key0 = 64 * tile + 32 * kb + 16 * sp + 4 * hh, col = pcol + h * hstride + dblk * 32 + d32;
    unsigned short e[8];
#pragma unroll
    for (int j = 0; j < 8; ++j) e[j] = P[(size_t)(b * SEQ + key0 + 8 * (j >> 2) + (j & 3)) * LDP + col];
    uint4 u; u.x = e[0] | ((unsigned)e[1] << 16); u.y = e[2] | ((unsigned)e[3] << 16); u.z = e[4] | ((unsigned)e[5] << 16); u.w = e[6] | ((unsigned)e[7] << 16);
    *(uint4*)(Vf + (size_t)idx * 8) = u;
}

__device__ __forceinline__ int kcf_off(int n, int d);
__device__ __forceinline__ int vcf_off(int n, int d);
__device__ __forceinline__ void nsa_compress_unit(FA_LAS unsigned char* lds, int tid, const bf16_t* P, const float* pos, const bf16_t* W1T, const float* w2, const float* kgain0, float* cmp, int item) {
    const int lane = tid & 63, wave = tid >> 6, r32 = lane & 31, hi = lane >> 5, j = item >> 5, rt = item & 31;
    const int pc = j == 0 ? PC_KC : PC_VC;
    {   const int R = min(rt * 32 + r32, NB * NCMP - 1), b = R / NCMP, n = R % NCMP;
        fa::f32x16 acc0, acc1;
#pragma unroll
        for (int r = 0; r < 16; ++r) { acc0[r] = 0.f; acc1[r] = 0.f; }
        const bf16_t* arow = P + (size_t)(b * SEQ + 16 * n) * LDP + pc;
#pragma unroll 4
        for (int ksl = 0; ksl < 16; ++ksl) {
            const int kbase = (wave * 16 + ksl) * 16 + 8 * hi, l = kbase >> 6, d = kbase & 63;
            const uint4 raw = *(const uint4*)(arow + (size_t)l * LDP + d);
            const float4 p0 = *(const float4*)(pos + (j * 32 + l) * 64 + d), p1 = *(const float4*)(pos + (j * 32 + l) * 64 + d + 4);
            fa::u32x4 aw;
            aw.x = pk2bf(__uint_as_float(raw.x << 16) + p0.x, __uint_as_float(raw.x & 0xffff0000u) + p0.y); aw.y = pk2bf(__uint_as_float(raw.y << 16) + p0.z, __uint_as_float(raw.y & 0xffff0000u) + p0.w);
            aw.z = pk2bf(__uint_as_float(raw.z << 16) + p1.x, __uint_as_float(raw.z & 0xffff0000u) + p1.y); aw.w = pk2bf(__uint_as_float(raw.w << 16) + p1.z, __uint_as_float(raw.w & 0xffff0000u) + p1.w);
            const fa::bf16x8 af = __builtin_bit_cast(fa::bf16x8, aw);
            const fa::bf16x8 b0 = *(const fa::bf16x8*)(W1T + (size_t)(j * 64 + r32) * 2048 + kbase), b1 = *(const fa::bf16x8*)(W1T + (size_t)(j * 64 + 32 + r32) * 2048 + kbase);
            acc0 = __builtin_amdgcn_mfma_f32_32x32x16_bf16(af, b0, acc0, 0, 0, 0);
            acc1 = __builtin_amdgcn_mfma_f32_32x32x16_bf16(af, b1, acc1, 0, 0, 0);
        }
        FA_LAS float* part = (FA_LAS float*)lds;
#pragma unroll
        for (int r = 0; r < 16; ++r) { const int row = (r & 3) + 8 * (r >> 2) + 4 * hi; part[(wave * 32 + row) * 64 + r32] = acc0[r]; part[(wave * 32 + row) * 64 + 32 + r32] = acc1[r]; }
    }
    __syncthreads();
    const int row = tid >> 4, c4 = (tid & 15) * 4;
    FA_LAS float* hidl = (FA_LAS float*)(lds + 65536);
    {   const FA_LAS float* part = (const FA_LAS float*)lds;
#pragma unroll
        for (int i = 0; i < 4; ++i) { float x = 0.f;
#pragma unroll
            for (int w = 0; w < 8; ++w) x += part[(w * 32 + row) * 64 + c4 + i];
            const float u = 0.7978845608028654f * (x + 0.044715f * x * x * x), th = 1.f - 2.f / (1.f + __expf(2.f * u));
            hidl[row * 64 + c4 + i] = 0.5f * x * (1.f + th); }
    }
    __syncthreads();
    float y[4] = {0.f, 0.f, 0.f, 0.f};
#pragma unroll 1
    for (int k0 = 0; k0 < 64; k0 += 16) {
        float4 wv[16];
#pragma unroll
        for (int u = 0; u < 16; ++u) wv[u] = *(const float4*)(w2 + (j * 64 + k0 + u) * 64 + c4);
#pragma unroll
        for (int u = 0; u < 16; ++u) { const float hv = hidl[row * 64 + k0 + u]; y[0] += hv * wv[u].x; y[1] += hv * wv[u].y; y[2] += hv * wv[u].z; y[3] += hv * wv[u].w; } }
    if (j == 0) { float ss = y[0] * y[0] + y[1] * y[1] + y[2] * y[2] + y[3] * y[3];
#pragma unroll
        for (int o = 1; o < 16; o <<= 1) ss += __int_as_float(__builtin_amdgcn_ds_bpermute((lane ^ o) << 2, __float_as_int(ss)));
        const float r = rsqrtf(ss * (1.f / 64) + EPS);
#pragma unroll
        for (int i = 0; i < 4; ++i) y[i] = y[i] * r * kgain0[c4 + i]; }
    const int R = rt * 32 + row;
    if (R < NB * NCMP) { const int b = R / NCMP, n = R % NCMP;
        bf16_t* dst = (bf16_t*)cmp + (size_t)j * 65536 + (size_t)b * 4 * 4096;
#pragma unroll
        for (int i = 0; i < 4; ++i) { if (j == 0) dst[kcf_off(n, c4 + i)] = f2bf(y[i]); else dst[vcf_off(n, c4 + i)] = f2bf(y[i]);
            if (n == NCMP - 1) { if (j == 0) dst[kcf_off(NCMP, c4 + i)] = 0; else dst[vcf_off(NCMP, c4 + i)] = 0; } } }
    __syncthreads();
}
__device__ __forceinline__ void moe_route_row(const float* x, const float* gain, const FA_LAS float* wl  , const float* bg, const float* be, bf16_t* t, int* re, float* rw, int* rs, FA_LAS int* cnt  ,
                                              int row, int lane) {
    const float4* xr = (const float4*)(x + (size_t)row * DM);
    float4 v[4]; float s = 0.f;
#pragma unroll
    for (int j = 0; j < 4; ++j) { v[j] = xr[lane + 64 * j]; s += v[j].x * v[j].x + v[j].y * v[j].y + v[j].z * v[j].z + v[j].w * v[j].w; }
    const float r = rsqrtf(wave_sum(s, lane) * (1.f / DM) + EPS);
    float lg[36];
#pragma unroll
    for (int o = 0; o < 36; ++o) lg[o] = 0.f;
#pragma unroll
    for (int j = 0; j < 4; ++j) {
        const float4 g = ((const float4*)gain)[lane + 64 * j];
        float tn[4] = {v[j].x * r * g.x, v[j].y * r * g.y, v[j].z * r * g.z, v[j].w * r * g.w};
        ushort4 o4; o4.x = f2bf(tn[0]); o4.y = f2bf(tn[1]); o4.z = f2bf(tn[2]); o4.w = f2bf(tn[3]);
        ((ushort4*)(t + (size_t)row * DM))[lane + 64 * j] = o4;
#pragma unroll
        for (int i = 0; i < 4; ++i) {
            const int k = (lane + 64 * j) * 4 + i;
            typedef float f32x4v __attribute__((ext_vector_type(4)));
            const FA_LAS f32x4v* wr = (const FA_LAS f32x4v*)(wl + (((j * 4 + i) * 64 + lane) * 36)); (void)k;
            const f32x4v w4 = wr[0];
            lg[0] += tn[i] * w4.x; lg[1] += tn[i] * w4.y; lg[2] += tn[i] * w4.z; lg[3] += tn[i] * w4.w;
#pragma unroll
            for (int e4 = 0; e4 < 8; ++e4) { const f32x4v w = wr[1 + e4];
                lg[4 + e4 * 4 + 0] += tn[i] * w.x; lg[4 + e4 * 4 + 1] += tn[i] * w.y; lg[4 + e4 * 4 + 2] += tn[i] * w.z; lg[4 + e4 * 4 + 3] += tn[i] * w.w; }
            asm volatile("" ::: "memory");
        }
    }
#pragma unroll
    for (int o = 0; o < 36; ++o) lg[o] = wave_sum(lg[o], lane);
    float gl[4]; float gmx = NEG; int gs = 0;
#pragma unroll
    for (int g = 0; g < 4; ++g) { gl[g] = lg[g] + bg[g]; if (gl[g] > gmx) { gmx = gl[g]; gs = g; } }
    float gz = 0.f;
#pragma unroll
    for (int g = 0; g < 4; ++g) gz += __expf(gl[g] - gmx);
    const float gprob = 1.f / gz;
    float el[8];
#pragma unroll
    for (int e = 0; e < 8; ++e) {
        const float a0 = lg[4 + e] + be[e], a1 = lg[12 + e] + be[8 + e], a2 = lg[20 + e] + be[16 + e], a3 = lg[28 + e] + be[24 + e];
        el[e] = gs == 0 ? a0 : (gs == 1 ? a1 : (gs == 2 ? a2 : a3));
    }
    float m1 = NEG; int i1 = 0;
#pragma unroll
    for (int e = 0; e < 8; ++e) if (el[e] > m1) { m1 = el[e]; i1 = e; }
    float m2 = NEG; int i2 = 0;
#pragma unroll
    for (int e = 0; e < 8; ++e) if (e != i1 && el[e] > m2) { m2 = el[e]; i2 = e; }
    const float p2 = __expf(m2 - m1);
    const float w1 = gprob / (1.f + p2), w2 = gprob * p2 / (1.f + p2);
    if (lane == 0) { const int e1 = gs * 8 + i1, e2 = gs * 8 + i2;
        re[row * 2] = e1; re[row * 2 + 1] = e2; rw[row * 2] = w1; rw[row * 2 + 1] = w2;
        rs[row * 2] = __hip_atomic_fetch_add(cnt + e1, 1, __ATOMIC_RELAXED, __HIP_MEMORY_SCOPE_WORKGROUP); rs[row * 2 + 1] = __hip_atomic_fetch_add(cnt + e2, 1, __ATOMIC_RELAXED, __HIP_MEMORY_SCOPE_WORKGROUP); }
}


constexpr int RT_RS = 1032;
constexpr int RT_IMG_BYTES = 2 * 36 * RT_RS * 2;
static_assert(RT_IMG_BYTES == (int)RIMG_BYTES, "router image size");
static_assert(RT_IMG_BYTES + 128 + 1024 <= LDS_TIDTAB, "router weight image + counters + sum-of-squares exchange fit below the LDS control words");
__device__ __forceinline__ void moe_route_round(FA_LAS unsigned char* lds, int tid, const bf16_t* x, const float* gain, const float* bg, const float* be, float* rstd_out, int* re, float* rw, int* rs,
                                                int tile, bool valid) {
    const int lane = tid & 63, wave = tid >> 6, r32 = lane & 31, hi = lane >> 5, tsel = wave >> 2, kq = wave & 3;
    const FA_LAS bf16_t* wimg = (const FA_LAS bf16_t*)lds;
    FA_LAS int* cnt = (FA_LAS int*)(lds + RT_IMG_BYTES);
    FA_LAS float* ssx = (FA_LAS float*)(lds + RT_IMG_BYTES + 128);
    const int row = tile * 32 + r32;
    const bf16_t* xr = x + (size_t)(valid ? row : 0) * DM + 256 * kq + 8 * hi;
    float ss = 0.f;
    {   uint4 xa[16];
#pragma unroll
        for (int ks = 0; ks < 16; ++ks) xa[ks] = *(const uint4*)(xr + 16 * ks);
#pragma unroll
        for (int ks = 0; ks < 16; ++ks) { const float4 a = bf4_to_f4(make_uint2(xa[ks].x, xa[ks].y)), b = bf4_to_f4(make_uint2(xa[ks].z, xa[ks].w)); ss += (a.x * a.x + a.y * a.y) + (a.z * a.z + a.w * a.w) + (b.x * b.x + b.y * b.y) + (b.z * b.z + b.w * b.w); } }
    ss += fa::xhalf(ss, lane);
    if (hi == 0) ssx[(tsel * 4 + kq) * 32 + r32] = ss;
    __syncthreads();
    const float rstd = rsqrtf(((ssx[(tsel * 4 + 0) * 32 + r32] + ssx[(tsel * 4 + 1) * 32 + r32]) + (ssx[(tsel * 4 + 2) * 32 + r32] + ssx[(tsel * 4 + 3) * 32 + r32])) * (1.f / DM) + EPS);
    fa::f32x16 acc0, acc1;
#pragma unroll
    for (int r = 0; r < 16; ++r) { acc0[r] = 0.f; acc1[r] = 0.f; }
    const FA_LAS bf16_t* whi0 = wimg + r32 * RT_RS + 256 * kq + 8 * hi; const FA_LAS bf16_t* whi1 = wimg + min(32 + r32, 35) * RT_RS + 256 * kq + 8 * hi;
    const FA_LAS bf16_t* wlo0 = whi0 + 36 * RT_RS; const FA_LAS bf16_t* wlo1 = whi1 + 36 * RT_RS;
    if (valid && kq == 0 && hi == 0) rstd_out[row] = rstd;
    const float* gq = gain + 256 * kq + 8 * hi;
#pragma unroll 4
    for (int ks = 0; ks < 16; ++ks) {
        const uint4 xv = *(const uint4*)(xr + 16 * ks); const float4 a = bf4_to_f4(make_uint2(xv.x, xv.y)), b = bf4_to_f4(make_uint2(xv.z, xv.w));
        const float4 ga = *(const float4*)(gq + 16 * ks), gb = *(const float4*)(gq + 16 * ks + 4);
        const float t[8] = {a.x * rstd * ga.x, a.y * rstd * ga.y, a.z * rstd * ga.z, a.w * rstd * ga.w, b.x * rstd * gb.x, b.y * rstd * gb.y, b.z * rstd * gb.z, b.w * rstd * gb.w};
        fa::u32x4 ph, pl;
        ph.x = fa::cvtpk(t[0], t[1]); ph.y = fa::cvtpk(t[2], t[3]); ph.z = fa::cvtpk(t[4], t[5]); ph.w = fa::cvtpk(t[6], t[7]);
        pl.x = fa::cvtpk(t[0] - __uint_as_float(ph.x << 16), t[1] - __uint_as_float(ph.x & 0xffff0000u)); pl.y = fa::cvtpk(t[2] - __uint_as_float(ph.y << 16), t[3] - __uint_as_float(ph.y & 0xffff0000u));
        pl.z = fa::cvtpk(t[4] - __uint_as_float(ph.z << 16), t[5] - __uint_as_float(ph.z & 0xffff0000u)); pl.w = fa::cvtpk(t[6] - __uint_as_float(ph.w << 16), t[7] - __uint_as_float(ph.w & 0xffff0000u));
        const fa::bf16x8 bh = __builtin_bit_cast(fa::bf16x8, ph), bl = __builtin_bit_cast(fa::bf16x8, pl);
        const fa::bf16x8 ah0 = *(const FA_LAS fa::bf16x8*)(whi0 + 16 * ks), ah1 = *(const FA_LAS fa::bf16x8*)(whi1 + 16 * ks);
        const fa::bf16x8 al0 = *(const FA_LAS fa::bf16x8*)(wlo0 + 16 * ks), al1 = *(const FA_LAS fa::bf16x8*)(wlo1 + 16 * ks);
        acc0 = __builtin_amdgcn_mfma_f32_32x32x16_bf16(ah0, bh, acc0, 0, 0, 0); acc1 = __builtin_amdgcn_mfma_f32_32x32x16_bf16(ah1, bh, acc1, 0, 0, 0);
        acc0 = __builtin_amdgcn_mfma_f32_32x32x16_bf16(al0, bh, acc0, 0, 0, 0); acc1 = __builtin_amdgcn_mfma_f32_32x32x16_bf16(al1, bh, acc1, 0, 0, 0);
        acc0 = __builtin_amdgcn_mfma_f32_32x32x16_bf16(ah0, bl, acc0, 0, 0, 0); acc1 = __builtin_amdgcn_mfma_f32_32x32x16_bf16(ah1, bl, acc1, 0, 0, 0);
    }
    __syncthreads();
    FA_LAS float* xch = (FA_LAS float*)lds;
#pragma unroll
    for (int r = 0; r < 16; ++r) xch[((tsel * 4 + kq) * 20 + r) * 64 + lane] = acc0[r];
#pragma unroll
    for (int r = 0; r < 4; ++r) xch[((tsel * 4 + kq) * 20 + 16 + r) * 64 + lane] = acc1[r];
    __syncthreads();
    if (kq == 0 && valid) {
#pragma unroll
        for (int r = 0; r < 16; ++r) acc0[r] = (xch[((tsel * 4 + 0) * 20 + r) * 64 + lane] + xch[((tsel * 4 + 1) * 20 + r) * 64 + lane]) + (xch[((tsel * 4 + 2) * 20 + r) * 64 + lane] + xch[((tsel * 4 + 3) * 20 + r) * 64 + lane]);
#pragma unroll
        for (int r = 0; r < 4; ++r) acc1[r] = (xch[((tsel * 4 + 0) * 20 + 16 + r) * 64 + lane] + xch[((tsel * 4 + 1) * 20 + 16 + r) * 64 + lane]) + (xch[((tsel * 4 + 2) * 20 + 16 + r) * 64 + lane] + xch[((tsel * 4 + 3) * 20 + 16 + r) * 64 + lane]);
        float L[36];
#pragma unroll
        for (int r = 0; r < 16; ++r) { const float other = fa::xhalf(acc0[r], lane); const int o_mine = (r & 3) + 8 * (r >> 2);
            L[o_mine] = hi ? other : acc0[r]; L[o_mine + 4] = hi ? acc0[r] : other; }
#pragma unroll
        for (int r = 0; r < 4; ++r) { const float other = fa::xhalf(acc1[r], lane); L[32 + r] = hi ? other : acc1[r]; }
        float gl[4]; float gmx = NEG; int gs = 0;
#pragma unroll
        for (int g = 0; g < 4; ++g) { gl[g] = L[g] + bg[g]; if (gl[g] > gmx) { gmx = gl[g]; gs = g; } }
        float gz = 0.f;
#pragma unroll
        for (int g = 0; g < 4; ++g) gz += __expf(gl[g] - gmx);
        const float gprob = 1.f / gz;
        float el[8];
#pragma unroll
        for (int e = 0; e < 8; ++e) {
            const float a0 = L[4 + e] + be[e], a1 = L[12 + e] + be[8 + e], a2 = L[20 + e] + be[16 + e], a3 = L[28 + e] + be[24 + e];
            el[e] = gs == 0 ? a0 : (gs == 1 ? a1 : (gs == 2 ? a2 : a3));
        }
        float m1 = NEG; int i1 = 0;
#pragma unroll
        for (int e = 0; e < 8; ++e) if (el[e] > m1) { m1 = el[e]; i1 = e; }
        float m2 = NEG; int i2 = 0;
#pragma unroll
        for (int e = 0; e < 8; ++e) if (e != i1 && el[e] > m2) { m2 = el[e]; i2 = e; }
        const float p2 = __expf(m2 - m1);
        const float w1 = gprob / (1.f + p2), w2 = gprob * p2 / (1.f + p2);
        if (hi == 0) { const int e1 = gs * 8 + i1, e2 = gs * 8 + i2;
            re[row * 2] = e1; re[row * 2 + 1] = e2; rw[row * 2] = w1; rw[row * 2 + 1] = w2;
            rs[row * 2] = __hip_atomic_fetch_add(cnt + e1, 1, __ATOMIC_RELAXED, __HIP_MEMORY_SCOPE_WORKGROUP); rs[row * 2 + 1] = __hip_atomic_fetch_add(cnt + e2, 1, __ATOMIC_RELAXED, __HIP_MEMORY_SCOPE_WORKGROUP); }
    }
}


__device__ __forceinline__ void moe_tr_item(int it, const float* wgate, const float* wup, const float* wdown, const float* gain, bf16_t* WguT, bf16_t* WdT, lds_f32* scr, int lane) {
    if (it < 32 * 256) { const int e = it >> 8, r = it & 255, kb = r >> 4, nb = r & 15, j = nb >> 3, hf = (nb >> 2) & 1, cb = nb & 3;
        transpose_item<false, true>((hf ? wup : wgate) + (size_t)e * DM * 256 + j * 128 + cb * 32, DM, 256, 32, WguT + ((size_t)e * 512 + nb * 32) * DM, scr, kb, lane, gain); }
    else { const int i2 = it - 32 * 256, e = i2 >> 7, r = i2 & 127;
        transpose_item<false>(wdown + (size_t)e * 256 * DM, 256, DM, DM, WdT + (size_t)e * DM * 256, scr, r, lane); }
}
#define MOE_TR_DRAIN() do { \
    FA_LAS int* qs_ = (FA_LAS int*)(lds + LDS_BYTES - 128); lds_f32* scr_ = (lds_f32*)lds + wave * (64 * 33); \
    const float* wg_ = pq->moe_w_gate + (size_t)l * 32 * DM * 256; const float* wu_ = pq->moe_w_up + (size_t)l * 32 * DM * 256; const float* wd_ = pq->moe_w_down + (size_t)l * 32 * 256 * DM; \
    for (;;) { if (tid == 0) *qs_ = (int)atomicAdd(W_QUEUE + (32 + l) * 16, 1u); __syncthreads(); const int bi_ = *qs_; __syncthreads(); \
        if (bi_ >= (32 * 256 + 32 * 128) / 8) break; moe_tr_item(bi_ * 8 + wave, wg_, wu_, wd_, pq->norm_ffn + l * DM, W_WGU_T, W_WD_T, scr_, lane); } } while (0)

__device__ __forceinline__ void nsa_prep_q(const bf16_t* P, const float* qgain, bf16_t* Qn, int idx) {
    const int m = idx >> 2, h = idx & 3;
    const uint4* p = (const uint4*)(P + (size_t)m * LDP + PC_DQ + h * 64); float v[64]; float ss = 0.f;
#pragma unroll
    for (int i = 0; i < 8; ++i) { const uint4 u = p[i]; const unsigned w[4] = {u.x, u.y, u.z, u.w};
#pragma unroll
        for (int j = 0; j < 4; ++j) { v[i * 8 + 2 * j] = __uint_as_float(w[j] << 16); v[i * 8 + 2 * j + 1] = __uint_as_float(w[j] & 0xffff0000u); } }
#pragma unroll
    for (int d = 0; d < 64; ++d) ss += v[d] * v[d];
    const float r = rsqrtf(ss * (1.f / 64) + EPS) * (0.125f * LOG2E);
    uint4* o = (uint4*)(Qn + (size_t)m * 256 + h * 64);
#pragma unroll
    for (int i = 0; i < 8; ++i) { uint4 u; u.x = pk2bf(v[i * 8 + 0] * r * qgain[i * 8 + 0], v[i * 8 + 1] * r * qgain[i * 8 + 1]); u.y = pk2bf(v[i * 8 + 2] * r * qgain[i * 8 + 2], v[i * 8 + 3] * r * qgain[i * 8 + 3]);
        u.z = pk2bf(v[i * 8 + 4] * r * qgain[i * 8 + 4], v[i * 8 + 5] * r * qgain[i * 8 + 5]); u.w = pk2bf(v[i * 8 + 6] * r * qgain[i * 8 + 6], v[i * 8 + 7] * r * qgain[i * 8 + 7]); o[i] = u; }
}
__device__ __forceinline__ void nsa_prep_k(const bf16_t* P, int pcol, const float* kgain, bf16_t* Kf, int m) {
    const uint4* p = (const uint4*)(P + (size_t)m * LDP + pcol); float v[64]; float ss = 0.f;
#pragma unroll
    for (int i = 0; i < 8; ++i) { const uint4 u = p[i]; const unsigned w[4] = {u.x, u.y, u.z, u.w};
#pragma unroll
        for (int j = 0; j < 4; ++j) { v[i * 8 + 2 * j] = __uint_as_float(w[j] << 16); v[i * 8 + 2 * j + 1] = __uint_as_float(w[j] & 0xffff0000u); } }
#pragma unroll
    for (int d = 0; d < 64; ++d) ss += v[d] * v[d];
    const float r = rsqrtf(ss * (1.f / 64) + EPS);
    const int b = m / SEQ, t = m % SEQ, tile = t >> 6, kb = (t >> 5) & 1, rr = t & 31;
#pragma unroll
    for (int i = 0; i < 8; ++i) { uint4 u; u.x = pk2bf(v[i * 8 + 0] * r * kgain[i * 8 + 0], v[i * 8 + 1] * r * kgain[i * 8 + 1]); u.y = pk2bf(v[i * 8 + 2] * r * kgain[i * 8 + 2], v[i * 8 + 3] * r * kgain[i * 8 + 3]);
        u.z = pk2bf(v[i * 8 + 4] * r * kgain[i * 8 + 4], v[i * 8 + 5] * r * kgain[i * 8 + 5]); u.w = pk2bf(v[i * 8 + 6] * r * kgain[i * 8 + 6], v[i * 8 + 7] * r * kgain[i * 8 + 7]);
        const int ks = i >> 1, hh = i & 1;
        *(uint4*)(Kf + (((((size_t)(b * 64 + tile) * 2 + kb) * 4 + ks) * 32 + rr) * 2 + hh) * 8) = u; }
}
__device__ __forceinline__ int kcf_off(int n, int d) { return ((((((n >> 6) * 2 + ((n >> 5) & 1)) * 4 + (d >> 4)) * 32 + (n & 31)) * 2 + ((d >> 3) & 1)) * 8) + (d & 7); }
__device__ __forceinline__ int vcf_off(int n, int d) { const int s16 = n & 15; return (((((((n >> 6) * 2 + ((n >> 5) & 1)) * 2 + ((n >> 4) & 1)) * 2 + (d >> 5)) * 32 + (d & 31)) * 2 + ((s16 >> 2) & 1)) * 8) + (((s16 >> 3) << 2) | (s16 & 3)); }

__device__ __forceinline__ void nsa_cmp_unit(FA_LAS unsigned char* lds, int tid, const bf16_t* Qn, const bf16_t* Kcf, const bf16_t* Vcf, float* ocmp, unsigned long long* selmask, int b, int qb) {
    const int lane = tid & 63, wave = tid >> 6, r32 = lane & 31, hi = lane >> 5, head = wave >> 1, tl = 32 * (wave & 1) + r32, t = qb * 64 + tl;
    const size_t m = (size_t)b * SEQ + t;
    const float slope2 = exp2f(-(float)(2 * head + 2)) * LOG2E;
    const int ntiles = (4 * qb + 66) >> 6;
    const bf16_t* kb0 = Kcf + (size_t)b * 4 * 4096; const bf16_t* vb0 = Vcf + (size_t)b * 4 * 4096;
    auto tile_of = [=](int i) { fa::Tile T; T.kg = kb0 + (size_t)i * 4096; T.vg = vb0 + (size_t)i * 4096; T.key0 = i * 64; T.kg2 = nullptr; return T; };
    float mfin, lfin;
    {   fa::f32x16 a0, a1; float ilc; fa::attn_unit<4, 3, false>(lds, tid, ntiles, tile_of, Qn + m * 256 + head * 64, t, slope2, 0ull, 0, a0, a1, ilc, mfin, lfin);
        fa::store_o_f32(ocmp + (m * 4 + head) * 64, a0, a1, ilc, hi); }
    FA_LAS float* impH = (FA_LAS float*)lds;
    for (int i = tid; i < 4 * 64 * 64; i += NTHR) impH[i] = 0.f;
    __syncthreads();
    const int nv = t >= 31 ? ((t - 31) >> 4) + 1 : 0;
    const float il = (nv > 0 && lfin > 0.f) ? 1.f / lfin : 0.f;
    fa::bf16x8 qf[4];
#pragma unroll
    for (int ks = 0; ks < 4; ++ks) qf[ks] = *(const fa::bf16x8*)(Qn + m * 256 + head * 64 + 16 * ks + 8 * hi);
    float carry = 0.f;
    fa::bf16x8 kfr[2][4];
#pragma unroll
    for (int kb = 0; kb < 2; ++kb)
#pragma unroll
        for (int ks = 0; ks < 4; ++ks) kfr[kb][ks] = *(const fa::bf16x8*)(kb0 + (((kb * 4 + ks) * 32 + r32) * 2 + hi) * 8);
    for (int ti = 0; ti < ntiles; ++ti) {
        fa::bf16x8 kcur[2][4];
#pragma unroll
        for (int kb = 0; kb < 2; ++kb)
#pragma unroll
            for (int ks = 0; ks < 4; ++ks) kcur[kb][ks] = kfr[kb][ks];
        if (ti + 1 < ntiles) {
#pragma unroll
            for (int kb = 0; kb < 2; ++kb)
#pragma unroll
                for (int ks = 0; ks < 4; ++ks) kfr[kb][ks] = *(const fa::bf16x8*)(kb0 + (size_t)(ti + 1) * 4096 + (((kb * 4 + ks) * 32 + r32) * 2 + hi) * 8); }
#pragma unroll
        for (int kb = 0; kb < 2; ++kb) {
            fa::f32x16 sc;
#pragma unroll
            for (int r = 0; r < 16; ++r) sc[r] = 0.f;
#pragma unroll
            for (int ks = 0; ks < 4; ++ks) sc = __builtin_amdgcn_mfma_f32_32x32x16_bf16(kcur[kb][ks], qf[ks], sc, 0, 0, 0);
#pragma unroll
            for (int g = 0; g < 4; ++g) {
                const int n0 = 64 * ti + 32 * kb + 8 * g + 4 * hi;
                float p[4];
#pragma unroll
                for (int i = 0; i < 4; ++i) { const int n = n0 + i; const float val = sc[4 * g + i] + slope2 * (float)(16 * n + 31 - t);
                    p[i] = n < nv ? __builtin_amdgcn_exp2f(val - mfin) * il : 0.f; }
                const float a1 = (p[0] + p[1]) + (p[2] + 0.5f * p[3]), a2 = 0.5f * p[3];
                const float recv = fa::xhalf(a2, lane);
                const float val = a1 + (hi ? recv : carry);
                if (!hi) carry = recv;
                impH[(head * 64 + tl) * 64 + (n0 >> 2)] = val;
            }
        }
    }
    __syncthreads();
    FA_LAS long long* keys = (FA_LAS long long*)(lds + 65536) + wave * 512;
    long long mykey[8];
#pragma unroll
    for (int tt = 0; tt < 8; ++tt) {
        const int tok = 8 * wave + tt;
        float v = ((impH[(0 * 64 + tok) * 64 + lane] + impH[(1 * 64 + tok) * 64 + lane]) + impH[(2 * 64 + tok) * 64 + lane]) + impH[(3 * 64 + tok) * 64 + lane];
        v = lane <= qb ? v : -1.f;
        if (lane == 0 || lane == qb || lane == qb - 1) v = 2.f;
        mykey[tt] = (long long)(((unsigned long long)(long long)__float_as_int(v) << 6) | (unsigned long long)(63 - lane));
        keys[tt * 64 + lane] = mykey[tt];
    }
#pragma unroll
    for (int tt = 0; tt < 8; ++tt) {
        const int tok = 8 * wave + tt;
        int rank = 0;
#pragma unroll 8
        for (int i = 0; i < 64; i += 2) { const fa::u32x4 kk = *(const FA_LAS fa::u32x4*)(keys + tt * 64 + i);
            const long long k0 = (long long)(((unsigned long long)kk.y << 32) | kk.x), k1 = (long long)(((unsigned long long)kk.w << 32) | kk.z);
            rank += (k0 > mykey[tt] ? 1 : 0) + (k1 > mykey[tt] ? 1 : 0); }
        const unsigned long long msk = __builtin_amdgcn_ballot_w64(rank < 16);
        if (lane == 0) selmask[(size_t)b * SEQ + qb * 64 + tok] = msk;
    }
    __syncthreads();
}
__device__ __forceinline__ void nsa_selwin_unit(FA_LAS unsigned char* lds, int tid, const bf16_t* Qn, const bf16_t* Ksf, const bf16_t* Vsf, const bf16_t* Kwf, const bf16_t* Vwf,
                                                const unsigned long long* selmask, const float* ocmp, const bf16_t* P, const float* outg, bf16_t* mixed, int b, int qb) {
    const int lane = tid & 63, wave = tid >> 6, hi = lane >> 5, head = wave >> 1, tl = 32 * (wave & 1) + (lane & 31), t = qb * 64 + tl;
    const size_t m = (size_t)b * SEQ + t;
    const float slope2 = exp2f(-(float)(2 * head + 2)) * LOG2E;
    float mo, lo, ilx;
    fa::f32x16 acc0, acc1;
    {
        const bf16_t* kb0 = Ksf + (size_t)b * 64 * 4096; const bf16_t* vb0 = Vsf + (size_t)b * 64 * 4096;
        const unsigned long long sel = selmask[m];
        unsigned lo32 = (unsigned)sel, hi32 = (unsigned)(sel >> 32);
#pragma unroll
        for (int o = 1; o < 64; o <<= 1) { lo32 |= (unsigned)__builtin_amdgcn_ds_bpermute((lane ^ o) << 2, (int)lo32); hi32 |= (unsigned)__builtin_amdgcn_ds_bpermute((lane ^ o) << 2, (int)hi32); }
        FA_LAS unsigned* uni = (FA_LAS unsigned*)(lds + 49152);
        FA_LAS unsigned char* tlist = lds + 49152 + 16;
        if (wave < 2 && lane == 0) { uni[wave * 2] = lo32; uni[wave * 2 + 1] = hi32; }
        __syncthreads();
        const unsigned long long U = ((unsigned long long)(uni[1] | uni[3]) << 32) | (unsigned long long)(uni[0] | uni[2]);
        if (tid < 64 && ((U >> tid) & 1ull)) tlist[__builtin_popcountll(U & ((1ull << tid) - 1ull))] = (unsigned char)tid;
        __syncthreads();
        const int ntiles = __builtin_popcountll(U);
        auto tile_of = [=](int i) { const int j = tlist[i]; fa::Tile T; T.kg = kb0 + (size_t)j * 4096; T.vg = vb0 + (size_t)j * 4096; T.key0 = j * 64; T.kg2 = nullptr; return T; };
        fa::attn_unit<4, 1, false>(lds, tid, ntiles, tile_of, Qn + m * 256 + head * 64, t, slope2, sel, 0, acc0, acc1, ilx, mo, lo);
        const float g1 = sigmoidf_(bf2f(P[m * 12 + head * 3 + 1])) * ilx;
#pragma unroll
        for (int r = 0; r < 16; ++r) { acc0[r] *= g1; acc1[r] *= g1; }
    }
    {
        const bf16_t* kb0 = Kwf + (size_t)b * 64 * 4096; const bf16_t* vb0 = Vwf + (size_t)b * 64 * 4096;
        const int first = qb >= 8 ? qb - 8 : 0;
        auto tile_of = [=](int i) { const int j = first + i; fa::Tile T; T.kg = kb0 + (size_t)j * 4096; T.vg = vb0 + (size_t)j * 4096; T.key0 = j * 64; T.kg2 = nullptr; return T; };
        fa::f32x16 w0, w1;
        fa::attn_unit<4, 2, false>(lds, tid, qb - first + 1, tile_of, Qn + m * 256 + head * 64, t, slope2, 0ull, 0, w0, w1, ilx, mo, lo);
        const float g2 = sigmoidf_(bf2f(P[m * 12 + head * 3 + 2])) * ilx;
#pragma unroll
        for (int r = 0; r < 16; ++r) { acc0[r] += g2 * w0[r]; acc1[r] += g2 * w1[r]; }
    }
    {
        const float g0 = sigmoidf_(bf2f(P[m * 12 + head * 3 + 0]));
        const float* oc = ocmp + (m * 4 + head) * 64;
#pragma unroll
        for (int g = 0; g < 4; ++g) { const int d = 8 * g + 4 * hi; const float4 c0 = *(const float4*)(oc + d), c1 = *(const float4*)(oc + 32 + d);
            acc0[4 * g] += g0 * c0.x; acc0[4 * g + 1] += g0 * c0.y; acc0[4 * g + 2] += g0 * c0.z; acc0[4 * g + 3] += g0 * c0.w;
            acc1[4 * g] += g0 * c1.x; acc1[4 * g + 1] += g0 * c1.y; acc1[4 * g + 2] += g0 * c1.z; acc1[4 * g + 3] += g0 * c1.w; }
    }
    fa::store_normed_bf16(mixed + m * DM + 768 + head * 64, acc0, acc1, outg + head * 64, 1.f, lane, hi);
}
__device__ __forceinline__ void diff_unit(FA_LAS unsigned char* lds, int tid, const bf16_t* Qbf, const bf16_t* Kf, const bf16_t* Vf, const float* lamv, const float* subg, float lam_init,
                                          bf16_t* mixed, int b, int h, int qh) {
    const int lane = tid & 63, wave = tid >> 6, hi = lane >> 5, c = wave >> 2;
    const bf16_t* vbase = Vf + (size_t)(b * 4 + h) * 64 * 4096;
    const bf16_t* kbase0 = Kf + (size_t)((b * 4 + h) * 2 + 0) * 64 * 2048; const bf16_t* kbase1 = Kf + (size_t)((b * 4 + h) * 2 + 1) * 64 * 2048;
    const int back = h == 0 ? 4 : (h == 1 ? 15 : 60), first = 2 * qh - back > 0 ? 2 * qh - back : 0;
    const float slope2 = exp2f(-(float)(2 * h + 1)) * LOG2E;
    const int t = qh * 128 + (wave & 3) * 32 + (lane & 31); const size_t m = (size_t)b * SEQ + t;
    fa::f32x16 a0, a1; float ila, mo, lo;
    auto tile_of = [=](int i) { const int j = first + i; fa::Tile T; T.kg = kbase0 + (size_t)j * 2048; T.kg2 = kbase1 + (size_t)j * 2048; T.vg = vbase + (size_t)j * 4096; T.key0 = j * 64; return T; };
    fa::attn_unit<2, 0, true>(lds, tid, 2 * (qh + 1) - first, tile_of, Qbf + m * 256 + h * 64 + c * 32, t, slope2, 0ull, c * 4096, a0, a1, ila, mo, lo);
    FA_LAS float* xch = (FA_LAS float*)lds;
    if (c == 1) {
#pragma unroll
        for (int r = 0; r < 16; ++r) { xch[((wave & 3) * 32 + r) * 64 + lane] = a0[r] * ila; xch[((wave & 3) * 32 + 16 + r) * 64 + lane] = a1[r] * ila; }
    }
    __syncthreads();
    if (c == 0) {
        float d01 = 0.f, d23 = 0.f;
        {   float4 lv[32];
#pragma unroll
            for (int i = 0; i < 32; ++i) lv[i] = ((const float4*)lamv)[i];
#pragma unroll
            for (int i = 0; i < 8; ++i) { d01 += lv[i].x * lv[8 + i].x + lv[i].y * lv[8 + i].y + lv[i].z * lv[8 + i].z + lv[i].w * lv[8 + i].w;
                d23 += lv[16 + i].x * lv[24 + i].x + lv[16 + i].y * lv[24 + i].y + lv[16 + i].z * lv[24 + i].z + lv[16 + i].w * lv[24 + i].w; } }
        const float lam = __expf(d01) - __expf(d23) + lam_init;
#pragma unroll
        for (int r = 0; r < 16; ++r) { a0[r] = a0[r] * ila - lam * xch[(wave * 32 + r) * 64 + lane]; a1[r] = a1[r] * ila - lam * xch[(wave * 32 + 16 + r) * 64 + lane]; }
        fa::store_normed_bf16(mixed + m * DM + h * 64, a0, a1, subg + h * 64, 1.f - lam_init, lane, hi);
    }
    __syncthreads();
}

__device__ __forceinline__ void moe_table(const int* cnt, __attribute__((address_space(3))) int* tab, int tid) {
    if (tid < 64) {
        const int lane = tid; const int c = lane < 32 ? cnt[lane] : 0; const int pc = (c + 255) >> 8;
        int x = pc;
#pragma unroll
        for (int o = 1; o < 32; o <<= 1) { const int y = __builtin_amdgcn_ds_bpermute(((lane - o) & 63) << 2, x); if (lane >= o) x += y; }
        const int ex = x - pc;
        if (lane < 32) { tab[lane] = ex * 256; tab[32 + lane] = c; for (int t = 0; t < pc; ++t) tab[128 + ex + t] = lane; }
        if (lane == 31) tab[64] = x;
    }
    __syncthreads();
}

#define XB_TMO      128
#define XB_XCNT(j)  (256  + 64 * (j))
#define XB_XSUB(j)  (1280 + 64 * (j))
#define XB_XGEN(j)  (2304 + 64 * (j))
#define XB_TOP      3328
#define XB_TOPGEN   3392
#define XCD_BAR_WORDS 3456
#define XB_SPIN_CAP (1u << 18)

__device__ __forceinline__ unsigned xb_ld(unsigned* p)              { return __hip_atomic_load(p, __ATOMIC_RELAXED, __HIP_MEMORY_SCOPE_AGENT); }
__device__ __forceinline__ unsigned xb_add(unsigned* p, unsigned v) { return __hip_atomic_fetch_add(p, v, __ATOMIC_RELAXED, __HIP_MEMORY_SCOPE_AGENT); }
__device__ __forceinline__ unsigned xb_xcc_id() { return (unsigned)__builtin_amdgcn_s_getreg((3 << 11) | 20) & 0xFu; }
#define XB_SPIN(cond, bar) do { unsigned _sp = 0; while (cond) { __builtin_amdgcn_s_sleep(1); \
    if ((++_sp & 255u) == 0u) { if (xb_ld(&(bar)[XB_TMO])) break; if (_sp > XB_SPIN_CAP) { atomicAdd(&(bar)[XB_TMO], 1u); break; } } } } while (0)

struct XcdBarrier {
    unsigned* bar; unsigned x;
    volatile __attribute__((address_space(3))) unsigned* st;
};

__device__ __forceinline__ XcdBarrier xcd_barrier_post(unsigned* bar, volatile __attribute__((address_space(3))) unsigned* st) {
    XcdBarrier b; b.bar = bar; b.x = xb_xcc_id(); b.st = st;
    if (threadIdx.x == 0) (void)xb_add(&bar[XB_XCNT(b.x)], 1u);
    return b;
}
__device__ __forceinline__ void xcd_barrier_complete(unsigned* bar, unsigned x, unsigned& nloc, unsigned& nx) {
    const unsigned G = gridDim.x * gridDim.y * gridDim.z;
    unsigned sum, cnt, mine, sp = 0u;
    for (;;) {
        sum = 0u; cnt = 0u; mine = 0u;
#pragma unroll
        for (unsigned j = 0; j < 16; ++j) { const unsigned c = xb_ld(&bar[XB_XCNT(j)]); sum += c; cnt += (c > 0u) ? 1u : 0u; mine = (j == x) ? c : mine; }
        if (sum == G) break;
        __builtin_amdgcn_s_sleep(1);
        if ((++sp & 255u) == 0u) { if (xb_ld(&bar[XB_TMO])) break; if (sp > XB_SPIN_CAP) { atomicAdd(&bar[XB_TMO], 1u); break; } }
    }
    nloc = mine > 0u ? mine : 1u; nx = cnt > 0u ? cnt : 1u;
}

__device__ __forceinline__ void xcd_barrier(const XcdBarrier& b, const int tid) {
    asm volatile("s_waitcnt vmcnt(0)" ::: "memory");
    __syncthreads();
    if (tid == 0) {
        unsigned* bar = b.bar;
        __builtin_amdgcn_s_waitcnt(0);
        unsigned nloc = b.st[0], nx = b.st[1];
        if (nloc == 0u) { xcd_barrier_complete(bar, b.x, nloc, nx); b.st[0] = nloc; b.st[1] = nx; }
        const unsigned old = xb_add(&bar[XB_XSUB(b.x)], 1u);
        const unsigned gen = old / nloc;
        if (old + 1u == (gen + 1u) * nloc) {
            __builtin_amdgcn_fence(__ATOMIC_RELEASE, "agent");
            asm volatile("s_waitcnt vmcnt(0)" ::: "memory");
            const unsigned og = xb_add(&bar[XB_TOP], 1u);
            const unsigned tg = og / nx;
            if (og + 1u == (tg + 1u) * nx) xb_add(&bar[XB_TOPGEN], 1u);
            else XB_SPIN(xb_ld(&bar[XB_TOPGEN]) == tg, bar);
            __builtin_amdgcn_fence(__ATOMIC_ACQUIRE, "agent");
            xb_add(&bar[XB_XGEN(b.x)], 1u);
            asm volatile("s_waitcnt vmcnt(0)" ::: "memory");
        } else {
            XB_SPIN(xb_ld(&bar[XB_XGEN(b.x)]) == gen, bar);
            __builtin_amdgcn_fence(__ATOMIC_ACQUIRE, "agent");
            asm volatile("s_waitcnt vmcnt(0)" ::: "memory");
        }
    }
    __syncthreads();
}


__global__ void __launch_bounds__(NTHR) mega_fwd(Params p_unused) {
    extern __shared__ __attribute__((aligned(16))) unsigned char lds[];
    cg::grid_group grid = cg::this_grid(); grid.sync();
    volatile __attribute__((address_space(3))) unsigned* bar_st = (volatile __attribute__((address_space(3))) unsigned*)(lds + LDS_BYTES - 64);
    if (threadIdx.x < 2) bar_st[threadIdx.x] = 0u;
    if ((threadIdx.x & 63) == 0) ((__attribute__((address_space(3))) int*)((__attribute__((address_space(3))) unsigned char*)lds + LDS_TIDTAB))[hw_wave_slot()] = threadIdx.x >> 6;
    __syncthreads();
#ifndef USE_XCD_BARRIER
#define USE_XCD_BARRIER 1
#endif
#ifndef PROBE_LO
#define PROBE_LO (-1)
#define PROBE_HI 0
#endif
#define PROBE_MULT 8
#define PROBE_STAMPS ((unsigned long long*)(((const __attribute__((address_space(4))) Params*)__builtin_amdgcn_kernarg_segment_ptr())->ws + WS_BAR + 24576))
#define GRID_BARRIER() do { const int tb_ = phase_tid(lds); xcd_barrier(xbar, tb_); if (PROBE_LO >= 0) { if (blockIdx.x == 0 && tb_ == 0) PROBE_STAMPS[layer * 16 + (__COUNTER__ - BAR_BASE)] = __builtin_amdgcn_s_memrealtime(); } } while (0)
    constexpr int BAR_BASE = __COUNTER__;
    XcdBarrier xbar; (void)xbar;
    {   typedef const __attribute__((address_space(4))) Params* cparams0_t; const cparams0_t p0 = (cparams0_t)__builtin_amdgcn_kernarg_segment_ptr();
        xbar = xcd_barrier_post((unsigned*)(p0->ws + WS_BAR), bar_st); }
    if (PROBE_LO >= 0) { if (blockIdx.x == 0 && threadIdx.x == 0) PROBE_STAMPS[0] = __builtin_amdgcn_s_memrealtime(); }
    typedef const __attribute__((address_space(4))) Params* cparams_t;
    const cparams_t pp = (cparams_t)__builtin_amdgcn_kernarg_segment_ptr();
#define PHASE_VARS \
    const int tid = phase_tid(lds); \
    int bid = blockIdx.x; asm volatile("" : "+s"(bid)); int G = gridDim.x; asm volatile("" : "+s"(G)); int l = layer; asm volatile("" : "+s"(l)); \
    cparams_t pq = pp; asm volatile("" : "+s"(pq)); \
    const float* xcur = l == 0 ? pq->x_in : pq->out; (void)xcur; \
    const int lane = tid & 63, wave = tid >> 6, half = tid >> 8, tid256 = tid & 255; \
    const int gw = bid * NWAVE + wave, NGW = G * NWAVE; \
    const int gt = bid * NTHR + tid, NGT = G * NTHR; \
    float* ldsf = (float*)lds + half * 4096; \
    (void)lane; (void)tid256; (void)gw; (void)NGW; (void)gt; (void)NGT; (void)ldsf;

    auto layer_body = [&](auto LC) __attribute__((always_inline)) {
        constexpr int layer = decltype(LC)::value;
        {   PHASE_VARS
        if (l == 0) {
            lds_f32* scr = (lds_f32*)lds + wave * (64 * 33);
            constexpr int N1 = (DM / 64) * (LDP / 32), N2 = (DM / 64) * (DM / 32), N3 = 128, NL = N1 + N2 + N3;
            for (int i = gt; i < 2 * DM * 36; i += NGT) { const int L = i / (DM * 36), r = i - L * (DM * 36), k = r / 36, o = r - k * 36;
                const float wv = o < 4 ? pq->moe_w_group[(size_t)L * DM * 4 + k * 4 + o] : pq->moe_w_expert[(size_t)L * DM * 32 + k * 32 + o - 4];
                const bf16_t h16 = f2bf(wv); bf16_t* img = W_RIMG_L(L); img[o * RT_RS + k] = h16; img[(36 + o) * RT_RS + k] = f2bf(wv - bf2f(h16)); }
            const int nlay = G >= 2 ? 1 : 2;
            for (int it = gw; it < nlay * NL; it += NGW) { const int L = it / NL, r = it - L * NL;
                if (r < N1) transpose_item<true, true>(pq->w_in + (size_t)L * DM * IN_COLS, DM, IN_COLS, LDP, W_WIN_T_L(L), scr, r, lane, pq->norm_mix + L * DM);
                else if (r < N1 + N2) transpose_item<false>(pq->w_out + (size_t)L * DM * DM, DM, DM, DM, W_WOUT_T_L(L), scr, r - N1, lane);
                else { const int r3 = r - N1 - N2; transpose_item<false>(pq->nsa_cmp_w1 + ((size_t)L * 2 + (r3 >> 6)) * 2048 * 64, 2048, 64, 64, W_W1T_L(L) + (size_t)(r3 >> 6) * 64 * 2048, scr, r3 & 63, lane); } }
        }
        {   int row = gw;
            if constexpr (layer == 0) {
                for (; row + (NORM_NR - 1) * NGW < MT; row += NORM_NR * NGW) norm_rows_x<NORM_NR>((bf16_t*)pq->out, pq->x_in, W_RSTD, row, NGW, lane);
                for (; row < MT; row += NGW) norm_rows_x<1>((bf16_t*)pq->out, pq->x_in, W_RSTD, row, NGW, lane);
            } else {
                for (; row + NGW < MT; row += 2 * NGW) norm_rows_bf<2>((bf16_t*)pq->out, W_RES, W_YMOE, W_RSTD, row, NGW, lane);
                for (; row < MT; row += NGW) norm_rows_bf<1>((bf16_t*)pq->out, W_RES, W_YMOE, W_RSTD, row, NGW, lane); } }
        }
        GRID_BARRIER();
        {   PHASE_VARS
        {   pg8::Gemm g{(const bf16_t*)pq->out, W_WIN_T, MT, LDP, DM}; pg8::StaticOrder S; S.init(MT, LDP, G, bid);
            pg8::EpiBf16<0> E{W_P, LDP, nullptr, 0, 0, 1.f, W_RSTD};
            pg8::gemm_phase<pg8::EpiBf16<0>, pg8::StaticOrder, true, true>((PG8_LAS unsigned char*)lds, g, S, E, tid, lds); }
        if constexpr (layer == 0) {
            if (G >= 2 && bid >= (G >> 1)) {
                lds_f32* scr = (lds_f32*)lds + wave * (64 * 33);
                constexpr int N1 = (DM / 64) * (LDP / 32), N2 = (DM / 64) * (DM / 32), N3 = 128, NL = N1 + N2 + N3;
                for (int r = (bid - (G >> 1)) * NWAVE + wave; r < NL; r += (G - (G >> 1)) * NWAVE) {
                    if (r < N1) transpose_item<true, true>(pq->w_in + (size_t)DM * IN_COLS, DM, IN_COLS, LDP, W_WIN_T_L(1), scr, r, lane, pq->norm_mix + DM);
                    else if (r < N1 + N2) transpose_item<false>(pq->w_out + (size_t)DM * DM, DM, DM, DM, W_WOUT_T_L(1), scr, r - N1, lane);
                    else { const int r3 = r - N1 - N2; transpose_item<false>(pq->nsa_cmp_w1 + ((size_t)2 + (r3 >> 6)) * 2048 * 64, 2048, 64, 64, W_W1T_L(1) + (size_t)(r3 >> 6) * 64 * 2048, scr, r3 & 63, lane); } }
            }
        }
        }
        GRID_BARRIER();
        {   PHASE_VARS
        SCAN_BUFS(Bm, Bh)
        const int half_t = (G >> 1) * NTHR;
        for (int i = gt; i < 4 * 65536; i += NGT) { const int w = i >> 16, j = i & 65535;
            if (w == 0) scan::prep_k<0>(W_P, pq->mlstm_conv + l * 4 * 512, pq->mlstm_gate_bias + l * 8, nullptr, l, Bm, j);
            else if (w == 1) scan::prep_k<1>(W_P, nullptr, nullptr, pq->hgrn_lb, l, Bh, j);
            else if (half_t != 65536) { if (w == 2) scan::prep_v(W_P, PC_BV, Bm.VT(), j); else scan::prep_v(W_P, PC_CI, Bh.VT(), j); } }
        if (half_t == 65536 && gt >= half_t) {
            for (int i = gt - half_t; i < 2 * 65536; i += half_t) { const int j = i & 65535;
                if (i < 65536) scan::prep_v(W_P, PC_BV, Bm.VT(), j); else scan::prep_v(W_P, PC_CI, Bh.VT(), j); } }
        }
        GRID_BARRIER();
        {   PHASE_VARS
        SCAN_BUFS(Bm, Bh)
        for (int it = gw; it < 2048; it += NGW) { if (it < 1024) scan::stepA<0>(Bm, it, lane); else scan::stepA<1>(Bh, it - 1024, lane); }
        }
        GRID_BARRIER();
        {   PHASE_VARS
        SCAN_BUFS(Bm, Bh)
        for (int i = gt; i < 2 * 65536; i += NGT) { if (i < 65536) scan::stepB<0>(Bm, i); else scan::stepB<1>(Bh, i - 65536); }
        }
        GRID_BARRIER();
        {   PHASE_VARS
        SCAN_BUFS(Bm, Bh)
        for (int it = gw; it < 2048; it += NGW) {
            if (it < 1024) scan::stepC<0>(Bm, W_P, PC_BO, pq->mlstm_out_gain + l * 256, W_MIXED, 256, it, lane);
            else scan::stepC<1>(Bh, W_P, PC_CG, pq->hgrn_out_gain + l * 256, W_MIXED, 512, it - 1024, lane); }
        }
        GRID_BARRIER();
        {   PHASE_VARS
        for (int i = gt; i < MT * 8; i += NGT) diff_prep_qk(W_P, pq->diff_q_gain + l * 32, pq->diff_k_gain + l * 32, W_QBF, W_DKF, i);
        const int nskip = G >= 128 ? 64 : 0, gt_v = (bid - nskip) * NTHR + tid, NGT_v = (G - nskip) * NTHR;
        if (bid >= nskip) for (int i = gt_v; i < NB * 4 * 64 * 512; i += NGT_v) vfrag_item(W_P, PC_AV, 64, 4, W_DVF, i);
        const int gt_q = ((bid + G - (G >> 1)) % G) * NTHR + tid, gt_k = ((bid + G - (G >> 2)) % G) * NTHR + tid;
        for (int i = gt_q; i < MT * 4; i += NGT) nsa_prep_q(W_P, pq->nsa_q_gain + l * 64, W_NQB, i);
        for (int i = gt_k; i < 2 * MT; i += NGT) { if (i < MT) nsa_prep_k(W_P, PC_KS, pq->nsa_k_gain + (l * 3 + 1) * 64, W_KSF, i); else nsa_prep_k(W_P, PC_KW, pq->nsa_k_gain + (l * 3 + 2) * 64, W_KWF, i - MT); }
        if (bid >= nskip) for (int i = gt_v; i < 2 * NB * 64 * 512; i += NGT_v) { if (i < NB * 64 * 512) vfrag_item(W_P, PC_VS, 0, 1, W_VSF, i); else vfrag_item(W_P, PC_VW, 0, 1, W_VWF, i - NB * 64 * 512); }
        for (int i = gt_q; i < MT * 12; i += NGT) W_DGATE[i] = W_P[(size_t)(i / 12) * LDP + PC_DG + (i % 12)];
        for (int it = bid; it < 64; it += G)
            nsa_compress_unit((FA_LAS unsigned char*)lds, tid, W_P, pq->nsa_cmp_pos + l * 2 * 32 * 64, W_W1T, pq->nsa_cmp_w2 + l * 2 * 64 * 64, pq->nsa_k_gain + (l * 3 + 0) * 64, W_CMP, it);
        }
        GRID_BARRIER();
        {   PHASE_VARS
        {
            FA_LAS int* qslot = (FA_LAS int*)(lds + LDS_BYTES - 128);
            for (int kq = 0; kq < 8; ++kq) {
                const int q = (bid + kq) & 7;
                for (;;) {
                    if (tid == 0) *qslot = (int)atomicAdd(W_QUEUE + ((l * 2 + 0) * 8 + q) * 16, 1u);
                    __syncthreads();
                    const int it = *qslot;
                    __syncthreads();
                    if (it >= 96) break;
                    const bool is_cmp = it >= 20 && it < 52;
                    if (!is_cmp) {
                        bool lo; int qh;
                        if (it < 20) { lo = false; qh = 31 - it; } else if (it < 56) { lo = false; qh = 11 - (it - 52); } else if (it < 80) { lo = true; qh = 31 - (it - 56); }
                        else if (it < 88) { lo = false; qh = 7 - (it - 80); } else { lo = true; qh = 7 - (it - 88); }
                        const int b = q >> 1, hp = q & 1, h = lo ? hp : 3 - hp;
                        diff_unit((FA_LAS unsigned char*)lds, tid, W_QBF, W_DKF, W_DVF, pq->diff_lambda + l * 128, pq->diff_sub_gain + l * 256, 0.8f - 0.6f * __expf(-0.3f * (float)l), W_MIXED, b, h, qh);
                    } else { const int u = q * 32 + (it - 20); nsa_cmp_unit((FA_LAS unsigned char*)lds, tid, W_NQB, W_KCF, W_VCF, W_OCMP, W_SELMASK, u >> 6, 63 - (u & 63)); }
                }
            }
            __syncthreads();
            MOE_TR_DRAIN();
        }
        }
        GRID_BARRIER();
        {   PHASE_VARS
        {
            FA_LAS int* qslot = (FA_LAS int*)(lds + LDS_BYTES - 128);
            for (int kq = 0; kq < 8; ++kq) {
                const int q = (bid + kq) & 7;
                for (;;) {
                    if (tid == 0) *qslot = (int)atomicAdd(W_QUEUE + ((l * 2 + 1) * 8 + q) * 16, 1u);
                    __syncthreads();
                    const int it = *qslot;
                    __syncthreads();
                    if (it >= 32) break;
                    const int b = q >> 1, qb = 2 * (31 - it) + (q & 1);
                    nsa_selwin_unit((FA_LAS unsigned char*)lds, tid, W_NQB, W_KSF, W_VSF, W_KWF, W_VWF, W_SELMASK, W_OCMP, W_DGATE, pq->nsa_out_gain + l * 256, W_MIXED, b, qb);
                }
            }
            __syncthreads();
            MOE_TR_DRAIN();
        }
        }
        GRID_BARRIER();
        {   PHASE_VARS
        {   pg8::Gemm g{W_MIXED, W_WOUT_T, MT, DM, DM}; pg8::StaticOrder S; S.init(MT, DM, G, bid);
            pg8::EpiResB<true> E{pq->out, W_RES, DM};
            pg8::gemm_phase<pg8::EpiResB<true>, pg8::StaticOrder, true, true>((PG8_LAS unsigned char*)lds, g, S, E, tid, lds); }
        }
        GRID_BARRIER();
        {   PHASE_VARS
        MOE_TR_DRAIN();
        __syncthreads();
        {   FA_LAS bf16_t* wimg = (FA_LAS bf16_t*)lds; const float* wg = pq->moe_w_group + l * DM * 4; const float* we = pq->moe_w_expert + l * DM * 32;
            FA_LAS int* lcnt = (FA_LAS int*)(lds + RT_IMG_BYTES);
            if (tid < 32) lcnt[tid] = 0;
            for (int t0 = bid; t0 < MT / 32; t0 += 2 * G) {
                __syncthreads();
#pragma unroll 1
                for (int i0 = tid; i0 < RT_IMG_BYTES / 16; i0 += 10 * NTHR) {
                    v4u_t wv[10];
#pragma unroll
                    for (int u = 0; u < 10; ++u) { const int i = i0 + u * NTHR; if (i < RT_IMG_BYTES / 16) wv[u] = ((const v4u_t*)W_RIMG_L(l))[i]; }
#pragma unroll
                    for (int u = 0; u < 10; ++u) { const int i = i0 + u * NTHR; if (i < RT_IMG_BYTES / 16) ((__attribute__((address_space(3))) v4u_t*)wimg)[i] = wv[u]; }
                }
                __syncthreads();
                const int tile = t0 + (wave >> 2) * G;
                moe_route_round((FA_LAS unsigned char*)lds, tid, W_RES, pq->norm_ffn + l * DM, pq->moe_b_group + l * 4, pq->moe_b_expert + l * 32, W_RSTD, W_RE, W_RW, W_RS, tile, tile < MT / 32);
            }
            __syncthreads();
            if (tid < 32) W_CNTBLK[bid * 32 + tid] = lcnt[tid];
        }
        }
        GRID_BARRIER();
        {   PHASE_VARS
        __attribute__((address_space(3))) int* tab = (__attribute__((address_space(3))) int*)(lds + 131072);
        {
            __attribute__((address_space(3))) int* part = tab + 512;
            const int e = tid & 31, pg = tid >> 5; int tot = 0, bs = 0;
            for (int b2 = pg; b2 < G; b2 += 16) { const int c = W_CNTBLK[b2 * 32 + e]; tot += c; bs += b2 < bid ? c : 0; }
            part[pg * 32 + e] = tot; part[512 + pg * 32 + e] = bs;
            __syncthreads();
            if (tid < 32) { int t2 = 0, b3 = 0;
#pragma unroll
                for (int i = 0; i < 16; ++i) { t2 += part[i * 32 + tid]; b3 += part[512 + i * 32 + tid]; }
                tab[96 + tid] = b3; part[tid] = t2; if (bid == 0) W_CNT[tid] = t2; }
            __syncthreads();
            if (tid < 64) { const int c = tid < 32 ? part[tid] : 0; const int pc = (c + 255) >> 8; int x = pc;
#pragma unroll
                for (int o = 1; o < 32; o <<= 1) { const int y = __builtin_amdgcn_ds_bpermute(((tid - o) & 63) << 2, x); if (tid >= o) x += y; }
                const int ex = x - pc;
                if (tid < 32) { tab[tid] = ex * 256; tab[32 + tid] = c; } }
            __syncthreads();
        }
        for (int rr = tid; rr < 32 * ((MT / 32 - bid + G - 1) / G); rr += NTHR) { const int row = (bid + (rr >> 5) * G) * 32 + (rr & 31);
            const int2 ee = ((const int2*)W_RE)[row], ss = ((const int2*)W_RS)[row]; const float2 ww = ((const float2*)W_RW)[row];
            const int r0 = tab[ee.x] + tab[96 + ee.x] + ss.x, r1 = tab[ee.y] + tab[96 + ee.y] + ss.y;
            const float sd = W_RSTD[row];
            W_ROWTOK[r0] = row * 2; W_ROWW[r0] = ww.x; W_ROWS[r0] = sd; W_ROWTOK[r1] = row * 2 + 1; W_ROWW[r1] = ww.y; W_ROWS[r1] = sd; }
        if (bid == 0) for (int e = wave; e < 32; e += NWAVE) { const int r0 = tab[e] + tab[32 + e], r1 = tab[e] + ((tab[32 + e] + 255) & ~255);
            for (int r = r0 + lane; r < r1; r += 64) { W_ROWTOK[r] = -1; W_ROWW[r] = 0.f; W_ROWS[r] = 0.f; } }
        }
        GRID_BARRIER();
        {   PHASE_VARS
        __attribute__((address_space(3))) int* tab = (__attribute__((address_space(3))) int*)(lds + 131072);
        moe_table(W_CNT, tab, tid);
        const int nT = tab[64]; const bool split3 = G >= 256 && 2 * nT > G;
        {   pg8::Gemm g{W_RES, W_WGU_T, MOE_ROWS_MAX, 32 * 512, DM, W_ROWTOK}; const int cx = (G & 7) ? bid : (bid & 7) * (G >> 3) + (bid >> 3);
            pg8::EpiSwiglu E{W_HS, W_ROWW, W_ROWS}; const int L1 = split3 ? G : 2 * nT;
            for (int L0r = 0; L0r < L1; L0r += G) { pg8::MoeOrder S{G, cx, nT, 2, tab + 128, L0r, L0r + G < L1 ? L0r + G : L1};
                pg8::gemm_phase<pg8::EpiSwiglu, pg8::MoeOrder, true, true, true>((PG8_LAS unsigned char*)lds, g, S, E, tid, lds); } }
        }
        GRID_BARRIER();
        {   PHASE_VARS
        __attribute__((address_space(3))) int* tab = (__attribute__((address_space(3))) int*)(lds + 131072);
        moe_table(W_CNT, tab, tid);
        const int nT = tab[64]; const bool split3 = G >= 256 && 2 * nT > G; const int n_extra = split3 ? 2 * nT - G : 0, tdone = split3 ? G / 2 : nT;
        const int xq = bid & 7, xr = bid >> 3, neq = n_extra >> 3, ner = n_extra & 7, ne_x = neq + (xq < ner ? 1 : 0), ne_pre = xq * neq + (xq < ner ? xq : ner);
        const bool sw = (G & 7) == 0, is_extra = sw ? xr < ne_x : bid < n_extra;
        const int cu_ = sw ? ne_pre + xr : bid, cd_ = sw ? xq * (G >> 3) - ne_pre + xr - ne_x : bid - n_extra;
        if (is_extra) {
            pg8::Gemm g{W_RES, W_WGU_T, MOE_ROWS_MAX, 32 * 512, DM, W_ROWTOK};
            pg8::EpiSwiglu E{W_HS, W_ROWW, W_ROWS};
            for (int L0r = G; L0r < 2 * nT; L0r += G) { pg8::MoeOrder S{G, cu_, nT, 2, tab + 128, L0r, L0r + G < 2 * nT ? L0r + G : 2 * nT};
                pg8::gemm_phase<pg8::EpiSwiglu, pg8::MoeOrder, true, true, true>((PG8_LAS unsigned char*)lds, g, S, E, tid, lds); }
        } else {
            pg8::Gemm g{W_HS, W_WD_T, MOE_ROWS_MAX, 32 * DM, 256}; pg8::MoeOrder S{G - n_extra, cd_, nT, 4, tab + 128, 0, 4 * tdone};
            pg8::EpiScatterStore E{W_YMOE, W_ROWTOK};
            pg8::gemm_phase<pg8::EpiScatterStore, pg8::MoeOrder, true, true>((PG8_LAS unsigned char*)lds, g, S, E, tid, lds);
        }
        }
        GRID_BARRIER();
        {   PHASE_VARS
        __attribute__((address_space(3))) int* tab = (__attribute__((address_space(3))) int*)(lds + 131072);
        moe_table(W_CNT, tab, tid);
        const int nT = tab[64]; const bool split3 = G >= 256 && 2 * nT > G; const int tdone = split3 ? G / 2 : nT;
        {   pg8::Gemm g{W_HS, W_WD_T, MOE_ROWS_MAX, 32 * DM, 256}; const int nrem = 4 * (nT - tdone), chk = (nrem + 7) >> 3;
            const int cx = (G & 7) ? bid : nrem <= G ? ((bid >> 3) < chk ? (bid & 7) * chk + (bid >> 3) : -1) : (bid & 7) * (G >> 3) + (bid >> 3);
            pg8::MoeOrder S{G, cx, nT, 4, tab + 128, 4 * tdone, 4 * nT};
            pg8::EpiScatterStore E{W_YMOE, W_ROWTOK};
            pg8::gemm_phase<pg8::EpiScatterStore, pg8::MoeOrder, true, true>((PG8_LAS unsigned char*)lds, g, S, E, tid, lds); }
        }
        GRID_BARRIER();
    };
    layer_body(IntC<0>{});
    layer_body(IntC<1>{});
    {   const int layer = DEPTH; PHASE_VARS
        for (int i0 = gt; i0 < MT * DM / 4; i0 += 4 * NGT) {
            float4 v[4]; uint2 ya[4], yb[4];
#pragma unroll
            for (int u = 0; u < 4; ++u) { const int i = i0 + u * NGT; if (i < MT * DM / 4) { const int row = i >> 8, c4 = i & 255;
                v[u] = bf4_to_f4(ldnt_u2((const uint2*)W_RES + i)); ya[u] = ldnt_u2((const uint2*)(W_YMOE + (size_t)row * 2 * DM) + c4); yb[u] = ldnt_u2((const uint2*)(W_YMOE + ((size_t)row * 2 + 1) * DM) + c4); } }
#pragma unroll
            for (int u = 0; u < 4; ++u) { const int i = i0 + u * NGT; if (i < MT * DM / 4) { const float4 a = bf4_to_f4(ya[u]), b = bf4_to_f4(yb[u]);
                v[u].x += a.x + b.x; v[u].y += a.y + b.y; v[u].z += a.z + b.z; v[u].w += a.w + b.w; stnt_f4((float4*)pq->out + i, v[u]); } }
        }
    }
    if (PROBE_LO >= 0) {
        const int tb_ = phase_tid(lds); xcd_barrier(xbar, tb_);
        if (tb_ == 0) { const unsigned long long d = (__hip_atomic_load(PROBE_STAMPS + PROBE_HI, __ATOMIC_RELAXED, __HIP_MEMORY_SCOPE_AGENT) - __hip_atomic_load(PROBE_STAMPS + PROBE_LO, __ATOMIC_RELAXED, __HIP_MEMORY_SCOPE_AGENT))
                + (__hip_atomic_load(PROBE_STAMPS + 16 + PROBE_HI, __ATOMIC_RELAXED, __HIP_MEMORY_SCOPE_AGENT) - __hip_atomic_load(PROBE_STAMPS + 16 + PROBE_LO, __ATOMIC_RELAXED, __HIP_MEMORY_SCOPE_AGENT));
            const unsigned long long t0 = __builtin_amdgcn_s_memrealtime(); while (__builtin_amdgcn_s_memrealtime() - t0 < PROBE_MULT * d) __builtin_amdgcn_s_sleep(32); }
        __syncthreads();
    }
}
}

extern "C" void kernel_launch(void* const* d_in, const int* in_sizes, int n_in, void* d_out, int out_size, void* d_ws, size_t ws_size, hipStream_t stream) {
    Params p{};
    p.x_in = (const float*)d_in[0]; p.norm_mix = (const float*)d_in[1]; p.norm_ffn = (const float*)d_in[2]; p.w_in = (const float*)d_in[3]; p.w_out = (const float*)d_in[4];
    p.diff_q_gain = (const float*)d_in[5]; p.diff_k_gain = (const float*)d_in[6]; p.diff_lambda = (const float*)d_in[7]; p.diff_sub_gain = (const float*)d_in[8];
    p.mlstm_conv = (const float*)d_in[9]; p.mlstm_gate_bias = (const float*)d_in[10]; p.mlstm_out_gain = (const float*)d_in[11]; p.hgrn_lb = (const float*)d_in[12];
    p.hgrn_out_gain = (const float*)d_in[13]; p.nsa_cmp_pos = (const float*)d_in[14]; p.nsa_cmp_w1 = (const float*)d_in[15]; p.nsa_cmp_w2 = (const float*)d_in[16];
    p.nsa_q_gain = (const float*)d_in[17]; p.nsa_k_gain = (const float*)d_in[18]; p.nsa_out_gain = (const float*)d_in[19];
    p.moe_w_group = (const float*)d_in[20]; p.moe_b_group = (const float*)d_in[21]; p.moe_w_expert = (const float*)d_in[22]; p.moe_b_expert = (const float*)d_in[23];
    p.moe_w_gate = (const float*)d_in[24]; p.moe_w_up = (const float*)d_in[25]; p.moe_w_down = (const float*)d_in[26];
    p.out = (float*)d_out;

    p.ws = (char*)d_ws;
    if (WS_END > ws_size) { fprintf(stderr, "kernel_launch: workspace too small: need %zu, have %zu\n", (size_t)WS_END, ws_size); return; }

    static int grid_blocks = 0;
    if (!grid_blocks) {
        int dev = 0, cus = 0, per_cu = 0;
        hipGetDevice(&dev);
        hipDeviceGetAttribute(&cus, hipDeviceAttributeMultiprocessorCount, dev);
        hipFuncSetAttribute((const void*)mega_fwd, hipFuncAttributeMaxDynamicSharedMemorySize, LDS_BYTES);
        hipOccupancyMaxActiveBlocksPerMultiprocessor(&per_cu, (const void*)mega_fwd, NTHR, LDS_BYTES);
        if (per_cu < 1) per_cu = 1;
        if (per_cu > 1) per_cu = 1;
        grid_blocks = cus * per_cu;
    }
    hipMemsetAsync((char*)d_ws + WS_BAR, 0, 32768, stream);
    void* args[] = {&p};
    hipError_t e = hipLaunchCooperativeKernel((const void*)mega_fwd, dim3(grid_blocks), dim3(NTHR), args, LDS_BYTES, stream);
    if (e != hipSuccess) fprintf(stderr, "cooperative launch failed: %s (grid %d)\n", hipGetErrorString(e), grid_blocks);
}
```
